# Optimizing an MI355X kernel written in HIP

```python
import math
import jax, jax.numpy as jnp
from jax import lax
import numpy as np

D_MODEL = 2048
BATCH = 4
SEQ = 2048
DEPTH = 4

N_MEM = 256
N_MIXERS = 3
EPS = 1e-6
D_FF = ((8 * D_MODEL // 3 + 127) // 128) * 128

HG_HEAD = 128
HG_HEADS = D_MODEL // HG_HEAD
HG_WIDTH = HG_HEADS * HG_HEAD
HG_CHUNK = 64
F_FLOOR = 1e-12

LRU_WIDTH = D_MODEL
LRU_BLOCKS = 8
LRU_BLOCK = LRU_WIDTH // LRU_BLOCKS
CONV_W = 4
LRU_C = 8.0

ML_HEADS = 8
ML_DQK = D_MODEL // (2 * ML_HEADS)
ML_DV = D_MODEL // ML_HEADS
ML_HQK = ML_HEADS * ML_DQK
ML_HV = ML_HEADS * ML_DV
ML_IN = 2 * ML_HQK + 2 * ML_HV + 2 * ML_HEADS
ML_SPLITS = (ML_HQK, 2 * ML_HQK, 2 * ML_HQK + ML_HV, 2 * ML_HQK + 2 * ML_HV, 2 * ML_HQK + 2 * ML_HV + ML_HEADS)
ML_CHUNK = 64
GATE_CAP = 15.0
NEG_BIG = -1e30

XA_HEADS = 4
XA_HEAD = D_MODEL // XA_HEADS

N_A = (DEPTH + N_MIXERS - 1) // N_MIXERS
N_B = (DEPTH + N_MIXERS - 2) // N_MIXERS
N_C = DEPTH // N_MIXERS

kernel_name = "hybrid_hgrn2_rglru_mlstm_macaron"


def rmsnorm(x, g):
    xf = x.astype(jnp.float32)
    y = xf * lax.rsqrt(jnp.mean(xf * xf, axis=-1, keepdims=True) + EPS)
    return (y * g.astype(jnp.float32)).astype(x.dtype)


def head_rmsnorm(h, g):
    hf = h.astype(jnp.float32)
    return hf * lax.rsqrt(jnp.mean(hf * hf, axis=-1, keepdims=True) + EPS) * g.astype(jnp.float32)


def swiglu(x, w_gu, w_down):
    gate, up = jnp.split(x @ w_gu, 2, axis=-1)
    return (jax.nn.silu(gate) * up) @ w_down


def _chunk(t, n_chunks, heads, d):
    b = t.shape[0]
    return t.reshape(b, n_chunks, -1, heads, d).transpose(1, 0, 3, 2, 4)


def _chunk_gate(t, n_chunks, heads):
    b = t.shape[0]
    return t.reshape(b, n_chunks, -1, heads).transpose(1, 0, 3, 2)


def _unchunk(t):
    n, b, h, c, d = t.shape
    return t.transpose(1, 0, 3, 2, 4).reshape(b, n * c, h, d)


def hgrn2_mixer(x, w_in, g_norm, w_out, lb):
    bsz, seq, _ = x.shape
    n = seq // HG_CHUNK
    proj = (x @ w_in).astype(jnp.float32)
    q, f_pre, v, g = jnp.split(proj, 4, axis=-1)
    q = jax.nn.silu(q)
    f = lb + (1.0 - lb) * jax.nn.sigmoid(f_pre)
    log_f = jnp.log(jnp.maximum(f, F_FLOOR))
    k = (1.0 - lb) * jax.nn.sigmoid(-f_pre)
    qc, kc, vc, lfc = (_chunk(t, n, HG_HEADS, HG_HEAD) for t in (q, k, v, log_f))
    causal = jnp.tril(jnp.ones((HG_CHUNK, HG_CHUNK), dtype=bool))[:, :, None]

    def step(state, inp):
        q_c, k_c, v_c, lf_c = inp
        b = jnp.cumsum(lf_c, axis=2)
        diff = b[:, :, :, None, :] - b[:, :, None, :, :]
        decay = jnp.where(causal, jnp.exp(jnp.where(causal, diff, 0.0)), 0.0)
        scores = jnp.einsum('bhtd,bhsd,bhtsd->bhts', q_c, k_c, decay)
        o = (jnp.einsum('bhts,bhsv->bhtv', scores, v_c)
             + jnp.einsum('bhtd,bhdv->bhtv', q_c * jnp.exp(b), state))
        b_last = b[:, :, -1:, :]
        new_state = (jnp.exp(b_last[:, :, 0, :])[..., None] * state
                     + jnp.einsum('bhsd,bhsv->bhdv', k_c * jnp.exp(b_last - b), v_c))
        return new_state, o

    s0 = jnp.zeros((bsz, HG_HEADS, HG_HEAD, HG_HEAD), jnp.float32)
    _, o = lax.scan(step, s0, (qc, kc, vc, lfc))
    o = head_rmsnorm(_unchunk(o), g_norm).reshape(bsz, seq, HG_WIDTH) * jax.nn.silu(g)
    return o.astype(x.dtype) @ w_out


def _lin_combine(left, right):
    a_l, b_l = left
    a_r, b_r = right
    return a_l * a_r, a_r * b_l + b_r


def rglru_mixer(x, w_in, conv_w, conv_b, w_a, b_a, w_x, b_x, lam, w_out):
    bsz, seq, _ = x.shape
    gate_branch, u = jnp.split(x @ w_in, 2, axis=-1)
    u = lax.conv_general_dilated(u, conv_w[:, None, :], window_strides=(1,),
                                 padding=[(CONV_W - 1, 0)],
                                 dimension_numbers=('NWC', 'WIO', 'NWC'),
                                 feature_group_count=LRU_WIDTH) + conv_b
    u = u.astype(jnp.float32)
    ub = u.reshape(bsz, seq, LRU_BLOCKS, LRU_BLOCK)
    r = jax.nn.sigmoid(jnp.einsum('bsnc,ncd->bsnd', ub, w_a.astype(jnp.float32)).reshape(bsz, seq, LRU_WIDTH)
                       + b_a.astype(jnp.float32))
    i = jax.nn.sigmoid(jnp.einsum('bsnc,ncd->bsnd', ub, w_x.astype(jnp.float32)).reshape(bsz, seq, LRU_WIDTH)
                       + b_x.astype(jnp.float32))
    log_a = -LRU_C * r * jax.nn.softplus(-lam.astype(jnp.float32))
    a = jnp.exp(log_a)
    inp = jnp.sqrt(jnp.maximum(-jnp.expm1(2.0 * log_a), 0.0)) * (i * u)
    _, h = lax.associative_scan(_lin_combine, (a, inp), axis=1)
    y = jax.nn.gelu(gate_branch.astype(jnp.float32)) * h
    return y.astype(x.dtype) @ w_out


def _softcap(t):
    return GATE_CAP * jnp.tanh(t / GATE_CAP)


def mlstm_mixer(x, w_in, b_if, g_norm, w_out):
    bsz, seq, _ = x.shape
    n = seq // ML_CHUNK
    proj = (x @ w_in).astype(jnp.float32)
    q, k, v, o, ig, fg = jnp.split(proj, ML_SPLITS, axis=-1)
    b_if = b_if.astype(jnp.float32)
    ig = _softcap(ig + b_if[0])
    log_f = jax.nn.log_sigmoid(_softcap(fg + b_if[1]))
    k = k * (ML_DQK ** -0.5)
    qc = _chunk(q, n, ML_HEADS, ML_DQK)
    kc = _chunk(k, n, ML_HEADS, ML_DQK)
    vc = _chunk(v, n, ML_HEADS, ML_DV)
    igc = _chunk_gate(ig, n, ML_HEADS)
    lfc = _chunk_gate(log_f, n, ML_HEADS)
    causal = jnp.tril(jnp.ones((ML_CHUNK, ML_CHUNK), dtype=bool))

    def step(carry, inp):
        c_st, n_st, m_st = carry
        q_c, k_c, v_c, i_c, lf_c = inp
        b = jnp.cumsum(lf_c, axis=-1)
        d_mat = jnp.where(causal, b[..., :, None] - b[..., None, :] + i_c[..., None, :], NEG_BIG)
        inter = b + m_st[..., None]
        m_t = jnp.maximum(inter, jnp.max(d_mat, axis=-1))
        w_intra = jnp.where(causal, jnp.exp(jnp.minimum(d_mat - m_t[..., None], 0.0)), 0.0)
        w_inter = jnp.exp(inter - m_t)
        qk = jnp.einsum('bhtd,bhsd->bhts', q_c, k_c) * w_intra
        num = (jnp.einsum('bhts,bhsv->bhtv', qk, v_c)
               + w_inter[..., None] * jnp.einsum('bhtd,bhdv->bhtv', q_c, c_st))
        den = jnp.sum(qk, axis=-1) + w_inter * jnp.einsum('bhtd,bhd->bht', q_c, n_st)
        h = num / jnp.maximum(jnp.abs(den), jnp.exp(-m_t))[..., None]
        g = b[..., -1]
        upd = g[..., None] - b + i_c
        m_new = jnp.maximum(g + m_st, jnp.max(upd, axis=-1))
        w_upd = jnp.exp(upd - m_new[..., None])
        decay = jnp.exp(g + m_st - m_new)
        c_new = decay[..., None, None] * c_st + jnp.einsum('bhs,bhsd,bhsv->bhdv', w_upd, k_c, v_c)
        n_new = decay[..., None] * n_st + jnp.einsum('bhs,bhsd->bhd', w_upd, k_c)
        return (c_new, n_new, m_new), h

    carry0 = (jnp.zeros((bsz, ML_HEADS, ML_DQK, ML_DV), jnp.float32),
              jnp.zeros((bsz, ML_HEADS, ML_DQK), jnp.float32),
              jnp.zeros((bsz, ML_HEADS), jnp.float32))
    _, h = lax.scan(step, carry0, (qc, kc, vc, igc, lfc))
    h = head_rmsnorm(_unchunk(h), g_norm).reshape(bsz, seq, ML_HV) * jax.nn.sigmoid(o)
    return h.astype(x.dtype) @ w_out


def mem_cross_attention(x, mem_n, w_q, w_kv, w_o):
    bsz, seq, _ = x.shape
    q = (x @ w_q).reshape(bsz, seq, XA_HEADS, XA_HEAD)
    k, v = jnp.split(mem_n @ w_kv, 2, axis=-1)
    k = k.reshape(bsz, -1, XA_HEADS, XA_HEAD)
    v = v.reshape(bsz, -1, XA_HEADS, XA_HEAD)
    s = jnp.einsum('bshd,bmhd->bhsm', q, k).astype(jnp.float32) * (XA_HEAD ** -0.5)
    p = jax.nn.softmax(s, axis=-1).astype(v.dtype)
    o = jnp.einsum('bhsm,bmhd->bshd', p, v).reshape(bsz, seq, D_MODEL)
    return o @ w_o


def setup_inputs(seed: int = 0) -> dict:
    key = jax.random.key(seed)
    ks = iter(jax.random.split(key, 40))

    def nrm(shape, scale):
        return jax.random.normal(next(ks), shape, jnp.float32) * scale

    x = nrm((BATCH, SEQ, D_MODEL), 1.0)
    mem = nrm((BATCH, N_MEM, D_MODEL), 1.0)
    mem_norm_g = 1.0 + nrm((D_MODEL,), 0.02)
    norm_g = 1.0 + nrm((DEPTH, 4, D_MODEL), 0.02)
    final_norm_g = 1.0 + nrm((D_MODEL,), 0.02)
    ffn_w_gu = nrm((DEPTH, 2, D_MODEL, 2 * D_FF), D_MODEL ** -0.5)
    ffn_w_down = nrm((DEPTH, 2, D_FF, D_MODEL), D_FF ** -0.5)
    xa_w_q = nrm((DEPTH, D_MODEL, D_MODEL), D_MODEL ** -0.5)
    xa_w_kv = nrm((DEPTH, D_MODEL, 2 * D_MODEL), D_MODEL ** -0.5)
    xa_w_o = nrm((DEPTH, D_MODEL, D_MODEL), D_MODEL ** -0.5)
    hg_lb_param = nrm((DEPTH, HG_WIDTH), 0.1)
    hg_w_in = nrm((N_A, D_MODEL, 4 * HG_WIDTH), D_MODEL ** -0.5)
    hg_g_norm = 1.0 + nrm((N_A, HG_HEAD), 0.02)
    hg_w_out = nrm((N_A, HG_WIDTH, D_MODEL), HG_WIDTH ** -0.5)
    lru_w_in = nrm((N_B, D_MODEL, 2 * LRU_WIDTH), D_MODEL ** -0.5)
    lru_conv_w = nrm((N_B, CONV_W, LRU_WIDTH), CONV_W ** -0.5)
    lru_conv_b = nrm((N_B, LRU_WIDTH), 0.01)
    lru_w_a = nrm((N_B, LRU_BLOCKS, LRU_BLOCK, LRU_BLOCK), LRU_BLOCK ** -0.5)
    lru_b_a = nrm((N_B, LRU_WIDTH), 0.01)
    lru_w_x = nrm((N_B, LRU_BLOCKS, LRU_BLOCK, LRU_BLOCK), LRU_BLOCK ** -0.5)
    lru_b_x = nrm((N_B, LRU_WIDTH), 0.01)
    a0 = jax.random.uniform(next(ks), (N_B, LRU_WIDTH), jnp.float32, minval=0.9, maxval=0.999)
    lru_lambda = jnp.log(a0) - jnp.log1p(-a0)
    lru_w_out = nrm((N_B, LRU_WIDTH, D_MODEL), LRU_WIDTH ** -0.5)
    ml_w_in = nrm((N_C, D_MODEL, ML_IN), D_MODEL ** -0.5)
    ig_bias = nrm((N_C, ML_HEADS), 0.1)
    fg_bias = jnp.linspace(3.0, 6.0, ML_HEADS, dtype=jnp.float32)[None, :] + nrm((N_C, ML_HEADS), 0.1)
    ml_b_if = jnp.stack([ig_bias, fg_bias], axis=1)
    ml_g_norm = 1.0 + nrm((N_C, ML_DV), 0.02)
    ml_w_out = nrm((N_C, ML_HV, D_MODEL), ML_HV ** -0.5)
    return {
        "x": x, "mem": mem, "mem_norm_g": mem_norm_g, "norm_g": norm_g, "final_norm_g": final_norm_g,
        "ffn_w_gu": ffn_w_gu, "ffn_w_down": ffn_w_down,
        "xa_w_q": xa_w_q, "xa_w_kv": xa_w_kv, "xa_w_o": xa_w_o,
        "hg_lb_param": hg_lb_param, "hg_w_in": hg_w_in, "hg_g_norm": hg_g_norm, "hg_w_out": hg_w_out,
        "lru_w_in": lru_w_in, "lru_conv_w": lru_conv_w, "lru_conv_b": lru_conv_b,
        "lru_w_a": lru_w_a, "lru_b_a": lru_b_a, "lru_w_x": lru_w_x, "lru_b_x": lru_b_x,
        "lru_lambda": lru_lambda, "lru_w_out": lru_w_out,
        "ml_w_in": ml_w_in, "ml_b_if": ml_b_if, "ml_g_norm": ml_g_norm, "ml_w_out": ml_w_out,
    }


def reference(x, mem, mem_norm_g, norm_g, final_norm_g, ffn_w_gu, ffn_w_down,
              xa_w_q, xa_w_kv, xa_w_o,
              hg_lb_param, hg_w_in, hg_g_norm, hg_w_out,
              lru_w_in, lru_conv_w, lru_conv_b, lru_w_a, lru_b_a, lru_w_x, lru_b_x, lru_lambda, lru_w_out,
              ml_w_in, ml_b_if, ml_g_norm, ml_w_out):
    mem_n = rmsnorm(mem, mem_norm_g)
    lb_p = jax.nn.softmax(hg_lb_param.astype(jnp.float32), axis=0)
    lb_all = jnp.cumsum(lb_p, axis=0) - lb_p[0]

    for layer in range(DEPTH):
        kind = layer % N_MIXERS
        idx = layer // N_MIXERS
        x = x + 0.5 * swiglu(rmsnorm(x, norm_g[layer, 0]), ffn_w_gu[layer, 0], ffn_w_down[layer, 0])
        h = rmsnorm(x, norm_g[layer, 1])
        if kind == 0:
            h = hgrn2_mixer(h, hg_w_in[idx], hg_g_norm[idx], hg_w_out[idx], lb_all[layer])
        elif kind == 1:
            h = rglru_mixer(h, lru_w_in[idx], lru_conv_w[idx], lru_conv_b[idx], lru_w_a[idx], lru_b_a[idx],
                            lru_w_x[idx], lru_b_x[idx], lru_lambda[idx], lru_w_out[idx])
        else:
            h = mlstm_mixer(h, ml_w_in[idx], ml_b_if[idx], ml_g_norm[idx], ml_w_out[idx])
        x = x + h
        x = x + mem_cross_attention(rmsnorm(x, norm_g[layer, 2]), mem_n,
                                    xa_w_q[layer], xa_w_kv[layer], xa_w_o[layer])
        x = x + 0.5 * swiglu(rmsnorm(x, norm_g[layer, 3]), ffn_w_gu[layer, 1], ffn_w_down[layer, 1])
    return rmsnorm(x, final_norm_g)
```

```cpp
#include <hip/hip_runtime.h>
#include <cstdio>
#include <cstdint>

#ifndef X_F32
#define X_F32 0
#endif
#ifndef MK_ONE_LAUNCH
#define MK_ONE_LAUNCH 1
#endif

#define LAS __attribute__((address_space(3)))
typedef unsigned short bf16;
typedef short bf16x8 __attribute__((ext_vector_type(8)));
typedef float f32x4 __attribute__((ext_vector_type(4)));
typedef float f32x2 __attribute__((ext_vector_type(2)));
typedef unsigned u32x4 __attribute__((ext_vector_type(4)));
typedef unsigned u32x2 __attribute__((ext_vector_type(2)));

constexpr int BATCH = 4, SEQ = 2048, D = 2048, DEPTH = 4, M = BATCH * SEQ;
constexpr int NMEM = 256, MMEM = BATCH * NMEM;
constexpr int DFF = 5504, NGU = 2 * DFF;
constexpr int HG_H = 16, HG_D = 128;
constexpr int ML_H = 8, ML_DQK = 128, ML_DV = 256, ML_IN = 6160, ML_PROJ = 6144;
constexpr int XA_H = 4, XA_D = 512;
constexpr float EPS = 1e-6f;
constexpr int LDS_BYTES = 147456;
constexpr int CTRL = LDS_BYTES - 512;

__device__ __forceinline__ unsigned pk2(float lo, float hi) { unsigned r; asm volatile("v_cvt_pk_bf16_f32 %0, %1, %2" : "=v"(r) : "v"(lo), "v"(hi)); return r; }
__device__ __forceinline__ float bflo(unsigned w) { return __uint_as_float(w << 16); }
__device__ __forceinline__ float bfhi(unsigned w) { return __uint_as_float(w & 0xffff0000u); }
__device__ __forceinline__ float sigmoidf_(float x) { return __builtin_amdgcn_rcpf(1.0f + __expf(-x)); }
__device__ __forceinline__ float siluf_(float x) { return x * sigmoidf_(x); }
__device__ __forceinline__ float gelu_tanh_(float x) { const float u = 0.7978845608028654f * (x + 0.044715f * x * x * x); const float t = 1.0f - 2.0f * __builtin_amdgcn_rcpf(__expf(2.0f * u) + 1.0f); return 0.5f * x * (1.0f + t); }
__device__ __forceinline__ float wave_sum(float v) {
#pragma unroll
    for (int o = 1; o < 64; o <<= 1) v += __shfl_xor(v, o);
    return v;
}
__device__ __forceinline__ float wave_max(float v) {
#pragma unroll
    for (int o = 1; o < 64; o <<= 1) v = fmaxf(v, __shfl_xor(v, o));
    return v;
}

__device__ __forceinline__ int lds_ld_i32(LAS unsigned char* p) { return __builtin_amdgcn_readfirstlane(*(volatile LAS int*)p); }
__device__ __forceinline__ const char* lds_ld_ptr(LAS unsigned char* p) { const unsigned lo = __builtin_amdgcn_readfirstlane(*(volatile LAS unsigned*)p), hi = __builtin_amdgcn_readfirstlane(*(volatile LAS unsigned*)(p + 4)); return (const char*)(((unsigned long long)hi << 32) | lo); }

namespace pg8 {
constexpr int BM = 256, BK = 64, HALF = 128, HTB = HALF * BK * 2, STAGE_BYTES = 8 * HTB, NXCD = 8, WGM = 8;
__host__ __device__ __forceinline__ int lds_byte(int r, int c) { const int st = (r >> 4) * 2 + (c >> 5), rr = r & 15, cc = c & 31, ob = rr * 64 + cc * 2; return st * 1024 + (ob ^ (((ob >> 9) & 1) << 5)); }
__host__ __device__ __forceinline__ void stage_rc(int b, int& R, int& C) { const int st = b / 1024, sb = b % 1024, swz = sb ^ (((sb >> 9) & 1) << 5); R = (st >> 1) * 16 + swz / 64; C = (st & 1) * 32 + (swz % 64) / 2; }
__host__ __device__ __forceinline__ int perm32(int rho) { const int n = rho >> 4, i = rho & 15; return 8 * (i >> 2) + 4 * n + (i & 3); }

struct Unit { int pm, pn, z; };

template <int LDA, int LDB, int MROWS, int NCOLS, int ZSHIFT = 30, int AZ = 0, int BPMSHIFT = 30, unsigned BPMSTRIDE = 0>
struct PlainSched {
    static constexpr int nM = MROWS / BM, nN = NCOLS / BM, nwg = nM * nN; static constexpr unsigned a_tile = BM * LDA * 2, b_tile = BM * LDB * 2;
    LAS unsigned char* lds; int gsub = 0, coff = 0;
    __device__ void init(LAS unsigned char* lds_, const void* A_, const void* B_) { lds = lds_;
        *(volatile LAS unsigned long long*)(lds + CTRL + 304) = (unsigned long long)A_; *(volatile LAS unsigned long long*)(lds + CTRL + 312) = (unsigned long long)B_; __syncthreads(); }
    __device__ bool next(int i, Unit& u) const {
        const int G = gsub > 0 ? gsub : lds_ld_i32(lds + CTRL + 52), c = lds_ld_i32(lds + CTRL + 48) - coff;
        const int L = i * G + c; if (L >= nwg) return false;
        int wgid = L; { constexpr int q = nwg / NXCD, r = nwg % NXCD; const int xcd = wgid % NXCD, off = wgid / NXCD; wgid = (xcd < r ? xcd * (q + 1) : r * (q + 1) + (xcd - r) * q) + off; }
        constexpr int nig = WGM * nN; const int gid = wgid / nig, fm = gid * WGM, gsz = (nM - fm) < WGM ? (nM - fm) : WGM;
        u.pm = fm + ((wgid % nig) % gsz); u.pn = (wgid % nig) / gsz; u.z = u.pn >> ZSHIFT; return true;
    }
    __device__ __forceinline__ const char* a_ptr(const Unit& u) const { return lds_ld_ptr(lds + CTRL + 304) + (size_t)((unsigned)u.pm * a_tile) + (size_t)((unsigned)u.z * (unsigned)AZ); }
    __device__ __forceinline__ const char* b_ptr(const Unit& u) const { return lds_ld_ptr(lds + CTRL + 312) + (size_t)((unsigned)u.pn * b_tile) + (size_t)((unsigned)(u.pm >> BPMSHIFT) * BPMSTRIDE); }
};
struct BatchSched {
    LAS unsigned char* lds; unsigned a_b, a_h, a_pm, b_b, b_h, b_pn; int nM, nN, nwg;
    __device__ void init(LAS unsigned char* lds_, const void* A_, const void* B_) { lds = lds_;
        *(volatile LAS unsigned long long*)(lds + CTRL + 304) = (unsigned long long)A_; *(volatile LAS unsigned long long*)(lds + CTRL + 312) = (unsigned long long)B_; __syncthreads(); }
    __device__ bool next(int i, Unit& u) const {
        const int G = lds_ld_i32(lds + CTRL + 52), c = lds_ld_i32(lds + CTRL + 48);
        const int L = i * G + c; if (L >= nwg) return false;
        const int per = nM * nN, z = L / per, r = L % per; u.pm = r % nM; u.pn = r / nM; u.z = z;
        return true;
    }
    __device__ __forceinline__ const char* a_ptr(const Unit& u) const { return lds_ld_ptr(lds + CTRL + 304) + (size_t)((unsigned)(u.z >> 2) * a_b) + (size_t)((unsigned)(u.z & 3) * a_h) + (size_t)((unsigned)u.pm * a_pm); }
    __device__ __forceinline__ const char* b_ptr(const Unit& u) const { return lds_ld_ptr(lds + CTRL + 312) + (size_t)((unsigned)(u.z >> 2) * b_b) + (size_t)((unsigned)(u.z & 3) * b_h) + (size_t)((unsigned)u.pn * b_pn); }
};

typedef f32x4 Acc[2][2][4][2];

__device__ __forceinline__ void load_rstd(const float* SSQ, int row0, float (&rs)[2][4]) {
#pragma unroll
    for (int ai = 0; ai < 2; ++ai)
#pragma unroll
        for (int m = 0; m < 4; ++m) { const float* p = SSQ + (size_t)(row0 + ai * HALF + m * 16) * 8; const f32x4 a = *(const f32x4*)p, b = *(const f32x4*)(p + 4);
            rs[ai][m] = 1.0f / sqrtf((((a[0] + a[1]) + (a[2] + a[3])) + ((b[0] + b[1]) + (b[2] + b[3]))) * (1.0f / D) + EPS); }
}
struct EpiBf16P {
    static constexpr bool PERM = true;
    bf16* O; int ldc; size_t zb, zh; float scale; const float* SSQ; int cgrp = 0; size_t cgs = 0;
    __device__ __forceinline__ void operator()(const Acc& acc, const Unit& u, int wr, int wc, int fr, int fq) const {
        bf16* base = O + (size_t)(u.z >> 2) * zb + (size_t)(u.z & 3) * zh; int pnl = u.pn;
        if (cgrp > 0) { base += (size_t)(u.pn / cgrp) * cgs; pnl = u.pn % cgrp; }
        const int row0 = u.pm * BM + wr * 64 + fr, col0 = pnl * BM + wc * 32 + 8 * fq;
        float rs[2][4];
        if (SSQ) load_rstd(SSQ, row0, rs); else {
#pragma unroll
            for (int ai = 0; ai < 2; ++ai)
#pragma unroll
                for (int m = 0; m < 4; ++m) rs[ai][m] = 1.0f; }
#pragma unroll
        for (int ai = 0; ai < 2; ++ai)
#pragma unroll
            for (int m = 0; m < 4; ++m) { bf16* rowp = base + (size_t)(row0 + ai * HALF + m * 16) * ldc + col0; const float sc = scale * rs[ai][m];
#pragma unroll
                for (int bj = 0; bj < 2; ++bj) { const f32x4 v0 = acc[ai][bj][m][0] * sc, v1 = acc[ai][bj][m][1] * sc;
                    u32x4 w; w.x = pk2(v0[0], v0[1]); w.y = pk2(v0[2], v0[3]); w.z = pk2(v1[0], v1[1]); w.w = pk2(v1[2], v1[3]);
                    *(u32x4*)(rowp + bj * HALF) = w; } }
    }
};
struct EpiMlIn {
    static constexpr bool PERM = true;
    bf16* PB; float* GATES; const float* SSQ;
    __device__ __forceinline__ void operator()(const Acc& acc, const Unit& u, int wr, int wc, int fr, int fq) const {
        const int row0 = u.pm * BM + wr * 64 + fr, col0 = u.pn * BM + wc * 32 + 8 * fq;
        float rs[2][4]; load_rstd(SSQ, row0, rs);
        if (u.pn < 24) {
#pragma unroll
            for (int ai = 0; ai < 2; ++ai)
#pragma unroll
                for (int m = 0; m < 4; ++m) { bf16* rowp = PB + (size_t)(row0 + ai * HALF + m * 16) * ML_PROJ + col0; const float sc = rs[ai][m];
#pragma unroll
                    for (int bj = 0; bj < 2; ++bj) { const f32x4 v0 = acc[ai][bj][m][0] * sc, v1 = acc[ai][bj][m][1] * sc;
                        u32x4 w; w.x = pk2(v0[0], v0[1]); w.y = pk2(v0[2], v0[3]); w.z = pk2(v1[0], v1[1]); w.w = pk2(v1[2], v1[3]);
                        *(u32x4*)(rowp + bj * HALF) = w; } }
        } else if (wc == 0 && fq < 2) {
#pragma unroll
            for (int ai = 0; ai < 2; ++ai)
#pragma unroll
                for (int m = 0; m < 4; ++m) { float* gp = GATES + (size_t)(row0 + ai * HALF + m * 16) * 16 + 8 * fq; const float sc = rs[ai][m];
                    *(f32x4*)gp = acc[ai][0][m][0] * sc; *(f32x4*)(gp + 4) = acc[ai][0][m][1] * sc; }
        }
    }
};
struct EpiSwiGLU {
    static constexpr bool PERM = true;
    bf16* O; const float* SSQ;
    __device__ __forceinline__ void operator()(const Acc& acc, const Unit& u, int wr, int wc, int fr, int fq) const {
        const int row0 = u.pm * BM + wr * 64 + fr, col0 = u.pn * HALF + wc * 32 + 8 * fq;
        float rs[2][4]; load_rstd(SSQ, row0, rs);
#pragma unroll
        for (int ai = 0; ai < 2; ++ai)
#pragma unroll
            for (int m = 0; m < 4; ++m) { bf16* p = O + (size_t)(row0 + ai * HALF + m * 16) * DFF + col0; const float sc = rs[ai][m];
                const f32x4 g0 = acc[ai][0][m][0] * sc, g1 = acc[ai][0][m][1] * sc, u0 = acc[ai][1][m][0] * sc, u1 = acc[ai][1][m][1] * sc;
                u32x4 w; w.x = pk2(siluf_(g0[0]) * u0[0], siluf_(g0[1]) * u0[1]); w.y = pk2(siluf_(g0[2]) * u0[2], siluf_(g0[3]) * u0[3]);
                w.z = pk2(siluf_(g1[0]) * u1[0], siluf_(g1[1]) * u1[1]); w.w = pk2(siluf_(g1[2]) * u1[2], siluf_(g1[3]) * u1[3]);
                *(u32x4*)p = w; }
    }
};
template <bool XF32> struct EpiResidT {
    static constexpr bool PERM = true;
    const float* Xin; float* Xout; bf16* XB; float* SSQ; float scale; LAS unsigned char* lds; int tid;
    __device__ __forceinline__ void operator()(const Acc& acc, const Unit& u, int wr, int wc, int fr, int fq) const {
        typedef __attribute__((address_space(1))) const f32x4 gcf4; typedef __attribute__((address_space(1))) f32x4 gf4; typedef __attribute__((address_space(1))) u32x4 gu4;
        typedef __attribute__((address_space(1))) const float gcf; typedef __attribute__((address_space(1))) float gf; typedef __attribute__((address_space(1))) bf16 gb;
        gcf* xin = (gcf*)Xin; gf* xout = (gf*)Xout; gb* xb = (gb*)XB;
        const int row0 = u.pm * BM + wr * 64 + fr, col0 = u.pn * BM + wc * 32 + 8 * fq;
        LAS float* red = (LAS float*)(lds + STAGE_BYTES);
#pragma unroll
        for (int ai = 0; ai < 2; ++ai)
#pragma unroll
            for (int m = 0; m < 4; ++m) { const unsigned off = (unsigned)(row0 + ai * HALF + m * 16) * (unsigned)D + (unsigned)col0; float ss = 0.f;
#pragma unroll
                for (int bj = 0; bj < 2; ++bj) { const unsigned o = off + bj * HALF; f32x4 x0, x1;
                    if constexpr (XF32) { x0 = *(gcf4*)(xin + o); x1 = *(gcf4*)(xin + o + 4); }
                    else { const u32x4 w = *(const gu4*)(xb + o); x0 = (f32x4){bflo(w.x), bfhi(w.x), bflo(w.y), bfhi(w.y)}; x1 = (f32x4){bflo(w.z), bfhi(w.z), bflo(w.w), bfhi(w.w)}; }
                    x0 += acc[ai][bj][m][0] * scale; x1 += acc[ai][bj][m][1] * scale;
                    if constexpr (XF32) { *(gf4*)(xout + o) = x0; *(gf4*)(xout + o + 4) = x1; }
                    u32x4 w; w.x = pk2(x0[0], x0[1]); w.y = pk2(x0[2], x0[3]); w.z = pk2(x1[0], x1[1]); w.w = pk2(x1[2], x1[3]); *(gu4*)(xb + o) = w;
                    ss += ((x0[0] * x0[0] + x0[1] * x0[1]) + (x0[2] * x0[2] + x0[3] * x0[3])) + ((x1[0] * x1[0] + x1[1] * x1[1]) + (x1[2] * x1[2] + x1[3] * x1[3]));
                    asm volatile("" ::: "memory"); }
                ss += __shfl_xor(ss, 16); ss += __shfl_xor(ss, 32);
                if (fq == 0) red[(ai * HALF + wr * 64 + m * 16 + fr) * 4 + wc] = ss; }
        asm volatile("s_waitcnt lgkmcnt(0)" ::: "memory"); __builtin_amdgcn_s_barrier(); asm volatile("" ::: "memory");
        if (tid < 256) { const f32x4 r = *(const LAS f32x4*)(red + tid * 4); SSQ[(size_t)(u.pm * BM + tid) * 8 + u.pn] = (r[0] + r[1]) + (r[2] + r[3]); }
        asm volatile("s_waitcnt lgkmcnt(0)" ::: "memory"); __builtin_amdgcn_s_barrier(); asm volatile("" ::: "memory");
    }
};
typedef EpiResidT<(X_F32 != 0)> EpiResid;
struct EpiHgIn {
    static constexpr bool PERM = true;
    bf16* P0; bf16* LF; const float* lb; const float* SSQ;
    __device__ __forceinline__ void operator()(const Acc& acc, const Unit& u, int wr, int wc, int fr, int fq) const {
        const int grp = u.pn >> 3; const int row0 = u.pm * BM + wr * 64 + fr, col0 = (u.pn & 7) * BM + wc * 32 + 8 * fq;
        float rs[2][4]; load_rstd(SSQ, row0, rs);
        if (grp == 1) {
#pragma unroll
            for (int bj = 0; bj < 2; ++bj) {
                const f32x4 l0 = *(const f32x4*)(lb + col0 + bj * HALF), l1 = *(const f32x4*)(lb + col0 + bj * HALF + 4);
                const float lbv[8] = {l0[0], l0[1], l0[2], l0[3], l1[0], l1[1], l1[2], l1[3]};
#pragma unroll
                for (int ai = 0; ai < 2; ++ai)
#pragma unroll
                    for (int m = 0; m < 4; ++m) { const size_t o = (size_t)(row0 + ai * HALF + m * 16) * D + col0 + bj * HALF;
                        const f32x4 v0 = acc[ai][bj][m][0] * rs[ai][m], v1 = acc[ai][bj][m][1] * rs[ai][m];
                        const float a[8] = {v0[0], v0[1], v0[2], v0[3], v1[0], v1[1], v1[2], v1[3]};
                        float lf[8];
#pragma unroll
                        for (int j = 0; j < 8; ++j) { const float e = __expf(-a[j]); const float sg = __builtin_amdgcn_rcpf(1.0f + e); const float om = 1.0f - lbv[j];
                            const float f = lbv[j] + om * sg; lf[j] = __logf(fmaxf(f, 1e-12f)); }
                        { u32x4 w; w.x = pk2(lf[0], lf[1]); w.y = pk2(lf[2], lf[3]); w.z = pk2(lf[4], lf[5]); w.w = pk2(lf[6], lf[7]); *(u32x4*)(LF + o) = w; }
                        asm volatile("" ::: "memory"); }
            }
        } else {
            bf16* dst = P0 + (size_t)grp * M * D;
#pragma unroll
            for (int ai = 0; ai < 2; ++ai)
#pragma unroll
                for (int m = 0; m < 4; ++m) { const size_t ro = (size_t)(row0 + ai * HALF + m * 16) * D + col0;
#pragma unroll
                    for (int bj = 0; bj < 2; ++bj) { const f32x4 v0 = acc[ai][bj][m][0] * rs[ai][m], v1 = acc[ai][bj][m][1] * rs[ai][m];
                        float a[8] = {v0[0], v0[1], v0[2], v0[3], v1[0], v1[1], v1[2], v1[3]};
                        if (grp != 2) {
#pragma unroll
                            for (int j = 0; j < 8; ++j) a[j] = siluf_(a[j]); }
                        u32x4 w; w.x = pk2(a[0], a[1]); w.y = pk2(a[2], a[3]); w.z = pk2(a[4], a[5]); w.w = pk2(a[6], a[7]);
                        *(u32x4*)(dst + ro + bj * HALF) = w; }
                    asm volatile("" ::: "memory"); }
        }
    }
};
struct EpiLruIn {
    static constexpr bool PERM = true;
    bf16* GBR; bf16* UR; const float* SSQ;
    __device__ __forceinline__ void operator()(const Acc& acc, const Unit& u, int wr, int wc, int fr, int fq) const {
        const int grp = u.pn >> 3; const int row0 = u.pm * BM + wr * 64 + fr, col0 = (u.pn & 7) * BM + wc * 32 + 8 * fq;
        float rs[2][4]; load_rstd(SSQ, row0, rs);
#pragma unroll
        for (int ai = 0; ai < 2; ++ai)
#pragma unroll
            for (int m = 0; m < 4; ++m) { const size_t ro = (size_t)(row0 + ai * HALF + m * 16) * D + col0;
#pragma unroll
                for (int bj = 0; bj < 2; ++bj) { const f32x4 v0 = acc[ai][bj][m][0] * rs[ai][m], v1 = acc[ai][bj][m][1] * rs[ai][m]; const size_t o = ro + bj * HALF;
                    if (grp == 0) { u32x4 w; w.x = pk2(gelu_tanh_(v0[0]), gelu_tanh_(v0[1])); w.y = pk2(gelu_tanh_(v0[2]), gelu_tanh_(v0[3])); w.z = pk2(gelu_tanh_(v1[0]), gelu_tanh_(v1[1])); w.w = pk2(gelu_tanh_(v1[2]), gelu_tanh_(v1[3]));
                        *(u32x4*)(GBR + o) = w; }
                    else { u32x4 w; w.x = pk2(v0[0], v0[1]); w.y = pk2(v0[2], v0[3]); w.z = pk2(v1[0], v1[1]); w.w = pk2(v1[2], v1[3]); *(u32x4*)(UR + o) = w; } } }
    }
};
struct EpiLruGate {
    static constexpr bool PERM = false;
    const bf16* UC; const float* ba; const float* bx; const float* c8; bf16* LA; bf16* INP;
    __device__ __forceinline__ void operator()(const Acc& acc, const Unit& u, int wr, int wc, int fr, int fq) const {
        const int row0 = u.pm * BM + wr * 64 + fr, ch0 = u.z * 256 + (u.pn & 1) * HALF + wc * 32 + 4 * fq;
#pragma unroll
        for (int n = 0; n < 2; ++n) { const int ch = ch0 + 16 * n;
            const f32x4 vba = *(const f32x4*)(ba + ch), vbx = *(const f32x4*)(bx + ch), vc8 = *(const f32x4*)(c8 + ch);
#pragma unroll
            for (int ai = 0; ai < 2; ++ai)
#pragma unroll
                for (int m = 0; m < 4; ++m) { const size_t o = (size_t)(row0 + ai * HALF + m * 16) * D + ch;
                    const u32x2 uw = *(const u32x2*)(UC + o); const f32x4 uu = {bflo(uw.x), bfhi(uw.x), bflo(uw.y), bfhi(uw.y)}; const f32x4 pa = acc[ai][0][m][n] + vba, px = acc[ai][1][m][n] + vbx;
                    f32x4 av, iv;
#pragma unroll
                    for (int j = 0; j < 4; ++j) { const float r = sigmoidf_(pa[j]), ig = sigmoidf_(px[j]); const float la = -vc8[j] * r;
                        const float mult = sqrtf(fmaxf(-expm1f(2.0f * la), 0.0f)); av[j] = la; iv[j] = mult * (ig * uu[j]); }
                    { u32x2 wa, wi; wa.x = pk2(av[0], av[1]); wa.y = pk2(av[2], av[3]); wi.x = pk2(iv[0], iv[1]); wi.y = pk2(iv[2], iv[3]); *(u32x2*)(LA + o) = wa; *(u32x2*)(INP + o) = wi; } asm volatile("" ::: "memory"); } }
    }
};
struct EpiF32Z {
    static constexpr bool PERM = false;
    float* S; float scale;
    __device__ __forceinline__ void operator()(const Acc& acc, const Unit& u, int wr, int wc, int fr, int fq) const {
        float* base = S + (size_t)u.z * SEQ * NMEM; const int row0 = u.pm * BM + wr * 64 + fr, col0 = wc * 32 + 4 * fq;
#pragma unroll
        for (int ai = 0; ai < 2; ++ai)
#pragma unroll
            for (int m = 0; m < 4; ++m) { float* rowp = base + (size_t)(row0 + ai * HALF + m * 16) * NMEM + col0;
#pragma unroll
                for (int bj = 0; bj < 2; ++bj)
#pragma unroll
                    for (int n = 0; n < 2; ++n) *(f32x4*)(rowp + bj * HALF + n * 16) = acc[ai][bj][m][n] * scale; }
    }
};

struct GtSched { const char* Kall; const char* Wq; int G, c, L0, L1;
    __device__ bool next(int i, Unit& u) const { const int L = L0 + i * G + c; if (c < 0 || L >= L1) return false; u.pm = 0; u.pn = L & 7; u.z = L >> 3; return true; }
    __device__ __forceinline__ const char* a_ptr(const Unit& u) const { const int l = u.z >> 4, b = (u.z >> 2) & 3, h = u.z & 3; return Kall + ((size_t)b * NMEM * 4 * D + (size_t)l * D + h * XA_D) * 2; }
    __device__ __forceinline__ const char* b_ptr(const Unit& u) const { const int l = u.z >> 4, h = u.z & 3; return Wq + ((size_t)l * D * D + (size_t)u.pn * 256 * D + h * XA_D) * 2; }
};
struct UtSched { const char* Wo; const char* Vall; int G, c, L0, L1;
    __device__ bool next(int i, Unit& u) const { const int L = L0 + i * G + c; if (c < 0 || L >= L1) return false; u.pm = L & 7; u.pn = 0; u.z = L >> 3; return true; }
    __device__ __forceinline__ const char* a_ptr(const Unit& u) const { const int l = u.z >> 4, h = u.z & 3; return Wo + ((size_t)l * D * D + (size_t)u.pm * 256 * D + h * XA_D) * 2; }
    __device__ __forceinline__ const char* b_ptr(const Unit& u) const { const int l = u.z >> 4, b = (u.z >> 2) & 3, h = u.z & 3; return Vall + ((size_t)b * NMEM * 4 * D + (size_t)l * D + h * XA_D) * 2; }
};
struct ScSched { const char* XBp; const char* GTl; int G, c;
    __device__ bool next(int i, Unit& u) const { const int L = i * G + c; if (L >= 16 * 8) return false; u.pm = L & 7; u.pn = 0; u.z = L >> 3; return true; }
    __device__ __forceinline__ const char* a_ptr(const Unit& u) const { return XBp + ((size_t)(u.z >> 2) * SEQ + (size_t)u.pm * 256) * D * 2; }
    __device__ __forceinline__ const char* b_ptr(const Unit& u) const { return GTl + (size_t)u.z * NMEM * D * 2; }
};
struct OneSched {
    const char* A; const char* B; Unit u0;
    __device__ bool next(int i, Unit& u) const { if (i > 0) return false; u = u0; return true; }
    __device__ __forceinline__ const char* a_ptr(const Unit&) const { return A; }
    __device__ __forceinline__ const char* b_ptr(const Unit&) const { return B; }
};
struct EpiSoftmax {
    static constexpr bool PERM = true;
    bf16* Pall; float scale0; LAS unsigned char* lds; const float* SSQ;
    __device__ __forceinline__ void operator()(const Acc& acc, const Unit& u, int wr, int wc, int fr, int fq) const {
        LAS float* rmax = (LAS float*)(lds + STAGE_BYTES); LAS float* rsum = rmax + 1024;
        const int growb = (u.z >> 2) * SEQ + u.pm * BM; bf16* P = Pall + (size_t)growb * (4 * NMEM) + (u.z & 3) * NMEM;
        float rs[2][4]; load_rstd(SSQ, growb + wr * 64 + fr, rs);
        float mx[2][4];
#pragma unroll
        for (int ai = 0; ai < 2; ++ai)
#pragma unroll
            for (int m = 0; m < 4; ++m) { float v = -3.0e38f;
#pragma unroll
                for (int bj = 0; bj < 2; ++bj)
#pragma unroll
                    for (int n = 0; n < 2; ++n) { const f32x4 a = acc[ai][bj][m][n]; v = fmaxf(v, fmaxf(fmaxf(a[0], a[1]), fmaxf(a[2], a[3]))); }
                v = fmaxf(v, __shfl_xor(v, 16)); v = fmaxf(v, __shfl_xor(v, 32));
                if (fq == 0) rmax[(ai * HALF + wr * 64 + m * 16 + fr) * 4 + wc] = v; }
        asm volatile("s_waitcnt lgkmcnt(0)" ::: "memory"); __builtin_amdgcn_s_barrier(); asm volatile("" ::: "memory");
#pragma unroll
        for (int ai = 0; ai < 2; ++ai)
#pragma unroll
            for (int m = 0; m < 4; ++m) { const int rl = ai * HALF + wr * 64 + m * 16 + fr; const f32x4 r = *(const LAS f32x4*)(rmax + rl * 4); const float mxa = fmaxf(fmaxf(r[0], r[1]), fmaxf(r[2], r[3])); mx[ai][m] = mxa; const float scale = scale0 * rs[ai][m];
                float s = 0.f;
#pragma unroll
                for (int bj = 0; bj < 2; ++bj)
#pragma unroll
                    for (int n = 0; n < 2; ++n) { const f32x4 a = acc[ai][bj][m][n]; s += (__expf((a[0] - mxa) * scale) + __expf((a[1] - mxa) * scale)) + (__expf((a[2] - mxa) * scale) + __expf((a[3] - mxa) * scale)); }
                s += __shfl_xor(s, 16); s += __shfl_xor(s, 32);
                if (fq == 0) rsum[rl * 4 + wc] = s; }
        asm volatile("s_waitcnt lgkmcnt(0)" ::: "memory"); __builtin_amdgcn_s_barrier(); asm volatile("" ::: "memory");
#pragma unroll
        for (int ai = 0; ai < 2; ++ai)
#pragma unroll
            for (int m = 0; m < 4; ++m) { const int rl = ai * HALF + wr * 64 + m * 16 + fr; const f32x4 r = *(const LAS f32x4*)(rsum + rl * 4); const float inv = 1.0f / ((r[0] + r[1]) + (r[2] + r[3])); const float mxa = mx[ai][m]; const float scale = scale0 * rs[ai][m];
                bf16* rowp = P + (size_t)rl * (4 * NMEM) + wc * 32 + 8 * fq;
#pragma unroll
                for (int bj = 0; bj < 2; ++bj) { const f32x4 a0 = acc[ai][bj][m][0], a1 = acc[ai][bj][m][1];
                    u32x4 w; w.x = pk2(__expf((a0[0] - mxa) * scale) * inv, __expf((a0[1] - mxa) * scale) * inv); w.y = pk2(__expf((a0[2] - mxa) * scale) * inv, __expf((a0[3] - mxa) * scale) * inv);
                    w.z = pk2(__expf((a1[0] - mxa) * scale) * inv, __expf((a1[1] - mxa) * scale) * inv); w.w = pk2(__expf((a1[2] - mxa) * scale) * inv, __expf((a1[3] - mxa) * scale) * inv);
                    *(u32x4*)(rowp + bj * HALF) = w; } }
        asm volatile("s_waitcnt lgkmcnt(0)" ::: "memory"); __builtin_amdgcn_s_barrier(); asm volatile("" ::: "memory");
    }
};

template <class Epi, class Sched, class MkEpi, bool ALIGN_EPI = true, bool SP2 = true>
__device__ __forceinline__ void gemm_phase_(LAS unsigned char* lds, const int tid, const int lda, const int ldb, const int K, const Sched& S, const MkEpi& mk) {
    const int wid = __builtin_amdgcn_readfirstlane(tid >> 6), lane = tid & 63, wr = wid >> 2, wc = wid & 3, fr = lane & 15, fq = lane >> 4;
    int nt = K / BK; asm volatile("" : "+s"(nt));
    unsigned voffA[2], voffB[2];
#pragma unroll
    for (int i = 0; i < 2; ++i) { int R, C; stage_rc(tid * 16 + i * 8192, R, C); const int Rb = Epi::PERM ? ((R & ~31) + perm32(R & 31)) : R;
        voffA[i] = (unsigned)(R * lda + C) * 2u; voffB[i] = (unsigned)(Rb * ldb + C) * 2u; }
    constexpr unsigned kstep = BK * 2;
    const unsigned hstepA = (unsigned)(HALF * lda * 2), hstepB = (unsigned)(HALF * ldb * 2);
    const unsigned ldsw = (unsigned)wid * 1024u;
    const int aoff = lds_byte(wr * 64 + fr, fq * 8), boff = lds_byte(wc * 32 + fr, fq * 8);
#define PG8_SA(b, h) (((b) * 2 + (h)) * HTB)
#define PG8_SB(b, h) ((4 + (b) * 2 + (h)) * HTB)
#define PG8_STAGE(bufoff, gbase, voff) do { _Pragma("unroll") for (int _i = 0; _i < 2; ++_i) \
        __builtin_amdgcn_global_load_lds((const unsigned*)((const char*)(gbase) + (voff)[_i]), (LAS unsigned*)(lds + (bufoff) + ldsw + _i * 8192), 16, 0, 0); } while (0)
#define PG8_LDA(dst, b, h) do { _Pragma("unroll") for (int m = 0; m < 4; ++m) _Pragma("unroll") for (int k = 0; k < 2; ++k) dst[m][k] = *(const LAS bf16x8*)(lds + PG8_SA(b, h) + aoff + m * 2048 + k * 1024); } while (0)
#define PG8_LDB(dst, b, h) do { _Pragma("unroll") for (int n = 0; n < 2; ++n) _Pragma("unroll") for (int k = 0; k < 2; ++k) dst[n][k] = *(const LAS bf16x8*)(lds + PG8_SB(b, h) + boff + n * 2048 + k * 1024); } while (0)
#define PG8_MMA(ai, bj, At, Bt) do { __builtin_amdgcn_s_setprio(1); _Pragma("unroll") for (int m = 0; m < 4; ++m) _Pragma("unroll") for (int n = 0; n < 2; ++n) _Pragma("unroll") for (int k = 0; k < 2; ++k) \
        acc[ai][bj][m][n] = __builtin_amdgcn_mfma_f32_16x16x32_bf16(Bt[n][k], At[m][k], acc[ai][bj][m][n], 0, 0, 0); __builtin_amdgcn_s_setprio(0); } while (0)
#define PG8_WAIT_V(n) asm volatile("s_waitcnt vmcnt(" #n ")" ::: "memory")
#define PG8_WAIT_L(n) asm volatile("s_waitcnt lgkmcnt(" #n ")" ::: "memory")
#define PG8_BAR __builtin_amdgcn_s_barrier()
#define PG8_SCHED __builtin_amdgcn_sched_barrier(0)
    Unit cur, nxt; int ui = 0;
    if (!S.next(0, cur)) return;
    f32x4 acc[2][2][4][2];
#pragma unroll
    for (int a = 0; a < 2; ++a)
#pragma unroll
        for (int b = 0; b < 2; ++b)
#pragma unroll
            for (int m = 0; m < 4; ++m)
#pragma unroll
                for (int n = 0; n < 2; ++n) acc[a][b][m][n] = (f32x4){0.f, 0.f, 0.f, 0.f};
    bf16x8 At[4][2], B0[2][2], B1[2][2];
    const char* cA = S.a_ptr(cur); const char* cB = S.b_ptr(cur);
    if constexpr (SP2) {
        PG8_STAGE(PG8_SB(0, 0), cB, voffB); PG8_STAGE(PG8_SB(0, 1), cB + hstepB, voffB); PG8_STAGE(PG8_SA(0, 0), cA, voffA); PG8_STAGE(PG8_SA(0, 1), cA + hstepA, voffA);
        if (wr == 1) PG8_BAR;
        PG8_WAIT_V(2); PG8_BAR;
        PG8_STAGE(PG8_SB(1, 0), cB + kstep, voffB); PG8_STAGE(PG8_SA(1, 0), cA + kstep, voffA); PG8_STAGE(PG8_SB(1, 1), cB + hstepB + kstep, voffB);
        PG8_WAIT_V(6); PG8_BAR;
    } else {
        PG8_STAGE(PG8_SB(0, 0), cB, voffB); PG8_STAGE(PG8_SA(0, 0), cA, voffA); PG8_STAGE(PG8_SB(0, 1), cB + hstepB, voffB); PG8_STAGE(PG8_SA(0, 1), cA + hstepA, voffA);
        if (wr == 1) PG8_BAR;
        PG8_WAIT_V(4); PG8_BAR;
        PG8_STAGE(PG8_SB(1, 0), cB + kstep, voffB); PG8_STAGE(PG8_SA(1, 0), cA + kstep, voffA); PG8_STAGE(PG8_SB(1, 1), cB + hstepB + kstep, voffB);
        PG8_WAIT_V(6); PG8_BAR;
    }
    for (;;) {
        const bool has_next = S.next(ui + 1, nxt);
        if (!has_next) nxt = cur;
        const char* nA = S.a_ptr(nxt); const char* nB = S.b_ptr(nxt);
        for (int t = 0; t < nt; t += 2) {
            const bool last = (t == nt - 2);
            const char* a1 = cA + (size_t)(t + 1) * kstep;
            const char* a2 = last ? nA : cA + (size_t)(t + 2) * kstep; const char* b2 = last ? nB : cB + (size_t)(t + 2) * kstep;
            const char* a3 = a2 + kstep; const char* b3 = b2 + kstep;
            if constexpr (SP2) {
            PG8_LDB(B0, 0, 0); PG8_LDB(B1, 0, 1); PG8_SCHED; PG8_LDA(At, 0, 0); PG8_STAGE(PG8_SA(1, 1), a1 + hstepA, voffA);
            PG8_WAIT_V(8); PG8_WAIT_L(0); PG8_BAR; PG8_MMA(0, 0, At, B0); PG8_MMA(0, 1, At, B1); PG8_BAR; PG8_SCHED;
            PG8_LDA(At, 0, 1); PG8_STAGE(PG8_SB(0, 0), b2, voffB); PG8_STAGE(PG8_SB(0, 1), b2 + hstepB, voffB); PG8_STAGE(PG8_SA(0, 0), a2, voffA);
            PG8_WAIT_V(8); PG8_WAIT_L(0); PG8_BAR; PG8_MMA(1, 0, At, B0); PG8_MMA(1, 1, At, B1); PG8_BAR; PG8_SCHED;
            PG8_LDB(B0, 1, 0); PG8_LDB(B1, 1, 1); PG8_SCHED; PG8_LDA(At, 1, 0); PG8_STAGE(PG8_SA(0, 1), a2 + hstepA, voffA);
            PG8_WAIT_V(8); PG8_WAIT_L(0); PG8_BAR; PG8_MMA(0, 0, At, B0); PG8_MMA(0, 1, At, B1); PG8_BAR; PG8_SCHED;
            PG8_LDA(At, 1, 1); PG8_STAGE(PG8_SB(1, 0), b3, voffB); PG8_STAGE(PG8_SB(1, 1), b3 + hstepB, voffB); PG8_STAGE(PG8_SA(1, 0), a3, voffA);
            PG8_WAIT_V(8); PG8_WAIT_L(0); PG8_BAR; PG8_MMA(1, 0, At, B0); PG8_MMA(1, 1, At, B1); PG8_BAR; PG8_SCHED;
            } else {
            PG8_LDB(B0, 0, 0); PG8_SCHED; PG8_LDA(At, 0, 0); PG8_STAGE(PG8_SA(1, 1), a1 + hstepA, voffA);
            PG8_WAIT_L(8); PG8_BAR; PG8_WAIT_L(0); PG8_MMA(0, 0, At, B0); PG8_BAR; PG8_SCHED;
            PG8_LDB(B1, 0, 1); PG8_STAGE(PG8_SB(0, 0), b2, voffB);
            PG8_BAR; PG8_WAIT_L(0); PG8_MMA(0, 1, At, B1); PG8_BAR;
            PG8_LDA(At, 0, 1); PG8_STAGE(PG8_SA(0, 0), a2, voffA);
            PG8_BAR; PG8_WAIT_L(0); PG8_MMA(1, 0, At, B0); PG8_BAR; PG8_SCHED;
            PG8_STAGE(PG8_SB(0, 1), b2 + hstepB, voffB);
            PG8_WAIT_V(6); PG8_BAR; PG8_MMA(1, 1, At, B1); PG8_BAR;
            PG8_LDB(B0, 1, 0); PG8_SCHED; PG8_LDA(At, 1, 0); PG8_STAGE(PG8_SA(0, 1), a2 + hstepA, voffA);
            PG8_WAIT_L(8); PG8_BAR; PG8_WAIT_L(0); PG8_MMA(0, 0, At, B0); PG8_BAR; PG8_SCHED;
            PG8_LDB(B1, 1, 1); PG8_STAGE(PG8_SB(1, 0), b3, voffB);
            PG8_BAR; PG8_WAIT_L(0); PG8_MMA(0, 1, At, B1); PG8_BAR;
            PG8_LDA(At, 1, 1); PG8_STAGE(PG8_SA(1, 0), a3, voffA);
            PG8_BAR; PG8_WAIT_L(0); PG8_MMA(1, 0, At, B0); PG8_BAR; PG8_SCHED;
            PG8_STAGE(PG8_SB(1, 1), b3 + hstepB, voffB);
            PG8_WAIT_V(6); PG8_BAR; PG8_MMA(1, 1, At, B1); PG8_BAR;
            }
        }
        if constexpr (ALIGN_EPI) { if (wr == 0) PG8_BAR; }
        { asm volatile("" ::: "memory"); const Epi E = mk(); E(acc, cur, wr, wc, fr, fq); }
        if (!has_next) break;
#pragma unroll
        for (int a = 0; a < 2; ++a)
#pragma unroll
            for (int b = 0; b < 2; ++b)
#pragma unroll
                for (int m = 0; m < 4; ++m)
#pragma unroll
                    for (int n = 0; n < 2; ++n) acc[a][b][m][n] = (f32x4){0.f, 0.f, 0.f, 0.f};
        cur = nxt; cA = nA; cB = nB; ++ui;
        if constexpr (ALIGN_EPI) { if (wr == 1) PG8_BAR; }
    }
    PG8_WAIT_V(0);
    if constexpr (!ALIGN_EPI) { if (wr == 0) PG8_BAR; }
    PG8_BAR;
#undef PG8_SA
#undef PG8_SB
#undef PG8_STAGE
#undef PG8_LDA
#undef PG8_LDB
#undef PG8_MMA
#undef PG8_WAIT_V
#undef PG8_WAIT_L
#undef PG8_BAR
#undef PG8_SCHED
}
template <class MkEpi, class Sched> __device__ __forceinline__ void gemm_phase(LAS unsigned char* lds, const int tid, const int lda, const int ldb, const int K, const Sched& S, const MkEpi& mk) {
    gemm_phase_<decltype(mk()), Sched, MkEpi>(lds, tid, lda, ldb, K, S, mk); }
}

#define XB_TMO      128
#define XB_XCNT(j)  (256  + 64 * (j))
#define XB_XSUB(j)  (1280 + 64 * (j))
#define XB_XGEN(j)  (2304 + 64 * (j))
#define XB_TOP      3328
#define XB_TOPGEN   3392
#define XCD_BAR_WORDS 3456
#define XB_SPIN_CAP (1u << 18)

__device__ __forceinline__ unsigned xb_ld(unsigned* p)              { return __hip_atomic_load(p, __ATOMIC_RELAXED, __HIP_MEMORY_SCOPE_AGENT); }
__device__ __forceinline__ unsigned xb_add(unsigned* p, unsigned v) { return __hip_atomic_fetch_add(p, v, __ATOMIC_RELAXED, __HIP_MEMORY_SCOPE_AGENT); }
__device__ __forceinline__ unsigned xb_xcc_id() { return (unsigned)__builtin_amdgcn_s_getreg((3 << 11) | 20) & 0xFu; }
#define XB_SPIN(cond, bar) do { unsigned _sp = 0; while (cond) { __builtin_amdgcn_s_sleep(1); \
    if ((++_sp & 255u) == 0u) { if (xb_ld(&(bar)[XB_TMO])) break; if (_sp > XB_SPIN_CAP) { atomicAdd(&(bar)[XB_TMO], 1u); break; } } } } while (0)

struct XcdBarrier { unsigned* bar; unsigned x; volatile LAS unsigned* st; };

__device__ __forceinline__ XcdBarrier xcd_barrier_post(unsigned* bar, volatile LAS unsigned* st) {
    XcdBarrier b; b.bar = bar; b.x = xb_xcc_id(); b.st = st;
    if (threadIdx.x == 0) (void)xb_add(&bar[XB_XCNT(b.x)], 1u);
    return b;
}
__device__ __forceinline__ void xcd_barrier_complete(unsigned* bar, unsigned x, unsigned& nloc, unsigned& nx, const unsigned G) {
    unsigned sum, cnt, mine, sp = 0u;
    for (;;) {
        sum = 0u; cnt = 0u; mine = 0u;
#pragma unroll
        for (unsigned j = 0; j < 16; ++j) { const unsigned c = xb_ld(&bar[XB_XCNT(j)]); sum += c; cnt += (c > 0u) ? 1u : 0u; mine = (j == x) ? c : mine; }
        if (sum == G) break;
        __builtin_amdgcn_s_sleep(1);
        if ((++sp & 255u) == 0u) { if (xb_ld(&bar[XB_TMO])) break; if (sp > XB_SPIN_CAP) { atomicAdd(&bar[XB_TMO], 1u); break; } }
    }
    nloc = mine > 0u ? mine : 1u; nx = cnt > 0u ? cnt : 1u;
}
__device__ __forceinline__ void xcd_barrier(const XcdBarrier& b, const int tid, const unsigned G) {
    asm volatile("s_waitcnt vmcnt(0)" ::: "memory");
    __syncthreads();
    if (tid == 0) {
        unsigned* bar = b.bar;
        __builtin_amdgcn_s_waitcnt(0);
        unsigned nloc = b.st[0], nx = b.st[1];
        if (nloc == 0u) { xcd_barrier_complete(bar, b.x, nloc, nx, G); b.st[0] = nloc; b.st[1] = nx; }
        const unsigned old = xb_add(&bar[XB_XSUB(b.x)], 1u);
        const unsigned gen = old / nloc;
        if (old + 1u == (gen + 1u) * nloc) {
            __builtin_amdgcn_fence(__ATOMIC_RELEASE, "agent");
            asm volatile("s_waitcnt vmcnt(0)" ::: "memory");
            const unsigned og = xb_add(&bar[XB_TOP], 1u);
            const unsigned tg = og / nx;
            if (og + 1u == (tg + 1u) * nx) xb_add(&bar[XB_TOPGEN], 1u);
            else XB_SPIN(xb_ld(&bar[XB_TOPGEN]) == tg, bar);
            __builtin_amdgcn_fence(__ATOMIC_ACQUIRE, "agent");
            xb_add(&bar[XB_XGEN(b.x)], 1u);
            asm volatile("s_waitcnt vmcnt(0)" ::: "memory");
        } else {
            XB_SPIN(xb_ld(&bar[XB_XGEN(b.x)]) == gen, bar);
            __builtin_amdgcn_fence(__ATOMIC_ACQUIRE, "agent");
            asm volatile("s_waitcnt vmcnt(0)" ::: "memory");
        }
    }
    __syncthreads();
}

constexpr size_t MiB = 1u << 20;
constexpr size_t SZ_MD_BF = (size_t)M * D * 2, SZ_MD_F = (size_t)M * D * 4;
constexpr size_t WS_CTL = 0, CTL_BYTES = 1 * MiB;
constexpr size_t WS_X    = WS_CTL + CTL_BYTES;
constexpr size_t WS_HB   = WS_X + SZ_MD_F;
constexpr size_t WS_ACT  = WS_HB + SZ_MD_BF;
constexpr size_t WS_P0   = WS_ACT + (size_t)M * DFF * 2;
constexpr size_t WS_P1   = WS_P0 + 192 * MiB;
constexpr size_t WS_YB   = WS_P1 + 3 * SZ_MD_F;
constexpr size_t WS_QB2  = WS_YB + SZ_MD_BF;
constexpr size_t WS_SC   = WS_QB2 + SZ_MD_BF;
constexpr size_t WS_PB   = WS_SC + (size_t)16 * SEQ * NMEM * 4;
constexpr size_t WS_OB   = WS_PB + (size_t)16 * SEQ * NMEM * 2;
constexpr size_t WS_KALL = WS_OB + SZ_MD_BF;
constexpr size_t WS_VT   = WS_KALL + (size_t)MMEM * 4 * D * 2;
constexpr size_t WS_MEMN = WS_VT + (size_t)MMEM * 4 * D * 2;
constexpr size_t WS_MISC = WS_MEMN + (size_t)MMEM * D * 2;
constexpr size_t MISC_LB = 0, MISC_C8 = 4 * 2048 * 4, MISC_SSQ = MISC_C8 + 2048 * 4, MISC_GATES = MISC_SSQ + (size_t)M * 8 * 4, MISC_MLWG = MISC_GATES + (size_t)M * 16 * 4, MISC_BYTES = 1 * MiB;
static_assert(MISC_MLWG + 16 * 2048 * 4 <= MISC_BYTES, "misc");
constexpr int ML_NPAD = 6400;
constexpr size_t SZ_WGU = (size_t)NGU * D * 2, SZ_WDN = (size_t)D * DFF * 2, SZ_WDD = (size_t)D * D * 2;
constexpr size_t WS_WGU  = WS_MISC + MISC_BYTES;
constexpr size_t WS_WDN  = WS_WGU + 8 * SZ_WGU;
constexpr size_t WS_WQ   = WS_WDN + 8 * SZ_WDN;
constexpr size_t WS_WO   = WS_WQ + 4 * SZ_WDD;
constexpr size_t WS_WK   = WS_WO + 4 * SZ_WDD;
constexpr size_t WS_WV   = WS_WK + 4 * SZ_WDD;
constexpr size_t WS_HGIN = WS_WV + 4 * SZ_WDD;
constexpr size_t WS_HGOUT = WS_HGIN + 2 * 4 * SZ_WDD;
constexpr size_t WS_LRUIN = WS_HGOUT + 2 * SZ_WDD;
constexpr size_t WS_LRUG = WS_LRUIN + 2 * SZ_WDD;
constexpr size_t WS_LRUOUT = WS_LRUG + (size_t)4096 * 256 * 2;
constexpr size_t WS_MLIN = WS_LRUOUT + SZ_WDD;
constexpr size_t WS_MLOUT = WS_MLIN + (size_t)ML_NPAD * D * 2;
constexpr size_t WS_GT   = WS_MLOUT + SZ_WDD;
constexpr size_t WS_UT   = WS_GT + (size_t)4 * 16 * NMEM * D * 2;
constexpr size_t WS_END  = WS_UT + (size_t)4 * 4 * D * 4 * NMEM * 2;

constexpr int NWAVES = 8, NT = NWAVES * 64;

struct Args {
    const float* in[27]; float* out; unsigned char* ws; int ph_lo, ph_hi;
};
enum { I_X = 0, I_MEM, I_MEMG, I_NORMG, I_FINALG, I_WGU, I_WDN, I_XAQ, I_XAKV, I_XAO, I_HGLB, I_HGIN, I_HGG, I_HGOUT,
       I_LRUIN, I_CONVW, I_CONVB, I_LRUWA, I_LRUBA, I_LRUWX, I_LRUBX, I_LRULAM, I_LRUOUT, I_MLIN, I_MLBIF, I_MLG, I_MLOUT };

struct Frame { LAS unsigned char* lds; int tid, lane, wave, G, bid, gw, NGW;
    template <class T> __device__ __forceinline__ T* ptr(int i) const { const u32x2 v = *(const LAS u32x2*)(lds + CTRL + 64 + 8 * i);
        const unsigned lo = __builtin_amdgcn_readfirstlane(v.x), hi = __builtin_amdgcn_readfirstlane(v.y); return (T*)(((unsigned long long)hi << 32) | lo); }
    __device__ __forceinline__ const float* in(int i) const { return ptr<const float>(i); }
    __device__ __forceinline__ float* out() const { return ptr<float>(27); }
    __device__ __forceinline__ unsigned char* ws() const { return ptr<unsigned char>(28); }
};
__device__ __forceinline__ unsigned hw_wave_key() { return (unsigned)__builtin_amdgcn_s_getreg((12 - 1) << 11 | 4) & 0xfffu; }

struct CvtJob { const float* W; bf16* WT; const float* gk; int K, ldw, nrows, off, gu, nvalid; };
__device__ __forceinline__ void convert_job_rt(const Frame& F, int& rot, const CvtJob& j, const int num0 = 0, const int num1 = 8) {
    const int nnb = j.nrows / 64, nkb = j.K / 64, nitems = nnb * nkb; const int cg = F.lane & 15, kg = F.lane >> 4;
    const int i0 = (nitems * num0) >> 3, i1 = (nitems * num1) >> 3, nrange = i1 - i0;
    int q = F.gw - rot; if (q < 0) q += F.NGW;
    for (; q < nrange; q += F.NGW) { const int it = i0 + q;
        const int kb = it / nnb, nb = it % nnb, k0 = kb * 64, n0 = nb * 64; int sc = j.off + n0;
        if (j.gu) { const int pn = n0 >> 8, r = n0 & 255; sc = (r >> 7) * DFF + 128 * pn + (r & 127); }
        const bool ok = (sc + 4 * cg + 3) < j.nvalid; const float* src = j.W + (size_t)(k0 + 16 * kg) * j.ldw + (ok ? sc + 4 * cg : 0);
        f32x4 v[16];
#pragma unroll
        for (int i = 0; i < 16; ++i) v[i] = __builtin_nontemporal_load((const f32x4*)(src + (size_t)i * j.ldw));
        if (j.gk) { const f32x4* gp = (const f32x4*)(j.gk + k0 + 16 * kg);
#pragma unroll
            for (int q = 0; q < 4; ++q) { const f32x4 g = gp[q]; v[4 * q] *= g[0]; v[4 * q + 1] *= g[1]; v[4 * q + 2] *= g[2]; v[4 * q + 3] *= g[3]; } }
        if (!ok) {
#pragma unroll
            for (int i = 0; i < 16; ++i) v[i] = (f32x4){0.f, 0.f, 0.f, 0.f}; }
#pragma unroll
        for (int c = 0; c < 4; ++c) { bf16* dst = j.WT + (size_t)(n0 + 4 * cg + c) * j.K + k0 + 16 * kg;
            u32x4 lo, hi; lo.x = pk2(v[0][c], v[1][c]); lo.y = pk2(v[2][c], v[3][c]); lo.z = pk2(v[4][c], v[5][c]); lo.w = pk2(v[6][c], v[7][c]);
            hi.x = pk2(v[8][c], v[9][c]); hi.y = pk2(v[10][c], v[11][c]); hi.z = pk2(v[12][c], v[13][c]); hi.w = pk2(v[14][c], v[15][c]);
            *(u32x4*)dst = lo; *(u32x4*)(dst + 8) = hi; }
    }
    rot = (rot + nrange) % F.NGW;
}
struct MapPlain { int off; __device__ int operator()(int nb) const { return off + 64 * nb; } };
struct MapGU { __device__ int operator()(int nb) const { const int n = 64 * nb, pn = n >> 8, r = n & 255; return (r >> 7) * DFF + 128 * pn + (r & 127); } };

__device__ __forceinline__ void x_to_stream(const Frame& F, const float* x, bf16* XB, float* SSQ) {
    for (int row = F.gw; row < M; row += F.NGW) {
        const f32x4* xr = (const f32x4*)(x + (size_t)row * D) + F.lane; u32x2* o8 = (u32x2*)(XB + (size_t)row * D) + F.lane; float ss = 0.f;
#pragma unroll
        for (int j = 0; j < 8; ++j) { const f32x4 v = xr[64 * j]; ss += (v[0] * v[0] + v[1] * v[1]) + (v[2] * v[2] + v[3] * v[3]); u32x2 w; w.x = pk2(v[0], v[1]); w.y = pk2(v[2], v[3]); o8[64 * j] = w; }
        ss = wave_sum(ss);
        if (F.lane < 8) SSQ[(size_t)row * 8 + F.lane] = F.lane == 0 ? ss : 0.f;
    }
}
__device__ __forceinline__ void ml_gates_rows(const Frame& F, const bf16* XB, const float* SSQ, const bf16* wg, float* gates) {
    if (F.wave >= 2) return;
    const int lr = F.lane & 15, lq = F.lane >> 4;
    for (int tile = F.wave * F.G + F.bid; tile < M / 16; tile += 2 * F.G) {
        const int row0 = tile * 16;
        const bf16* ap = XB + (size_t)(row0 + lr) * D + 8 * lq; const bf16* bp = wg + (size_t)lr * D + 8 * lq;
        f32x4 acc = {0.f, 0.f, 0.f, 0.f};
        for (int k0 = 0; k0 < D; k0 += 256) { bf16x8 a[8], b[8];
#pragma unroll
            for (int j = 0; j < 8; ++j) { a[j] = *(const bf16x8*)(ap + k0 + 32 * j); b[j] = *(const bf16x8*)(bp + k0 + 32 * j); }
#pragma unroll
            for (int j = 0; j < 8; ++j) acc = __builtin_amdgcn_mfma_f32_16x16x32_bf16(a[j], b[j], acc, 0, 0, 0); }
#pragma unroll
        for (int r = 0; r < 4; ++r) { const int row = row0 + 4 * lq + r; const f32x4 s0 = *(const f32x4*)(SSQ + (size_t)row * 8), s1 = *(const f32x4*)(SSQ + (size_t)row * 8 + 4);
            const float rstd = 1.0f / sqrtf((((s0[0] + s0[1]) + (s0[2] + s0[3])) + ((s1[0] + s1[1]) + (s1[2] + s1[3]))) * (1.0f / D) + EPS);
            gates[(size_t)row * 16 + lr] = acc[r] * rstd; }
    }
}
__device__ __forceinline__ void final_norm_bf(const Frame& F, const bf16* XB, const float* SSQ, const float* g, float* out) {
    for (int row = F.gw; row < M; row += F.NGW) {
        const f32x4 a = *(const f32x4*)(SSQ + (size_t)row * 8), b = *(const f32x4*)(SSQ + (size_t)row * 8 + 4);
        const float rstd = 1.0f / sqrtf((((a[0] + a[1]) + (a[2] + a[3])) + ((b[0] + b[1]) + (b[2] + b[3]))) * (1.0f / D) + EPS);
        const u32x2* xr = (const u32x2*)(XB + (size_t)row * D) + F.lane; f32x4* o = (f32x4*)(out + (size_t)row * D) + F.lane;
#pragma unroll
        for (int j = 0; j < 8; ++j) { const u32x2 w = xr[64 * j]; const f32x4 gg = ((const f32x4*)g)[F.lane + 64 * j]; o[64 * j] = (f32x4){bflo(w.x), bfhi(w.x), bflo(w.y), bfhi(w.y)} * rstd * gg; }
    }
}
template <bool GATES>
__device__ __forceinline__ void norm_rows(const Frame& F, const float* x, const float* g, bf16* out, int nrows, const float* wg, float* gates) {
    for (int row = F.gw; row < nrows; row += F.NGW) {
        const f32x4* xr = (const f32x4*)(x + (size_t)row * D) + F.lane;
        f32x4 v[8]; float ss = 0.f;
#pragma unroll
        for (int j = 0; j < 8; ++j) { v[j] = xr[64 * j]; ss += (v[j][0] * v[j][0] + v[j][1] * v[j][1]) + (v[j][2] * v[j][2] + v[j][3] * v[j][3]); }
        ss = wave_sum(ss);
        const float rstd = 1.0f / sqrtf(ss * (1.0f / D) + EPS);
        u32x2* o8 = (u32x2*)(out + (size_t)row * D) + F.lane;
#pragma unroll
        for (int j = 0; j < 8; ++j) { const f32x4 gg = ((const f32x4*)g)[F.lane + 64 * j]; v[j] = v[j] * rstd * gg; u32x2 w; w.x = pk2(v[j][0], v[j][1]); w.y = pk2(v[j][2], v[j][3]); o8[64 * j] = w; }
        if constexpr (GATES) {
            for (int c = 0; c < 16; ++c) { const f32x4* wr_ = (const f32x4*)(wg + (size_t)c * D) + F.lane; float s = 0.f;
#pragma unroll
                for (int j = 0; j < 8; ++j) { const f32x4 w4 = wr_[64 * j]; s += (v[j][0] * w4[0] + v[j][1] * w4[1]) + (v[j][2] * w4[2] + v[j][3] * w4[3]); }
                s = wave_sum(s); if (F.lane == 0) gates[(size_t)row * 16 + c] = s; }
        }
    }
}
__device__ __forceinline__ void final_norm(const Frame& F, const float* x, const float* g, float* out) {
    for (int row = F.gw; row < M; row += F.NGW) {
        const f32x4* xr = (const f32x4*)(x + (size_t)row * D) + F.lane;
        f32x4 v[8]; float ss = 0.f;
#pragma unroll
        for (int j = 0; j < 8; ++j) { v[j] = xr[64 * j]; ss += (v[j][0] * v[j][0] + v[j][1] * v[j][1]) + (v[j][2] * v[j][2] + v[j][3] * v[j][3]); }
        ss = wave_sum(ss);
        const float rstd = 1.0f / sqrtf(ss * (1.0f / D) + EPS);
        f32x4* o = (f32x4*)(out + (size_t)row * D) + F.lane;
#pragma unroll
        for (int j = 0; j < 8; ++j) { const f32x4 gg = ((const f32x4*)g)[F.lane + 64 * j]; o[64 * j] = v[j] * rstd * gg; }
    }
}

template <bool ML>
__device__ __forceinline__ void recur_phase(const Frame& F, const bf16* QB, const float* LF, const bf16* KB, const bf16* VB, const bf16* PB, const float* gates, const float* bif, float* OF) {
    constexpr int H = ML ? ML_H : HG_H, DV = ML ? ML_DV : HG_D, NVS = DV / 32, TB = 32;
    LAS float* AL = (LAS float*)F.lds; LAS float* KA = AL + TB * 128; LAS float* QQ = KA + TB * 128; LAS float* VV = QQ + TB * 128; LAS float* OO = VV + TB * 32;
    const int dg = F.lane & 15, vsub = F.lane >> 4, vloc = F.wave * 4 + vsub;
    for (int unit = F.bid; unit < BATCH * H * NVS; unit += F.G) {
        const int b = unit / (H * NVS), h = (unit / NVS) % H, vs = unit % NVS;
        float S[8], Nn[8];
#pragma unroll
        for (int i = 0; i < 8; ++i) { S[i] = 0.f; Nn[i] = 0.f; }
        float bi_ = 0.f, bf_ = 0.f; if constexpr (ML) { bi_ = bif[h]; bf_ = bif[8 + h]; }
        for (int t0 = 0; t0 < SEQ; t0 += TB) {
            __syncthreads();
            { const int t = F.tid >> 4, d8 = (F.tid & 15) * 8; const size_t row = (size_t)b * SEQ + t0 + t;
                float al[8], ka[8], qq[8];
                if constexpr (!ML) {
                    const f32x4 l0 = *(const f32x4*)(LF + row * D + h * 128 + d8), l1 = *(const f32x4*)(LF + row * D + h * 128 + d8 + 4);
                    const u32x4 kw = *(const u32x4*)(KB + row * D + h * 128 + d8), qw = *(const u32x4*)(QB + row * D + h * 128 + d8);
                    const float lf[8] = {l0[0], l0[1], l0[2], l0[3], l1[0], l1[1], l1[2], l1[3]};
#pragma unroll
                    for (int i = 0; i < 8; ++i) al[i] = __expf(lf[i]);
                    ka[0] = bflo(kw.x); ka[1] = bfhi(kw.x); ka[2] = bflo(kw.y); ka[3] = bfhi(kw.y); ka[4] = bflo(kw.z); ka[5] = bfhi(kw.z); ka[6] = bflo(kw.w); ka[7] = bfhi(kw.w);
                    qq[0] = bflo(qw.x); qq[1] = bfhi(qw.x); qq[2] = bflo(qw.y); qq[3] = bfhi(qw.y); qq[4] = bflo(qw.z); qq[5] = bfhi(qw.z); qq[6] = bflo(qw.w); qq[7] = bfhi(qw.w);
                } else {
                    const float fg = gates[row * 16 + 8 + h] + bf_, ig = gates[row * 16 + h] + bi_;
                    const float a_ = 1.0f / (1.0f + expf(-15.0f * tanhf(fg * (1.0f / 15.0f))));
                    const float ei = expf(15.0f * tanhf(ig * (1.0f / 15.0f))) * 0.08838834764831845f;
                    const u32x4 qw = *(const u32x4*)(PB + row * ML_PROJ + h * 128 + d8), kw = *(const u32x4*)(PB + row * ML_PROJ + 1024 + h * 128 + d8);
#pragma unroll
                    for (int i = 0; i < 8; ++i) al[i] = a_;
                    ka[0] = bflo(kw.x) * ei; ka[1] = bfhi(kw.x) * ei; ka[2] = bflo(kw.y) * ei; ka[3] = bfhi(kw.y) * ei; ka[4] = bflo(kw.z) * ei; ka[5] = bfhi(kw.z) * ei; ka[6] = bflo(kw.w) * ei; ka[7] = bfhi(kw.w) * ei;
                    qq[0] = bflo(qw.x); qq[1] = bfhi(qw.x); qq[2] = bflo(qw.y); qq[3] = bfhi(qw.y); qq[4] = bflo(qw.z); qq[5] = bfhi(qw.z); qq[6] = bflo(qw.w); qq[7] = bfhi(qw.w);
                }
                *(LAS f32x4*)(AL + t * 128 + d8) = (f32x4){al[0], al[1], al[2], al[3]}; *(LAS f32x4*)(AL + t * 128 + d8 + 4) = (f32x4){al[4], al[5], al[6], al[7]};
                *(LAS f32x4*)(KA + t * 128 + d8) = (f32x4){ka[0], ka[1], ka[2], ka[3]}; *(LAS f32x4*)(KA + t * 128 + d8 + 4) = (f32x4){ka[4], ka[5], ka[6], ka[7]};
                *(LAS f32x4*)(QQ + t * 128 + d8) = (f32x4){qq[0], qq[1], qq[2], qq[3]}; *(LAS f32x4*)(QQ + t * 128 + d8 + 4) = (f32x4){qq[4], qq[5], qq[6], qq[7]};
                if (F.tid < 256) { const int tv = F.tid >> 3, v4 = (F.tid & 7) * 4; const size_t rv = (size_t)b * SEQ + t0 + tv;
                    const u32x2 vw = ML ? *(const u32x2*)(PB + rv * ML_PROJ + 2048 + h * 256 + vs * 32 + v4) : *(const u32x2*)(VB + rv * D + h * 128 + vs * 32 + v4);
                    *(LAS f32x4*)(VV + tv * 32 + v4) = (f32x4){bflo(vw.x), bfhi(vw.x), bflo(vw.y), bfhi(vw.y)}; }
            }
            __syncthreads();
#pragma unroll 4
            for (int t = 0; t < TB; ++t) {
                const f32x4 a0 = *(const LAS f32x4*)(AL + t * 128 + dg * 8), a1 = *(const LAS f32x4*)(AL + t * 128 + dg * 8 + 4);
                const f32x4 k0 = *(const LAS f32x4*)(KA + t * 128 + dg * 8), k1 = *(const LAS f32x4*)(KA + t * 128 + dg * 8 + 4);
                const f32x4 q0 = *(const LAS f32x4*)(QQ + t * 128 + dg * 8), q1 = *(const LAS f32x4*)(QQ + t * 128 + dg * 8 + 4);
                const float vv = VV[t * 32 + vloc];
                const float al[8] = {a0[0], a0[1], a0[2], a0[3], a1[0], a1[1], a1[2], a1[3]}, ka[8] = {k0[0], k0[1], k0[2], k0[3], k1[0], k1[1], k1[2], k1[3]}, qq[8] = {q0[0], q0[1], q0[2], q0[3], q1[0], q1[1], q1[2], q1[3]};
                float po = 0.f, pd = 0.f;
#pragma unroll
                for (int i = 0; i < 8; ++i) { S[i] = al[i] * S[i] + ka[i] * vv; po += S[i] * qq[i]; if constexpr (ML) { Nn[i] = al[i] * Nn[i] + ka[i]; pd += Nn[i] * qq[i]; } }
#pragma unroll
                for (int o = 1; o < 16; o <<= 1) { po += __shfl_xor(po, o); if constexpr (ML) pd += __shfl_xor(pd, o); }
                if (dg == 0) { float r = po; if constexpr (ML) r = po / fmaxf(fabsf(pd), 1.0f); OO[t * 32 + vloc] = r; }
            }
            __syncthreads();
            if (F.tid < 256) { const int tv = F.tid >> 3, v4 = (F.tid & 7) * 4; const size_t rv = (size_t)b * SEQ + t0 + tv;
                *(f32x4*)(OF + rv * D + h * DV + vs * 32 + v4) = *(const LAS f32x4*)(OO + tv * 32 + v4); }
        }
    }
}
namespace ck {
constexpr int SK = 136, SS = 72;
constexpr int O_QH = 0, O_KH = O_QH + 64 * SK * 2, O_QE = O_KH + 160 * SK * 2, O_KET = O_QE + 64 * SK * 2, O_VT = O_KET + 128 * SS * 2, O_P = O_VT + 48 * SS * 2,
              O_SB = O_P + 64 * SS * 2, O_EBC = O_SB + 48 * SK * 2, O_TOT = O_EBC + 512, O_GT = O_TOT + 2048, O_END = O_GT + 2048 + 2 * 1280;
static_assert(O_END <= CTRL, "chunk LDS map");
__device__ __forceinline__ f32x4 mm(const LAS bf16* A, int sa, int ar, const LAS bf16* B, int sb, int br, int ksteps, f32x4 acc, int lane) {
    const int r = lane & 15, q8 = (lane >> 4) * 8;
    const LAS bf16* ap = A + (ar + r) * sa + q8; const LAS bf16* bp = B + (br + r) * sb + q8;
    for (int ks = 0; ks < ksteps; ++ks) { const bf16x8 a = *(const LAS bf16x8*)(ap + ks * 32), b = *(const LAS bf16x8*)(bp + ks * 32);
        acc = __builtin_amdgcn_mfma_f32_16x16x32_bf16(a, b, acc, 0, 0, 0); }
    return acc;
}
__device__ __forceinline__ bf16 f2bf(float x) { return (bf16)(pk2(x, x) & 0xffffu); }
__device__ __forceinline__ float bf2f(unsigned short x) { return __uint_as_float((unsigned)x << 16); }
__device__ __forceinline__ void tile_of(int tile, int& qi, int& kj) {
    qi = tile < 1 ? 0 : (tile < 3 ? 1 : (tile < 6 ? 2 : 3)); kj = tile - (qi * (qi + 1)) / 2; }

__device__ __forceinline__ void store_pairs(bf16* op, const f32x4& v, int lr) {
    const bool odd = lr & 1;
    const float r01 = __shfl_xor(odd ? v[0] : v[1], 1), r23 = __shfl_xor(odd ? v[2] : v[3], 1);
    const unsigned w01 = odd ? pk2(r01, v[1]) : pk2(v[0], r01), w23 = odd ? pk2(r23, v[3]) : pk2(v[2], r23);
    *(unsigned*)(op + (size_t)(odd ? 1 : 0) * D) = w01; *(unsigned*)(op + (size_t)(odd ? 3 : 2) * D) = w23;
}
template <int NSL, bool ML>
__device__ __forceinline__ void headnorm_tail(const Frame& F, const bf16* OF, float* SSQP, unsigned* cnt, const int b, const int col0, const int slot0, const int vs,
                                              const bf16* gate, const int ldg, const int gcol0, const float* gain, bf16* Y) {
    constexpr float INV_HD = 1.0f / (NSL * 32);
    const int q = F.tid & 3, r0 = F.tid >> 2;
    asm volatile("s_waitcnt vmcnt(0)" ::: "memory"); __syncthreads();
    for (int i = 0; i < SEQ / 128; ++i) { const size_t row = (size_t)b * SEQ + r0 + 128 * i;
        const u32x4 w = *(const u32x4*)(OF + row * D + col0 + 8 * q);
        const float a0 = bflo(w.x), a1 = bfhi(w.x), a2 = bflo(w.y), a3 = bfhi(w.y), a4 = bflo(w.z), a5 = bfhi(w.z), a6 = bflo(w.w), a7 = bfhi(w.w);
        float ss = ((a0 * a0 + a1 * a1) + (a2 * a2 + a3 * a3)) + ((a4 * a4 + a5 * a5) + (a6 * a6 + a7 * a7));
        ss += __shfl_xor(ss, 1); ss += __shfl_xor(ss, 2);
        if (q == 0) SSQP[row * 64 + slot0 + vs] = ss; }
    asm volatile("s_waitcnt vmcnt(0)" ::: "memory"); __syncthreads();
    if (F.tid == 0) { __builtin_amdgcn_fence(__ATOMIC_RELEASE, "agent"); asm volatile("s_waitcnt vmcnt(0)" ::: "memory"); (void)xb_add(cnt, 1u);
        unsigned sp = 0u; while (xb_ld(cnt) < (unsigned)NSL) { __builtin_amdgcn_s_sleep(1); if (++sp > (1u << 24)) break; }
        __builtin_amdgcn_fence(__ATOMIC_ACQUIRE, "agent"); asm volatile("s_waitcnt vmcnt(0)" ::: "memory"); }
    __syncthreads();
    const f32x4 g0 = *(const f32x4*)(gain + 8 * q), g1 = *(const f32x4*)(gain + 8 * q + 4);
    for (int i = 0; i < SEQ / 128; ++i) { const size_t row = (size_t)b * SEQ + r0 + 128 * i;
        const u32x4 w = *(const u32x4*)(OF + row * D + col0 + 8 * q);
        const f32x4 p0 = *(const f32x4*)(SSQP + row * 64 + slot0); float tot = (p0[0] + p0[1]) + (p0[2] + p0[3]);
        if constexpr (NSL == 8) { const f32x4 p1 = *(const f32x4*)(SSQP + row * 64 + slot0 + 4); tot += (p1[0] + p1[1]) + (p1[2] + p1[3]); }
        const float rstd = 1.0f / sqrtf(tot * INV_HD + EPS);
        const u32x4 gw = *(const u32x4*)(gate + row * ldg + gcol0 + 8 * q);
        float gg[8] = {bflo(gw.x), bfhi(gw.x), bflo(gw.y), bfhi(gw.y), bflo(gw.z), bfhi(gw.z), bflo(gw.w), bfhi(gw.w)};
        if constexpr (ML) {
#pragma unroll
            for (int j = 0; j < 8; ++j) gg[j] = sigmoidf_(gg[j]); }
        const f32x4 a = (f32x4){bflo(w.x), bfhi(w.x), bflo(w.y), bfhi(w.y)} * rstd * g0, c = (f32x4){bflo(w.z), bfhi(w.z), bflo(w.w), bfhi(w.w)} * rstd * g1;
        u32x4 o; o.x = pk2(a[0] * gg[0], a[1] * gg[1]); o.y = pk2(a[2] * gg[2], a[3] * gg[3]); o.z = pk2(c[0] * gg[4], c[1] * gg[5]); o.w = pk2(c[2] * gg[6], c[3] * gg[7]);
        *(u32x4*)(Y + row * D + col0 + 8 * q) = o; }
}
__device__ __forceinline__ void hg_chunk_phase(const Frame& F, const bf16* QB, const bf16* LF, const bf16* KB, const bf16* VB, bf16* OF, const bf16* GB, const float* gn, bf16* Y, float* SSQP, unsigned* hcnt) {
    LAS bf16* QH = (LAS bf16*)(F.lds + O_QH); LAS bf16* KH = (LAS bf16*)(F.lds + O_KH); LAS bf16* QE = (LAS bf16*)(F.lds + O_QE); LAS bf16* KET = (LAS bf16*)(F.lds + O_KET);
    LAS bf16* VT = (LAS bf16*)(F.lds + O_VT); LAS bf16* P = (LAS bf16*)(F.lds + O_P); LAS bf16* SB = (LAS bf16*)(F.lds + O_SB);
    LAS float* EBC = (LAS float*)(F.lds + O_EBC); LAS float* TOT = (LAS float*)(F.lds + O_TOT);
    const int tid = F.tid, lane = F.lane, w = F.wave, lq = lane >> 4, lr = lane & 15;
    const int g = w, i = g >> 1, d2 = 2 * lane, sv = tid >> 3, v4 = (tid & 7) * 4;
    for (int unit = F.bid; unit < 256; unit += F.G) {
        const int xk = unit >> 3, vs = xk & 3, gq = (xk >> 2) * 8 + (unit & 7); const int b = gq >> 4, h = gq & 15;
        __syncthreads();
        for (int e = tid; e < 64 * SS / 2; e += NT) ((LAS unsigned*)P)[e] = 0u;
        for (int e = tid; e < 48 * SK / 2; e += NT) ((LAS unsigned*)SB)[e] = 0u;
        f32x4 S0 = {0.f, 0.f, 0.f, 0.f}, S1 = {0.f, 0.f, 0.f, 0.f};
        unsigned lfA[8], lfB[8]; unsigned qvA[8], qvB[8]; u32x2 vvA, vvB;
        const size_t colb = (size_t)h * 128 + d2, colv = (size_t)h * 128 + vs * 32 + v4;
        auto load = [&](unsigned (&lfw)[8], unsigned (&qv)[8], u32x2& vv, const int cc) { const size_t r0 = (size_t)b * SEQ + (size_t)cc * 64 + 8 * g;
#pragma unroll
            for (int tt = 0; tt < 8; ++tt) { lfw[tt] = *(const unsigned*)(LF + (r0 + tt) * D + colb); qv[tt] = *(const unsigned*)(QB + (r0 + tt) * D + colb); }
            vv = *(const u32x2*)(VB + ((size_t)b * SEQ + (size_t)cc * 64 + sv) * D + colv); };
        load(lfA, qvA, vvA, 0); load(lfB, qvB, vvB, 1);
        auto step = [&](unsigned (&lfw)[8], unsigned (&qv)[8], u32x2& vv, const int c) {
            f32x2 lf[8], loc[8]; { f32x2 run = {0.f, 0.f};
#pragma unroll
                for (int tt = 0; tt < 8; ++tt) { lf[tt] = (f32x2){bflo(lfw[tt]), bfhi(lfw[tt])}; run += lf[tt]; loc[tt] = run; }
                *(LAS f32x2*)(TOT + g * 128 + d2) = run; }
            __syncthreads();
            { u32x2 s0, s1; s0.x = pk2(S0[0], S0[1]); s0.y = pk2(S0[2], S0[3]); s1.x = pk2(S1[0], S1[1]); s1.y = pk2(S1[2], S1[3]);
                *(LAS u32x2*)(SB + lr * SK + 16 * w + 4 * lq) = s0; *(LAS u32x2*)(SB + (16 + lr) * SK + 16 * w + 4 * lq) = s1; }
            f32x2 tg[8];
#pragma unroll
            for (int j = 0; j < 8; ++j) tg[j] = *(const LAS f32x2*)(TOT + j * 128 + d2);
            f32x2 Pf[4]; Pf[0] = (f32x2){0.f, 0.f}; Pf[1] = tg[0] + tg[1]; Pf[2] = Pf[1] + tg[2] + tg[3]; Pf[3] = Pf[2] + tg[4] + tg[5]; const f32x2 bC = Pf[3] + tg[6] + tg[7];
            const f32x2 Pi = i == 0 ? Pf[0] : (i == 1 ? Pf[1] : (i == 2 ? Pf[2] : Pf[3]));
            const f32x2 half = (g & 1) ? (g == 1 ? tg[0] : (g == 3 ? tg[2] : (g == 5 ? tg[4] : tg[6]))) : (f32x2){0.f, 0.f};
            const f32x2 eP = {__expf(Pi.x), __expf(Pi.y)}; const f32x2 eC = {__expf(bC.x - Pi.x), __expf(bC.y - Pi.y)};
            f32x2 fac[4];
#pragma unroll
            for (int ip = 0; ip < 4; ++ip) fac[ip] = (f32x2){__expf(Pf[ip].x - Pi.x), __expf(Pf[ip].y - Pi.y)};
            const int koff[4] = {0, 16, 48, 96};
            unsigned ke0[4], ke1[4];
#pragma unroll
            for (int tt = 0; tt < 8; ++tt) { const int t = 8 * g + tt; const f32x2 lo = loc[tt] + half;
                const float q0 = bflo(qv[tt]), q1 = bfhi(qv[tt]), k0 = 1.0f - __expf(lf[tt].x), k1 = 1.0f - __expf(lf[tt].y);
                const float e0 = __expf(fmaxf(lo.x, -80.f)), e1 = __expf(fmaxf(lo.y, -80.f));
                const float kr0 = k0 * __builtin_amdgcn_rcpf(e0), kr1 = k1 * __builtin_amdgcn_rcpf(e1);
                *(LAS unsigned*)(QH + t * SK + d2) = pk2(q0 * e0, q1 * e1); *(LAS unsigned*)(QE + t * SK + d2) = pk2(q0 * e0 * eP.x, q1 * e1 * eP.y);
#pragma unroll
                for (int ip = 0; ip < 4; ++ip) if (ip >= i) *(LAS unsigned*)(KH + (koff[ip] + t) * SK + d2) = pk2(kr0 * fac[ip].x, kr1 * fac[ip].y);
                const float c0 = kr0 * eC.x, c1 = kr1 * eC.y;
                if (tt & 1) { ke0[tt >> 1] = pk2(__uint_as_float(ke0[tt >> 1]), c0); ke1[tt >> 1] = pk2(__uint_as_float(ke1[tt >> 1]), c1); } else { ke0[tt >> 1] = __float_as_uint(c0); ke1[tt >> 1] = __float_as_uint(c1); } }
            *(LAS u32x4*)(KET + d2 * SS + 8 * g) = (u32x4){ke0[0], ke0[1], ke0[2], ke0[3]}; *(LAS u32x4*)(KET + (d2 + 1) * SS + 8 * g) = (u32x4){ke1[0], ke1[1], ke1[2], ke1[3]};
            if (g == 0) *(LAS f32x2*)(EBC + d2) = (f32x2){__expf(bC.x), __expf(bC.y)};
            VT[(v4 + 0) * SS + sv] = (bf16)(vv.x & 0xffffu); VT[(v4 + 1) * SS + sv] = (bf16)(vv.x >> 16); VT[(v4 + 2) * SS + sv] = (bf16)(vv.y & 0xffffu); VT[(v4 + 3) * SS + sv] = (bf16)(vv.y >> 16);
            if (c + 2 < SEQ / 64) load(lfw, qv, vv, c + 2);
            __syncthreads();
            for (int tile = w; tile < 10; tile += 8) { int qi, kj; tile_of(tile, qi, kj);
                f32x4 acc = {0.f, 0.f, 0.f, 0.f}; acc = mm(QH, SK, 16 * qi, KH, SK, koff[qi] + 16 * kj, 4, acc, lane);
#pragma unroll
                for (int r = 0; r < 4; ++r) { const int tl = 4 * lq + r; const float val = (qi != kj || lr <= tl) ? acc[r] : 0.f; P[(16 * qi + tl) * SS + 16 * kj + lr] = f2bf(val); } }
            __syncthreads();
            { const int tq = w & 3, nv = w >> 2; f32x4 acc = {0.f, 0.f, 0.f, 0.f};
                acc = mm(P, SS, 16 * tq, VT, SS, 16 * nv, tq < 2 ? 1 : 2, acc, lane);
                acc = mm(QE, SK, 16 * tq, SB, SK, 16 * nv, 4, acc, lane);
                bf16* op = OF + ((size_t)b * SEQ + c * 64 + 16 * tq + 4 * lq) * D + h * 128 + vs * 32 + 16 * nv + (lr & ~1);
                store_pairs(op, acc, lr); }
            { f32x4 U0 = {0.f, 0.f, 0.f, 0.f}, U1 = {0.f, 0.f, 0.f, 0.f}; U0 = mm(KET, SS, 16 * w, VT, SS, 0, 2, U0, lane); U1 = mm(KET, SS, 16 * w, VT, SS, 16, 2, U1, lane);
                const f32x4 dec = *(const LAS f32x4*)(EBC + 16 * w + 4 * lq); S0 = S0 * dec + U0; S1 = S1 * dec + U1; }
        };
        for (int c = 0; c < SEQ / 64; c += 2) { step(lfA, qvA, vvA, c); step(lfB, qvB, vvB, c + 1); }
        if (hcnt) headnorm_tail<4, false>(F, OF, SSQP, hcnt + b * 16 + h, b, h * 128 + vs * 32, h * 4, vs, GB, D, h * 128 + vs * 32, gn + vs * 32, Y);
    }
}

__device__ __forceinline__ void ml_chunk_phase(const Frame& F, const bf16* PB, const float* gates, const float* bif, bf16* OF, const float* gn, bf16* Y, float* SSQP, unsigned* hcnt) {
    LAS bf16* QH = (LAS bf16*)(F.lds + O_QH); LAS bf16* KH = (LAS bf16*)(F.lds + O_KH); LAS bf16* KET = (LAS bf16*)(F.lds + O_KET);
    LAS bf16* VT = (LAS bf16*)(F.lds + O_VT); LAS bf16* P = (LAS bf16*)(F.lds + O_P); LAS bf16* SB = (LAS bf16*)(F.lds + O_SB);
    LAS float* GT0 = (LAS float*)(F.lds + O_GT + 2048);
    const int tid = F.tid, lane = F.lane, w = F.wave, lq = lane >> 4, lr = lane & 15;
    const int g = w, d2 = 2 * lane, sv = tid >> 3, v4 = (tid & 7) * 4;
    constexpr float S128 = 0.08838834764831845f;
    for (int unit = F.bid; unit < 256; unit += F.G) {
        const int xk = unit >> 3, vs = xk & 7, gq = (xk >> 3) * 8 + (unit & 7); const int b = gq >> 3, h = gq & 7;
        const float bi_ = bif[h], bf_ = bif[8 + h];
        __syncthreads();
        for (int e = tid; e < 64 * SS / 2; e += NT) ((LAS unsigned*)P)[e] = 0u;
        for (int e = tid; e < 48 * SK / 2; e += NT) ((LAS unsigned*)SB)[e] = 0u;
        for (int e = tid; e < 16 * SS; e += NT) VT[32 * SS + e] = (e < 64) ? (bf16)0x3F80u : (bf16)0u;
        f32x4 S0 = {0.f, 0.f, 0.f, 0.f}, S1 = {0.f, 0.f, 0.f, 0.f}, S2 = {0.f, 0.f, 0.f, 0.f};
        unsigned qvA[8], kvA[8], qvB[8], kvB[8]; u32x2 vvA, vvB; float giA = 0.f, gfA = 0.f, giB = 0.f, gfB = 0.f;
        const size_t colq = (size_t)h * 128 + d2, colv = (size_t)2048 + h * 256 + vs * 32 + v4;
        auto load = [&](unsigned (&qv)[8], unsigned (&kv)[8], u32x2& vv, float& gi, float& gf, const int cc) { const size_t r0 = (size_t)b * SEQ + (size_t)cc * 64 + 8 * g;
#pragma unroll
            for (int tt = 0; tt < 8; ++tt) { qv[tt] = *(const unsigned*)(PB + (r0 + tt) * ML_PROJ + colq); kv[tt] = *(const unsigned*)(PB + (r0 + tt) * ML_PROJ + 1024 + colq); }
            vv = *(const u32x2*)(PB + ((size_t)b * SEQ + (size_t)cc * 64 + sv) * ML_PROJ + colv);
            if (w == 0) { gi = gates[((size_t)b * SEQ + (size_t)cc * 64 + lane) * 16 + h]; gf = gates[((size_t)b * SEQ + (size_t)cc * 64 + lane) * 16 + 8 + h]; } };
        load(qvA, kvA, vvA, giA, gfA, 0); load(qvB, kvB, vvB, giB, gfB, 1);
        auto step = [&](unsigned (&qv)[8], unsigned (&kv)[8], u32x2& vv, float& gi, float& gf, const int c) {
            LAS float* BT = GT0 + (c & 1) * 320; LAS float* WI = BT + 64; LAS float* WK = WI + 64; LAS float* EB = WK + 64; LAS float* EC = EB + 64;
            if (w == 0) {
                const float it = 15.0f * tanhf((gi + bi_) * (1.0f / 15.0f)); const float y = 15.0f * tanhf((gf + bf_) * (1.0f / 15.0f));
                const float lfv = -(fmaxf(-y, 0.f) + log1pf(expf(-fabsf(y))));
                float bt = lfv;
#pragma unroll
                for (int o = 1; o < 64; o <<= 1) { const float up = __shfl_up(bt, o); if (lane >= o) bt += up; }
                const float bC = __shfl(bt, 63);
                BT[lane] = bt; WI[lane] = it - bt; WK[lane] = __expf(bC - bt + it) * S128; EB[lane] = __expf(bt); if (lane == 0) EC[0] = __expf(bC);
            }
            __syncthreads();
            { u32x2 s0, s1, s2; s0.x = pk2(S0[0], S0[1]); s0.y = pk2(S0[2], S0[3]); s1.x = pk2(S1[0], S1[1]); s1.y = pk2(S1[2], S1[3]); s2.x = pk2(S2[0], S2[1]); s2.y = pk2(S2[2], S2[3]);
                *(LAS u32x2*)(SB + lr * SK + 16 * w + 4 * lq) = s0; *(LAS u32x2*)(SB + (16 + lr) * SK + 16 * w + 4 * lq) = s1; *(LAS u32x2*)(SB + (32 + lr) * SK + 16 * w + 4 * lq) = s2; }
            { unsigned ke0[4], ke1[4];
#pragma unroll
                for (int tt = 0; tt < 8; ++tt) { const int t = 8 * g + tt; *(LAS unsigned*)(QH + t * SK + d2) = qv[tt]; *(LAS unsigned*)(KH + t * SK + d2) = kv[tt];
                    const float wk = WK[t]; const float c0 = bflo(kv[tt]) * wk, c1 = bfhi(kv[tt]) * wk;
                    if (tt & 1) { ke0[tt >> 1] = pk2(__uint_as_float(ke0[tt >> 1]), c0); ke1[tt >> 1] = pk2(__uint_as_float(ke1[tt >> 1]), c1); } else { ke0[tt >> 1] = __float_as_uint(c0); ke1[tt >> 1] = __float_as_uint(c1); } }
                *(LAS u32x4*)(KET + d2 * SS + 8 * g) = (u32x4){ke0[0], ke0[1], ke0[2], ke0[3]}; *(LAS u32x4*)(KET + (d2 + 1) * SS + 8 * g) = (u32x4){ke1[0], ke1[1], ke1[2], ke1[3]}; }
            VT[(v4 + 0) * SS + sv] = (bf16)(vv.x & 0xffffu); VT[(v4 + 1) * SS + sv] = (bf16)(vv.x >> 16); VT[(v4 + 2) * SS + sv] = (bf16)(vv.y & 0xffffu); VT[(v4 + 3) * SS + sv] = (bf16)(vv.y >> 16);
            if (c + 2 < SEQ / 64) load(qv, kv, vv, gi, gf, c + 2);
            __syncthreads();
            for (int tile = w; tile < 10; tile += 8) { int qi, kj; tile_of(tile, qi, kj);
                f32x4 acc = {0.f, 0.f, 0.f, 0.f}; acc = mm(QH, SK, 16 * qi, KH, SK, 16 * kj, 4, acc, lane);
                const float wis = WI[16 * kj + lr];
#pragma unroll
                for (int r = 0; r < 4; ++r) { const int tl = 4 * lq + r; const float wgt = __expf(BT[16 * qi + tl] + wis) * S128;
                    const float val = (qi != kj || lr <= tl) ? acc[r] * wgt : 0.f; P[(16 * qi + tl) * SS + 16 * kj + lr] = f2bf(val); } }
            __syncthreads();
            { const int tq = w & 3, nv = w >> 2, ksn = tq < 2 ? 1 : 2; f32x4 num = {0.f, 0.f, 0.f, 0.f}, den = num, qs = num, qn = num;
                num = mm(P, SS, 16 * tq, VT, SS, 16 * nv, ksn, num, lane); den = mm(P, SS, 16 * tq, VT, SS, 32, ksn, den, lane);
                qs = mm(QH, SK, 16 * tq, SB, SK, 16 * nv, 4, qs, lane); qn = mm(QH, SK, 16 * tq, SB, SK, 32, 4, qn, lane);
                const f32x4 eb = *(const LAS f32x4*)(EB + 16 * tq + 4 * lq);
                bf16* op = OF + ((size_t)b * SEQ + c * 64 + 16 * tq + 4 * lq) * D + h * 256 + vs * 32 + 16 * nv + (lr & ~1); f32x4 hv;
#pragma unroll
                for (int r = 0; r < 4; ++r) { const float nm = num[r] + eb[r] * qs[r]; float dn = den[r] + eb[r] * qn[r]; dn = __shfl(dn, lane & 48);
                    hv[r] = nm / fmaxf(fabsf(dn), 1.0f); }
                store_pairs(op, hv, lr); }
            { f32x4 U0 = {0.f, 0.f, 0.f, 0.f}, U1 = U0, U2 = U0; U0 = mm(KET, SS, 16 * w, VT, SS, 0, 2, U0, lane); U1 = mm(KET, SS, 16 * w, VT, SS, 16, 2, U1, lane); U2 = mm(KET, SS, 16 * w, VT, SS, 32, 2, U2, lane);
                const float dec = EC[0]; S0 = S0 * dec + U0; S1 = S1 * dec + U1; S2 = S2 * dec + U2; }
        };
        for (int c = 0; c < SEQ / 64; c += 2) { step(qvA, kvA, vvA, giA, gfA, c); step(qvB, kvB, vvB, giB, gfB, c + 1); }
        if (hcnt) headnorm_tail<8, true>(F, OF, SSQP, hcnt + b * 8 + h, b, h * 256 + vs * 32, h * 8, vs, PB, ML_PROJ, 4096 + h * 256 + vs * 32, gn + vs * 32, Y);
    }
}
}

template <bool ML>
__device__ __forceinline__ void headnorm_rows(const Frame& F, const bf16* OF, const float* gn, const bf16* gate, int ldg, bf16* Y) {
    constexpr int HD = ML ? 256 : 128, LPH = HD / 32;
    for (int row = F.gw; row < M; row += F.NGW) {
        const u32x4* p = (const u32x4*)(OF + (size_t)row * D + F.lane * 32);
        f32x4 v[8]; float ss = 0.f;
#pragma unroll
        for (int j = 0; j < 4; ++j) { const u32x4 w = p[j]; v[2 * j] = (f32x4){bflo(w.x), bfhi(w.x), bflo(w.y), bfhi(w.y)}; v[2 * j + 1] = (f32x4){bflo(w.z), bfhi(w.z), bflo(w.w), bfhi(w.w)}; }
#pragma unroll
        for (int j = 0; j < 8; ++j) ss += (v[j][0] * v[j][0] + v[j][1] * v[j][1]) + (v[j][2] * v[j][2] + v[j][3] * v[j][3]);
#pragma unroll
        for (int o = 1; o < LPH; o <<= 1) ss += __shfl_xor(ss, o);
        const float rstd = 1.0f / sqrtf(ss * (1.0f / HD) + EPS);
        const int cih = (F.lane * 32) % HD;
        const u32x4* gp = (const u32x4*)(gate + (size_t)row * ldg + F.lane * 32);
        u32x4* yp = (u32x4*)(Y + (size_t)row * D + F.lane * 32);
#pragma unroll
        for (int j = 0; j < 4; ++j) { const u32x4 gw = gp[j]; const f32x4 g0 = *(const f32x4*)(gn + cih + 8 * j), g1 = *(const f32x4*)(gn + cih + 8 * j + 4);
            float gg[8] = {bflo(gw.x), bfhi(gw.x), bflo(gw.y), bfhi(gw.y), bflo(gw.z), bfhi(gw.z), bflo(gw.w), bfhi(gw.w)};
            if constexpr (ML) {
#pragma unroll
                for (int i = 0; i < 8; ++i) gg[i] = sigmoidf_(gg[i]); }
            const f32x4 a = v[2 * j] * rstd * g0, c = v[2 * j + 1] * rstd * g1;
            u32x4 w; w.x = pk2(a[0] * gg[0], a[1] * gg[1]); w.y = pk2(a[2] * gg[2], a[3] * gg[3]); w.z = pk2(c[0] * gg[4], c[1] * gg[5]); w.w = pk2(c[2] * gg[6], c[3] * gg[7]);
            yp[j] = w; }
    }
}
__device__ __forceinline__ void lru_conv(const Frame& F, const bf16* UR, const float* cw, const float* cb, bf16* UCB) {
    const int total = M * (D / 4);
    for (int idx = F.bid * NT + F.tid; idx < total; idx += F.G * NT) {
        const int row = idx / (D / 4), c4 = (idx % (D / 4)) * 4, t = row % SEQ;
        f32x4 acc = *(const f32x4*)(cb + c4);
#pragma unroll
        for (int j = 0; j < 4; ++j) { const int dt = 3 - j; if (t - dt >= 0) { const u32x2 uw = *(const u32x2*)(UR + (size_t)(row - dt) * D + c4); acc += *(const f32x4*)(cw + j * D + c4) * (f32x4){bflo(uw.x), bfhi(uw.x), bflo(uw.y), bfhi(uw.y)}; } }
        u32x2 w; w.x = pk2(acc[0], acc[1]); w.y = pk2(acc[2], acc[3]); *(u32x2*)(UCB + (size_t)row * D + c4) = w;
    }
}
__device__ __forceinline__ void lru_scan(const Frame& F, const bf16* LA, const bf16* INP, const bf16* GBR, bf16* Y) {
    LAS float* CP = (LAS float*)F.lds; LAS float* CH = CP + 16 * 32;
    const int seg = F.tid >> 5, chl = F.tid & 31;
    for (int unit = F.bid; unit < BATCH * 64; unit += F.G) {
        const int b = unit >> 6, c = (unit & 63) * 32 + chl; const size_t base = ((size_t)b * SEQ + seg * 128) * D + c;
        float P = 1.f, h = 0.f;
        for (int t0 = 0; t0 < 128; t0 += 16) { float a[16], x[16];
#pragma unroll
            for (int j = 0; j < 16; ++j) { a[j] = ck::bf2f(LA[base + (size_t)(t0 + j) * D]); x[j] = ck::bf2f(INP[base + (size_t)(t0 + j) * D]); }
#pragma unroll
            for (int j = 0; j < 16; ++j) { a[j] = __expf(a[j]); h = a[j] * h + x[j]; P *= a[j]; } }
        __syncthreads();
        CP[seg * 32 + chl] = P; CH[seg * 32 + chl] = h;
        __syncthreads();
        float carry = 0.f;
        for (int s = 0; s < seg; ++s) carry = CP[s * 32 + chl] * carry + CH[s * 32 + chl];
        h = carry;
        for (int t0 = 0; t0 < 128; t0 += 16) { float a[16], x[16]; unsigned short gg[16];
#pragma unroll
            for (int j = 0; j < 16; ++j) { a[j] = ck::bf2f(LA[base + (size_t)(t0 + j) * D]); x[j] = ck::bf2f(INP[base + (size_t)(t0 + j) * D]); gg[j] = GBR[base + (size_t)(t0 + j) * D]; }
#pragma unroll
            for (int j = 0; j < 16; ++j) { h = __expf(a[j]) * h + x[j]; const float y = __uint_as_float((unsigned)gg[j] << 16) * h; Y[base + (size_t)(t0 + j) * D] = (bf16)(pk2(y, y) & 0xffffu); } }
    }
}
__device__ __forceinline__ void softmax_rows(const Frame& F, const float* S, bf16* P) {
    for (int row = F.gw; row < 16 * SEQ; row += F.NGW) {
        const f32x4 s = ((const f32x4*)(S + (size_t)row * NMEM))[F.lane];
        const float mx = wave_max(fmaxf(fmaxf(s[0], s[1]), fmaxf(s[2], s[3])));
        const f32x4 e = {__expf(s[0] - mx), __expf(s[1] - mx), __expf(s[2] - mx), __expf(s[3] - mx)};
        const float inv = 1.0f / wave_sum((e[0] + e[1]) + (e[2] + e[3]));
        u32x2 w; w.x = pk2(e[0] * inv, e[1] * inv); w.y = pk2(e[2] * inv, e[3] * inv); ((u32x2*)(P + (size_t)row * NMEM))[F.lane] = w;
    }
}


__device__ __forceinline__ int uni(int v) { return __builtin_amdgcn_readfirstlane(v); }
__device__ __forceinline__ Frame make_frame(unsigned ldsb) {
    Frame F; F.lds = (LAS unsigned char*)(size_t)__builtin_amdgcn_readfirstlane(ldsb);
    F.lane = (int)__builtin_amdgcn_mbcnt_hi(~0u, __builtin_amdgcn_mbcnt_lo(~0u, 0u));
    const unsigned key = hw_wave_key(); int w = 0;
#pragma unroll
    for (int i = 1; i < NWAVES; ++i) { const unsigned k = __builtin_amdgcn_readfirstlane(*(const LAS unsigned*)(F.lds + CTRL + 16 + 4 * i)); w = (k == key) ? i : w; }
    F.wave = w; F.tid = w * 64 + F.lane;
    F.bid = __builtin_amdgcn_readfirstlane(*(const LAS int*)(F.lds + CTRL + 48)); F.G = __builtin_amdgcn_readfirstlane(*(const LAS int*)(F.lds + CTRL + 52));
    F.gw = F.bid * NWAVES + F.wave; F.NGW = F.G * NWAVES; return F;
}
__device__ __forceinline__ void phase_end(const unsigned ldsb, int bar_) {
    if (uni(bar_)) { asm volatile("" ::: "memory"); const Frame F = make_frame(ldsb); XcdBarrier b; b.bar = (unsigned*)(F.ws() + WS_CTL); b.x = xb_xcc_id(); b.st = (volatile LAS unsigned*)(F.lds + CTRL); xcd_barrier(b, F.tid, (unsigned)F.G); }
}
#define PHASE_FN static __device__ __noinline__ __attribute__((not_tail_called)) void
#define PHASE_FN_G static __device__ __forceinline__ void

__device__ __forceinline__ int cvt_njobs(int l, int part) { return part == 0 ? ((l % 3) == 1 ? 2 + 1 + 32 : 2 + 1) : 3; }
__device__ __forceinline__ CvtJob cvt_job(const Frame& F, int l, int part, int j) {
    unsigned char* ws = F.ws(); const float* ng = F.in(I_NORMG); const int kind = l % 3, idx = l / 3;
    CvtJob J; J.gk = nullptr; J.off = 0; J.gu = 0; J.nvalid = 1 << 30;
    if (j == 0) { J.W = F.in(I_WGU) + (size_t)(l * 2 + part) * D * NGU; J.WT = (bf16*)(ws + WS_WGU + (size_t)(l * 2 + part) * SZ_WGU); J.K = D; J.ldw = NGU; J.nrows = NGU; J.gu = 1; J.gk = ng + ((size_t)l * 4 + (part ? 3 : 0)) * D; return J; }
    if (j == 1) { J.W = F.in(I_WDN) + (size_t)(l * 2 + part) * DFF * D; J.WT = (bf16*)(ws + WS_WDN + (size_t)(l * 2 + part) * SZ_WDN); J.K = DFF; J.ldw = D; J.nrows = D; return J; }
    if (part == 1) { J.K = D; J.ldw = D; J.nrows = D;
        if (kind == 0) { J.W = F.in(I_HGOUT) + (size_t)idx * D * D; J.WT = (bf16*)(ws + WS_HGOUT + (size_t)idx * SZ_WDD); }
        else if (kind == 1) { J.W = F.in(I_LRUOUT); J.WT = (bf16*)(ws + WS_LRUOUT); }
        else { J.W = F.in(I_MLOUT); J.WT = (bf16*)(ws + WS_MLOUT); }
        return J; }
    J.gk = ng + ((size_t)l * 4 + 1) * D; J.K = D;
    if (kind == 0) { J.W = F.in(I_HGIN) + (size_t)idx * D * 4 * D; J.WT = (bf16*)(ws + WS_HGIN + (size_t)idx * 4 * SZ_WDD); J.ldw = 4 * D; J.nrows = 4 * D; return J; }
    if (kind == 2) { J.W = F.in(I_MLIN); J.WT = (bf16*)(ws + WS_MLIN); J.ldw = ML_IN; J.nrows = ML_PROJ; return J; }
    if (j == 2) { J.W = F.in(I_LRUIN); J.WT = (bf16*)(ws + WS_LRUIN); J.ldw = 2 * D; J.nrows = 2 * D; return J; }
    { const int q = j - 3, g = q >> 4, blk = (q >> 1) & 7, jj = q & 1;
        J.gk = nullptr; J.W = F.in(g ? I_LRUWX : I_LRUWA) + (size_t)blk * 256 * 256; J.WT = (bf16*)(ws + WS_LRUG) + (size_t)(blk * 512 + jj * 256 + g * 128) * 256; J.K = 256; J.ldw = 256; J.nrows = 128; J.off = jj * 128; return J; }
}
__device__ __forceinline__ void convert_set(const Frame& F, int& rot, int l, int part, int num0 = 0, int num1 = 8) {
    const int nj = cvt_njobs(l, part);
    for (int j = 0; j < nj; ++j) { const CvtJob J = cvt_job(F, l, part, j); convert_job_rt(F, rot, J, num0, num1); }
}
constexpr int CVT_SC = 3;
PHASE_FN_G ph_prologue(unsigned ldsb, int bar_) {
    const Frame F = make_frame(ldsb);
    unsigned char* ws = F.ws(); int rot = 0;
    convert_set(F, rot, 0, 0);
    for (int l = 0; l < DEPTH; ++l) for (int kv = 0; kv < 2; ++kv) { CvtJob J; J.gk = nullptr; J.gu = 0; J.nvalid = 1 << 30; J.K = D; J.ldw = 2 * D; J.nrows = D; J.off = kv * D;
        J.W = F.in(I_XAKV) + (size_t)l * D * 2 * D; J.WT = (bf16*)(ws + (kv ? WS_WV : WS_WK) + (size_t)l * SZ_WDD); convert_job_rt(F, rot, J); }
    for (int l = 0; l < DEPTH; ++l) { CvtJob J; J.gk = nullptr; J.gu = 0; J.nvalid = 1 << 30; J.K = D; J.ldw = D; J.nrows = D; J.off = 0;
        J.W = F.in(I_XAO) + (size_t)l * D * D; J.WT = (bf16*)(ws + WS_WO + (size_t)l * SZ_WDD); convert_job_rt(F, rot, J); }
    { const float* wq = F.in(I_XAQ); const float* ngq = F.in(I_NORMG); bf16* wqn = (bf16*)(ws + WS_WQ);
      for (size_t i = (size_t)F.bid * NT + F.tid; i < (size_t)DEPTH * D * D / 8; i += (size_t)F.G * NT) { const size_t e = i * 8; const int l = (int)(e / ((size_t)D * D)), d = (int)((e / D) % D);
          const float g = ngq[((size_t)l * 4 + 2) * D + d]; const f32x4 a = __builtin_nontemporal_load((const f32x4*)(wq + e)), b = __builtin_nontemporal_load((const f32x4*)(wq + e + 4));
          u32x4 w; w.x = pk2(a[0] * g, a[1] * g); w.y = pk2(a[2] * g, a[3] * g); w.z = pk2(b[0] * g, b[1] * g); w.w = pk2(b[2] * g, b[3] * g); *(u32x4*)(wqn + e) = w; } }
    float* misc = (float*)(ws + WS_MISC);
    const int gt = F.bid * NT + F.tid, GT = F.G * NT;
    const float* hglb = F.in(I_HGLB); const float* lamp = F.in(I_LRULAM);
    for (int c = gt; c < 2048; c += GT) {
        const float p0 = hglb[c], p1 = hglb[2048 + c], p2 = hglb[4096 + c], p3 = hglb[6144 + c];
        const float mx = fmaxf(fmaxf(p0, p1), fmaxf(p2, p3)); const float e0 = expf(p0 - mx), e1 = expf(p1 - mx), e2 = expf(p2 - mx), e3 = expf(p3 - mx); const float inv = 1.0f / (e0 + e1 + e2 + e3);
        misc[MISC_LB / 4 + c] = 0.f; misc[MISC_LB / 4 + 2048 + c] = e1 * inv; misc[MISC_LB / 4 + 4096 + c] = (e1 + e2) * inv; misc[MISC_LB / 4 + 6144 + c] = (e1 + e2 + e3) * inv;
        const float lam = lamp[c]; const float sp = fmaxf(-lam, 0.f) + log1pf(expf(-fabsf(lam)));
        misc[MISC_C8 / 4 + c] = 8.0f * sp;
    }
    { const float* mlin = F.in(I_MLIN); const float* g21 = F.in(I_NORMG) + ((size_t)2 * 4 + 1) * D;
      bf16* wgb = (bf16*)(misc + MISC_MLWG / 4);
      for (int i = gt; i < 16 * 2048; i += GT) { const int c = i >> 11, k = i & 2047; const float w_ = g21[k] * mlin[(size_t)k * ML_IN + ML_PROJ + c]; wgb[i] = (bf16)(pk2(w_, w_) & 0xffffu); } }
    x_to_stream(F, F.in(I_X), (bf16*)(ws + WS_HB), misc + MISC_SSQ / 4);
    norm_rows<false>(F, F.in(I_MEM), F.in(I_MEMG), (bf16*)(ws + WS_MEMN), MMEM, nullptr, nullptr);
    phase_end(ldsb, bar_);
}

enum { NRM_FFN1 = 0, NRM_MIX = 1, NRM_ATT = 2, NRM_FFN2 = 3 };
PHASE_FN ph_final(unsigned ldsb) { const Frame F = make_frame(ldsb); unsigned char* ws = F.ws();
    if (X_F32) final_norm(F, (const float*)(ws + WS_X), F.in(I_FINALG), F.out()); else final_norm_bf(F, (const bf16*)(ws + WS_HB), (const float*)(ws + WS_MISC) + MISC_SSQ / 4, F.in(I_FINALG), F.out()); }
constexpr size_t CTL_HCNT = 32768;
PHASE_FN_G ph_hg_recur(unsigned ldsb, int l_, int bar_) { const Frame F = make_frame(ldsb); unsigned char* ws = F.ws(); const int l = uni(l_);
    bf16* QB = (bf16*)(ws + WS_P0); bf16* KB = QB + (size_t)M * D; bf16* VB = KB + (size_t)M * D; bf16* LF = (bf16*)(ws + WS_P1); bf16* OF = LF + (size_t)2 * M * D;
    const bool fuse = F.G >= 256;
    ck::hg_chunk_phase(F, QB, LF, KB, VB, OF, VB + (size_t)M * D, F.in(I_HGG) + (l / 3) * HG_D, (bf16*)(ws + WS_YB), (float*)(ws + WS_SC), fuse ? (unsigned*)(ws + WS_CTL + CTL_HCNT) + l * 64 : nullptr); phase_end(ldsb, bar_); }
PHASE_FN ph_hg_norm(unsigned ldsb, int idx_, int bar_) { const Frame F = make_frame(ldsb); unsigned char* ws = F.ws(); const int idx = uni(idx_); if (F.G >= 256) return;
    bf16* GB = (bf16*)(ws + WS_P0) + (size_t)3 * M * D; const bf16* OF = (const bf16*)(ws + WS_P1) + (size_t)2 * M * D;
    headnorm_rows<false>(F, OF, F.in(I_HGG) + idx * HG_D, GB, D, (bf16*)(ws + WS_YB)); phase_end(ldsb, bar_); }
PHASE_FN_G ph_ml_recur(unsigned ldsb, int l_, int bar_) { const Frame F = make_frame(ldsb); unsigned char* ws = F.ws(); const int l = uni(l_); const bool fuse = F.G >= 256;
    ck::ml_chunk_phase(F, (const bf16*)(ws + WS_P0), (const float*)(ws + WS_MISC) + MISC_GATES / 4, F.in(I_MLBIF), (bf16*)(ws + WS_P1), F.in(I_MLG), (bf16*)(ws + WS_YB), (float*)(ws + WS_SC), fuse ? (unsigned*)(ws + WS_CTL + CTL_HCNT) + l * 64 : nullptr); phase_end(ldsb, bar_); }
PHASE_FN ph_ml_gates(unsigned ldsb, int bar_) { const Frame F = make_frame(ldsb); unsigned char* ws = F.ws(); const float* misc = (const float*)(ws + WS_MISC);
    ml_gates_rows(F, (const bf16*)(ws + WS_HB), misc + MISC_SSQ / 4, (const bf16*)(misc + MISC_MLWG / 4), (float*)(ws + WS_MISC) + MISC_GATES / 4); phase_end(ldsb, bar_); }
PHASE_FN ph_ml_norm(unsigned ldsb, int bar_) { const Frame F = make_frame(ldsb); unsigned char* ws = F.ws(); if (F.G >= 256) return;
    headnorm_rows<true>(F, (const bf16*)(ws + WS_P1), F.in(I_MLG), (const bf16*)(ws + WS_P0) + 4096, ML_PROJ, (bf16*)(ws + WS_YB)); phase_end(ldsb, bar_); }
PHASE_FN ph_lru_conv(unsigned ldsb, int bar_) { const Frame F = make_frame(ldsb); unsigned char* ws = F.ws();
    lru_conv(F, (const bf16*)(ws + WS_P1), F.in(I_CONVW), F.in(I_CONVB), (bf16*)(ws + WS_P0) + (size_t)M * D); phase_end(ldsb, bar_); }
PHASE_FN ph_lru_scan(unsigned ldsb, int bar_) { const Frame F = make_frame(ldsb); unsigned char* ws = F.ws();
    lru_scan(F, (const bf16*)(ws + WS_P1) + (size_t)4 * M * D, (const bf16*)(ws + WS_P1) + (size_t)2 * M * D, (const bf16*)(ws + WS_P0), (bf16*)(ws + WS_YB)); phase_end(ldsb, bar_); }
PHASE_FN ph_softmax(unsigned ldsb, int bar_) { const Frame F = make_frame(ldsb); unsigned char* ws = F.ws(); softmax_rows(F, (const float*)(ws + WS_SC), (bf16*)(ws + WS_PB)); phase_end(ldsb, bar_); }

PHASE_FN_G ph_gemm_kv(unsigned ldsb, int bar_) {
    const Frame F = make_frame(ldsb); unsigned char* ws = F.ws(); const int half = F.G >> 1;
    if (F.bid < half) { pg8::PlainSched<D, D, MMEM, 4 * D> S; S.gsub = half; S.coff = 0; S.init(F.lds, ws + WS_MEMN, ws + WS_WK);
        auto E = [=]() { const Frame F2 = make_frame(ldsb); unsigned char* ws = F2.ws(); return pg8::EpiBf16P{(bf16*)(ws + WS_KALL), 4 * D, 0, 0, 1.f, nullptr}; };
        pg8::gemm_phase(F.lds, F.tid, D, D, D, S, E); }
    else { pg8::PlainSched<D, D, MMEM, 4 * D> S; S.gsub = F.G - half; S.coff = half; S.init(F.lds, ws + WS_MEMN, ws + WS_WV);
        auto E = [=]() { const Frame F2 = make_frame(ldsb); unsigned char* ws = F2.ws(); return pg8::EpiBf16P{(bf16*)(ws + WS_VT), 4 * D, 0, 0, 1.f, nullptr}; };
        pg8::gemm_phase(F.lds, F.tid, D, D, D, S, E); }
    phase_end(ldsb, bar_);
}
PHASE_FN_G ph_gemm_mlin(unsigned ldsb, int bar_) {
    const Frame F = make_frame(ldsb); unsigned char* ws = F.ws();
    pg8::PlainSched<D, D, M, ML_PROJ> S; S.init(F.lds, ws + WS_HB, ws + WS_MLIN); auto E = [=]() { const Frame F2 = make_frame(ldsb); unsigned char* ws = F2.ws(); (void)ws; return pg8::EpiBf16P{(bf16*)(ws + WS_P0), ML_PROJ, 0, 0, 1.f, (const float*)(ws + WS_MISC) + MISC_SSQ / 4}; };
    pg8::gemm_phase(F.lds, F.tid, D, D, D, S, E); phase_end(ldsb, bar_);
}
PHASE_FN_G ph_gemm_qproj(unsigned ldsb, int l_, int bar_) {
    const Frame F = make_frame(ldsb); const int l = uni(l_); unsigned char* ws = F.ws();
    pg8::PlainSched<D, D, M, D> S; S.init(F.lds, ws + WS_HB, ws + WS_WQ + (size_t)l * SZ_WDD); auto E = [=]() { const Frame F2 = make_frame(ldsb); unsigned char* ws = F2.ws(); (void)ws; return pg8::EpiBf16P{(bf16*)(ws + WS_QB2), D, 0, 0, 1.f, (const float*)(ws + WS_MISC) + MISC_SSQ / 4}; };
    pg8::gemm_phase(F.lds, F.tid, D, D, D, S, E); phase_end(ldsb, bar_);
}
PHASE_FN_G ph_gemm_dn(unsigned ldsb, int l_, int f_, int bar_) {
    const Frame F = make_frame(ldsb); const int l = uni(l_), f = uni(f_) & 1; const float dsc = uni(f_) >= 2 ? 0.0f : 0.5f; unsigned char* ws = F.ws();
    pg8::PlainSched<DFF, DFF, M, D> S; S.init(F.lds, ws + WS_ACT, ws + WS_WDN + (size_t)(l * 2 + f) * SZ_WDN); auto E = [=]() { const Frame F2 = make_frame(ldsb); unsigned char* ws = F2.ws(); (void)ws; float* X = (float*)(ws + WS_X); const float* xin = (l == 0 && f == 0) ? F2.in(I_X) : X; return pg8::EpiResid{xin, X, (bf16*)(ws + WS_HB), (float*)(ws + WS_MISC) + MISC_SSQ / 4, dsc, F2.lds, F2.tid}; };
    pg8::gemm_phase(F.lds, F.tid, DFF, DFF, DFF, S, E); phase_end(ldsb, bar_);
}
enum { GR_MIXOUT = 0, GR_OPROJ, GR_PROBE0 };
PHASE_FN_G ph_gemm_resid(unsigned ldsb, int which_, int l_, int bar_) {
    const Frame F = make_frame(ldsb); const int which = uni(which_), l = uni(l_); unsigned char* ws = F.ws();
    const int kind = l % 3, idx = l / 3;
    const size_t wo = which == GR_OPROJ ? WS_WO + (size_t)l * SZ_WDD : (kind == 0 ? WS_HGOUT + (size_t)idx * SZ_WDD : (kind == 1 ? WS_LRUOUT : WS_MLOUT));
    const size_t ao = which == GR_OPROJ ? WS_OB : WS_YB; const float rs_ = which == GR_PROBE0 ? 0.0f : 1.0f;
    pg8::PlainSched<D, D, M, D> S; S.init(F.lds, ws + ao, ws + wo); auto E = [=]() { const Frame F2 = make_frame(ldsb); unsigned char* ws = F2.ws(); (void)ws; float* X = (float*)(ws + WS_X); return pg8::EpiResid{X, X, (bf16*)(ws + WS_HB), (float*)(ws + WS_MISC) + MISC_SSQ / 4, rs_, F2.lds, F2.tid}; };
    pg8::gemm_phase(F.lds, F.tid, D, D, D, S, E); phase_end(ldsb, bar_);
}
PHASE_FN_G ph_gemm_gu(unsigned ldsb, int l_, int f_, int bar_) {
    const Frame F = make_frame(ldsb); const int l = uni(l_), f = uni(f_); unsigned char* ws = F.ws();
    pg8::PlainSched<D, D, M, NGU> S; S.init(F.lds, ws + WS_HB, ws + WS_WGU + (size_t)(l * 2 + f) * SZ_WGU); auto E = [=]() { const Frame F2 = make_frame(ldsb); unsigned char* ws = F2.ws(); (void)ws; return pg8::EpiSwiGLU{(bf16*)(ws + WS_ACT), (const float*)(ws + WS_MISC) + MISC_SSQ / 4}; };
    pg8::gemm_phase(F.lds, F.tid, D, D, D, S, E);
    { constexpr int NU = (M / 256) * (NGU / 256); const int rounds = (NU + F.G - 1) / F.G, busy = NU - (rounds - 1) * F.G;
        const int nl = f ? l + 1 : l, np = f ? 0 : 1;
        if (nl < DEPTH && F.bid >= busy && busy < F.G) { Frame Fc = F; Fc.gw = (F.bid - busy) * NWAVES + F.wave; Fc.NGW = (F.G - busy) * NWAVES; int rot = 0; convert_set(Fc, rot, nl, np); } }
    phase_end(ldsb, bar_);
}
PHASE_FN_G ph_gemm_hgin(unsigned ldsb, int l_, int bar_) {
    const Frame F = make_frame(ldsb); const int l = uni(l_), idx = l / 3; unsigned char* ws = F.ws();
    pg8::PlainSched<D, D, M, 4 * D> S; S.init(F.lds, ws + WS_HB, ws + WS_HGIN + (size_t)idx * 4 * SZ_WDD);
    auto E = [=]() { const Frame F2 = make_frame(ldsb); unsigned char* ws = F2.ws(); (void)ws; return pg8::EpiHgIn{(bf16*)(ws + WS_P0), (bf16*)(ws + WS_P1), (const float*)(ws + WS_MISC) + MISC_LB / 4 + l * 2048, (const float*)(ws + WS_MISC) + MISC_SSQ / 4}; };
    pg8::gemm_phase(F.lds, F.tid, D, D, D, S, E); phase_end(ldsb, bar_);
}
PHASE_FN_G ph_gemm_lruin(unsigned ldsb, int bar_) {
    const Frame F = make_frame(ldsb); unsigned char* ws = F.ws();
    pg8::PlainSched<D, D, M, 2 * D> S; S.init(F.lds, ws + WS_HB, ws + WS_LRUIN); auto E = [=]() { const Frame F2 = make_frame(ldsb); unsigned char* ws = F2.ws(); (void)ws; return pg8::EpiLruIn{(bf16*)(ws + WS_P0), (bf16*)(ws + WS_P1), (const float*)(ws + WS_MISC) + MISC_SSQ / 4}; };
    pg8::gemm_phase(F.lds, F.tid, D, D, D, S, E); phase_end(ldsb, bar_);
}
PHASE_FN_G ph_gemm_lrugate(unsigned ldsb, int bar_) {
    const Frame F = make_frame(ldsb); unsigned char* ws = F.ws();
    bf16* UCB = (bf16*)(ws + WS_P0) + (size_t)M * D;
    pg8::PlainSched<D, 256, M, 4096, 1, 512> S; S.init(F.lds, UCB, ws + WS_LRUG);
    auto E = [=]() { const Frame F2 = make_frame(ldsb); unsigned char* ws = F2.ws(); (void)ws; bf16* P1b = (bf16*)(ws + WS_P1); return pg8::EpiLruGate{(const bf16*)(ws + WS_P0) + (size_t)M * D, F2.in(I_LRUBA), F2.in(I_LRUBX), (const float*)(ws + WS_MISC) + MISC_C8 / 4, P1b + (size_t)4 * M * D, P1b + (size_t)2 * M * D}; };
    pg8::gemm_phase(F.lds, F.tid, D, 256, 256, S, E); phase_end(ldsb, bar_);
}
PHASE_FN_G ph_gemm_scores(unsigned ldsb, int l_, int bar_) {
    const Frame F = make_frame(ldsb); const int l = uni(l_); unsigned char* ws = F.ws();
    pg8::BatchSched S; S.init(F.lds, ws + WS_QB2, ws + WS_KALL + (size_t)l * D * 2);
    S.a_b = SEQ * D * 2; S.a_h = XA_D * 2; S.a_pm = 256 * D * 2; S.b_b = NMEM * 4 * D * 2; S.b_h = XA_D * 2; S.b_pn = 0; S.nM = SEQ / 256; S.nN = 1; S.nwg = 16 * S.nM;
    auto E = [=]() { const Frame F2 = make_frame(ldsb); unsigned char* ws = F2.ws(); (void)ws; return pg8::EpiF32Z{(float*)(ws + WS_SC), 0.044194173824159216f}; };
    pg8::gemm_phase(F.lds, F.tid, D, 4 * D, XA_D, S, E);
    phase_end(ldsb, bar_);
}
PHASE_FN_G ph_gemm_pv(unsigned ldsb, int l_, int bar_) {
    const Frame F = make_frame(ldsb); const int l = uni(l_); unsigned char* ws = F.ws();
    pg8::BatchSched S; S.init(F.lds, ws + WS_PB, ws + WS_VT + (size_t)l * D * MMEM * 2);
    S.a_b = 4 * SEQ * NMEM * 2; S.a_h = SEQ * NMEM * 2; S.a_pm = 256 * NMEM * 2; S.b_b = NMEM * 2; S.b_h = XA_D * MMEM * 2; S.b_pn = 256 * MMEM * 2; S.nM = SEQ / 256; S.nN = 2; S.nwg = 16 * S.nM * 2;
    auto E = [=]() { const Frame F2 = make_frame(ldsb); unsigned char* ws = F2.ws(); (void)ws; return pg8::EpiBf16P{(bf16*)(ws + WS_OB), D, (size_t)SEQ * D, XA_D, 1.f, nullptr}; };
    pg8::gemm_phase(F.lds, F.tid, NMEM, MMEM, NMEM, S, E);
    phase_end(ldsb, bar_);
}

PHASE_FN_G ph_attn(unsigned ldsb, int l_, int bar_) {
    const Frame F = make_frame(ldsb); const int l = uni(l_); unsigned char* ws = F.ws();
    for (int u = F.bid; u < 256; u += F.G) {
        const int z = u >> 4, pm = (u >> 1) & 7, pn = u & 1, b = z >> 2, h = z & 3;
        bf16* Pc = (bf16*)(ws + (pn ? WS_SC : WS_PB)) + ((size_t)z * SEQ + pm * 256) * NMEM;
        { pg8::OneSched S; S.A = (const char*)((const bf16*)(ws + WS_QB2) + ((size_t)b * SEQ + pm * 256) * D + h * XA_D); S.B = (const char*)((const bf16*)(ws + WS_KALL) + (size_t)b * NMEM * 4 * D + (size_t)l * D + h * XA_D); S.u0 = pg8::Unit{pm, 0, z};
          auto E = [=]() { const Frame F2 = make_frame(ldsb); return pg8::EpiSoftmax{Pc, 0.044194173824159216f, F2.lds}; };
          pg8::gemm_phase(F.lds, F.tid, D, 4 * D, XA_D, S, E); }
        if (F.tid == 0) __builtin_amdgcn_fence(__ATOMIC_ACQUIRE, "agent");
        asm volatile("s_waitcnt vmcnt(0)" ::: "memory"); __syncthreads();
        { pg8::OneSched S; S.A = (const char*)Pc; S.B = (const char*)((const bf16*)(ws + WS_VT) + ((size_t)l * D + h * XA_D + pn * 256) * MMEM + b * NMEM); S.u0 = pg8::Unit{pm, pn, z};
          auto E = [=]() { const Frame F2 = make_frame(ldsb); unsigned char* ws2 = F2.ws(); return pg8::EpiBf16P{(bf16*)(ws2 + WS_OB), D, (size_t)SEQ * D, XA_D, 1.f, nullptr}; };
          pg8::gemm_phase(F.lds, F.tid, NMEM, MMEM, NMEM, S, E); }
    }
    phase_end(ldsb, bar_);
}

__device__ __forceinline__ void gtut_units(const Frame& F, const unsigned ldsb, int la, int lb, int gsub, int coff) {
    unsigned char* ws = F.ws(); const int c = (F.bid >= coff && F.bid < coff + gsub) ? F.bid - coff : -1;
    { pg8::GtSched S{(const char*)(ws + WS_KALL), (const char*)(ws + WS_WQ), gsub, c, la * 128, lb * 128};
      auto E = [=]() { const Frame F2 = make_frame(ldsb); unsigned char* ws2 = F2.ws(); return pg8::EpiBf16P{(bf16*)(ws2 + WS_GT), D, (size_t)4 * NMEM * D, (size_t)NMEM * D, 1.f, nullptr}; };
      pg8::gemm_phase(F.lds, F.tid, 4 * D, D, XA_D, S, E); }
    { pg8::UtSched S{(const char*)(ws + WS_WO), (const char*)(ws + WS_VT), gsub, c, la * 128, lb * 128};
      auto E = [=]() { const Frame F2 = make_frame(ldsb); unsigned char* ws2 = F2.ws(); return pg8::EpiBf16P{(bf16*)(ws2 + WS_UT), 4 * NMEM, (size_t)D * 4 * NMEM, (size_t)NMEM, 1.f, nullptr}; };
      pg8::gemm_phase(F.lds, F.tid, D, 4 * D, XA_D, S, E); }
}
PHASE_FN_G ph_gemm_gtut(unsigned ldsb, int bar_) {
    const Frame F = make_frame(ldsb); gtut_units(F, ldsb, 0, 1, F.G, 0); phase_end(ldsb, bar_);
}
PHASE_FN_G ph_attn_scores(unsigned ldsb, int l_, int bar_) {
    const Frame F = make_frame(ldsb); const int l = uni(l_); unsigned char* ws = F.ws();
    pg8::ScSched S{(const char*)(ws + WS_HB), (const char*)(ws + WS_GT) + (size_t)l * 16 * NMEM * D * 2, F.G, F.bid};
    auto E = [=]() { const Frame F2 = make_frame(ldsb); unsigned char* ws2 = F2.ws(); return pg8::EpiSoftmax{(bf16*)(ws2 + WS_PB), 0.044194173824159216f, F2.lds, (const float*)(ws2 + WS_MISC) + MISC_SSQ / 4}; };
    pg8::gemm_phase(F.lds, F.tid, D, D, D, S, E);
    if (l + 1 < DEPTH) gtut_units(F, ldsb, l + 1, l + 2, F.G > 128 ? F.G - 128 : F.G, F.G > 128 ? 128 : 0);
    phase_end(ldsb, bar_);
}
PHASE_FN_G ph_gemm_attnout(unsigned ldsb, int l_, int bar_) {
    const Frame F = make_frame(ldsb); const int l = uni(l_); unsigned char* ws = F.ws();
    pg8::PlainSched<4 * NMEM, 4 * NMEM, M, D, 30, 0, 3, (unsigned)(D * 4 * NMEM * 2)> S; S.init(F.lds, ws + WS_PB, ws + WS_UT + (size_t)l * 4 * D * 4 * NMEM * 2);
    auto E = [=]() { const Frame F2 = make_frame(ldsb); unsigned char* ws2 = F2.ws(); float* X = (float*)(ws2 + WS_X); return pg8::EpiResid{X, X, (bf16*)(ws2 + WS_HB), (float*)(ws2 + WS_MISC) + MISC_SSQ / 4, 1.0f, F2.lds, F2.tid}; };
    pg8::gemm_phase(F.lds, F.tid, 4 * NMEM, 4 * NMEM, 4 * NMEM, S, E);
    phase_end(ldsb, bar_);
}

constexpr int SLOTS = 19, PH_LAYER0 = 3, PH_FINAL = PH_LAYER0 + DEPTH * SLOTS, N_PHASES = PH_FINAL + 1;
enum { SL_NORM0 = 0, SL_GU1, SL_DN1, SL_NORM1, SL_MIXIN, SL_MIXA, SL_MIXB, SL_MIXC, SL_MIXOUT, SL_NORM2, SL_QPROJ, SL_SCORES, SL_SOFTMAX, SL_PV, SL_OPROJ, SL_NORM3, SL_GU2, SL_DN2, SL_SPARE };
__host__ __device__ constexpr bool phase_used(int ph) {
    if (ph < PH_LAYER0 || ph == PH_FINAL) return true;
    const int l = (ph - PH_LAYER0) / SLOTS, s = (ph - PH_LAYER0) % SLOTS, kind = l % 3;
    if (s == SL_SPARE || s == SL_QPROJ || s == SL_SOFTMAX || s == SL_PV || s == SL_NORM0 || s == SL_NORM1 || s == SL_NORM2 || s == SL_NORM3) return false;
    if (s == SL_MIXC) return kind != 0;
    return true;
}
__device__ __forceinline__ int ctl_lo(unsigned ldsb) { return __builtin_amdgcn_readfirstlane(*(volatile LAS int*)((LAS unsigned char*)(size_t)ldsb + CTRL + 56)); }
__device__ __forceinline__ int ctl_hi(unsigned ldsb) { return __builtin_amdgcn_readfirstlane(*(volatile LAS int*)((LAS unsigned char*)(size_t)ldsb + CTRL + 60)); }
#define RUN(k, fn, ...) do { const int hi_ = ctl_hi(ldsb); if (ctl_lo(ldsb) <= (k) && (k) < hi_) fn(ldsb, ##__VA_ARGS__, ((k) + 1 < hi_) ? 1 : 0); } while (0)

template <int L> __device__ __forceinline__ void run_layer(const unsigned ldsb) {
    constexpr int pb = PH_LAYER0 + L * SLOTS, kind = L % 3;
    RUN(pb + SL_GU1, ph_gemm_gu, L, 0);
    RUN(pb + SL_DN1, ph_gemm_dn, L, 0);
    if constexpr (kind == 0) {
        RUN(pb + SL_MIXIN, ph_gemm_hgin, L);
        RUN(pb + SL_MIXA, ph_hg_recur, L);
        RUN(pb + SL_MIXB, ph_hg_norm, L / 3);
    } else if constexpr (kind == 1) {
        RUN(pb + SL_MIXIN, ph_gemm_lruin);
        RUN(pb + SL_MIXA, ph_lru_conv);
        RUN(pb + SL_MIXB, ph_gemm_lrugate);
        RUN(pb + SL_MIXC, ph_lru_scan);
    } else {
        RUN(pb + SL_MIXIN, ph_gemm_mlin);
        RUN(pb + SL_MIXA, ph_ml_gates);
        RUN(pb + SL_MIXB, ph_ml_recur, L);
        RUN(pb + SL_MIXC, ph_ml_norm);
    }
    RUN(pb + SL_MIXOUT, ph_gemm_resid, GR_MIXOUT, L);
    RUN(pb + SL_SCORES, ph_attn_scores, L);
    RUN(pb + SL_OPROJ, ph_gemm_attnout, L);
    RUN(pb + SL_GU2, ph_gemm_gu, L, 1);
    RUN(pb + SL_DN2, ph_gemm_dn, L, 1);
}

__global__ void __launch_bounds__(NT, 2) fwd_kernel(Args args) {
    extern __shared__ __attribute__((aligned(16))) unsigned char lds_raw[];
    LAS unsigned char* lds = (LAS unsigned char*)lds_raw;
    const unsigned ldsb = (unsigned)(size_t)lds;
    {
        const int tid = threadIdx.x, lane = tid & 63, wave = tid >> 6;
        LAS unsigned* cw = (LAS unsigned*)(lds + CTRL);
        if (tid < 4) cw[tid] = 0u;
        if (lane == 0) cw[4 + wave] = hw_wave_key();
        if (tid == 0) { cw[12] = blockIdx.x; cw[13] = gridDim.x; cw[14] = (unsigned)args.ph_lo; cw[15] = (unsigned)args.ph_hi;
            LAS unsigned long long* ap = (LAS unsigned long long*)(lds + CTRL + 64);
#pragma unroll
            for (int i = 0; i < 27; ++i) ap[i] = (unsigned long long)args.in[i];
            ap[27] = (unsigned long long)args.out; ap[28] = (unsigned long long)args.ws; }
        __syncthreads();
        if (args.ph_hi - args.ph_lo > 1 && tid == 0) (void)xb_add(&((unsigned*)(args.ws + WS_CTL))[XB_XCNT(xb_xcc_id())], 1u);
    }
    RUN(0, ph_prologue);
    RUN(1, ph_gemm_kv);
    RUN(2, ph_gemm_gtut);
    run_layer<0>(ldsb); run_layer<1>(ldsb); run_layer<2>(ldsb); run_layer<3>(ldsb);
    { if (ctl_lo(ldsb) <= PH_FINAL && PH_FINAL < ctl_hi(ldsb)) ph_final(ldsb); }
}

extern "C" void kernel_launch(void* const* d_in, const int* in_sizes, int n_in, void* d_out, int out_size, void* d_ws, size_t ws_size, hipStream_t stream) {
    static int grid = 0;
    if (grid == 0) {
        if (n_in != 27 || in_sizes[0] != M * D || out_size != M * D || ws_size < WS_END) { fprintf(stderr, "kernel_launch: unexpected shapes (n_in %d, in0 %d, out %d, ws %zu < %zu)\n", n_in, n_in > 0 ? in_sizes[0] : -1, out_size, ws_size, (size_t)WS_END); grid = -1; return; }
        int dev = 0, cus = 0, per_cu = 0;
        if (hipGetDevice(&dev) != hipSuccess || hipDeviceGetAttribute(&cus, hipDeviceAttributeMultiprocessorCount, dev) != hipSuccess) { grid = -1; return; }
        if (hipFuncSetAttribute((const void*)fwd_kernel, hipFuncAttributeMaxDynamicSharedMemorySize, LDS_BYTES) != hipSuccess) { fprintf(stderr, "kernel_launch: hipFuncSetAttribute failed\n"); grid = -1; return; }
        if (hipOccupancyMaxActiveBlocksPerMultiprocessor(&per_cu, (const void*)fwd_kernel, NT, LDS_BYTES) != hipSuccess || per_cu < 1) fprintf(stderr, "kernel_launch: occupancy query reports %d\n", per_cu);
        (void)hipGetLastError();
        grid = cus;
    }
    if (grid < 0) return;
    if (hipMemsetAsync((char*)d_ws + WS_CTL, 0, CTL_BYTES, stream) != hipSuccess) { fprintf(stderr, "kernel_launch: memset failed\n"); return; }
    Args a{};
    for (int i = 0; i < 27; ++i) a.in[i] = (const float*)d_in[i];
    a.out = (float*)d_out; a.ws = (unsigned char*)d_ws;
#if MK_ONE_LAUNCH
    a.ph_lo = 0; a.ph_hi = N_PHASES;
    hipLaunchKernelGGL(fwd_kernel, dim3(grid), dim3(NT), LDS_BYTES, stream, a);
#else
    for (int ph = 0; ph < N_PHASES; ++ph) { if (!phase_used(ph)) continue; a.ph_lo = ph; a.ph_hi = ph + 1;
        hipLaunchKernelGGL(fwd_kernel, dim3(grid), dim3(NT), LDS_BYTES, stream, a);
        const hipError_t le = hipPeekAtLastError(); if (le != hipSuccess) { fprintf(stderr, "kernel_launch: launch of phase %d failed: %s\n", ph, hipGetErrorName(le)); break; } }
#endif
}
```

```cpp
#include <hip/hip_runtime.h>
#include <cstdio>
#include <cstdint>

#ifndef X_F32
#define X_F32 0
#endif
#ifndef MK_ONE_LAUNCH
#define MK_ONE_LAUNCH 1
#endif

#define LAS __attribute__((address_space(3)))
typedef unsigned short bf16;
typedef short bf16x8 __attribute__((ext_vector_type(8)));
typedef float f32x4 __attribute__((ext_vector_type(4)));
typedef float f32x2 __attribute__((ext_vector_type(2)));
typedef unsigned u32x4 __attribute__((ext_vector_type(4)));
typedef unsigned u32x2 __attribute__((ext_vector_type(2)));

constexpr int BATCH = 4, SEQ = 2048, D = 2048, DEPTH = 4, M = BATCH * SEQ;
constexpr int NMEM = 256, MMEM = BATCH * NMEM;
constexpr int DFF = 5504, NGU = 2 * DFF;
constexpr int HG_H = 16, HG_D = 128;
constexpr int ML_H = 8, ML_DQK = 128, ML_DV = 256, ML_IN = 6160, ML_PROJ = 6144;
constexpr int XA_H = 4, XA_D = 512;
constexpr float EPS = 1e-6f;
constexpr int LDS_BYTES = 147456;
constexpr int CTRL = LDS_BYTES - 512;

__device__ __forceinline__ unsigned pk2(float lo, float hi) { unsigned r; asm volatile("v_cvt_pk_bf16_f32 %0, %1, %2" : "=v"(r) : "v"(lo), "v"(hi)); return r; }
__device__ __forceinline__ float bflo(unsigned w) { return __uint_as_float(w << 16); }
__device__ __forceinline__ float bfhi(unsigned w) { return __uint_as_float(w & 0xffff0000u); }
__device__ __forceinline__ float sigmoidf_(float x) { return __builtin_amdgcn_rcpf(1.0f + __expf(-x)); }
__device__ __forceinline__ float siluf_(float x) { return x * sigmoidf_(x); }
__device__ __forceinline__ float gelu_tanh_(float x) { const float u = 0.7978845608028654f * (x + 0.044715f * x * x * x); const float t = 1.0f - 2.0f * __builtin_amdgcn_rcpf(__expf(2.0f * u) + 1.0f); return 0.5f * x * (1.0f + t); }
__device__ __forceinline__ float wave_sum(float v) {
#pragma unroll
    for (int o = 1; o < 64; o <<= 1) v += __shfl_xor(v, o);
    return v;
}
__device__ __forceinline__ float wave_max(float v) {
#pragma unroll
    for (int o = 1; o < 64; o <<= 1) v = fmaxf(v, __shfl_xor(v, o));
    return v;
}

__device__ __forceinline__ int lds_ld_i32(LAS unsigned char* p) { return __builtin_amdgcn_readfirstlane(*(volatile LAS int*)p); }
__device__ __forceinline__ const char* lds_ld_ptr(LAS unsigned char* p) { const unsigned lo = __builtin_amdgcn_readfirstlane(*(volatile LAS unsigned*)p), hi = __builtin_amdgcn_readfirstlane(*(volatile LAS unsigned*)(p + 4)); return (const char*)(((unsigned long long)hi << 32) | lo); }

namespace pg8 {
constexpr int BM = 256, BK = 64, HALF = 128, HTB = HALF * BK * 2, STAGE_BYTES = 8 * HTB, NXCD = 8, WGM = 8;
__host__ __device__ __forceinline__ int lds_byte(int r, int c) { const int st = (r >> 4) * 2 + (c >> 5), rr = r & 15, cc = c & 31, ob = rr * 64 + cc * 2; return st * 1024 + (ob ^ (((ob >> 9) & 1) << 5)); }
__host__ __device__ __forceinline__ void stage_rc(int b, int& R, int& C) { const int st = b / 1024, sb = b % 1024, swz = sb ^ (((sb >> 9) & 1) << 5); R = (st >> 1) * 16 + swz / 64; C = (st & 1) * 32 + (swz % 64) / 2; }
__host__ __device__ __forceinline__ int perm32(int rho) { const int n = rho >> 4, i = rho & 15; return 8 * (i >> 2) + 4 * n + (i & 3); }

struct Unit { int pm, pn, z; };

template <int LDA, int LDB, int MROWS, int NCOLS, int ZSHIFT = 30, int AZ = 0, int BPMSHIFT = 30, unsigned BPMSTRIDE = 0>
struct PlainSched {
    static constexpr int nM = MROWS / BM, nN = NCOLS / BM, nwg = nM * nN; static constexpr unsigned a_tile = BM * LDA * 2, b_tile = BM * LDB * 2;
    LAS unsigned char* lds; int gsub = 0, coff = 0;
    __device__ void init(LAS unsigned char* lds_, const void* A_, const void* B_) { lds = lds_;
        *(volatile LAS unsigned long long*)(lds + CTRL + 304) = (unsigned long long)A_; *(volatile LAS unsigned long long*)(lds + CTRL + 312) = (unsigned long long)B_; __syncthreads(); }
    __device__ bool next(int i, Unit& u) const {
        const int G = gsub > 0 ? gsub : lds_ld_i32(lds + CTRL + 52), c = lds_ld_i32(lds + CTRL + 48) - coff;
        const int L = i * G + c; if (L >= nwg) return false;
        int wgid = L; { constexpr int q = nwg / NXCD, r = nwg % NXCD; const int xcd = wgid % NXCD, off = wgid / NXCD; wgid = (xcd < r ? xcd * (q + 1) : r * (q + 1) + (xcd - r) * q) + off; }
        constexpr int nig = WGM * nN; const int gid = wgid / nig, fm = gid * WGM, gsz = (nM - fm) < WGM ? (nM - fm) : WGM;
        u.pm = fm + ((wgid % nig) % gsz); u.pn = (wgid % nig) / gsz; u.z = u.pn >> ZSHIFT; return true;
    }
    __device__ __forceinline__ const char* a_ptr(const Unit& u) const { return lds_ld_ptr(lds + CTRL + 304) + (size_t)((unsigned)u.pm * a_tile) + (size_t)((unsigned)u.z * (unsigned)AZ); }
    __device__ __forceinline__ const char* b_ptr(const Unit& u) const { return lds_ld_ptr(lds + CTRL + 312) + (size_t)((unsigned)u.pn * b_tile) + (size_t)((unsigned)(u.pm >> BPMSHIFT) * BPMSTRIDE); }
};
struct BatchSched {
    LAS unsigned char* lds; unsigned a_b, a_h, a_pm, b_b, b_h, b_pn; int nM, nN, nwg;
    __device__ void init(LAS unsigned char* lds_, const void* A_, const void* B_) { lds = lds_;
        *(volatile LAS unsigned long long*)(lds + CTRL + 304) = (unsigned long long)A_; *(volatile LAS unsigned long long*)(lds + CTRL + 312) = (unsigned long long)B_; __syncthreads(); }
    __device__ bool next(int i, Unit& u) const {
        const int G = lds_ld_i32(lds + CTRL + 52), c = lds_ld_i32(lds + CTRL + 48);
        const int L = i * G + c; if (L >= nwg) return false;
        const int per = nM * nN, z = L / per, r = L % per; u.pm = r % nM; u.pn = r / nM; u.z = z;
        return true;
    }
    __device__ __forceinline__ const char* a_ptr(const Unit& u) const { return lds_ld_ptr(lds + CTRL + 304) + (size_t)((unsigned)(u.z >> 2) * a_b) + (size_t)((unsigned)(u.z & 3) * a_h) + (size_t)((unsigned)u.pm * a_pm); }
    __device__ __forceinline__ const char* b_ptr(const Unit& u) const { return lds_ld_ptr(lds + CTRL + 312) + (size_t)((unsigned)(u.z >> 2) * b_b) + (size_t)((unsigned)(u.z & 3) * b_h) + (size_t)((unsigned)u.pn * b_pn); }
};

typedef f32x4 Acc[2][2][4][2];

__device__ __forceinline__ void load_rstd(const float* SSQ, int row0, float (&rs)[2][4]) {
#pragma unroll
    for (int ai = 0; ai < 2; ++ai)
#pragma unroll
        for (int m = 0; m < 4; ++m) { const float* p = SSQ + (size_t)(row0 + ai * HALF + m * 16) * 8; const f32x4 a = *(const f32x4*)p, b = *(const f32x4*)(p + 4);
            rs[ai][m] = 1.0f / sqrtf((((a[0] + a[1]) + (a[2] + a[3])) + ((b[0] + b[1]) + (b[2] + b[3]))) * (1.0f / D) + EPS); }
}
struct EpiBf16P {
    static constexpr bool PERM = true;
    bf16* O; int ldc; size_t zb, zh; float scale; const float* SSQ; int cgrp = 0; size_t cgs = 0;
    __device__ __forceinline__ void operator()(const Acc& acc, const Unit& u, int wr, int wc, int fr, int fq) const {
        bf16* base = O + (size_t)(u.z >> 2) * zb + (size_t)(u.z & 3) * zh; int pnl = u.pn;
        if (cgrp > 0) { base += (size_t)(u.pn / cgrp) * cgs; pnl = u.pn % cgrp; }
        const int row0 = u.pm * BM + wr * 64 + fr, col0 = pnl * BM + wc * 32 + 8 * fq;
        float rs[2][4];
        if (SSQ) load_rstd(SSQ, row0, rs); else {
#pragma unroll
            for (int ai = 0; ai < 2; ++ai)
#pragma unroll
                for (int m = 0; m < 4; ++m) rs[ai][m] = 1.0f; }
#pragma unroll
        for (int ai = 0; ai < 2; ++ai)
#pragma unroll
            for (int m = 0; m < 4; ++m) { bf16* rowp = base + (size_t)(row0 + ai * HALF + m * 16) * ldc + col0; const float sc = scale * rs[ai][m];
#pragma unroll
                for (int bj = 0; bj < 2; ++bj) { const f32x4 v0 = acc[ai][bj][m][0] * sc, v1 = acc[ai][bj][m][1] * sc;
                    u32x4 w; w.x = pk2(v0[0], v0[1]); w.y = pk2(v0[2], v0[3]); w.z = pk2(v1[0], v1[1]); w.w = pk2(v1[2], v1[3]);
                    *(u32x4*)(rowp + bj * HALF) = w; } }
    }
};
struct EpiMlIn {
    static constexpr bool PERM = true;
    bf16* PB; float* GATES; const float* SSQ;
    __device__ __forceinline__ void operator()(const Acc& acc, const Unit& u, int wr, int wc, int fr, int fq) const {
        const int row0 = u.pm * BM + wr * 64 + fr, col0 = u.pn * BM + wc * 32 + 8 * fq;
        float rs[2][4]; load_rstd(SSQ, row0, rs);
        if (u.pn < 24) {
#pragma unroll
            for (int ai = 0; ai < 2; ++ai)
#pragma unroll
                for (int m = 0; m < 4; ++m) { bf16* rowp = PB + (size_t)(row0 + ai * HALF + m * 16) * ML_PROJ + col0; const float sc = rs[ai][m];
#pragma unroll
                    for (int bj = 0; bj < 2; ++bj) { const f32x4 v0 = acc[ai][bj][m][0] * sc, v1 = acc[ai][bj][m][1] * sc;
                        u32x4 w; w.x = pk2(v0[0], v0[1]); w.y = pk2(v0[2], v0[3]); w.z = pk2(v1[0], v1[1]); w.w = pk2(v1[2], v1[3]);
                        *(u32x4*)(rowp + bj * HALF) = w; } }
        } else if (wc == 0 && fq < 2) {
#pragma unroll
            for (int ai = 0; ai < 2; ++ai)
#pragma unroll
                for (int m = 0; m < 4; ++m) { float* gp = GATES + (size_t)(row0 + ai * HALF + m * 16) * 16 + 8 * fq; const float sc = rs[ai][m];
                    *(f32x4*)gp = acc[ai][0][m][0] * sc; *(f32x4*)(gp + 4) = acc[ai][0][m][1] * sc; }
        }
    }
};
struct EpiSwiGLU {
    static constexpr bool PERM = true;
    bf16* O; const float* SSQ;
    __device__ __forceinline__ void operator()(const Acc& acc, const Unit& u, int wr, int wc, int fr, int fq) const {
        const int row0 = u.pm * BM + wr * 64 + fr, col0 = u.pn * HALF + wc * 32 + 8 * fq;
        float rs[2][4]; load_rstd(SSQ, row0, rs);
#pragma unroll
        for (int ai = 0; ai < 2; ++ai)
#pragma unroll
            for (int m = 0; m < 4; ++m) { bf16* p = O + (size_t)(row0 + ai * HALF + m * 16) * DFF + col0; const float sc = rs[ai][m];
                const f32x4 g0 = acc[ai][0][m][0] * sc, g1 = acc[ai][0][m][1] * sc, u0 = acc[ai][1][m][0] * sc, u1 = acc[ai][1][m][1] * sc;
                u32x4 w; w.x = pk2(siluf_(g0[0]) * u0[0], siluf_(g0[1]) * u0[1]); w.y = pk2(siluf_(g0[2]) * u0[2], siluf_(g0[3]) * u0[3]);
                w.z = pk2(siluf_(g1[0]) * u1[0], siluf_(g1[1]) * u1[1]); w.w = pk2(siluf_(g1[2]) * u1[2], siluf_(g1[3]) * u1[3]);
                *(u32x4*)p = w; }
    }
};
template <bool XF32> struct EpiResidT {
    static constexpr bool PERM = true;
    const float* Xin; float* Xout; bf16* XB; float* SSQ; float scale; LAS unsigned char* lds; int tid;
    __device__ __forceinline__ void operator()(const Acc& acc, const Unit& u, int wr, int wc, int fr, int fq) const {
        typedef __attribute__((address_space(1))) const f32x4 gcf4; typedef __attribute__((address_space(1))) f32x4 gf4; typedef __attribute__((address_space(1))) u32x4 gu4;
        typedef __attribute__((address_space(1))) const float gcf; typedef __attribute__((address_space(1))) float gf; typedef __attribute__((address_space(1))) bf16 gb;
        gcf* xin = (gcf*)Xin; gf* xout = (gf*)Xout; gb* xb = (gb*)XB;
        const int row0 = u.pm * BM + wr * 64 + fr, col0 = u.pn * BM + wc * 32 + 8 * fq;
        LAS float* red = (LAS float*)(lds + STAGE_BYTES);
#pragma unroll
        for (int ai = 0; ai < 2; ++ai)
#pragma unroll
            for (int m = 0; m < 4; ++m) { const unsigned off = (unsigned)(row0 + ai * HALF + m * 16) * (unsigned)D + (unsigned)col0; float ss = 0.f;
#pragma unroll
                for (int bj = 0; bj < 2; ++bj) { const unsigned o = off + bj * HALF; f32x4 x0, x1;
                    if constexpr (XF32) { x0 = *(gcf4*)(xin + o); x1 = *(gcf4*)(xin + o + 4); }
                    else { const u32x4 w = *(const gu4*)(xb + o); x0 = (f32x4){bflo(w.x), bfhi(w.x), bflo(w.y), bfhi(w.y)}; x1 = (f32x4){bflo(w.z), bfhi(w.z), bflo(w.w), bfhi(w.w)}; }
                    x0 += acc[ai][bj][m][0] * scale; x1 += acc[ai][bj][m][1] * scale;
                    if constexpr (XF32) { *(gf4*)(xout + o) = x0; *(gf4*)(xout + o + 4) = x1; }
                    u32x4 w; w.x = pk2(x0[0], x0[1]); w.y = pk2(x0[2], x0[3]); w.z = pk2(x1[0], x1[1]); w.w = pk2(x1[2], x1[3]); *(gu4*)(xb + o) = w;
                    ss += ((x0[0] * x0[0] + x0[1] * x0[1]) + (x0[2] * x0[2] + x0[3] * x0[3])) + ((x1[0] * x1[0] + x1[1] * x1[1]) + (x1[2] * x1[2] + x1[3] * x1[3]));
                    asm volatile("" ::: "memory"); }
                ss += __shfl_xor(ss, 16); ss += __shfl_xor(ss, 32);
                if (fq == 0) red[(ai * HALF + wr * 64 + m * 16 + fr) * 4 + wc] = ss; }
        asm volatile("s_waitcnt lgkmcnt(0)" ::: "memory"); __builtin_amdgcn_s_barrier(); asm volatile("" ::: "memory");
        if (tid < 256) { const f32x4 r = *(const LAS f32x4*)(red + tid * 4); SSQ[(size_t)(u.pm * BM + tid) * 8 + u.pn] = (r[0] + r[1]) + (r[2] + r[3]); }
        asm volatile("s_waitcnt lgkmcnt(0)" ::: "memory"); __builtin_amdgcn_s_barrier(); asm volatile("" ::: "memory");
    }
};
typedef EpiResidT<(X_F32 != 0)> EpiResid;
struct EpiHgIn {
    static constexpr bool PERM = true;
    bf16* P0; bf16* LF; const float* lb; const float* SSQ;
    __device__ __forceinline__ void operator()(const Acc& acc, const Unit& u, int wr, int wc, int fr, int fq) const {
        const int grp = u.pn >> 3; const int row0 = u.pm * BM + wr * 64 + fr, col0 = (u.pn & 7) * BM + wc * 32 + 8 * fq;
        float rs[2][4]; load_rstd(SSQ, row0, rs);
        if (grp == 1) {
#pragma unroll
            for (int bj = 0; bj < 2; ++bj) {
                const f32x4 l0 = *(const f32x4*)(lb + col0 + bj * HALF), l1 = *(const f32x4*)(lb + col0 + bj * HALF + 4);
                const float lbv[8] = {l0[0], l0[1], l0[2], l0[3], l1[0], l1[1], l1[2], l1[3]};
#pragma unroll
                for (int ai = 0; ai < 2; ++ai)
#pragma unroll
                    for (int m = 0; m < 4; ++m) { const size_t o = (size_t)(row0 + ai * HALF + m * 16) * D + col0 + bj * HALF;
                        const f32x4 v0 = acc[ai][bj][m][0] * rs[ai][m], v1 = acc[ai][bj][m][1] * rs[ai][m];
                        const float a[8] = {v0[0], v0[1], v0[2], v0[3], v1[0], v1[1], v1[2], v1[3]};
                        float lf[8];
#pragma unroll
                        for (int j = 0; j < 8; ++j) { const float e = __expf(-a[j]); const float sg = __builtin_amdgcn_rcpf(1.0f + e); const float om = 1.0f - lbv[j];
                            const float f = lbv[j] + om * sg; lf[j] = __logf(fmaxf(f, 1e-12f)); }
                        { u32x4 w; w.x = pk2(lf[0], lf[1]); w.y = pk2(lf[2], lf[3]); w.z = pk2(lf[4], lf[5]); w.w = pk2(lf[6], lf[7]); *(u32x4*)(LF + o) = w; }
                        asm volatile("" ::: "memory"); }
            }
        } else {
            bf16* dst = P0 + (size_t)grp * M * D;
#pragma unroll
            for (int ai = 0; ai < 2; ++ai)
#pragma unroll
                for (int m = 0; m < 4; ++m) { const size_t ro = (size_t)(row0 + ai * HALF + m * 16) * D + col0;
#pragma unroll
                    for (int bj = 0; bj < 2; ++bj) { const f32x4 v0 = acc[ai][bj][m][0] * rs[ai][m], v1 = acc[ai][bj][m][1] * rs[ai][m];
                        float a[8] = {v0[0], v0[1], v0[2], v0[3], v1[0], v1[1], v1[2], v1[3]};
                        if (grp != 2) {
#pragma unroll
                            for (int j = 0; j < 8; ++j) a[j] = siluf_(a[j]); }
                        u32x4 w; w.x = pk2(a[0], a[1]); w.y = pk2(a[2], a[3]); w.z = pk2(a[4], a[5]); w.w = pk2(a[6], a[7]);
                        *(u32x4*)(dst + ro + bj * HALF) = w; }
                    asm volatile("" ::: "memory"); }
        }
    }
};
struct EpiLruIn {
    static constexpr bool PERM = true;
    bf16* GBR; bf16* UR; const float* SSQ;
    __device__ __forceinline__ void operator()(const Acc& acc, const Unit& u, int wr, int wc, int fr, int fq) const {
        const int grp = u.pn >> 3; const int row0 = u.pm * BM + wr * 64 + fr, col0 = (u.pn & 7) * BM + wc * 32 + 8 * fq;
        float rs[2][4]; load_rstd(SSQ, row0, rs);
#pragma unroll
        for (int ai = 0; ai < 2; ++ai)
#pragma unroll
            for (int m = 0; m < 4; ++m) { const size_t ro = (size_t)(row0 + ai * HALF + m * 16) * D + col0;
#pragma unroll
                for (int bj = 0; bj < 2; ++bj) { const f32x4 v0 = acc[ai][bj][m][0] * rs[ai][m], v1 = acc[ai][bj][m][1] * rs[ai][m]; const size_t o = ro + bj * HALF;
                    if (grp == 0) { u32x4 w; w.x = pk2(gelu_tanh_(v0[0]), gelu_tanh_(v0[1])); w.y = pk2(gelu_tanh_(v0[2]), gelu_tanh_(v0[3])); w.z = pk2(gelu_tanh_(v1[0]), gelu_tanh_(v1[1])); w.w = pk2(gelu_tanh_(v1[2]), gelu_tanh_(v1[3]));
                        *(u32x4*)(GBR + o) = w; }
                    else { u32x4 w; w.x = pk2(v0[0], v0[1]); w.y = pk2(v0[2], v0[3]); w.z = pk2(v1[0], v1[1]); w.w = pk2(v1[2], v1[3]); *(u32x4*)(UR + o) = w; } } }
    }
};
struct EpiLruGate {
    static constexpr bool PERM = false;
    const bf16* UC; const float* ba; const float* bx; const float* c8; bf16* LA; bf16* INP;
    __device__ __forceinline__ void operator()(const Acc& acc, const Unit& u, int wr, int wc, int fr, int fq) const {
        const int row0 = u.pm * BM + wr * 64 + fr, ch0 = u.z * 256 + (u.pn & 1) * HALF + wc * 32 + 4 * fq;
#pragma unroll
        for (int n = 0; n < 2; ++n) { const int ch = ch0 + 16 * n;
            const f32x4 vba = *(const f32x4*)(ba + ch), vbx = *(const f32x4*)(bx + ch), vc8 = *(const f32x4*)(c8 + ch);
#pragma unroll
            for (int ai = 0; ai < 2; ++ai)
#pragma unroll
                for (int m = 0; m < 4; ++m) { const size_t o = (size_t)(row0 + ai * HALF + m * 16) * D + ch;
                    const u32x2 uw = *(const u32x2*)(UC + o); const f32x4 uu = {bflo(uw.x), bfhi(uw.x), bflo(uw.y), bfhi(uw.y)}; const f32x4 pa = acc[ai][0][m][n] + vba, px = acc[ai][1][m][n] + vbx;
                    f32x4 av, iv;
#pragma unroll
                    for (int j = 0; j < 4; ++j) { const float r = sigmoidf_(pa[j]), ig = sigmoidf_(px[j]); const float la = -vc8[j] * r;
                        const float mult = sqrtf(fmaxf(-expm1f(2.0f * la), 0.0f)); av[j] = la; iv[j] = mult * (ig * uu[j]); }
                    { u32x2 wa, wi; wa.x = pk2(av[0], av[1]); wa.y = pk2(av[2], av[3]); wi.x = pk2(iv[0], iv[1]); wi.y = pk2(iv[2], iv[3]); *(u32x2*)(LA + o) = wa; *(u32x2*)(INP + o) = wi; } asm volatile("" ::: "memory"); } }
    }
};
struct EpiF32Z {
    static constexpr bool PERM = false;
    float* S; float scale;
    __device__ __forceinline__ void operator()(const Acc& acc, const Unit& u, int wr, int wc, int fr, int fq) const {
        float* base = S + (size_t)u.z * SEQ * NMEM; const int row0 = u.pm * BM + wr * 64 + fr, col0 = wc * 32 + 4 * fq;
#pragma unroll
        for (int ai = 0; ai < 2; ++ai)
#pragma unroll
            for (int m = 0; m < 4; ++m) { float* rowp = base + (size_t)(row0 + ai * HALF + m * 16) * NMEM + col0;
#pragma unroll
                for (int bj = 0; bj < 2; ++bj)
#pragma unroll
                    for (int n = 0; n < 2; ++n) *(f32x4*)(rowp + bj * HALF + n * 16) = acc[ai][bj][m][n] * scale; }
    }
};

struct GtSched { const char* Kall; const char* Wq; int G, c, L0, L1;
    __device__ bool next(int i, Unit& u) const { const int L = L0 + i * G + c; if (c < 0 || L >= L1) return false; u.pm = 0; u.pn = L & 7; u.z = L >> 3; return true; }
    __device__ __forceinline__ const char* a_ptr(const Unit& u) const { const int l = u.z >> 4, b = (u.z >> 2) & 3, h = u.z & 3; return Kall + ((size_t)b * NMEM * 4 * D + (size_t)l * D + h * XA_D) * 2; }
    __device__ __forceinline__ const char* b_ptr(const Unit& u) const { const int l = u.z >> 4, h = u.z & 3; return Wq + ((size_t)l * D * D + (size_t)u.pn * 256 * D + h * XA_D) * 2; }
};
struct UtSched { const char* Wo; const char* Vall; int G, c, L0, L1;
    __device__ bool next(int i, Unit& u) const { const int L = L0 + i * G + c; if (c < 0 || L >= L1) return false; u.pm = L & 7; u.pn = 0; u.z = L >> 3; return true; }
    __device__ __forceinline__ const char* a_ptr(const Unit& u) const { const int l = u.z >> 4, h = u.z & 3; return Wo + ((size_t)l * D * D + (size_t)u.pm * 256 * D + h * XA_D) * 2; }
    __device__ __forceinline__ const char* b_ptr(const Unit& u) const { const int l = u.z >> 4, b = (u.z >> 2) & 3, h = u.z & 3; return Vall + ((size_t)b * NMEM * 4 * D + (size_t)l * D + h * XA_D) * 2; }
};
struct ScSched { const char* XBp; const char* GTl; int G, c;
    __device__ bool next(int i, Unit& u) const { const int L = i * G + c; if (L >= 16 * 8) return false; u.pm = L & 7; u.pn = 0; u.z = L >> 3; return true; }
    __device__ __forceinline__ const char* a_ptr(const Unit& u) const { return XBp + ((size_t)(u.z >> 2) * SEQ + (size_t)u.pm * 256) * D * 2; }
    __device__ __forceinline__ const char* b_ptr(const Unit& u) const { return GTl + (size_t)u.z * NMEM * D * 2; }
};
struct OneSched {
    const char* A; const char* B; Unit u0;
    __device__ bool next(int i, Unit& u) const { if (i > 0) return false; u = u0; return true; }
    __device__ __forceinline__ const char* a_ptr(const Unit&) const { return A; }
    __device__ __forceinline__ const char* b_ptr(const Unit&) const { return B; }
};
struct EpiSoftmax {
    static constexpr bool PERM = true;
    bf16* Pall; float scale0; LAS unsigned char* lds; const float* SSQ;
    __device__ __forceinline__ void operator()(const Acc& acc, const Unit& u, int wr, int wc, int fr, int fq) const {
        LAS float* rmax = (LAS float*)(lds + STAGE_BYTES); LAS float* rsum = rmax + 1024;
        const int growb = (u.z >> 2) * SEQ + u.pm * BM; bf16* P = Pall + (size_t)growb * (4 * NMEM) + (u.z & 3) * NMEM;
        float rs[2][4]; load_rstd(SSQ, growb + wr * 64 + fr, rs);
        float mx[2][4];
#pragma unroll
        for (int ai = 0; ai < 2; ++ai)
#pragma unroll
            for (int m = 0; m < 4; ++m) { float v = -3.0e38f;
#pragma unroll
                for (int bj = 0; bj < 2; ++bj)
#pragma unroll
                    for (int n = 0; n < 2; ++n) { const f32x4 a = acc[ai][bj][m][n]; v = fmaxf(v, fmaxf(fmaxf(a[0], a[1]), fmaxf(a[2], a[3]))); }
                v = fmaxf(v, __shfl_xor(v, 16)); v = fmaxf(v, __shfl_xor(v, 32));
                if (fq == 0) rmax[(ai * HALF + wr * 64 + m * 16 + fr) * 4 + wc] = v; }
        asm volatile("s_waitcnt lgkmcnt(0)" ::: "memory"); __builtin_amdgcn_s_barrier(); asm volatile("" ::: "memory");
#pragma unroll
        for (int ai = 0; ai < 2; ++ai)
#pragma unroll
            for (int m = 0; m < 4; ++m) { const int rl = ai * HALF + wr * 64 + m * 16 + fr; const f32x4 r = *(const LAS f32x4*)(rmax + rl * 4); const float mxa = fmaxf(fmaxf(r[0], r[1]), fmaxf(r[2], r[3])); mx[ai][m] = mxa; const float scale = scale0 * rs[ai][m];
                float s = 0.f;
#pragma unroll
                for (int bj = 0; bj < 2; ++bj)
#pragma unroll
                    for (int n = 0; n < 2; ++n) { const f32x4 a = acc[ai][bj][m][n]; s += (__expf((a[0] - mxa) * scale) + __expf((a[1] - mxa) * scale)) + (__expf((a[2] - mxa) * scale) + __expf((a[3] - mxa) * scale)); }
                s += __shfl_xor(s, 16); s += __shfl_xor(s, 32);
                if (fq == 0) rsum[rl * 4 + wc] = s; }
        asm volatile("s_waitcnt lgkmcnt(0)" ::: "memory"); __builtin_amdgcn_s_barrier(); asm volatile("" ::: "memory");
#pragma unroll
        for (int ai = 0; ai < 2; ++ai)
#pragma unroll
            for (int m = 0; m < 4; ++m) { const int rl = ai * HALF + wr * 64 + m * 16 + fr; const f32x4 r = *(const LAS f32x4*)(rsum + rl * 4); const float inv = 1.0f / ((r[0] + r[1]) + (r[2] + r[3])); const float mxa = mx[ai][m]; const float scale = scale0 * rs[ai][m];
                bf16* rowp = P + (size_t)rl * (4 * NMEM) + wc * 32 + 8 * fq;
#pragma unroll
                for (int bj = 0; bj < 2; ++bj) { const f32x4 a0 = acc[ai][bj][m][0], a1 = acc[ai][bj][m][1];
                    u32x4 w; w.x = pk2(__expf((a0[0] - mxa) * scale) * inv, __expf((a0[1] - mxa) * scale) * inv); w.y = pk2(__expf((a0[2] - mxa) * scale) * inv, __expf((a0[3] - mxa) * scale) * inv);
                    w.z = pk2(__expf((a1[0] - mxa) * scale) * inv, __expf((a1[1] - mxa) * scale) * inv); w.w = pk2(__expf((a1[2] - mxa) * scale) * inv, __expf((a1[3] - mxa) * scale) * inv);
                    *(u32x4*)(rowp + bj * HALF) = w; } }
        asm volatile("s_waitcnt lgkmcnt(0)" ::: "memory"); __builtin_amdgcn_s_barrier(); asm volatile("" ::: "memory");
    }
};

template <class Epi, class Sched, class MkEpi, bool ALIGN_EPI = true, bool SP2 = true>
__device__ __forceinline__ void gemm_phase_(LAS unsigned char* lds, const int tid, const int lda, const int ldb, const int K, const Sched& S, const MkEpi& mk) {
    const int wid = __builtin_amdgcn_readfirstlane(tid >> 6), lane = tid & 63, wr = wid >> 2, wc = wid & 3, fr = lane & 15, fq = lane >> 4;
    int nt = K / BK; asm volatile("" : "+s"(nt));
    unsigned voffA[2], voffB[2];
#pragma unroll
    for (int i = 0; i < 2; ++i) { int R, C; stage_rc(tid * 16 + i * 8192, R, C); const int Rb = Epi::PERM ? ((R & ~31) + perm32(R & 31)) : R;
        voffA[i] = (unsigned)(R * lda + C) * 2u; voffB[i] = (unsigned)(Rb * ldb + C) * 2u; }
    constexpr unsigned kstep = BK * 2;
    const unsigned hstepA = (unsigned)(HALF * lda * 2), hstepB = (unsigned)(HALF * ldb * 2);
    const unsigned ldsw = (unsigned)wid * 1024u;
    const int aoff = lds_byte(wr * 64 + fr, fq * 8), boff = lds_byte(wc * 32 + fr, fq * 8);
#define PG8_SA(b, h) (((b) * 2 + (h)) * HTB)
#define PG8_SB(b, h) ((4 + (b) * 2 + (h)) * HTB)
#define PG8_STAGE(bufoff, gbase, voff) do { _Pragma("unroll") for (int _i = 0; _i < 2; ++_i) \
        __builtin_amdgcn_global_load_lds((const unsigned*)((const char*)(gbase) + (voff)[_i]), (LAS unsigned*)(lds + (bufoff) + ldsw + _i * 8192), 16, 0, 0); } while (0)
#define PG8_LDA(dst, b, h) do { _Pragma("unroll") for (int m = 0; m < 4; ++m) _Pragma("unroll") for (int k = 0; k < 2; ++k) dst[m][k] = *(const LAS bf16x8*)(lds + PG8_SA(b, h) + aoff + m * 2048 + k * 1024); } while (0)
#define PG8_LDB(dst, b, h) do { _Pragma("unroll") for (int n = 0; n < 2; ++n) _Pragma("unroll") for (int k = 0; k < 2; ++k) dst[n][k] = *(const LAS bf16x8*)(lds + PG8_SB(b, h) + boff + n * 2048 + k * 1024); } while (0)
#define PG8_MMA(ai, bj, At, Bt) do { __builtin_amdgcn_s_setprio(1); _Pragma("unroll") for (int m = 0; m < 4; ++m) _Pragma("unroll") for (int n = 0; n < 2; ++n) _Pragma("unroll") for (int k = 0; k < 2; ++k) \
        acc[ai][bj][m][n] = __builtin_amdgcn_mfma_f32_16x16x32_bf16(Bt[n][k], At[m][k], acc[ai][bj][m][n], 0, 0, 0); __builtin_amdgcn_s_setprio(0); } while (0)
#define PG8_WAIT_V(n) asm volatile("s_waitcnt vmcnt(" #n ")" ::: "memory")
#define PG8_WAIT_L(n) asm volatile("s_waitcnt lgkmcnt(" #n ")" ::: "memory")
#define PG8_BAR __builtin_amdgcn_s_barrier()
#define PG8_SCHED __builtin_amdgcn_sched_barrier(0)
    Unit cur, nxt; int ui = 0;
    if (!S.next(0, cur)) return;
    f32x4 acc[2][2][4][2];
#pragma unroll
    for (int a = 0; a < 2; ++a)
#pragma unroll
        for (int b = 0; b < 2; ++b)
#pragma unroll
            for (int m = 0; m < 4; ++m)
#pragma unroll
                for (int n = 0; n < 2; ++n) acc[a][b][m][n] = (f32x4){0.f, 0.f, 0.f, 0.f};
    bf16x8 At[4][2], B0[2][2], B1[2][2];
    const char* cA = S.a_ptr(cur); const char* cB = S.b_ptr(cur);
    if constexpr (SP2) {
        PG8_STAGE(PG8_SB(0, 0), cB, voffB); PG8_STAGE(PG8_SB(0, 1), cB + hstepB, voffB); PG8_STAGE(PG8_SA(0, 0), cA, voffA); PG8_STAGE(PG8_SA(0, 1), cA + hstepA, voffA);
        if (wr == 1) PG8_BAR;
        PG8_WAIT_V(2); PG8_BAR;
        PG8_STAGE(PG8_SB(1, 0), cB + kstep, voffB); PG8_STAGE(PG8_SA(1, 0), cA + kstep, voffA); PG8_STAGE(PG8_SB(1, 1), cB + hstepB + kstep, voffB);
        PG8_WAIT_V(6); PG8_BAR;
    } else {
        PG8_STAGE(PG8_SB(0, 0), cB, voffB); PG8_STAGE(PG8_SA(0, 0), cA, voffA); PG8_STAGE(PG8_SB(0, 1), cB + hstepB, voffB); PG8_STAGE(PG8_SA(0, 1), cA + hstepA, voffA);
        if (wr == 1) PG8_BAR;
        PG8_WAIT_V(4); PG8_BAR;
        PG8_STAGE(PG8_SB(1, 0), cB + kstep, voffB); PG8_STAGE(PG8_SA(1, 0), cA + kstep, voffA); PG8_STAGE(PG8_SB(1, 1), cB + hstepB + kstep, voffB);
        PG8_WAIT_V(6); PG8_BAR;
    }
    for (;;) {
        const bool has_next = S.next(ui + 1, nxt);
        if (!has_next) nxt = cur;
        const char* nA = S.a_ptr(nxt); const char* nB = S.b_ptr(nxt);
        for (int t = 0; t < nt; t += 2) {
            const bool last = (t == nt - 2);
            const char* a1 = cA + (size_t)(t + 1) * kstep;
            const char* a2 = last ? nA : cA + (size_t)(t + 2) * kstep; const char* b2 = last ? nB : cB + (size_t)(t + 2) * kstep;
            const char* a3 = a2 + kstep; const char* b3 = b2 + kstep;
            if constexpr (SP2) {
            PG8_LDB(B0, 0, 0); PG8_LDB(B1, 0, 1); PG8_SCHED; PG8_LDA(At, 0, 0); PG8_STAGE(PG8_SA(1, 1), a1 + hstepA, voffA);
            PG8_WAIT_V(8); PG8_WAIT_L(0); PG8_BAR; PG8_MMA(0, 0, At, B0); PG8_MMA(0, 1, At, B1); PG8_BAR; PG8_SCHED;
            PG8_LDA(At, 0, 1); PG8_STAGE(PG8_SB(0, 0), b2, voffB); PG8_STAGE(PG8_SB(0, 1), b2 + hstepB, voffB); PG8_STAGE(PG8_SA(0, 0), a2, voffA);
            PG8_WAIT_V(8); PG8_WAIT_L(0); PG8_BAR; PG8_MMA(1, 0, At, B0); PG8_MMA(1, 1, At, B1); PG8_BAR; PG8_SCHED;
            PG8_LDB(B0, 1, 0); PG8_LDB(B1, 1, 1); PG8_SCHED; PG8_LDA(At, 1, 0); PG8_STAGE(PG8_SA(0, 1), a2 + hstepA, voffA);
            PG8_WAIT_V(8); PG8_WAIT_L(0); PG8_BAR; PG8_MMA(0, 0, At, B0); PG8_MMA(0, 1, At, B1); PG8_BAR; PG8_SCHED;
            PG8_LDA(At, 1, 1); PG8_STAGE(PG8_SB(1, 0), b3, voffB); PG8_STAGE(PG8_SB(1, 1), b3 + hstepB, voffB); PG8_STAGE(PG8_SA(1, 0), a3, voffA);
            PG8_WAIT_V(8); PG8_WAIT_L(0); PG8_BAR; PG8_MMA(1, 0, At, B0); PG8_MMA(1, 1, At, B1); PG8_BAR; PG8_SCHED;
            } else {
            PG8_LDB(B0, 0, 0); PG8_SCHED; PG8_LDA(At, 0, 0); PG8_STAGE(PG8_SA(1, 1), a1 + hstepA, voffA);
            PG8_WAIT_L(8); PG8_BAR; PG8_WAIT_L(0); PG8_MMA(0, 0, At, B0); PG8_BAR; PG8_SCHED;
            PG8_LDB(B1, 0, 1); PG8_STAGE(PG8_SB(0, 0), b2, voffB);
            PG8_BAR; PG8_WAIT_L(0); PG8_MMA(0, 1, At, B1); PG8_BAR;
            PG8_LDA(At, 0, 1); PG8_STAGE(PG8_SA(0, 0), a2, voffA);
            PG8_BAR; PG8_WAIT_L(0); PG8_MMA(1, 0, At, B0); PG8_BAR; PG8_SCHED;
            PG8_STAGE(PG8_SB(0, 1), b2 + hstepB, voffB);
            PG8_WAIT_V(6); PG8_BAR; PG8_MMA(1, 1, At, B1); PG8_BAR;
            PG8_LDB(B0, 1, 0); PG8_SCHED; PG8_LDA(At, 1, 0); PG8_STAGE(PG8_SA(0, 1), a2 + hstepA, voffA);
            PG8_WAIT_L(8); PG8_BAR; PG8_WAIT_L(0); PG8_MMA(0, 0, At, B0); PG8_BAR; PG8_SCHED;
            PG8_LDB(B1, 1, 1); PG8_STAGE(PG8_SB(1, 0), b3, voffB);
            PG8_BAR; PG8_WAIT_L(0); PG8_MMA(0, 1, At, B1); PG8_BAR;
            PG8_LDA(At, 1, 1); PG8_STAGE(PG8_SA(1, 0), a3, voffA);
            PG8_BAR; PG8_WAIT_L(0); PG8_MMA(1, 0, At, B0); PG8_BAR; PG8_SCHED;
            PG8_STAGE(PG8_SB(1, 1), b3 + hstepB, voffB);
            PG8_WAIT_V(6); PG8_BAR; PG8_MMA(1, 1, At, B1); PG8_BAR;
            }
        }
        if constexpr (ALIGN_EPI) { if (wr == 0) PG8_BAR; }
        { asm volatile("" ::: "memory"); const Epi E = mk(); E(acc, cur, wr, wc, fr, fq); }
        if (!has_next) break;
#pragma unroll
        for (int a = 0; a < 2; ++a)
#pragma unroll
            for (int b = 0; b < 2; ++b)
#pragma unroll
                for (int m = 0; m < 4; ++m)
#pragma unroll
                    for (int n = 0; n < 2; ++n) acc[a][b][m][n] = (f32x4){0.f, 0.f, 0.f, 0.f};
        cur = nxt; cA = nA; cB = nB; ++ui;
        if constexpr (ALIGN_EPI) { if (wr == 1) PG8_BAR; }
    }
    PG8_WAIT_V(0);
    if constexpr (!ALIGN_EPI) { if (wr == 0) PG8_BAR; }
    PG8_BAR;
#undef PG8_SA
#undef PG8_SB
#undef PG8_STAGE
#undef PG8_LDA
#undef PG8_LDB
#undef PG8_MMA
#undef PG8_WAIT_V
#undef PG8_WAIT_L
#undef PG8_BAR
#undef PG8_SCHED
}
template <class MkEpi, class Sched> __device__ __forceinline__ void gemm_phase(LAS unsigned char* lds, const int tid, const int lda, const int ldb, const int K, const Sched& S, const MkEpi& mk) {
    gemm_phase_<decltype(mk()), Sched, MkEpi>(lds, tid, lda, ldb, K, S, mk); }
}

#define XB_TMO      128
#define XB_XCNT(j)  (256  + 64 * (j))
#define XB_XSUB(j)  (1280 + 64 * (j))
#define XB_XGEN(j)  (2304 + 64 * (j))
#define XB_TOP      3328
#define XB_TOPGEN   3392
#define XCD_BAR_WORDS 3456
#define XB_SPIN_CAP (1u << 18)

__device__ __forceinline__ unsigned xb_ld(unsigned* p)              { return __hip_atomic_load(p, __ATOMIC_RELAXED, __HIP_MEMORY_SCOPE_AGENT); }
__device__ __forceinline__ unsigned xb_add(unsigned* p, unsigned v) { return __hip_atomic_fetch_add(p, v, __ATOMIC_RELAXED, __HIP_MEMORY_SCOPE_AGENT); }
__device__ __forceinline__ unsigned xb_xcc_id() { return (unsigned)__builtin_amdgcn_s_getreg((3 << 11) | 20) & 0xFu; }
#define XB_SPIN(cond, bar) do { unsigned _sp = 0; while (cond) { __builtin_amdgcn_s_sleep(1); \
    if ((++_sp & 255u) == 0u) { if (xb_ld(&(bar)[XB_TMO])) break; if (_sp > XB_SPIN_CAP) { atomicAdd(&(bar)[XB_TMO], 1u); break; } } } } while (0)

struct XcdBarrier { unsigned* bar; unsigned x; volatile LAS unsigned* st; };

__device__ __forceinline__ XcdBarrier xcd_barrier_post(unsigned* bar, volatile LAS unsigned* st) {
    XcdBarrier b; b.bar = bar; b.x = xb_xcc_id(); b.st = st;
    if (threadIdx.x == 0) (void)xb_add(&bar[XB_XCNT(b.x)], 1u);
    return b;
}
__device__ __forceinline__ void xcd_barrier_complete(unsigned* bar, unsigned x, unsigned& nloc, unsigned& nx, const unsigned G) {
    unsigned sum, cnt, mine, sp = 0u;
    for (;;) {
        sum = 0u; cnt = 0u; mine = 0u;
#pragma unroll
        for (unsigned j = 0; j < 16; ++j) { const unsigned c = xb_ld(&bar[XB_XCNT(j)]); sum += c; cnt += (c > 0u) ? 1u : 0u; mine = (j == x) ? c : mine; }
        if (sum == G) break;
        __builtin_amdgcn_s_sleep(1);
        if ((++sp & 255u) == 0u) { if (xb_ld(&bar[XB_TMO])) break; if (sp > XB_SPIN_CAP) { atomicAdd(&bar[XB_TMO], 1u); break; } }
    }
    nloc = mine > 0u ? mine : 1u; nx = cnt > 0u ? cnt : 1u;
}
__device__ __forceinline__ void xcd_barrier(const XcdBarrier& b, const int tid, const unsigned G) {
    asm volatile("s_waitcnt vmcnt(0)" ::: "memory");
    __syncthreads();
    if (tid == 0) {
        unsigned* bar = b.bar;
        __builtin_amdgcn_s_waitcnt(0);
        unsigned nloc = b.st[0], nx = b.st[1];
        if (nloc == 0u) { xcd_barrier_complete(bar, b.x, nloc, nx, G); b.st[0] = nloc; b.st[1] = nx; }
        const unsigned old = xb_add(&bar[XB_XSUB(b.x)], 1u);
        const unsigned gen = old / nloc;
        if (old + 1u == (gen + 1u) * nloc) {
            __builtin_amdgcn_fence(__ATOMIC_RELEASE, "agent");
            asm volatile("s_waitcnt vmcnt(0)" ::: "memory");
            const unsigned og = xb_add(&bar[XB_TOP], 1u);
            const unsigned tg = og / nx;
            if (og + 1u == (tg + 1u) * nx) xb_add(&bar[XB_TOPGEN], 1u);
            else XB_SPIN(xb_ld(&bar[XB_TOPGEN]) == tg, bar);
            __builtin_amdgcn_fence(__ATOMIC_ACQUIRE, "agent");
            xb_add(&bar[XB_XGEN(b.x)], 1u);
            asm volatile("s_waitcnt vmcnt(0)" ::: "memory");
        } else {
            XB_SPIN(xb_ld(&bar[XB_XGEN(b.x)]) == gen, bar);
            __builtin_amdgcn_fence(__ATOMIC_ACQUIRE, "agent");
            asm volatile("s_waitcnt vmcnt(0)" ::: "memory");
        }
    }
    __syncthreads();
}

constexpr size_t MiB = 1u << 20;
constexpr size_t SZ_MD_BF = (size_t)M * D * 2, SZ_MD_F = (size_t)M * D * 4;
constexpr size_t WS_CTL = 0, CTL_BYTES = 1 * MiB;
constexpr size_t WS_X    = WS_CTL + CTL_BYTES;
constexpr size_t WS_HB   = WS_X + SZ_MD_F;
constexpr size_t WS_ACT  = WS_HB + SZ_MD_BF;
constexpr size_t WS_P0   = WS_ACT + (size_t)M * DFF * 2;
constexpr size_t WS_P1   = WS_P0 + 192 * MiB;
constexpr size_t WS_YB   = WS_P1 + 3 * SZ_MD_F;
constexpr size_t WS_QB2  = WS_YB + SZ_MD_BF;
constexpr size_t WS_SC   = WS_QB2 + SZ_MD_BF;
constexpr size_t WS_PB   = WS_SC + (size_t)16 * SEQ * NMEM * 4;
constexpr size_t WS_OB   = WS_PB + (size_t)16 * SEQ * NMEM * 2;
constexpr size_t WS_KALL = WS_OB + SZ_MD_BF;
constexpr size_t WS_VT   = WS_KALL + (size_t)MMEM * 4 * D * 2;
constexpr size_t WS_MEMN = WS_VT + (size_t)MMEM * 4 * D * 2;
constexpr size_t WS_MISC = WS_MEMN + (size_t)MMEM * D * 2;
constexpr size_t MISC_LB = 0, MISC_C8 = 4 * 2048 * 4, MISC_SSQ = MISC_C8 + 2048 * 4, MISC_GATES = MISC_SSQ + (size_t)M * 8 * 4, MISC_MLWG = MISC_GATES + (size_t)M * 16 * 4, MISC_BYTES = 1 * MiB;
static_assert(MISC_MLWG + 16 * 2048 * 4 <= MISC_BYTES, "misc");
constexpr int ML_NPAD = 6400;
constexpr size_t SZ_WGU = (size_t)NGU * D * 2, SZ_WDN = (size_t)D * DFF * 2, SZ_WDD = (size_t)D * D * 2;
constexpr size_t WS_WGU  = WS_MISC + MISC_BYTES;
constexpr size_t WS_WDN  = WS_WGU + 8 * SZ_WGU;
constexpr size_t WS_WQ   = WS_WDN + 8 * SZ_WDN;
constexpr size_t WS_WO   = WS_WQ + 4 * SZ_WDD;
constexpr size_t WS_WK   = WS_WO + 4 * SZ_WDD;
constexpr size_t WS_WV   = WS_WK + 4 * SZ_WDD;
constexpr size_t WS_HGIN = WS_WV + 4 * SZ_WDD;
constexpr size_t WS_HGOUT = WS_HGIN + 2 * 4 * SZ_WDD;
constexpr size_t WS_LRUIN = WS_HGOUT + 2 * SZ_WDD;
constexpr size_t WS_LRUG = WS_LRUIN + 2 * SZ_WDD;
constexpr size_t WS_LRUOUT = WS_LRUG + (size_t)4096 * 256 * 2;
constexpr size_t WS_MLIN = WS_LRUOUT + SZ_WDD;
constexpr size_t WS_MLOUT = WS_MLIN + (size_t)ML_NPAD * D * 2;
constexpr size_t WS_GT   = WS_MLOUT + SZ_WDD;
constexpr size_t WS_UT   = WS_GT + (size_t)4 * 16 * NMEM * D * 2;
constexpr size_t WS_END  = WS_UT + (size_t)4 * 4 * D * 4 * NMEM * 2;

constexpr int NWAVES = 8, NT = NWAVES * 64;

struct Args {
    const float* in[27]; float* out; unsigned char* ws; int ph_lo, ph_hi;
};
enum { I_X = 0, I_MEM, I_MEMG, I_NORMG, I_FINALG, I_WGU, I_WDN, I_XAQ, I_XAKV, I_XAO, I_HGLB, I_HGIN, I_HGG, I_HGOUT,
       I_LRUIN, I_CONVW, I_CONVB, I_LRUWA, I_LRUBA, I_LRUWX, I_LRUBX, I_LRULAM, I_LRUOUT, I_MLIN, I_MLBIF, I_MLG, I_MLOUT };

struct Frame { LAS unsigned char* lds; int tid, lane, wave, G, bid, gw, NGW;
    template <class T> __device__ __forceinline__ T* ptr(int i) const { const u32x2 v = *(const LAS u32x2*)(lds + CTRL + 64 + 8 * i);
        const unsigned lo = __builtin_amdgcn_readfirstlane(v.x), hi = __builtin_amdgcn_readfirstlane(v.y); return (T*)(((unsigned long long)hi << 32) | lo); }
    __device__ __forceinline__ const float* in(int i) const { return ptr<const float>(i); }
    __device__ __forceinline__ float* out() const { return ptr<float>(27); }
    __device__ __forceinline__ unsigned char* ws() const { return ptr<unsigned char>(28); }
};
__device__ __forceinline__ unsigned hw_wave_key() { return (unsigned)__builtin_amdgcn_s_getreg((12 - 1) << 11 | 4) & 0xfffu; }

struct CvtJob { const float* W; bf16* WT; const float* gk; int K, ldw, nrows, off, gu, nvalid; };
__device__ __forceinline__ void convert_job_rt(const Frame& F, int& rot, const CvtJob& j, const int num0 = 0, const int num1 = 8) {
    const int nnb = j.nrows / 64, nkb = j.K / 64, nitems = nnb * nkb; const int cg = F.lane & 15, kg = F.lane >> 4;
    const int i0 = (nitems * num0) >> 3, i1 = (nitems * num1) >> 3, nrange = i1 - i0;
    int q = F.gw - rot; if (q < 0) q += F.NGW;
    for (; q < nrange; q += F.NGW) { const int it = i0 + q;
        const int kb = it / nnb, nb = it % nnb, k0 = kb * 64, n0 = nb * 64; int sc = j.off + n0;
        if (j.gu) { const int pn = n0 >> 8, r = n0 & 255; sc = (r >> 7) * DFF + 128 * pn + (r & 127); }
        const bool ok = (sc + 4 * cg + 3) < j.nvalid; const float* src = j.W + (size_t)(k0 + 16 * kg) * j.ldw + (ok ? sc + 4 * cg : 0);
        f32x4 v[16];
#pragma unroll
        for (int i = 0; i < 16; ++i) v[i] = __builtin_nontemporal_load((const f32x4*)(src + (size_t)i * j.ldw));
        if (j.gk) { const f32x4* gp = (const f32x4*)(j.gk + k0 + 16 * kg);
#pragma unroll
            for (int q = 0; q < 4; ++q) { const f32x4 g = gp[q]; v[4 * q] *= g[0]; v[4 * q + 1] *= g[1]; v[4 * q + 2] *= g[2]; v[4 * q + 3] *= g[3]; } }
        if (!ok) {
#pragma unroll
            for (int i = 0; i < 16; ++i) v[i] = (f32x4){0.f, 0.f, 0.f, 0.f}; }
#pragma unroll
        for (int c = 0; c < 4; ++c) { bf16* dst = j.WT + (size_t)(n0 + 4 * cg + c) * j.K + k0 + 16 * kg;
            u32x4 lo, hi; lo.x = pk2(v[0][c], v[1][c]); lo.y = pk2(v[2][c], v[3][c]); lo.z = pk2(v[4][c], v[5][c]); lo.w = pk2(v[6][c], v[7][c]);
            hi.x = pk2(v[8][c], v[9][c]); hi.y = pk2(v[10][c], v[11][c]); hi.z = pk2(v[12][c], v[13][c]); hi.w = pk2(v[14][c], v[15][c]);
            *(u32x4*)dst = lo; *(u32x4*)(dst + 8) = hi; }
    }
    rot = (rot + nrange) % F.NGW;
}
struct MapPlain { int off; __device__ int operator()(int nb) const { return off + 64 * nb; } };
struct MapGU { __device__ int operator()(int nb) const { const int n = 64 * nb, pn = n >> 8, r = n & 255; return (r >> 7) * DFF + 128 * pn + (r & 127); } };

__device__ __forceinline__ void x_to_stream(const Frame& F, const float* x, bf16* XB, float* SSQ) {
    for (int row = F.gw; row < M; row += F.NGW) {
        const f32x4* xr = (const f32x4*)(x + (size_t)row * D) + F.lane; u32x2* o8 = (u32x2*)(XB + (size_t)row * D) + F.lane; float ss = 0.f;
#pragma unroll
        for (int j = 0; j < 8; ++j) { const f32x4 v = xr[64 * j]; ss += (v[0] * v[0] + v[1] * v[1]) + (v[2] * v[2] + v[3] * v[3]); u32x2 w; w.x = pk2(v[0], v[1]); w.y = pk2(v[2], v[3]); o8[64 * j] = w; }
        ss = wave_sum(ss);
        if (F.lane < 8) SSQ[(size_t)row * 8 + F.lane] = F.lane == 0 ? ss : 0.f;
    }
}
__device__ __forceinline__ void ml_gates_rows(const Frame& F, const bf16* XB, const float* SSQ, const bf16* wg, float* gates) {
    if (F.wave >= 2) return;
    const int lr = F.lane & 15, lq = F.lane >> 4;
    for (int tile = F.wave * F.G + F.bid; tile < M / 16; tile += 2 * F.G) {
        const int row0 = tile * 16;
        const bf16* ap = XB + (size_t)(row0 + lr) * D + 8 * lq; const bf16* bp = wg + (size_t)lr * D + 8 * lq;
        f32x4 acc = {0.f, 0.f, 0.f, 0.f};
        for (int k0 = 0; k0 < D; k0 += 256) { bf16x8 a[8], b[8];
#pragma unroll
            for (int j = 0; j < 8; ++j) { a[j] = *(const bf16x8*)(ap + k0 + 32 * j); b[j] = *(const bf16x8*)(bp + k0 + 32 * j); }
#pragma unroll
            for (int j = 0; j < 8; ++j) acc = __builtin_amdgcn_mfma_f32_16x16x32_bf16(a[j], b[j], acc, 0, 0, 0); }
#pragma unroll
        for (int r = 0; r < 4; ++r) { const int row = row0 + 4 * lq + r; const f32x4 s0 = *(const f32x4*)(SSQ + (size_t)row * 8), s1 = *(const f32x4*)(SSQ + (size_t)row * 8 + 4);
            const float rstd = 1.0f / sqrtf((((s0[0] + s0[1]) + (s0[2] + s0[3])) + ((s1[0] + s1[1]) + (s1[2] + s1[3]))) * (1.0f / D) + EPS);
            gates[(size_t)row * 16 + lr] = acc[r] * rstd; }
    }
}
__device__ __forceinline__ void final_norm_bf(const Frame& F, const bf16* XB, const float* SSQ, const float* g, float* out) {
    for (int row = F.gw; row < M; row += F.NGW) {
        const f32x4 a = *(const f32x4*)(SSQ + (size_t)row * 8), b = *(const f32x4*)(SSQ + (size_t)row * 8 + 4);
        const float rstd = 1.0f / sqrtf((((a[0] + a[1]) + (a[2] + a[3])) + ((b[0] + b[1]) + (b[2] + b[3]))) * (1.0f / D) + EPS);
        const u32x2* xr = (const u32x2*)(XB + (size_t)row * D) + F.lane; f32x4* o = (f32x4*)(out + (size_t)row * D) + F.lane;
#pragma unroll
        for (int j = 0; j < 8; ++j) { const u32x2 w = xr[64 * j]; const f32x4 gg = ((const f32x4*)g)[F.lane + 64 * j]; o[64 * j] = (f32x4){bflo(w.x), bfhi(w.x), bflo(w.y), bfhi(w.y)} * rstd * gg; }
    }
}
template <bool GATES>
__device__ __forceinline__ void norm_rows(const Frame& F, const float* x, const float* g, bf16* out, int nrows, const float* wg, float* gates) {
    for (int row = F.gw; row < nrows; row += F.NGW) {
        const f32x4* xr = (const f32x4*)(x + (size_t)row * D) + F.lane;
        f32x4 v[8]; float ss = 0.f;
#pragma unroll
        for (int j = 0; j < 8; ++j) { v[j] = xr[64 * j]; ss += (v[j][0] * v[j][0] + v[j][1] * v[j][1]) + (v[j][2] * v[j][2] + v[j][3] * v[j][3]); }
        ss = wave_sum(ss);
        const float rstd = 1.0f / sqrtf(ss * (1.0f / D) + EPS);
        u32x2* o8 = (u32x2*)(out + (size_t)row * D) + F.lane;
#pragma unroll
        for (int j = 0; j < 8; ++j) { const f32x4 gg = ((const f32x4*)g)[F.lane + 64 * j]; v[j] = v[j] * rstd * gg; u32x2 w; w.x = pk2(v[j][0], v[j][1]); w.y = pk2(v[j][2], v[j][3]); o8[64 * j] = w; }
        if constexpr (GATES) {
            for (int c = 0; c < 16; ++c) { const f32x4* wr_ = (const f32x4*)(wg + (size_t)c * D) + F.lane; float s = 0.f;
#pragma unroll
                for (int j = 0; j < 8; ++j) { const f32x4 w4 = wr_[64 * j]; s += (v[j][0] * w4[0] + v[j][1] * w4[1]) + (v[j][2] * w4[2] + v[j][3] * w4[3]); }
                s = wave_sum(s); if (F.lane == 0) gates[(size_t)row * 16 + c] = s; }
        }
    }
}
__device__ __forceinline__ void final_norm(const Frame& F, const float* x, const float* g, float* out) {
    for (int row = F.gw; row < M; row += F.NGW) {
        const f32x4* xr = (const f32x4*)(x + (size_t)row * D) + F.lane;
        f32x4 v[8]; float ss = 0.f;
#pragma unroll
        for (int j = 0; j < 8; ++j) { v[j] = xr[64 * j]; ss += (v[j][0] * v[j][0] + v[j][1] * v[j][1]) + (v[j][2] * v[j][2] + v[j][3] * v[j][3]); }
        ss = wave_sum(ss);
        const float rstd = 1.0f / sqrtf(ss * (1.0f / D) + EPS);
        f32x4* o = (f32x4*)(out + (size_t)row * D) + F.lane;
#pragma unroll
        for (int j = 0; j < 8; ++j) { const f32x4 gg = ((const f32x4*)g)[F.lane + 64 * j]; o[64 * j] = v[j] * rstd * gg; }
    }
}

template <bool ML>
__device__ __forceinline__ void recur_phase(const Frame& F, const bf16* QB, const float* LF, const bf16* KB, const bf16* VB, const bf16* PB, const float* gates, const float* bif, float* OF) {
    constexpr int H = ML ? ML_H : HG_H, DV = ML ? ML_DV : HG_D, NVS = DV / 32, TB = 32;
    LAS float* AL = (LAS float*)F.lds; LAS float* KA = AL + TB * 128; LAS float* QQ = KA + TB * 128; LAS float* VV = QQ + TB * 128; LAS float* OO = VV + TB * 32;
    const int dg = F.lane & 15, vsub = F.lane >> 4, vloc = F.wave * 4 + vsub;
    for (int unit = F.bid; unit < BATCH * H * NVS; unit += F.G) {
        const int b = unit / (H * NVS), h = (unit / NVS) % H, vs = unit % NVS;
        float S[8], Nn[8];
#pragma unroll
        for (int i = 0; i < 8; ++i) { S[i] = 0.f; Nn[i] = 0.f; }
        float bi_ = 0.f, bf_ = 0.f; if constexpr (ML) { bi_ = bif[h]; bf_ = bif[8 + h]; }
        for (int t0 = 0; t0 < SEQ; t0 += TB) {
            __syncthreads();
            { const int t = F.tid >> 4, d8 = (F.tid & 15) * 8; const size_t row = (size_t)b * SEQ + t0 + t;
                float al[8], ka[8], qq[8];
                if constexpr (!ML) {
                    const f32x4 l0 = *(const f32x4*)(LF + row * D + h * 128 + d8), l1 = *(const f32x4*)(LF + row * D + h * 128 + d8 + 4);
                    const u32x4 kw = *(const u32x4*)(KB + row * D + h * 128 + d8), qw = *(const u32x4*)(QB + row * D + h * 128 + d8);
                    const float lf[8] = {l0[0], l0[1], l0[2], l0[3], l1[0], l1[1], l1[2], l1[3]};
#pragma unroll
                    for (int i = 0; i < 8; ++i) al[i] = __expf(lf[i]);
                    ka[0] = bflo(kw.x); ka[1] = bfhi(kw.x); ka[2] = bflo(kw.y); ka[3] = bfhi(kw.y); ka[4] = bflo(kw.z); ka[5] = bfhi(kw.z); ka[6] = bflo(kw.w); ka[7] = bfhi(kw.w);
                    qq[0] = bflo(qw.x); qq[1] = bfhi(qw.x); qq[2] = bflo(qw.y); qq[3] = bfhi(qw.y); qq[4] = bflo(qw.z); qq[5] = bfhi(qw.z); qq[6] = bflo(qw.w); qq[7] = bfhi(qw.w);
                } else {
                    const float fg = gates[row * 16 + 8 + h] + bf_, ig = gates[row * 16 + h] + bi_;
                    const float a_ = 1.0f / (1.0f + expf(-15.0f * tanhf(fg * (1.0f / 15.0f))));
                    const float ei = expf(15.0f * tanhf(ig * (1.0f / 15.0f))) * 0.08838834764831845f;
                    const u32x4 qw = *(const u32x4*)(PB + row * ML_PROJ + h * 128 + d8), kw = *(const u32x4*)(PB + row * ML_PROJ + 1024 + h * 128 + d8);
#pragma unroll
                    for (int i = 0; i < 8; ++i) al[i] = a_;
                    ka[0] = bflo(kw.x) * ei; ka[1] = bfhi(kw.x) * ei; ka[2] = bflo(kw.y) * ei; ka[3] = bfhi(kw.y) * ei; ka[4] = bflo(kw.z) * ei; ka[5] = bfhi(kw.z) * ei; ka[6] = bflo(kw.w) * ei; ka[7] = bfhi(kw.w) * ei;
                    qq[0] = bflo(qw.x); qq[1] = bfhi(qw.x); qq[2] = bflo(qw.y); qq[3] = bfhi(qw.y); qq[4] = bflo(qw.z); qq[5] = bfhi(qw.z); qq[6] = bflo(qw.w); qq[7] = bfhi(qw.w);
                }
                *(LAS f32x4*)(AL + t * 128 + d8) = (f32x4){al[0], al[1], al[2], al[3]}; *(LAS f32x4*)(AL + t * 128 + d8 + 4) = (f32x4){al[4], al[5], al[6], al[7]};
                *(LAS f32x4*)(KA + t * 128 + d8) = (f32x4){ka[0], ka[1], ka[2], ka[3]}; *(LAS f32x4*)(KA + t * 128 + d8 + 4) = (f32x4){ka[4], ka[5], ka[6], ka[7]};
                *(LAS f32x4*)(QQ + t * 128 + d8) = (f32x4){qq[0], qq[1], qq[2], qq[3]}; *(LAS f32x4*)(QQ + t * 128 + d8 + 4) = (f32x4){qq[4], qq[5], qq[6], qq[7]};
                if (F.tid < 256) { const int tv = F.tid >> 3, v4 = (F.tid & 7) * 4; const size_t rv = (size_t)b * SEQ + t0 + tv;
                    const u32x2 vw = ML ? *(const u32x2*)(PB + rv * ML_PROJ + 2048 + h * 256 + vs * 32 + v4) : *(const u32x2*)(VB + rv * D + h * 128 + vs * 32 + v4);
                    *(LAS f32x4*)(VV + tv * 32 + v4) = (f32x4){bflo(vw.x), bfhi(vw.x), bflo(vw.y), bfhi(vw.y)}; }
            }
            __syncthreads();
#pragma unroll 4
            for (int t = 0; t < TB; ++t) {
                const f32x4 a0 = *(const LAS f32x4*)(AL + t * 128 + dg * 8), a1 = *(const LAS f32x4*)(AL + t * 128 + dg * 8 + 4);
                const f32x4 k0 = *(const LAS f32x4*)(KA + t * 128 + dg * 8), k1 = *(const LAS f32x4*)(KA + t * 128 + dg * 8 + 4);
                const f32x4 q0 = *(const LAS f32x4*)(QQ + t * 128 + dg * 8), q1 = *(const LAS f32x4*)(QQ + t * 128 + dg * 8 + 4);
                const float vv = VV[t * 32 + vloc];
                const float al[8] = {a0[0], a0[1], a0[2], a0[3], a1[0], a1[1], a1[2], a1[3]}, ka[8] = {k0[0], k0[1], k0[2], k0[3], k1[0], k1[1], k1[2], k1[3]}, qq[8] = {q0[0], q0[1], q0[2], q0[3], q1[0], q1[1], q1[2], q1[3]};
                float po = 0.f, pd = 0.f;
#pragma unroll
                for (int i = 0; i < 8; ++i) { S[i] = al[i] * S[i] + ka[i] * vv; po += S[i] * qq[i]; if constexpr (ML) { Nn[i] = al[i] * Nn[i] + ka[i]; pd += Nn[i] * qq[i]; } }
#pragma unroll
                for (int o = 1; o < 16; o <<= 1) { po += __shfl_xor(po, o); if constexpr (ML) pd += __shfl_xor(pd, o); }
                if (dg == 0) { float r = po; if constexpr (ML) r = po / fmaxf(fabsf(pd), 1.0f); OO[t * 32 + vloc] = r; }
            }
            __syncthreads();
            if (F.tid < 256) { const int tv = F.tid >> 3, v4 = (F.tid & 7) * 4; const size_t rv = (size_t)b * SEQ + t0 + tv;
                *(f32x4*)(OF + rv * D + h * DV + vs * 32 + v4) = *(const LAS f32x4*)(OO + tv * 32 + v4); }
        }
    }
}
namespace ck {
constexpr int SK = 136, SS = 72;
constexpr int O_QH = 0, O_KH = O_QH + 64 * SK * 2, O_QE = O_KH + 160 * SK * 2, O_KET = O_QE + 64 * SK * 2, O_VT = O_KET + 128 * SS * 2, O_P = O_VT + 48 * SS * 2,
              O_SB = O_P + 64 * SS * 2, O_EBC = O_SB + 48 * SK * 2, O_TOT = O_EBC + 512, O_GT = O_TOT + 2048, O_END = O_GT + 2048 + 2 * 1280;
static_assert(O_END <= CTRL, "chunk LDS map");
__device__ __forceinline__ f32x4 mm(const LAS bf16* A, int sa, int ar, const LAS bf16* B, int sb, int br, int ksteps, f32x4 acc, int lane) {
    const int r = lane & 15, q8 = (lane >> 4) * 8;
    const LAS bf16* ap = A + (ar + r) * sa + q8; const LAS bf16* bp = B + (br + r) * sb + q8;
    for (int ks = 0; ks < ksteps; ++ks) { const bf16x8 a = *(const LAS bf16x8*)(ap + ks * 32), b = *(const LAS bf16x8*)(bp + ks * 32);
        acc = __builtin_amdgcn_mfma_f32_16x16x32_bf16(a, b, acc, 0, 0, 0); }
    return acc;
}
__device__ __forceinline__ bf16 f2bf(float x) { return (bf16)(pk2(x, x) & 0xffffu); }
__device__ __forceinline__ float bf2f(unsigned short x) { return __uint_as_float((unsigned)x << 16); }
__device__ __forceinline__ void tile_of(int tile, int& qi, int& kj) {
    qi = tile < 1 ? 0 : (tile < 3 ? 1 : (tile < 6 ? 2 : 3)); kj = tile - (qi * (qi + 1)) / 2; }

__device__ __forceinline__ void store_pairs(bf16* op, const f32x4& v, int lr) {
    const bool odd = lr & 1;
    const float r01 = __shfl_xor(odd ? v[0] : v[1], 1), r23 = __shfl_xor(odd ? v[2] : v[3], 1);
    const unsigned w01 = odd ? pk2(r01, v[1]) : pk2(v[0], r01), w23 = odd ? pk2(r23, v[3]) : pk2(v[2], r23);
    *(unsigned*)(op + (size_t)(odd ? 1 : 0) * D) = w01; *(unsigned*)(op + (size_t)(odd ? 3 : 2) * D) = w23;
}
template <int NSL, bool ML>
__device__ __forceinline__ void headnorm_tail(const Frame& F, const bf16* OF, float* SSQP, unsigned* cnt, const int b, const int col0, const int slot0, const int vs,
                                              const bf16* gate, const int ldg, const int gcol0, const float* gain, bf16* Y) {
    constexpr float INV_HD = 1.0f / (NSL * 32);
    const int q = F.tid & 3, r0 = F.tid >> 2;
    asm volatile("s_waitcnt vmcnt(0)" ::: "memory"); __syncthreads();
    const size_t rowb = (size_t)b * SEQ + r0;
#pragma unroll
    for (int i0 = 0; i0 < 16; i0 += 8) { u32x4 w[8];
#pragma unroll
        for (int i = 0; i < 8; ++i) w[i] = *(const u32x4*)(OF + (rowb + 128 * (i0 + i)) * D + col0 + 8 * q);
#pragma unroll
        for (int i = 0; i < 8; ++i) {
            const float a0 = bflo(w[i].x), a1 = bfhi(w[i].x), a2 = bflo(w[i].y), a3 = bfhi(w[i].y), a4 = bflo(w[i].z), a5 = bfhi(w[i].z), a6 = bflo(w[i].w), a7 = bfhi(w[i].w);
            float ss = ((a0 * a0 + a1 * a1) + (a2 * a2 + a3 * a3)) + ((a4 * a4 + a5 * a5) + (a6 * a6 + a7 * a7));
            ss += __shfl_xor(ss, 1); ss += __shfl_xor(ss, 2);
            if (q == 0) SSQP[(rowb + 128 * (i0 + i)) * 64 + slot0 + vs] = ss; } }
    asm volatile("s_waitcnt vmcnt(0)" ::: "memory"); __syncthreads();
    if (F.tid == 0) { __builtin_amdgcn_fence(__ATOMIC_RELEASE, "agent"); asm volatile("s_waitcnt vmcnt(0)" ::: "memory"); (void)xb_add(cnt, 1u);
        unsigned sp = 0u; while (xb_ld(cnt) < (unsigned)NSL) { __builtin_amdgcn_s_sleep(1); if (++sp > (1u << 24)) break; }
        __builtin_amdgcn_fence(__ATOMIC_ACQUIRE, "agent"); asm volatile("s_waitcnt vmcnt(0)" ::: "memory"); }
    __syncthreads();
    const f32x4 g0 = *(const f32x4*)(gain + 8 * q), g1 = *(const f32x4*)(gain + 8 * q + 4);
#pragma unroll
    for (int i0 = 0; i0 < 16; i0 += 4) {
        u32x4 w[4], gw[4]; f32x4 p0[4], p1[4];
#pragma unroll
        for (int j = 0; j < 4; ++j) { const size_t row = rowb + 128 * (i0 + j);
            w[j] = *(const u32x4*)(OF + row * D + col0 + 8 * q); gw[j] = *(const u32x4*)(gate + row * ldg + gcol0 + 8 * q);
            p0[j] = *(const f32x4*)(SSQP + row * 64 + slot0); if constexpr (NSL == 8) p1[j] = *(const f32x4*)(SSQP + row * 64 + slot0 + 4); else p1[j] = (f32x4){0.f, 0.f, 0.f, 0.f}; }
#pragma unroll
        for (int j = 0; j < 4; ++j) { const size_t row = rowb + 128 * (i0 + j);
            const float tot = ((p0[j][0] + p0[j][1]) + (p0[j][2] + p0[j][3])) + ((p1[j][0] + p1[j][1]) + (p1[j][2] + p1[j][3]));
            const float rstd = 1.0f / sqrtf(tot * INV_HD + EPS);
            float gg[8] = {bflo(gw[j].x), bfhi(gw[j].x), bflo(gw[j].y), bfhi(gw[j].y), bflo(gw[j].z), bfhi(gw[j].z), bflo(gw[j].w), bfhi(gw[j].w)};
            if constexpr (ML) {
#pragma unroll
                for (int e = 0; e < 8; ++e) gg[e] = sigmoidf_(gg[e]); }
            const f32x4 a = (f32x4){bflo(w[j].x), bfhi(w[j].x), bflo(w[j].y), bfhi(w[j].y)} * rstd * g0, c = (f32x4){bflo(w[j].z), bfhi(w[j].z), bflo(w[j].w), bfhi(w[j].w)} * rstd * g1;
            u32x4 o; o.x = pk2(a[0] * gg[0], a[1] * gg[1]); o.y = pk2(a[2] * gg[2], a[3] * gg[3]); o.z = pk2(c[0] * gg[4], c[1] * gg[5]); o.w = pk2(c[2] * gg[6], c[3] * gg[7]);
            *(u32x4*)(Y + row * D + col0 + 8 * q) = o; } }
}
__device__ __forceinline__ void hg_chunk_phase(const Frame& F, const bf16* QB, const bf16* LF, const bf16* KB, const bf16* VB, bf16* OF, const bf16* GB, const float* gn, bf16* Y, float* SSQP, unsigned* hcnt) {
    LAS bf16* QH = (LAS bf16*)(F.lds + O_QH); LAS bf16* KH = (LAS bf16*)(F.lds + O_KH); LAS bf16* QE = (LAS bf16*)(F.lds + O_QE); LAS bf16* KET = (LAS bf16*)(F.lds + O_KET);
    LAS bf16* VT = (LAS bf16*)(F.lds + O_VT); LAS bf16* P = (LAS bf16*)(F.lds + O_P); LAS bf16* SB = (LAS bf16*)(F.lds + O_SB);
    LAS float* EBC = (LAS float*)(F.lds + O_EBC); LAS float* TOT = (LAS float*)(F.lds + O_TOT);
    const int tid = F.tid, lane = F.lane, w = F.wave, lq = lane >> 4, lr = lane & 15;
    const int g = w, i = g >> 1, d2 = 2 * lane, sv = tid >> 3, v4 = (tid & 7) * 4;
    for (int unit = F.bid; unit < 256; unit += F.G) {
        const int xk = unit >> 3, vs = xk & 3, gq = (xk >> 2) * 8 + (unit & 7); const int b = gq >> 4, h = gq & 15;
        __syncthreads();
        for (int e = tid; e < 64 * SS / 2; e += NT) ((LAS unsigned*)P)[e] = 0u;
        for (int e = tid; e < 48 * SK / 2; e += NT) ((LAS unsigned*)SB)[e] = 0u;
        f32x4 S0 = {0.f, 0.f, 0.f, 0.f}, S1 = {0.f, 0.f, 0.f, 0.f};
        unsigned lfA[8], lfB[8]; unsigned qvA[8], qvB[8]; u32x2 vvA, vvB;
        const size_t colb = (size_t)h * 128 + d2, colv = (size_t)h * 128 + vs * 32 + v4;
        auto load = [&](unsigned (&lfw)[8], unsigned (&qv)[8], u32x2& vv, const int cc) { const size_t r0 = (size_t)b * SEQ + (size_t)cc * 64 + 8 * g;
#pragma unroll
            for (int tt = 0; tt < 8; ++tt) { lfw[tt] = *(const unsigned*)(LF + (r0 + tt) * D + colb); qv[tt] = *(const unsigned*)(QB + (r0 + tt) * D + colb); }
            vv = *(const u32x2*)(VB + ((size_t)b * SEQ + (size_t)cc * 64 + sv) * D + colv); };
        load(lfA, qvA, vvA, 0); load(lfB, qvB, vvB, 1);
        auto step = [&](unsigned (&lfw)[8], unsigned (&qv)[8], u32x2& vv, const int c) {
            f32x2 lf[8], loc[8]; { f32x2 run = {0.f, 0.f};
#pragma unroll
                for (int tt = 0; tt < 8; ++tt) { lf[tt] = (f32x2){bflo(lfw[tt]), bfhi(lfw[tt])}; run += lf[tt]; loc[tt] = run; }
                *(LAS f32x2*)(TOT + g * 128 + d2) = run; }
            __syncthreads();
            { u32x2 s0, s1; s0.x = pk2(S0[0], S0[1]); s0.y = pk2(S0[2], S0[3]); s1.x = pk2(S1[0], S1[1]); s1.y = pk2(S1[2], S1[3]);
                *(LAS u32x2*)(SB + lr * SK + 16 * w + 4 * lq) = s0; *(LAS u32x2*)(SB + (16 + lr) * SK + 16 * w + 4 * lq) = s1; }
            f32x2 tg[8];
#pragma unroll
            for (int j = 0; j < 8; ++j) tg[j] = *(const LAS f32x2*)(TOT + j * 128 + d2);
            f32x2 Pf[4]; Pf[0] = (f32x2){0.f, 0.f}; Pf[1] = tg[0] + tg[1]; Pf[2] = Pf[1] + tg[2] + tg[3]; Pf[3] = Pf[2] + tg[4] + tg[5]; const f32x2 bC = Pf[3] + tg[6] + tg[7];
            const f32x2 Pi = i == 0 ? Pf[0] : (i == 1 ? Pf[1] : (i == 2 ? Pf[2] : Pf[3]));
            const f32x2 half = (g & 1) ? (g == 1 ? tg[0] : (g == 3 ? tg[2] : (g == 5 ? tg[4] : tg[6]))) : (f32x2){0.f, 0.f};
            const f32x2 eP = {__expf(Pi.x), __expf(Pi.y)}; const f32x2 eC = {__expf(bC.x - Pi.x), __expf(bC.y - Pi.y)};
            f32x2 fac[4];
#pragma unroll
            for (int ip = 0; ip < 4; ++ip) fac[ip] = (f32x2){__expf(Pf[ip].x - Pi.x), __expf(Pf[ip].y - Pi.y)};
            const int koff[4] = {0, 16, 48, 96};
            unsigned ke0[4], ke1[4];
#pragma unroll
            for (int tt = 0; tt < 8; ++tt) { const int t = 8 * g + tt; const f32x2 lo = loc[tt] + half;
                const float q0 = bflo(qv[tt]), q1 = bfhi(qv[tt]), k0 = 1.0f - __expf(lf[tt].x), k1 = 1.0f - __expf(lf[tt].y);
                const float e0 = __expf(fmaxf(lo.x, -80.f)), e1 = __expf(fmaxf(lo.y, -80.f));
                const float kr0 = k0 * __builtin_amdgcn_rcpf(e0), kr1 = k1 * __builtin_amdgcn_rcpf(e1);
                *(LAS unsigned*)(QH + t * SK + d2) = pk2(q0 * e0, q1 * e1); *(LAS unsigned*)(QE + t * SK + d2) = pk2(q0 * e0 * eP.x, q1 * e1 * eP.y);
#pragma unroll
                for (int ip = 0; ip < 4; ++ip) if (ip >= i) *(LAS unsigned*)(KH + (koff[ip] + t) * SK + d2) = pk2(kr0 * fac[ip].x, kr1 * fac[ip].y);
                const float c0 = kr0 * eC.x, c1 = kr1 * eC.y;
                if (tt & 1) { ke0[tt >> 1] = pk2(__uint_as_float(ke0[tt >> 1]), c0); ke1[tt >> 1] = pk2(__uint_as_float(ke1[tt >> 1]), c1); } else { ke0[tt >> 1] = __float_as_uint(c0); ke1[tt >> 1] = __float_as_uint(c1); } }
            *(LAS u32x4*)(KET + d2 * SS + 8 * g) = (u32x4){ke0[0], ke0[1], ke0[2], ke0[3]}; *(LAS u32x4*)(KET + (d2 + 1) * SS + 8 * g) = (u32x4){ke1[0], ke1[1], ke1[2], ke1[3]};
            if (g == 0) *(LAS f32x2*)(EBC + d2) = (f32x2){__expf(bC.x), __expf(bC.y)};
            VT[(v4 + 0) * SS + sv] = (bf16)(vv.x & 0xffffu); VT[(v4 + 1) * SS + sv] = (bf16)(vv.x >> 16); VT[(v4 + 2) * SS + sv] = (bf16)(vv.y & 0xffffu); VT[(v4 + 3) * SS + sv] = (bf16)(vv.y >> 16);
            if (c + 2 < SEQ / 64) load(lfw, qv, vv, c + 2);
            __syncthreads();
            for (int tile = w; tile < 10; tile += 8) { int qi, kj; tile_of(tile, qi, kj);
                f32x4 acc = {0.f, 0.f, 0.f, 0.f}; acc = mm(QH, SK, 16 * qi, KH, SK, koff[qi] + 16 * kj, 4, acc, lane);
#pragma unroll
                for (int r = 0; r < 4; ++r) { const int tl = 4 * lq + r; const float val = (qi != kj || lr <= tl) ? acc[r] : 0.f; P[(16 * qi + tl) * SS + 16 * kj + lr] = f2bf(val); } }
            __syncthreads();
            { const int tq = w & 3, nv = w >> 2; f32x4 acc = {0.f, 0.f, 0.f, 0.f};
                acc = mm(P, SS, 16 * tq, VT, SS, 16 * nv, tq < 2 ? 1 : 2, acc, lane);
                acc = mm(QE, SK, 16 * tq, SB, SK, 16 * nv, 4, acc, lane);
                bf16* op = OF + ((size_t)b * SEQ + c * 64 + 16 * tq + 4 * lq) * D + h * 128 + vs * 32 + 16 * nv + (lr & ~1);
                store_pairs(op, acc, lr); }
            { f32x4 U0 = {0.f, 0.f, 0.f, 0.f}, U1 = {0.f, 0.f, 0.f, 0.f}; U0 = mm(KET, SS, 16 * w, VT, SS, 0, 2, U0, lane); U1 = mm(KET, SS, 16 * w, VT, SS, 16, 2, U1, lane);
                const f32x4 dec = *(const LAS f32x4*)(EBC + 16 * w + 4 * lq); S0 = S0 * dec + U0; S1 = S1 * dec + U1; }
        };
        for (int c = 0; c < SEQ / 64; c += 2) { step(lfA, qvA, vvA, c); step(lfB, qvB, vvB, c + 1); }
        if (hcnt) headnorm_tail<4, false>(F, OF, SSQP, hcnt + b * 16 + h, b, h * 128 + vs * 32, h * 4, vs, GB, D, h * 128 + vs * 32, gn + vs * 32, Y);
    }
}

__device__ __forceinline__ void ml_chunk_phase(const Frame& F, const bf16* PB, const float* gates, const float* bif, bf16* OF, const float* gn, bf16* Y, float* SSQP, unsigned* hcnt) {
    LAS bf16* QH = (LAS bf16*)(F.lds + O_QH); LAS bf16* KH = (LAS bf16*)(F.lds + O_KH); LAS bf16* KET = (LAS bf16*)(F.lds + O_KET);
    LAS bf16* VT = (LAS bf16*)(F.lds + O_VT); LAS bf16* P = (LAS bf16*)(F.lds + O_P); LAS bf16* SB = (LAS bf16*)(F.lds + O_SB);
    LAS float* GT0 = (LAS float*)(F.lds + O_GT + 2048);
    const int tid = F.tid, lane = F.lane, w = F.wave, lq = lane >> 4, lr = lane & 15;
    const int g = w, d2 = 2 * lane, sv = tid >> 3, v4 = (tid & 7) * 4;
    constexpr float S128 = 0.08838834764831845f;
    for (int unit = F.bid; unit < 256; unit += F.G) {
        const int xk = unit >> 3, vs = xk & 7, gq = (xk >> 3) * 8 + (unit & 7); const int b = gq >> 3, h = gq & 7;
        const float bi_ = bif[h], bf_ = bif[8 + h];
        __syncthreads();
        for (int e = tid; e < 64 * SS / 2; e += NT) ((LAS unsigned*)P)[e] = 0u;
        for (int e = tid; e < 48 * SK / 2; e += NT) ((LAS unsigned*)SB)[e] = 0u;
        for (int e = tid; e < 16 * SS; e += NT) VT[32 * SS + e] = (e < 64) ? (bf16)0x3F80u : (bf16)0u;
        f32x4 S0 = {0.f, 0.f, 0.f, 0.f}, S1 = {0.f, 0.f, 0.f, 0.f}, S2 = {0.f, 0.f, 0.f, 0.f};
        unsigned qvA[8], kvA[8], qvB[8], kvB[8]; u32x2 vvA, vvB; float giA = 0.f, gfA = 0.f, giB = 0.f, gfB = 0.f;
        const size_t colq = (size_t)h * 128 + d2, colv = (size_t)2048 + h * 256 + vs * 32 + v4;
        auto load = [&](unsigned (&qv)[8], unsigned (&kv)[8], u32x2& vv, float& gi, float& gf, const int cc) { const size_t r0 = (size_t)b * SEQ + (size_t)cc * 64 + 8 * g;
#pragma unroll
            for (int tt = 0; tt < 8; ++tt) { qv[tt] = *(const unsigned*)(PB + (r0 + tt) * ML_PROJ + colq); kv[tt] = *(const unsigned*)(PB + (r0 + tt) * ML_PROJ + 1024 + colq); }
            vv = *(const u32x2*)(PB + ((size_t)b * SEQ + (size_t)cc * 64 + sv) * ML_PROJ + colv);
            if (w == 0) { gi = gates[((size_t)b * SEQ + (size_t)cc * 64 + lane) * 16 + h]; gf = gates[((size_t)b * SEQ + (size_t)cc * 64 + lane) * 16 + 8 + h]; } };
        load(qvA, kvA, vvA, giA, gfA, 0); load(qvB, kvB, vvB, giB, gfB, 1);
        auto step = [&](unsigned (&qv)[8], unsigned (&kv)[8], u32x2& vv, float& gi, float& gf, const int c) {
            LAS float* BT = GT0 + (c & 1) * 320; LAS float* WI = BT + 64; LAS float* WK = WI + 64; LAS float* EB = WK + 64; LAS float* EC = EB + 64;
            if (w == 0) {
                const float it = 15.0f * tanhf((gi + bi_) * (1.0f / 15.0f)); const float y = 15.0f * tanhf((gf + bf_) * (1.0f / 15.0f));
                const float lfv = -(fmaxf(-y, 0.f) + log1pf(expf(-fabsf(y))));
                float bt = lfv;
#pragma unroll
                for (int o = 1; o < 64; o <<= 1) { const float up = __shfl_up(bt, o); if (lane >= o) bt += up; }
                const float bC = __shfl(bt, 63);
                BT[lane] = bt; WI[lane] = it - bt; WK[lane] = __expf(bC - bt + it) * S128; EB[lane] = __expf(bt); if (lane == 0) EC[0] = __expf(bC);
            }
            __syncthreads();
            { u32x2 s0, s1, s2; s0.x = pk2(S0[0], S0[1]); s0.y = pk2(S0[2], S0[3]); s1.x = pk2(S1[0], S1[1]); s1.y = pk2(S1[2], S1[3]); s2.x = pk2(S2[0], S2[1]); s2.y = pk2(S2[2], S2[3]);
                *(LAS u32x2*)(SB + lr * SK + 16 * w + 4 * lq) = s0; *(LAS u32x2*)(SB + (16 + lr) * SK + 16 * w + 4 * lq) = s1; *(LAS u32x2*)(SB + (32 + lr) * SK + 16 * w + 4 * lq) = s2; }
            { unsigned ke0[4], ke1[4];
#pragma unroll
                for (int tt = 0; tt < 8; ++tt) { const int t = 8 * g + tt; *(LAS unsigned*)(QH + t * SK + d2) = qv[tt]; *(LAS unsigned*)(KH + t * SK + d2) = kv[tt];
                    const float wk = WK[t]; const float c0 = bflo(kv[tt]) * wk, c1 = bfhi(kv[tt]) * wk;
                    if (tt & 1) { ke0[tt >> 1] = pk2(__uint_as_float(ke0[tt >> 1]), c0); ke1[tt >> 1] = pk2(__uint_as_float(ke1[tt >> 1]), c1); } else { ke0[tt >> 1] = __float_as_uint(c0); ke1[tt >> 1] = __float_as_uint(c1); } }
                *(LAS u32x4*)(KET + d2 * SS + 8 * g) = (u32x4){ke0[0], ke0[1], ke0[2], ke0[3]}; *(LAS u32x4*)(KET + (d2 + 1) * SS + 8 * g) = (u32x4){ke1[0], ke1[1], ke1[2], ke1[3]}; }
            VT[(v4 + 0) * SS + sv] = (bf16)(vv.x & 0xffffu); VT[(v4 + 1) * SS + sv] = (bf16)(vv.x >> 16); VT[(v4 + 2) * SS + sv] = (bf16)(vv.y & 0xffffu); VT[(v4 + 3) * SS + sv] = (bf16)(vv.y >> 16);
            if (c + 2 < SEQ / 64) load(qv, kv, vv, gi, gf, c + 2);
            __syncthreads();
            for (int tile = w; tile < 10; tile += 8) { int qi, kj; tile_of(tile, qi, kj);
                f32x4 acc = {0.f, 0.f, 0.f, 0.f}; acc = mm(QH, SK, 16 * qi, KH, SK, 16 * kj, 4, acc, lane);
                const float wis = WI[16 * kj + lr];
#pragma unroll
                for (int r = 0; r < 4; ++r) { const int tl = 4 * lq + r; const float wgt = __expf(BT[16 * qi + tl] + wis) * S128;
                    const float val = (qi != kj || lr <= tl) ? acc[r] * wgt : 0.f; P[(16 * qi + tl) * SS + 16 * kj + lr] = f2bf(val); } }
            __syncthreads();
            { const int tq = w & 3, nv = w >> 2, ksn = tq < 2 ? 1 : 2; f32x4 num = {0.f, 0.f, 0.f, 0.f}, den = num, qs = num, qn = num;
                num = mm(P, SS, 16 * tq, VT, SS, 16 * nv, ksn, num, lane); den = mm(P, SS, 16 * tq, VT, SS, 32, ksn, den, lane);
                qs = mm(QH, SK, 16 * tq, SB, SK, 16 * nv, 4, qs, lane); qn = mm(QH, SK, 16 * tq, SB, SK, 32, 4, qn, lane);
                const f32x4 eb = *(const LAS f32x4*)(EB + 16 * tq + 4 * lq);
                bf16* op = OF + ((size_t)b * SEQ + c * 64 + 16 * tq + 4 * lq) * D + h * 256 + vs * 32 + 16 * nv + (lr & ~1); f32x4 hv;
#pragma unroll
                for (int r = 0; r < 4; ++r) { const float nm = num[r] + eb[r] * qs[r]; float dn = den[r] + eb[r] * qn[r]; dn = __shfl(dn, lane & 48);
                    hv[r] = nm / fmaxf(fabsf(dn), 1.0f); }
                store_pairs(op, hv, lr); }
            { f32x4 U0 = {0.f, 0.f, 0.f, 0.f}, U1 = U0, U2 = U0; U0 = mm(KET, SS, 16 * w, VT, SS, 0, 2, U0, lane); U1 = mm(KET, SS, 16 * w, VT, SS, 16, 2, U1, lane); U2 = mm(KET, SS, 16 * w, VT, SS, 32, 2, U2, lane);
                const float dec = EC[0]; S0 = S0 * dec + U0; S1 = S1 * dec + U1; S2 = S2 * dec + U2; }
        };
        for (int c = 0; c < SEQ / 64; c += 2) { step(qvA, kvA, vvA, giA, gfA, c); step(qvB, kvB, vvB, giB, gfB, c + 1); }
        if (hcnt) headnorm_tail<8, true>(F, OF, SSQP, hcnt + b * 8 + h, b, h * 256 + vs * 32, h * 8, vs, PB, ML_PROJ, 4096 + h * 256 + vs * 32, gn + vs * 32, Y);
    }
}
}

template <bool ML>
__device__ __forceinline__ void headnorm_rows(const Frame& F, const bf16* OF, const float* gn, const bf16* gate, int ldg, bf16* Y) {
    constexpr int HD = ML ? 256 : 128, LPH = HD / 32;
    for (int row = F.gw; row < M; row += F.NGW) {
        const u32x4* p = (const u32x4*)(OF + (size_t)row * D + F.lane * 32);
        f32x4 v[8]; float ss = 0.f;
#pragma unroll
        for (int j = 0; j < 4; ++j) { const u32x4 w = p[j]; v[2 * j] = (f32x4){bflo(w.x), bfhi(w.x), bflo(w.y), bfhi(w.y)}; v[2 * j + 1] = (f32x4){bflo(w.z), bfhi(w.z), bflo(w.w), bfhi(w.w)}; }
#pragma unroll
        for (int j = 0; j < 8; ++j) ss += (v[j][0] * v[j][0] + v[j][1] * v[j][1]) + (v[j][2] * v[j][2] + v[j][3] * v[j][3]);
#pragma unroll
        for (int o = 1; o < LPH; o <<= 1) ss += __shfl_xor(ss, o);
        const float rstd = 1.0f / sqrtf(ss * (1.0f / HD) + EPS);
        const int cih = (F.lane * 32) % HD;
        const u32x4* gp = (const u32x4*)(gate + (size_t)row * ldg + F.lane * 32);
        u32x4* yp = (u32x4*)(Y + (size_t)row * D + F.lane * 32);
#pragma unroll
        for (int j = 0; j < 4; ++j) { const u32x4 gw = gp[j]; const f32x4 g0 = *(const f32x4*)(gn + cih + 8 * j), g1 = *(const f32x4*)(gn + cih + 8 * j + 4);
            float gg[8] = {bflo(gw.x), bfhi(gw.x), bflo(gw.y), bfhi(gw.y), bflo(gw.z), bfhi(gw.z), bflo(gw.w), bfhi(gw.w)};
            if constexpr (ML) {
#pragma unroll
                for (int i = 0; i < 8; ++i) gg[i] = sigmoidf_(gg[i]); }
            const f32x4 a = v[2 * j] * rstd * g0, c = v[2 * j + 1] * rstd * g1;
            u32x4 w; w.x = pk2(a[0] * gg[0], a[1] * gg[1]); w.y = pk2(a[2] * gg[2], a[3] * gg[3]); w.z = pk2(c[0] * gg[4], c[1] * gg[5]); w.w = pk2(c[2] * gg[6], c[3] * gg[7]);
            yp[j] = w; }
    }
}
__device__ __forceinline__ void lru_conv(const Frame& F, const bf16* UR, const float* cw, const float* cb, bf16* UCB) {
    const int total = M * (D / 4);
    for (int idx = F.bid * NT + F.tid; idx < total; idx += F.G * NT) {
        const int row = idx / (D / 4), c4 = (idx % (D / 4)) * 4, t = row % SEQ;
        f32x4 acc = *(const f32x4*)(cb + c4);
#pragma unroll
        for (int j = 0; j < 4; ++j) { const int dt = 3 - j; if (t - dt >= 0) { const u32x2 uw = *(const u32x2*)(UR + (size_t)(row - dt) * D + c4); acc += *(const f32x4*)(cw + j * D + c4) * (f32x4){bflo(uw.x), bfhi(uw.x), bflo(uw.y), bfhi(uw.y)}; } }
        u32x2 w; w.x = pk2(acc[0], acc[1]); w.y = pk2(acc[2], acc[3]); *(u32x2*)(UCB + (size_t)row * D + c4) = w;
    }
}
__device__ __forceinline__ void lru_scan(const Frame& F, const bf16* LA, const bf16* INP, const bf16* GBR, bf16* Y) {
    LAS float* CP = (LAS float*)F.lds; LAS float* CH = CP + 16 * 32;
    const int seg = F.tid >> 5, chl = F.tid & 31;
    for (int unit = F.bid; unit < BATCH * 64; unit += F.G) {
        const int b = unit >> 6, c = (unit & 63) * 32 + chl; const size_t base = ((size_t)b * SEQ + seg * 128) * D + c;
        float P = 1.f, h = 0.f;
        for (int t0 = 0; t0 < 128; t0 += 16) { float a[16], x[16];
#pragma unroll
            for (int j = 0; j < 16; ++j) { a[j] = ck::bf2f(LA[base + (size_t)(t0 + j) * D]); x[j] = ck::bf2f(INP[base + (size_t)(t0 + j) * D]); }
#pragma unroll
            for (int j = 0; j < 16; ++j) { a[j] = __expf(a[j]); h = a[j] * h + x[j]; P *= a[j]; } }
        __syncthreads();
        CP[seg * 32 + chl] = P; CH[seg * 32 + chl] = h;
        __syncthreads();
        float carry = 0.f;
        for (int s = 0; s < seg; ++s) carry = CP[s * 32 + chl] * carry + CH[s * 32 + chl];
        h = carry;
        for (int t0 = 0; t0 < 128; t0 += 16) { float a[16], x[16]; unsigned short gg[16];
#pragma unroll
            for (int j = 0; j < 16; ++j) { a[j] = ck::bf2f(LA[base + (size_t)(t0 + j) * D]); x[j] = ck::bf2f(INP[base + (size_t)(t0 + j) * D]); gg[j] = GBR[base + (size_t)(t0 + j) * D]; }
#pragma unroll
            for (int j = 0; j < 16; ++j) { h = __expf(a[j]) * h + x[j]; const float y = __uint_as_float((unsigned)gg[j] << 16) * h; Y[base + (size_t)(t0 + j) * D] = (bf16)(pk2(y, y) & 0xffffu); } }
    }
}
__device__ __forceinline__ void softmax_rows(const Frame& F, const float* S, bf16* P) {
    for (int row = F.gw; row < 16 * SEQ; row += F.NGW) {
        const f32x4 s = ((const f32x4*)(S + (size_t)row * NMEM))[F.lane];
        const float mx = wave_max(fmaxf(fmaxf(s[0], s[1]), fmaxf(s[2], s[3])));
        const f32x4 e = {__expf(s[0] - mx), __expf(s[1] - mx), __expf(s[2] - mx), __expf(s[3] - mx)};
        const float inv = 1.0f / wave_sum((e[0] + e[1]) + (e[2] + e[3]));
        u32x2 w; w.x = pk2(e[0] * inv, e[1] * inv); w.y = pk2(e[2] * inv, e[3] * inv); ((u32x2*)(P + (size_t)row * NMEM))[F.lane] = w;
    }
}


__device__ __forceinline__ int uni(int v) { return __builtin_amdgcn_readfirstlane(v); }
__device__ __forceinline__ Frame make_frame(unsigned ldsb) {
    Frame F; F.lds = (LAS unsigned char*)(size_t)__builtin_amdgcn_readfirstlane(ldsb);
    F.lane = (int)__builtin_amdgcn_mbcnt_hi(~0u, __builtin_amdgcn_mbcnt_lo(~0u, 0u));
    const unsigned key = hw_wave_key(); int w = 0;
#pragma unroll
    for (int i = 1; i < NWAVES; ++i) { const unsigned k = __builtin_amdgcn_readfirstlane(*(const LAS unsigned*)(F.lds + CTRL + 16 + 4 * i)); w = (k == key) ? i : w; }
    F.wave = w; F.tid = w * 64 + F.lane;
    F.bid = __builtin_amdgcn_readfirstlane(*(const LAS int*)(F.lds + CTRL + 48)); F.G = __builtin_amdgcn_readfirstlane(*(const LAS int*)(F.lds + CTRL + 52));
    F.gw = F.bid * NWAVES + F.wave; F.NGW = F.G * NWAVES; return F;
}
__device__ __forceinline__ void phase_end(const unsigned ldsb, int bar_) {
    if (uni(bar_)) { asm volatile("" ::: "memory"); const Frame F = make_frame(ldsb); XcdBarrier b; b.bar = (unsigned*)(F.ws() + WS_CTL); b.x = xb_xcc_id(); b.st = (volatile LAS unsigned*)(F.lds + CTRL); xcd_barrier(b, F.tid, (unsigned)F.G); }
}
#define PHASE_FN static __device__ __noinline__ __attribute__((not_tail_called)) void
#define PHASE_FN_G static __device__ __forceinline__ void

__device__ __forceinline__ int cvt_njobs(int l, int part) { return part == 0 ? ((l % 3) == 1 ? 2 + 1 + 32 : 2 + 1) : 3; }
__device__ __forceinline__ CvtJob cvt_job(const Frame& F, int l, int part, int j) {
    unsigned char* ws = F.ws(); const float* ng = F.in(I_NORMG); const int kind = l % 3, idx = l / 3;
    CvtJob J; J.gk = nullptr; J.off = 0; J.gu = 0; J.nvalid = 1 << 30;
    if (j == 0) { J.W = F.in(I_WGU) + (size_t)(l * 2 + part) * D * NGU; J.WT = (bf16*)(ws + WS_WGU + (size_t)(l * 2 + part) * SZ_WGU); J.K = D; J.ldw = NGU; J.nrows = NGU; J.gu = 1; J.gk = ng + ((size_t)l * 4 + (part ? 3 : 0)) * D; return J; }
    if (j == 1) { J.W = F.in(I_WDN) + (size_t)(l * 2 + part) * DFF * D; J.WT = (bf16*)(ws + WS_WDN + (size_t)(l * 2 + part) * SZ_WDN); J.K = DFF; J.ldw = D; J.nrows = D; return J; }
    if (part == 1) { J.K = D; J.ldw = D; J.nrows = D;
        if (kind == 0) { J.W = F.in(I_HGOUT) + (size_t)idx * D * D; J.WT = (bf16*)(ws + WS_HGOUT + (size_t)idx * SZ_WDD); }
        else if (kind == 1) { J.W = F.in(I_LRUOUT); J.WT = (bf16*)(ws + WS_LRUOUT); }
        else { J.W = F.in(I_MLOUT); J.WT = (bf16*)(ws + WS_MLOUT); }
        return J; }
    J.gk = ng + ((size_t)l * 4 + 1) * D; J.K = D;
    if (kind == 0) { J.W = F.in(I_HGIN) + (size_t)idx * D * 4 * D; J.WT = (bf16*)(ws + WS_HGIN + (size_t)idx * 4 * SZ_WDD); J.ldw = 4 * D; J.nrows = 4 * D; return J; }
    if (kind == 2) { J.W = F.in(I_MLIN); J.WT = (bf16*)(ws + WS_MLIN); J.ldw = ML_IN; J.nrows = ML_PROJ; return J; }
    if (j == 2) { J.W = F.in(I_LRUIN); J.WT = (bf16*)(ws + WS_LRUIN); J.ldw = 2 * D; J.nrows = 2 * D; return J; }
    { const int q = j - 3, g = q >> 4, blk = (q >> 1) & 7, jj = q & 1;
        J.gk = nullptr; J.W = F.in(g ? I_LRUWX : I_LRUWA) + (size_t)blk * 256 * 256; J.WT = (bf16*)(ws + WS_LRUG) + (size_t)(blk * 512 + jj * 256 + g * 128) * 256; J.K = 256; J.ldw = 256; J.nrows = 128; J.off = jj * 128; return J; }
}
__device__ __forceinline__ void convert_set(const Frame& F, int& rot, int l, int part, int num0 = 0, int num1 = 8) {
    const int nj = cvt_njobs(l, part);
    for (int j = 0; j < nj; ++j) { const CvtJob J = cvt_job(F, l, part, j); convert_job_rt(F, rot, J, num0, num1); }
}
constexpr int CVT_SC = 3;
PHASE_FN_G ph_prologue(unsigned ldsb, int bar_) {
    const Frame F = make_frame(ldsb);
    unsigned char* ws = F.ws(); int rot = 0;
    convert_set(F, rot, 0, 0);
    for (int l = 0; l < DEPTH; ++l) for (int kv = 0; kv < 2; ++kv) { CvtJob J; J.gk = nullptr; J.gu = 0; J.nvalid = 1 << 30; J.K = D; J.ldw = 2 * D; J.nrows = D; J.off = kv * D;
        J.W = F.in(I_XAKV) + (size_t)l * D * 2 * D; J.WT = (bf16*)(ws + (kv ? WS_WV : WS_WK) + (size_t)l * SZ_WDD); convert_job_rt(F, rot, J); }
    for (int l = 0; l < DEPTH; ++l) { CvtJob J; J.gk = nullptr; J.gu = 0; J.nvalid = 1 << 30; J.K = D; J.ldw = D; J.nrows = D; J.off = 0;
        J.W = F.in(I_XAO) + (size_t)l * D * D; J.WT = (bf16*)(ws + WS_WO + (size_t)l * SZ_WDD); convert_job_rt(F, rot, J); }
    { const float* wq = F.in(I_XAQ); const float* ngq = F.in(I_NORMG); bf16* wqn = (bf16*)(ws + WS_WQ);
      for (size_t i = (size_t)F.bid * NT + F.tid; i < (size_t)DEPTH * D * D / 8; i += (size_t)F.G * NT) { const size_t e = i * 8; const int l = (int)(e / ((size_t)D * D)), d = (int)((e / D) % D);
          const float g = ngq[((size_t)l * 4 + 2) * D + d]; const f32x4 a = __builtin_nontemporal_load((const f32x4*)(wq + e)), b = __builtin_nontemporal_load((const f32x4*)(wq + e + 4));
          u32x4 w; w.x = pk2(a[0] * g, a[1] * g); w.y = pk2(a[2] * g, a[3] * g); w.z = pk2(b[0] * g, b[1] * g); w.w = pk2(b[2] * g, b[3] * g); *(u32x4*)(wqn + e) = w; } }
    float* misc = (float*)(ws + WS_MISC);
    const int gt = F.bid * NT + F.tid, GT = F.G * NT;
    const float* hglb = F.in(I_HGLB); const float* lamp = F.in(I_LRULAM);
    for (int c = gt; c < 2048; c += GT) {
        const float p0 = hglb[c], p1 = hglb[2048 + c], p2 = hglb[4096 + c], p3 = hglb[6144 + c];
        const float mx = fmaxf(fmaxf(p0, p1), fmaxf(p2, p3)); const float e0 = expf(p0 - mx), e1 = expf(p1 - mx), e2 = expf(p2 - mx), e3 = expf(p3 - mx); const float inv = 1.0f / (e0 + e1 + e2 + e3);
        misc[MISC_LB / 4 + c] = 0.f; misc[MISC_LB / 4 + 2048 + c] = e1 * inv; misc[MISC_LB / 4 + 4096 + c] = (e1 + e2) * inv; misc[MISC_LB / 4 + 6144 + c] = (e1 + e2 + e3) * inv;
        const float lam = lamp[c]; const float sp = fmaxf(-lam, 0.f) + log1pf(expf(-fabsf(lam)));
        misc[MISC_C8 / 4 + c] = 8.0f * sp;
    }
    { const float* mlin = F.in(I_MLIN); const float* g21 = F.in(I_NORMG) + ((size_t)2 * 4 + 1) * D;
      bf16* wgb = (bf16*)(misc + MISC_MLWG / 4);
      for (int i = gt; i < 16 * 2048; i += GT) { const int c = i >> 11, k = i & 2047; const float w_ = g21[k] * mlin[(size_t)k * ML_IN + ML_PROJ + c]; wgb[i] = (bf16)(pk2(w_, w_) & 0xffffu); } }
    x_to_stream(F, F.in(I_X), (bf16*)(ws + WS_HB), misc + MISC_SSQ / 4);
    norm_rows<false>(F, F.in(I_MEM), F.in(I_MEMG), (bf16*)(ws + WS_MEMN), MMEM, nullptr, nullptr);
    phase_end(ldsb, bar_);
}

enum { NRM_FFN1 = 0, NRM_MIX = 1, NRM_ATT = 2, NRM_FFN2 = 3 };
PHASE_FN ph_final(unsigned ldsb) { const Frame F = make_frame(ldsb); unsigned char* ws = F.ws();
    if (X_F32) final_norm(F, (const float*)(ws + WS_X), F.in(I_FINALG), F.out()); else final_norm_bf(F, (const bf16*)(ws + WS_HB), (const float*)(ws + WS_MISC) + MISC_SSQ / 4, F.in(I_FINALG), F.out()); }
constexpr size_t CTL_HCNT = 32768;
PHASE_FN_G ph_hg_recur(unsigned ldsb, int l_, int bar_) { const Frame F = make_frame(ldsb); unsigned char* ws = F.ws(); const int l = uni(l_);
    bf16* QB = (bf16*)(ws + WS_P0); bf16* KB = QB + (size_t)M * D; bf16* VB = KB + (size_t)M * D; bf16* LF = (bf16*)(ws + WS_P1); bf16* OF = LF + (size_t)2 * M * D;
    const bool fuse = F.G >= 256;
    ck::hg_chunk_phase(F, QB, LF, KB, VB, OF, VB + (size_t)M * D, F.in(I_HGG) + (l / 3) * HG_D, (bf16*)(ws + WS_YB), (float*)(ws + WS_SC), fuse ? (unsigned*)(ws + WS_CTL + CTL_HCNT) + l * 64 : nullptr); phase_end(ldsb, bar_); }
PHASE_FN ph_hg_norm(unsigned ldsb, int idx_, int bar_) { const Frame F = make_frame(ldsb); unsigned char* ws = F.ws(); const int idx = uni(idx_); if (F.G >= 256) return;
    bf16* GB = (bf16*)(ws + WS_P0) + (size_t)3 * M * D; const bf16* OF = (const bf16*)(ws + WS_P1) + (size_t)2 * M * D;
    headnorm_rows<false>(F, OF, F.in(I_HGG) + idx * HG_D, GB, D, (bf16*)(ws + WS_YB)); phase_end(ldsb, bar_); }
PHASE_FN_G ph_ml_recur(unsigned ldsb, int l_, int bar_) { const Frame F = make_frame(ldsb); unsigned char* ws = F.ws(); const int l = uni(l_); const bool fuse = F.G >= 256;
    ck::ml_chunk_phase(F, (const bf16*)(ws + WS_P0), (const float*)(ws + WS_MISC) + MISC_GATES / 4, F.in(I_MLBIF), (bf16*)(ws + WS_P1), F.in(I_MLG), (bf16*)(ws + WS_YB), (float*)(ws + WS_SC), fuse ? (unsigned*)(ws + WS_CTL + CTL_HCNT) + l * 64 : nullptr); phase_end(ldsb, bar_); }
PHASE_FN ph_ml_gates(unsigned ldsb, int bar_) { const Frame F = make_frame(ldsb); unsigned char* ws = F.ws(); const float* misc = (const float*)(ws + WS_MISC);
    ml_gates_rows(F, (const bf16*)(ws + WS_HB), misc + MISC_SSQ / 4, (const bf16*)(misc + MISC_MLWG / 4), (float*)(ws + WS_MISC) + MISC_GATES / 4); phase_end(ldsb, bar_); }
PHASE_FN ph_ml_norm(unsigned ldsb, int bar_) { const Frame F = make_frame(ldsb); unsigned char* ws = F.ws(); if (F.G >= 256) return;
    headnorm_rows<true>(F, (const bf16*)(ws + WS_P1), F.in(I_MLG), (const bf16*)(ws + WS_P0) + 4096, ML_PROJ, (bf16*)(ws + WS_YB)); phase_end(ldsb, bar_); }
PHASE_FN ph_lru_conv(unsigned ldsb, int bar_) { const Frame F = make_frame(ldsb); unsigned char* ws = F.ws();
    lru_conv(F, (const bf16*)(ws + WS_P1), F.in(I_CONVW), F.in(I_CONVB), (bf16*)(ws + WS_P0) + (size_t)M * D); phase_end(ldsb, bar_); }
PHASE_FN ph_lru_scan(unsigned ldsb, int bar_) { const Frame F = make_frame(ldsb); unsigned char* ws = F.ws();
    lru_scan(F, (const bf16*)(ws + WS_P1) + (size_t)4 * M * D, (const bf16*)(ws + WS_P1) + (size_t)2 * M * D, (const bf16*)(ws + WS_P0), (bf16*)(ws + WS_YB)); phase_end(ldsb, bar_); }
PHASE_FN ph_softmax(unsigned ldsb, int bar_) { const Frame F = make_frame(ldsb); unsigned char* ws = F.ws(); softmax_rows(F, (const float*)(ws + WS_SC), (bf16*)(ws + WS_PB)); phase_end(ldsb, bar_); }

PHASE_FN_G ph_gemm_kv(unsigned ldsb, int bar_) {
    const Frame F = make_frame(ldsb); unsigned char* ws = F.ws(); const int half = F.G >> 1;
    if (F.bid < half) { pg8::PlainSched<D, D, MMEM, 4 * D> S; S.gsub = half; S.coff = 0; S.init(F.lds, ws + WS_MEMN, ws + WS_WK);
        auto E = [=]() { const Frame F2 = make_frame(ldsb); unsigned char* ws = F2.ws(); return pg8::EpiBf16P{(bf16*)(ws + WS_KALL), 4 * D, 0, 0, 1.f, nullptr}; };
        pg8::gemm_phase(F.lds, F.tid, D, D, D, S, E); }
    else { pg8::PlainSched<D, D, MMEM, 4 * D> S; S.gsub = F.G - half; S.coff = half; S.init(F.lds, ws + WS_MEMN, ws + WS_WV);
        auto E = [=]() { const Frame F2 = make_frame(ldsb); unsigned char* ws = F2.ws(); return pg8::EpiBf16P{(bf16*)(ws + WS_VT), 4 * D, 0, 0, 1.f, nullptr}; };
        pg8::gemm_phase(F.lds, F.tid, D, D, D, S, E); }
    phase_end(ldsb, bar_);
}
PHASE_FN_G ph_gemm_mlin(unsigned ldsb, int bar_) {
    const Frame F = make_frame(ldsb); unsigned char* ws = F.ws();
    pg8::PlainSched<D, D, M, ML_PROJ> S; S.init(F.lds, ws + WS_HB, ws + WS_MLIN); auto E = [=]() { const Frame F2 = make_frame(ldsb); unsigned char* ws = F2.ws(); (void)ws; return pg8::EpiBf16P{(bf16*)(ws + WS_P0), ML_PROJ, 0, 0, 1.f, (const float*)(ws + WS_MISC) + MISC_SSQ / 4}; };
    pg8::gemm_phase(F.lds, F.tid, D, D, D, S, E); phase_end(ldsb, bar_);
}
PHASE_FN_G ph_gemm_qproj(unsigned ldsb, int l_, int bar_) {
    const Frame F = make_frame(ldsb); const int l = uni(l_); unsigned char* ws = F.ws();
    pg8::PlainSched<D, D, M, D> S; S.init(F.lds, ws + WS_HB, ws + WS_WQ + (size_t)l * SZ_WDD); auto E = [=]() { const Frame F2 = make_frame(ldsb); unsigned char* ws = F2.ws(); (void)ws; return pg8::EpiBf16P{(bf16*)(ws + WS_QB2), D, 0, 0, 1.f, (const float*)(ws + WS_MISC) + MISC_SSQ / 4}; };
    pg8::gemm_phase(F.lds, F.tid, D, D, D, S, E); phase_end(ldsb, bar_);
}
PHASE_FN_G ph_gemm_dn(unsigned ldsb, int l_, int f_, int bar_) {
    const Frame F = make_frame(ldsb); const int l = uni(l_), f = uni(f_) & 1; const float dsc = uni(f_) >= 2 ? 0.0f : 0.5f; unsigned char* ws = F.ws();
    pg8::PlainSched<DFF, DFF, M, D> S; S.init(F.lds, ws + WS_ACT, ws + WS_WDN + (size_t)(l * 2 + f) * SZ_WDN); auto E = [=]() { const Frame F2 = make_frame(ldsb); unsigned char* ws = F2.ws(); (void)ws; float* X = (float*)(ws + WS_X); const float* xin = (l == 0 && f == 0) ? F2.in(I_X) : X; return pg8::EpiResid{xin, X, (bf16*)(ws + WS_HB), (float*)(ws + WS_MISC) + MISC_SSQ / 4, dsc, F2.lds, F2.tid}; };
    pg8::gemm_phase(F.lds, F.tid, DFF, DFF, DFF, S, E); phase_end(ldsb, bar_);
}
enum { GR_MIXOUT = 0, GR_OPROJ, GR_PROBE0 };
PHASE_FN_G ph_gemm_resid(unsigned ldsb, int which_, int l_, int bar_) {
    const Frame F = make_frame(ldsb); const int which = uni(which_), l = uni(l_); unsigned char* ws = F.ws();
    const int kind = l % 3, idx = l / 3;
    const size_t wo = which == GR_OPROJ ? WS_WO + (size_t)l * SZ_WDD : (kind == 0 ? WS_HGOUT + (size_t)idx * SZ_WDD : (kind == 1 ? WS_LRUOUT : WS_MLOUT));
    const size_t ao = which == GR_OPROJ ? WS_OB : WS_YB; const float rs_ = which == GR_PROBE0 ? 0.0f : 1.0f;
    pg8::PlainSched<D, D, M, D> S; S.init(F.lds, ws + ao, ws + wo); auto E = [=]() { const Frame F2 = make_frame(ldsb); unsigned char* ws = F2.ws(); (void)ws; float* X = (float*)(ws + WS_X); return pg8::EpiResid{X, X, (bf16*)(ws + WS_HB), (float*)(ws + WS_MISC) + MISC_SSQ / 4, rs_, F2.lds, F2.tid}; };
    pg8::gemm_phase(F.lds, F.tid, D, D, D, S, E); phase_end(ldsb, bar_);
}
PHASE_FN_G ph_gemm_gu(unsigned ldsb, int l_, int f_, int bar_) {
    const Frame F = make_frame(ldsb); const int l = uni(l_), f = uni(f_); unsigned char* ws = F.ws();
    pg8::PlainSched<D, D, M, NGU> S; S.init(F.lds, ws + WS_HB, ws + WS_WGU + (size_t)(l * 2 + f) * SZ_WGU); auto E = [=]() { const Frame F2 = make_frame(ldsb); unsigned char* ws = F2.ws(); (void)ws; return pg8::EpiSwiGLU{(bf16*)(ws + WS_ACT), (const float*)(ws + WS_MISC) + MISC_SSQ / 4}; };
    pg8::gemm_phase(F.lds, F.tid, D, D, D, S, E);
    { constexpr int NU = (M / 256) * (NGU / 256); const int rounds = (NU + F.G - 1) / F.G, busy = NU - (rounds - 1) * F.G;
        const int nl = f ? l + 1 : l, np = f ? 0 : 1;
        if (nl < DEPTH && F.bid >= busy && busy < F.G) { Frame Fc = F; Fc.gw = (F.bid - busy) * NWAVES + F.wave; Fc.NGW = (F.G - busy) * NWAVES; int rot = 0; convert_set(Fc, rot, nl, np); } }
    phase_end(ldsb, bar_);
}
PHASE_FN_G ph_gemm_hgin(unsigned ldsb, int l_, int bar_) {
    const Frame F = make_frame(ldsb); const int l = uni(l_), idx = l / 3; unsigned char* ws = F.ws();
    pg8::PlainSched<D, D, M, 4 * D> S; S.init(F.lds, ws + WS_HB, ws + WS_HGIN + (size_t)idx * 4 * SZ_WDD);
    auto E = [=]() { const Frame F2 = make_frame(ldsb); unsigned char* ws = F2.ws(); (void)ws; return pg8::EpiHgIn{(bf16*)(ws + WS_P0), (bf16*)(ws + WS_P1), (const float*)(ws + WS_MISC) + MISC_LB / 4 + l * 2048, (const float*)(ws + WS_MISC) + MISC_SSQ / 4}; };
    pg8::gemm_phase(F.lds, F.tid, D, D, D, S, E); phase_end(ldsb, bar_);
}
PHASE_FN_G ph_gemm_lruin(unsigned ldsb, int bar_) {
    const Frame F = make_frame(ldsb); unsigned char* ws = F.ws();
    pg8::PlainSched<D, D, M, 2 * D> S; S.init(F.lds, ws + WS_HB, ws + WS_LRUIN); auto E = [=]() { const Frame F2 = make_frame(ldsb); unsigned char* ws = F2.ws(); (void)ws; return pg8::EpiLruIn{(bf16*)(ws + WS_P0), (bf16*)(ws + WS_P1), (const float*)(ws + WS_MISC) + MISC_SSQ / 4}; };
    pg8::gemm_phase(F.lds, F.tid, D, D, D, S, E); phase_end(ldsb, bar_);
}
PHASE_FN_G ph_gemm_lrugate(unsigned ldsb, int bar_) {
    const Frame F = make_frame(ldsb); unsigned char* ws = F.ws();
    bf16* UCB = (bf16*)(ws + WS_P0) + (size_t)M * D;
    pg8::PlainSched<D, 256, M, 4096, 1, 512> S; S.init(F.lds, UCB, ws + WS_LRUG);
    auto E = [=]() { const Frame F2 = make_frame(ldsb); unsigned char* ws = F2.ws(); (void)ws; bf16* P1b = (bf16*)(ws + WS_P1); return pg8::EpiLruGate{(const bf16*)(ws + WS_P0) + (size_t)M * D, F2.in(I_LRUBA), F2.in(I_LRUBX), (const float*)(ws + WS_MISC) + MISC_C8 / 4, P1b + (size_t)4 * M * D, P1b + (size_t)2 * M * D}; };
    pg8::gemm_phase(F.lds, F.tid, D, 256, 256, S, E); phase_end(ldsb, bar_);
}
PHASE_FN_G ph_gemm_scores(unsigned ldsb, int l_, int bar_) {
    const Frame F = make_frame(ldsb); const int l = uni(l_); unsigned char* ws = F.ws();
    pg8::BatchSched S; S.init(F.lds, ws + WS_QB2, ws + WS_KALL + (size_t)l * D * 2);
    S.a_b = SEQ * D * 2; S.a_h = XA_D * 2; S.a_pm = 256 * D * 2; S.b_b = NMEM * 4 * D * 2; S.b_h = XA_D * 2; S.b_pn = 0; S.nM = SEQ / 256; S.nN = 1; S.nwg = 16 * S.nM;
    auto E = [=]() { const Frame F2 = make_frame(ldsb); unsigned char* ws = F2.ws(); (void)ws; return pg8::EpiF32Z{(float*)(ws + WS_SC), 0.044194173824159216f}; };
    pg8::gemm_phase(F.lds, F.tid, D, 4 * D, XA_D, S, E);
    phase_end(ldsb, bar_);
}
PHASE_FN_G ph_gemm_pv(unsigned ldsb, int l_, int bar_) {
    const Frame F = make_frame(ldsb); const int l = uni(l_); unsigned char* ws = F.ws();
    pg8::BatchSched S; S.init(F.lds, ws + WS_PB, ws + WS_VT + (size_t)l * D * MMEM * 2);
    S.a_b = 4 * SEQ * NMEM * 2; S.a_h = SEQ * NMEM * 2; S.a_pm = 256 * NMEM * 2; S.b_b = NMEM * 2; S.b_h = XA_D * MMEM * 2; S.b_pn = 256 * MMEM * 2; S.nM = SEQ / 256; S.nN = 2; S.nwg = 16 * S.nM * 2;
    auto E = [=]() { const Frame F2 = make_frame(ldsb); unsigned char* ws = F2.ws(); (void)ws; return pg8::EpiBf16P{(bf16*)(ws + WS_OB), D, (size_t)SEQ * D, XA_D, 1.f, nullptr}; };
    pg8::gemm_phase(F.lds, F.tid, NMEM, MMEM, NMEM, S, E);
    phase_end(ldsb, bar_);
}

PHASE_FN_G ph_attn(unsigned ldsb, int l_, int bar_) {
    const Frame F = make_frame(ldsb); const int l = uni(l_); unsigned char* ws = F.ws();
    for (int u = F.bid; u < 256; u += F.G) {
        const int z = u >> 4, pm = (u >> 1) & 7, pn = u & 1, b = z >> 2, h = z & 3;
        bf16* Pc = (bf16*)(ws + (pn ? WS_SC : WS_PB)) + ((size_t)z * SEQ + pm * 256) * NMEM;
        { pg8::OneSched S; S.A = (const char*)((const bf16*)(ws + WS_QB2) + ((size_t)b * SEQ + pm * 256) * D + h * XA_D); S.B = (const char*)((const bf16*)(ws + WS_KALL) + (size_t)b * NMEM * 4 * D + (size_t)l * D + h * XA_D); S.u0 = pg8::Unit{pm, 0, z};
          auto E = [=]() { const Frame F2 = make_frame(ldsb); return pg8::EpiSoftmax{Pc, 0.044194173824159216f, F2.lds}; };
          pg8::gemm_phase(F.lds, F.tid, D, 4 * D, XA_D, S, E); }
        if (F.tid == 0) __builtin_amdgcn_fence(__ATOMIC_ACQUIRE, "agent");
        asm volatile("s_waitcnt vmcnt(0)" ::: "memory"); __syncthreads();
        { pg8::OneSched S; S.A = (const char*)Pc; S.B = (const char*)((const bf16*)(ws + WS_VT) + ((size_t)l * D + h * XA_D + pn * 256) * MMEM + b * NMEM); S.u0 = pg8::Unit{pm, pn, z};
          auto E = [=]() { const Frame F2 = make_frame(ldsb); unsigned char* ws2 = F2.ws(); return pg8::EpiBf16P{(bf16*)(ws2 + WS_OB), D, (size_t)SEQ * D, XA_D, 1.f, nullptr}; };
          pg8::gemm_phase(F.lds, F.tid, NMEM, MMEM, NMEM, S, E); }
    }
    phase_end(ldsb, bar_);
}

__device__ __forceinline__ void gtut_units(const Frame& F, const unsigned ldsb, int la, int lb, int gsub, int coff) {
    unsigned char* ws = F.ws(); const int c = (F.bid >= coff && F.bid < coff + gsub) ? F.bid - coff : -1;
    { pg8::GtSched S{(const char*)(ws + WS_KALL), (const char*)(ws + WS_WQ), gsub, c, la * 128, lb * 128};
      auto E = [=]() { const Frame F2 = make_frame(ldsb); unsigned char* ws2 = F2.ws(); return pg8::EpiBf16P{(bf16*)(ws2 + WS_GT), D, (size_t)4 * NMEM * D, (size_t)NMEM * D, 1.f, nullptr}; };
      pg8::gemm_phase(F.lds, F.tid, 4 * D, D, XA_D, S, E); }
    { pg8::UtSched S{(const char*)(ws + WS_WO), (const char*)(ws + WS_VT), gsub, c, la * 128, lb * 128};
      auto E = [=]() { const Frame F2 = make_frame(ldsb); unsigned char* ws2 = F2.ws(); return pg8::EpiBf16P{(bf16*)(ws2 + WS_UT), 4 * NMEM, (size_t)D * 4 * NMEM, (size_t)NMEM, 1.f, nullptr}; };
      pg8::gemm_phase(F.lds, F.tid, D, 4 * D, XA_D, S, E); }
}
PHASE_FN_G ph_gemm_gtut(unsigned ldsb, int bar_) {
    const Frame F = make_frame(ldsb); gtut_units(F, ldsb, 0, 1, F.G, 0); phase_end(ldsb, bar_);
}
PHASE_FN_G ph_attn_scores(unsigned ldsb, int l_, int bar_) {
    const Frame F = make_frame(ldsb); const int l = uni(l_); unsigned char* ws = F.ws();
    pg8::ScSched S{(const char*)(ws + WS_HB), (const char*)(ws + WS_GT) + (size_t)l * 16 * NMEM * D * 2, F.G, F.bid};
    auto E = [=]() { const Frame F2 = make_frame(ldsb); unsigned char* ws2 = F2.ws(); return pg8::EpiSoftmax{(bf16*)(ws2 + WS_PB), 0.044194173824159216f, F2.lds, (const float*)(ws2 + WS_MISC) + MISC_SSQ / 4}; };
    pg8::gemm_phase(F.lds, F.tid, D, D, D, S, E);
    if (l + 1 < DEPTH) gtut_units(F, ldsb, l + 1, l + 2, F.G > 128 ? F.G - 128 : F.G, F.G > 128 ? 128 : 0);
    phase_end(ldsb, bar_);
}
PHASE_FN_G ph_gemm_attnout(unsigned ldsb, int l_, int bar_) {
    const Frame F = make_frame(ldsb); const int l = uni(l_); unsigned char* ws = F.ws();
    pg8::PlainSched<4 * NMEM, 4 * NMEM, M, D, 30, 0, 3, (unsigned)(D * 4 * NMEM * 2)> S; S.init(F.lds, ws + WS_PB, ws + WS_UT + (size_t)l * 4 * D * 4 * NMEM * 2);
    auto E = [=]() { const Frame F2 = make_frame(ldsb); unsigned char* ws2 = F2.ws(); float* X = (float*)(ws2 + WS_X); return pg8::EpiResid{X, X, (bf16*)(ws2 + WS_HB), (float*)(ws2 + WS_MISC) + MISC_SSQ / 4, 1.0f, F2.lds, F2.tid}; };
    pg8::gemm_phase(F.lds, F.tid, 4 * NMEM, 4 * NMEM, 4 * NMEM, S, E);
    phase_end(ldsb, bar_);
}

constexpr int SLOTS = 19, PH_LAYER0 = 3, PH_FINAL = PH_LAYER0 + DEPTH * SLOTS, N_PHASES = PH_FINAL + 1;
enum { SL_NORM0 = 0, SL_GU1, SL_DN1, SL_NORM1, SL_MIXIN, SL_MIXA, SL_MIXB, SL_MIXC, SL_MIXOUT, SL_NORM2, SL_QPROJ, SL_SCORES, SL_SOFTMAX, SL_PV, SL_OPROJ, SL_NORM3, SL_GU2, SL_DN2, SL_SPARE };
__host__ __device__ constexpr bool phase_used(int ph) {
    if (ph < PH_LAYER0 || ph == PH_FINAL) return true;
    const int l = (ph - PH_LAYER0) / SLOTS, s = (ph - PH_LAYER0) % SLOTS, kind = l % 3;
    if (s == SL_SPARE || s == SL_QPROJ || s == SL_SOFTMAX || s == SL_PV || s == SL_NORM0 || s == SL_NORM1 || s == SL_NORM2 || s == SL_NORM3) return false;
    if (s == SL_MIXC) return kind != 0;
    return true;
}
__device__ __forceinline__ int ctl_lo(unsigned ldsb) { return __builtin_amdgcn_readfirstlane(*(volatile LAS int*)((LAS unsigned char*)(size_t)ldsb + CTRL + 56)); }
__device__ __forceinline__ int ctl_hi(unsigned ldsb) { return __builtin_amdgcn_readfirstlane(*(volatile LAS int*)((LAS unsigned char*)(size_t)ldsb + CTRL + 60)); }
#define RUN(k, fn, ...) do { const int hi_ = ctl_hi(ldsb); if (ctl_lo(ldsb) <= (k) && (k) < hi_) fn(ldsb, ##__VA_ARGS__, ((k) + 1 < hi_) ? 1 : 0); } while (0)

template <int L> __device__ __forceinline__ void run_layer(const unsigned ldsb) {
    constexpr int pb = PH_LAYER0 + L * SLOTS, kind = L % 3;
    RUN(pb + SL_GU1, ph_gemm_gu, L, 0);
    RUN(pb + SL_DN1, ph_gemm_dn, L, 0);
    if constexpr (kind == 0) {
        RUN(pb + SL_MIXIN, ph_gemm_hgin, L);
        RUN(pb + SL_MIXA, ph_hg_recur, L);
        RUN(pb + SL_MIXB, ph_hg_norm, L / 3);
    } else if constexpr (kind == 1) {
        RUN(pb + SL_MIXIN, ph_gemm_lruin);
        RUN(pb + SL_MIXA, ph_lru_conv);
        RUN(pb + SL_MIXB, ph_gemm_lrugate);
        RUN(pb + SL_MIXC, ph_lru_scan);
    } else {
        RUN(pb + SL_MIXIN, ph_gemm_mlin);
        RUN(pb + SL_MIXA, ph_ml_gates);
        RUN(pb + SL_MIXB, ph_ml_recur, L);
        RUN(pb + SL_MIXC, ph_ml_norm);
    }
    RUN(pb + SL_MIXOUT, ph_gemm_resid, GR_MIXOUT, L);
    RUN(pb + SL_SCORES, ph_attn_scores, L);
    RUN(pb + SL_OPROJ, ph_gemm_attnout, L);
    RUN(pb + SL_GU2, ph_gemm_gu, L, 1);
    RUN(pb + SL_DN2, ph_gemm_dn, L, 1);
}

__global__ void __launch_bounds__(NT, 2) fwd_kernel(Args args) {
    extern __shared__ __attribute__((aligned(16))) unsigned char lds_raw[];
    LAS unsigned char* lds = (LAS unsigned char*)lds_raw;
    const unsigned ldsb = (unsigned)(size_t)lds;
    {
        const int tid = threadIdx.x, lane = tid & 63, wave = tid >> 6;
        LAS unsigned* cw = (LAS unsigned*)(lds + CTRL);
        if (tid < 4) cw[tid] = 0u;
        if (lane == 0) cw[4 + wave] = hw_wave_key();
        if (tid == 0) { cw[12] = blockIdx.x; cw[13] = gridDim.x; cw[14] = (unsigned)args.ph_lo; cw[15] = (unsigned)args.ph_hi;
            LAS unsigned long long* ap = (LAS unsigned long long*)(lds + CTRL + 64);
#pragma unroll
            for (int i = 0; i < 27; ++i) ap[i] = (unsigned long long)args.in[i];
            ap[27] = (unsigned long long)args.out; ap[28] = (unsigned long long)args.ws; }
        __syncthreads();
        if (args.ph_hi - args.ph_lo > 1 && tid == 0) (void)xb_add(&((unsigned*)(args.ws + WS_CTL))[XB_XCNT(xb_xcc_id())], 1u);
    }
    RUN(0, ph_prologue);
    RUN(1, ph_gemm_kv);
    RUN(2, ph_gemm_gtut);
    run_layer<0>(ldsb); run_layer<1>(ldsb); run_layer<2>(ldsb); run_layer<3>(ldsb);
    { if (ctl_lo(ldsb) <= PH_FINAL && PH_FINAL < ctl_hi(ldsb)) ph_final(ldsb); }
}

extern "C" void kernel_launch(void* const* d_in, const int* in_sizes, int n_in, void* d_out, int out_size, void* d_ws, size_t ws_size, hipStream_t stream) {
    static int grid = 0;
    if (grid == 0) {
        if (n_in != 27 || in_sizes[0] != M * D || out_size != M * D || ws_size < WS_END) { fprintf(stderr, "kernel_launch: unexpected shapes (n_in %d, in0 %d, out %d, ws %zu < %zu)\n", n_in, n_in > 0 ? in_sizes[0] : -1, out_size, ws_size, (size_t)WS_END); grid = -1; return; }
        int dev = 0, cus = 0, per_cu = 0;
        if (hipGetDevice(&dev) != hipSuccess || hipDeviceGetAttribute(&cus, hipDeviceAttributeMultiprocessorCount, dev) != hipSuccess) { grid = -1; return; }
        if (hipFuncSetAttribute((const void*)fwd_kernel, hipFuncAttributeMaxDynamicSharedMemorySize, LDS_BYTES) != hipSuccess) { fprintf(stderr, "kernel_launch: hipFuncSetAttribute failed\n"); grid = -1; return; }
        if (hipOccupancyMaxActiveBlocksPerMultiprocessor(&per_cu, (const void*)fwd_kernel, NT, LDS_BYTES) != hipSuccess || per_cu < 1) fprintf(stderr, "kernel_launch: occupancy query reports %d\n", per_cu);
        (void)hipGetLastError();
        grid = cus;
    }
    if (grid < 0) return;
    if (hipMemsetAsync((char*)d_ws + WS_CTL, 0, CTL_BYTES, stream) != hipSuccess) { fprintf(stderr, "kernel_launch: memset failed\n"); return; }
    Args a{};
    for (int i = 0; i < 27; ++i) a.in[i] = (const float*)d_in[i];
    a.out = (float*)d_out; a.ws = (unsigned char*)d_ws;
#if MK_ONE_LAUNCH
    a.ph_lo = 0; a.ph_hi = N_PHASES;
    hipLaunchKernelGGL(fwd_kernel, dim3(grid), dim3(NT), LDS_BYTES, stream, a);
#else
    for (int ph = 0; ph < N_PHASES; ++ph) { if (!phase_used(ph)) continue; a.ph_lo = ph; a.ph_hi = ph + 1;
        hipLaunchKernelGGL(fwd_kernel, dim3(grid), dim3(NT), LDS_BYTES, stream, a);
        const hipError_t le = hipPeekAtLastError(); if (le != hipSuccess) { fprintf(stderr, "kernel_launch: launch of phase %d failed: %s\n", ph, hipGetErrorName(le)); break; } }
#endif
}
```

```cpp
#include <hip/hip_runtime.h>
#include <cstdio>
#include <cstdint>

#ifndef X_F32
#define X_F32 0
#endif
#ifndef MK_ONE_LAUNCH
#define MK_ONE_LAUNCH 1
#define FUSE_TAIL 0
#ifndef FUSE_TAIL
#define FUSE_TAIL 1
#endif
#endif

#define LAS __attribute__((address_space(3)))
typedef unsigned short bf16;
typedef short bf16x8 __attribute__((ext_vector_type(8)));
typedef float f32x4 __attribute__((ext_vector_type(4)));
typedef float f32x2 __attribute__((ext_vector_type(2)));
typedef unsigned u32x4 __attribute__((ext_vector_type(4)));
typedef unsigned u32x2 __attribute__((ext_vector_type(2)));
#define GAS __attribute__((address_space(1)))

constexpr int BATCH = 4, SEQ = 2048, D = 2048, DEPTH = 4, M = BATCH * SEQ;
constexpr int NMEM = 256, MMEM = BATCH * NMEM;
constexpr int DFF = 5504, NGU = 2 * DFF;
constexpr int HG_H = 16, HG_D = 128;
constexpr int ML_H = 8, ML_DQK = 128, ML_DV = 256, ML_IN = 6160, ML_PROJ = 6144;
constexpr int XA_H = 4, XA_D = 512;
constexpr float EPS = 1e-6f;
constexpr int LDS_BYTES = 147456;
constexpr int CTRL = LDS_BYTES - 512;

__device__ __forceinline__ unsigned pk2(float lo, float hi) { unsigned r; asm volatile("v_cvt_pk_bf16_f32 %0, %1, %2" : "=v"(r) : "v"(lo), "v"(hi)); return r; }
__device__ __forceinline__ float bflo(unsigned w) { return __uint_as_float(w << 16); }
__device__ __forceinline__ float bfhi(unsigned w) { return __uint_as_float(w & 0xffff0000u); }
__device__ __forceinline__ float sigmoidf_(float x) { return __builtin_amdgcn_rcpf(1.0f + __expf(-x)); }
__device__ __forceinline__ float siluf_(float x) { return x * sigmoidf_(x); }
__device__ __forceinline__ float gelu_tanh_(float x) { const float u = 0.7978845608028654f * (x + 0.044715f * x * x * x); const float t = 1.0f - 2.0f * __builtin_amdgcn_rcpf(__expf(2.0f * u) + 1.0f); return 0.5f * x * (1.0f + t); }
__device__ __forceinline__ float wave_sum(float v) {
#pragma unroll
    for (int o = 1; o < 64; o <<= 1) v += __shfl_xor(v, o);
    return v;
}
__device__ __forceinline__ float wave_max(float v) {
#pragma unroll
    for (int o = 1; o < 64; o <<= 1) v = fmaxf(v, __shfl_xor(v, o));
    return v;
}

__device__ __forceinline__ int lds_ld_i32(LAS unsigned char* p) { return __builtin_amdgcn_readfirstlane(*(volatile LAS int*)p); }
__device__ __forceinline__ const char* lds_ld_ptr(LAS unsigned char* p) { const unsigned lo = __builtin_amdgcn_readfirstlane(*(volatile LAS unsigned*)p), hi = __builtin_amdgcn_readfirstlane(*(volatile LAS unsigned*)(p + 4)); return (const char*)(((unsigned long long)hi << 32) | lo); }

namespace pg8 {
constexpr int BM = 256, BK = 64, HALF = 128, HTB = HALF * BK * 2, STAGE_BYTES = 8 * HTB, NXCD = 8, WGM = 8;
__host__ __device__ __forceinline__ int lds_byte(int r, int c) { const int st = (r >> 4) * 2 + (c >> 5), rr = r & 15, cc = c & 31, ob = rr * 64 + cc * 2; return st * 1024 + (ob ^ (((ob >> 9) & 1) << 5)); }
__host__ __device__ __forceinline__ void stage_rc(int b, int& R, int& C) { const int st = b / 1024, sb = b % 1024, swz = sb ^ (((sb >> 9) & 1) << 5); R = (st >> 1) * 16 + swz / 64; C = (st & 1) * 32 + (swz % 64) / 2; }
__host__ __device__ __forceinline__ int perm32(int rho) { const int n = rho >> 4, i = rho & 15; return 8 * (i >> 2) + 4 * n + (i & 3); }

struct Unit { int pm, pn, z; };

template <int LDA, int LDB, int MROWS, int NCOLS, int ZSHIFT = 30, int AZ = 0, int BPMSHIFT = 30, unsigned BPMSTRIDE = 0>
struct PlainSched {
    static constexpr int nM = MROWS / BM, nN = NCOLS / BM, nwg = nM * nN; static constexpr unsigned a_tile = BM * LDA * 2, b_tile = BM * LDB * 2;
    LAS unsigned char* lds; int gsub = 0, coff = 0;
    __device__ void init(LAS unsigned char* lds_, const void* A_, const void* B_) { lds = lds_;
        *(volatile LAS unsigned long long*)(lds + CTRL + 304) = (unsigned long long)A_; *(volatile LAS unsigned long long*)(lds + CTRL + 312) = (unsigned long long)B_; __syncthreads(); }
    __device__ bool next(int i, Unit& u) const {
        const int G = gsub > 0 ? gsub : lds_ld_i32(lds + CTRL + 52), c = lds_ld_i32(lds + CTRL + 48) - coff;
        const int L = i * G + c; if (L >= nwg) return false;
        int wgid = L; { constexpr int q = nwg / NXCD, r = nwg % NXCD; const int xcd = wgid % NXCD, off = wgid / NXCD; wgid = (xcd < r ? xcd * (q + 1) : r * (q + 1) + (xcd - r) * q) + off; }
        constexpr int nig = WGM * nN; const int gid = wgid / nig, fm = gid * WGM, gsz = (nM - fm) < WGM ? (nM - fm) : WGM;
        u.pm = fm + ((wgid % nig) % gsz); u.pn = (wgid % nig) / gsz; u.z = u.pn >> ZSHIFT; return true;
    }
    __device__ __forceinline__ const char* a_ptr(const Unit& u) const { return lds_ld_ptr(lds + CTRL + 304) + (size_t)((unsigned)u.pm * a_tile) + (size_t)((unsigned)u.z * (unsigned)AZ); }
    __device__ __forceinline__ const char* b_ptr(const Unit& u) const { return lds_ld_ptr(lds + CTRL + 312) + (size_t)((unsigned)u.pn * b_tile) + (size_t)((unsigned)(u.pm >> BPMSHIFT) * BPMSTRIDE); }
};
struct BatchSched {
    LAS unsigned char* lds; unsigned a_b, a_h, a_pm, b_b, b_h, b_pn; int nM, nN, nwg;
    __device__ void init(LAS unsigned char* lds_, const void* A_, const void* B_) { lds = lds_;
        *(volatile LAS unsigned long long*)(lds + CTRL + 304) = (unsigned long long)A_; *(volatile LAS unsigned long long*)(lds + CTRL + 312) = (unsigned long long)B_; __syncthreads(); }
    __device__ bool next(int i, Unit& u) const {
        const int G = lds_ld_i32(lds + CTRL + 52), c = lds_ld_i32(lds + CTRL + 48);
        const int L = i * G + c; if (L >= nwg) return false;
        const int per = nM * nN, z = L / per, r = L % per; u.pm = r % nM; u.pn = r / nM; u.z = z;
        return true;
    }
    __device__ __forceinline__ const char* a_ptr(const Unit& u) const { return lds_ld_ptr(lds + CTRL + 304) + (size_t)((unsigned)(u.z >> 2) * a_b) + (size_t)((unsigned)(u.z & 3) * a_h) + (size_t)((unsigned)u.pm * a_pm); }
    __device__ __forceinline__ const char* b_ptr(const Unit& u) const { return lds_ld_ptr(lds + CTRL + 312) + (size_t)((unsigned)(u.z >> 2) * b_b) + (size_t)((unsigned)(u.z & 3) * b_h) + (size_t)((unsigned)u.pn * b_pn); }
};

typedef f32x4 Acc[2][2][4][2];

__device__ __forceinline__ void load_rstd(const float* SSQ, int row0, float (&rs)[2][4]) {
#pragma unroll
    for (int ai = 0; ai < 2; ++ai)
#pragma unroll
        for (int m = 0; m < 4; ++m) { const float* p = SSQ + (size_t)(row0 + ai * HALF + m * 16) * 8; const f32x4 a = *(const f32x4*)p, b = *(const f32x4*)(p + 4);
            rs[ai][m] = 1.0f / sqrtf((((a[0] + a[1]) + (a[2] + a[3])) + ((b[0] + b[1]) + (b[2] + b[3]))) * (1.0f / D) + EPS); }
}
struct EpiBf16P {
    static constexpr bool PERM = true;
    bf16* O; int ldc; size_t zb, zh; float scale; const float* SSQ; int cgrp = 0; size_t cgs = 0;
    __device__ __forceinline__ void operator()(const Acc& acc, const Unit& u, int wr, int wc, int fr, int fq) const {
        bf16* base = O + (size_t)(u.z >> 2) * zb + (size_t)(u.z & 3) * zh; int pnl = u.pn;
        if (cgrp > 0) { base += (size_t)(u.pn / cgrp) * cgs; pnl = u.pn % cgrp; }
        const int row0 = u.pm * BM + wr * 64 + fr, col0 = pnl * BM + wc * 32 + 8 * fq;
        float rs[2][4];
        if (SSQ) load_rstd(SSQ, row0, rs); else {
#pragma unroll
            for (int ai = 0; ai < 2; ++ai)
#pragma unroll
                for (int m = 0; m < 4; ++m) rs[ai][m] = 1.0f; }
#pragma unroll
        for (int ai = 0; ai < 2; ++ai)
#pragma unroll
            for (int m = 0; m < 4; ++m) { bf16* rowp = base + (size_t)(row0 + ai * HALF + m * 16) * ldc + col0; const float sc = scale * rs[ai][m];
#pragma unroll
                for (int bj = 0; bj < 2; ++bj) { const f32x4 v0 = acc[ai][bj][m][0] * sc, v1 = acc[ai][bj][m][1] * sc;
                    u32x4 w; w.x = pk2(v0[0], v0[1]); w.y = pk2(v0[2], v0[3]); w.z = pk2(v1[0], v1[1]); w.w = pk2(v1[2], v1[3]);
                    *(u32x4*)(rowp + bj * HALF) = w; } }
    }
};
struct EpiMlIn {
    static constexpr bool PERM = true;
    bf16* PB; float* GATES; const float* SSQ;
    __device__ __forceinline__ void operator()(const Acc& acc, const Unit& u, int wr, int wc, int fr, int fq) const {
        const int row0 = u.pm * BM + wr * 64 + fr, col0 = u.pn * BM + wc * 32 + 8 * fq;
        float rs[2][4]; load_rstd(SSQ, row0, rs);
        if (u.pn < 24) {
#pragma unroll
            for (int ai = 0; ai < 2; ++ai)
#pragma unroll
                for (int m = 0; m < 4; ++m) { bf16* rowp = PB + (size_t)(row0 + ai * HALF + m * 16) * ML_PROJ + col0; const float sc = rs[ai][m];
#pragma unroll
                    for (int bj = 0; bj < 2; ++bj) { const f32x4 v0 = acc[ai][bj][m][0] * sc, v1 = acc[ai][bj][m][1] * sc;
                        u32x4 w; w.x = pk2(v0[0], v0[1]); w.y = pk2(v0[2], v0[3]); w.z = pk2(v1[0], v1[1]); w.w = pk2(v1[2], v1[3]);
                        *(u32x4*)(rowp + bj * HALF) = w; } }
        } else if (wc == 0 && fq < 2) {
#pragma unroll
            for (int ai = 0; ai < 2; ++ai)
#pragma unroll
                for (int m = 0; m < 4; ++m) { float* gp = GATES + (size_t)(row0 + ai * HALF + m * 16) * 16 + 8 * fq; const float sc = rs[ai][m];
                    *(f32x4*)gp = acc[ai][0][m][0] * sc; *(f32x4*)(gp + 4) = acc[ai][0][m][1] * sc; }
        }
    }
};
struct EpiSwiGLU {
    static constexpr bool PERM = true;
    bf16* O; const float* SSQ;
    __device__ __forceinline__ void operator()(const Acc& acc, const Unit& u, int wr, int wc, int fr, int fq) const {
        const int row0 = u.pm * BM + wr * 64 + fr, col0 = u.pn * HALF + wc * 32 + 8 * fq;
        float rs[2][4]; load_rstd(SSQ, row0, rs);
#pragma unroll
        for (int ai = 0; ai < 2; ++ai)
#pragma unroll
            for (int m = 0; m < 4; ++m) { bf16* p = O + (size_t)(row0 + ai * HALF + m * 16) * DFF + col0; const float sc = rs[ai][m];
                const f32x4 g0 = acc[ai][0][m][0] * sc, g1 = acc[ai][0][m][1] * sc, u0 = acc[ai][1][m][0] * sc, u1 = acc[ai][1][m][1] * sc;
                u32x4 w; w.x = pk2(siluf_(g0[0]) * u0[0], siluf_(g0[1]) * u0[1]); w.y = pk2(siluf_(g0[2]) * u0[2], siluf_(g0[3]) * u0[3]);
                w.z = pk2(siluf_(g1[0]) * u1[0], siluf_(g1[1]) * u1[1]); w.w = pk2(siluf_(g1[2]) * u1[2], siluf_(g1[3]) * u1[3]);
                *(u32x4*)p = w; }
    }
};
template <bool XF32> struct EpiResidT {
    static constexpr bool PERM = true;
    const float* Xin; float* Xout; bf16* XB; float* SSQ; float scale; LAS unsigned char* lds; int tid;
    __device__ __forceinline__ void operator()(const Acc& acc, const Unit& u, int wr, int wc, int fr, int fq) const {
        typedef __attribute__((address_space(1))) const f32x4 gcf4; typedef __attribute__((address_space(1))) f32x4 gf4; typedef __attribute__((address_space(1))) u32x4 gu4;
        typedef __attribute__((address_space(1))) const float gcf; typedef __attribute__((address_space(1))) float gf; typedef __attribute__((address_space(1))) bf16 gb;
        gcf* xin = (gcf*)Xin; gf* xout = (gf*)Xout; gb* xb = (gb*)XB;
        const int row0 = u.pm * BM + wr * 64 + fr, col0 = u.pn * BM + wc * 32 + 8 * fq;
        LAS float* red = (LAS float*)(lds + STAGE_BYTES);
#pragma unroll
        for (int ai = 0; ai < 2; ++ai)
#pragma unroll
            for (int m = 0; m < 4; ++m) { const unsigned off = (unsigned)(row0 + ai * HALF + m * 16) * (unsigned)D + (unsigned)col0; float ss = 0.f;
#pragma unroll
                for (int bj = 0; bj < 2; ++bj) { const unsigned o = off + bj * HALF; f32x4 x0, x1;
                    if constexpr (XF32) { x0 = *(gcf4*)(xin + o); x1 = *(gcf4*)(xin + o + 4); }
                    else { const u32x4 w = *(const gu4*)(xb + o); x0 = (f32x4){bflo(w.x), bfhi(w.x), bflo(w.y), bfhi(w.y)}; x1 = (f32x4){bflo(w.z), bfhi(w.z), bflo(w.w), bfhi(w.w)}; }
                    x0 += acc[ai][bj][m][0] * scale; x1 += acc[ai][bj][m][1] * scale;
                    if constexpr (XF32) { *(gf4*)(xout + o) = x0; *(gf4*)(xout + o + 4) = x1; }
                    u32x4 w; w.x = pk2(x0[0], x0[1]); w.y = pk2(x0[2], x0[3]); w.z = pk2(x1[0], x1[1]); w.w = pk2(x1[2], x1[3]); *(gu4*)(xb + o) = w;
                    ss += ((x0[0] * x0[0] + x0[1] * x0[1]) + (x0[2] * x0[2] + x0[3] * x0[3])) + ((x1[0] * x1[0] + x1[1] * x1[1]) + (x1[2] * x1[2] + x1[3] * x1[3]));
                    asm volatile("" ::: "memory"); }
                ss += __shfl_xor(ss, 16); ss += __shfl_xor(ss, 32);
                if (fq == 0) red[(ai * HALF + wr * 64 + m * 16 + fr) * 4 + wc] = ss; }
        asm volatile("s_waitcnt lgkmcnt(0)" ::: "memory"); __builtin_amdgcn_s_barrier(); asm volatile("" ::: "memory");
        if (tid < 256) { const f32x4 r = *(const LAS f32x4*)(red + tid * 4); SSQ[(size_t)(u.pm * BM + tid) * 8 + u.pn] = (r[0] + r[1]) + (r[2] + r[3]); }
        asm volatile("s_waitcnt lgkmcnt(0)" ::: "memory"); __builtin_amdgcn_s_barrier(); asm volatile("" ::: "memory");
    }
};
typedef EpiResidT<(X_F32 != 0)> EpiResid;
struct EpiHgIn {
    static constexpr bool PERM = true;
    bf16* P0; bf16* LF; const float* lb; const float* SSQ;
    __device__ __forceinline__ void operator()(const Acc& acc, const Unit& u, int wr, int wc, int fr, int fq) const {
        const int grp = u.pn >> 3; const int row0 = u.pm * BM + wr * 64 + fr, col0 = (u.pn & 7) * BM + wc * 32 + 8 * fq;
        float rs[2][4]; load_rstd(SSQ, row0, rs);
        if (grp == 1) {
#pragma unroll
            for (int bj = 0; bj < 2; ++bj) {
                const f32x4 l0 = *(const f32x4*)(lb + col0 + bj * HALF), l1 = *(const f32x4*)(lb + col0 + bj * HALF + 4);
                const float lbv[8] = {l0[0], l0[1], l0[2], l0[3], l1[0], l1[1], l1[2], l1[3]};
#pragma unroll
                for (int ai = 0; ai < 2; ++ai)
#pragma unroll
                    for (int m = 0; m < 4; ++m) { const size_t o = (size_t)(row0 + ai * HALF + m * 16) * D + col0 + bj * HALF;
                        const f32x4 v0 = acc[ai][bj][m][0] * rs[ai][m], v1 = acc[ai][bj][m][1] * rs[ai][m];
                        const float a[8] = {v0[0], v0[1], v0[2], v0[3], v1[0], v1[1], v1[2], v1[3]};
                        float lf[8];
#pragma unroll
                        for (int j = 0; j < 8; ++j) { const float e = __expf(-a[j]); const float sg = __builtin_amdgcn_rcpf(1.0f + e); const float om = 1.0f - lbv[j];
                            const float f = lbv[j] + om * sg; lf[j] = __logf(fmaxf(f, 1e-12f)); }
                        { u32x4 w; w.x = pk2(lf[0], lf[1]); w.y = pk2(lf[2], lf[3]); w.z = pk2(lf[4], lf[5]); w.w = pk2(lf[6], lf[7]); *(u32x4*)(LF + o) = w; }
                        asm volatile("" ::: "memory"); }
            }
        } else {
            bf16* dst = P0 + (size_t)grp * M * D;
#pragma unroll
            for (int ai = 0; ai < 2; ++ai)
#pragma unroll
                for (int m = 0; m < 4; ++m) { const size_t ro = (size_t)(row0 + ai * HALF + m * 16) * D + col0;
#pragma unroll
                    for (int bj = 0; bj < 2; ++bj) { const f32x4 v0 = acc[ai][bj][m][0] * rs[ai][m], v1 = acc[ai][bj][m][1] * rs[ai][m];
                        float a[8] = {v0[0], v0[1], v0[2], v0[3], v1[0], v1[1], v1[2], v1[3]};
                        if (grp != 2) {
#pragma unroll
                            for (int j = 0; j < 8; ++j) a[j] = siluf_(a[j]); }
                        u32x4 w; w.x = pk2(a[0], a[1]); w.y = pk2(a[2], a[3]); w.z = pk2(a[4], a[5]); w.w = pk2(a[6], a[7]);
                        *(u32x4*)(dst + ro + bj * HALF) = w; }
                    asm volatile("" ::: "memory"); }
        }
    }
};
struct EpiLruIn {
    static constexpr bool PERM = true;
    bf16* GBR; bf16* UR; const float* SSQ;
    __device__ __forceinline__ void operator()(const Acc& acc, const Unit& u, int wr, int wc, int fr, int fq) const {
        const int grp = u.pn >> 3; const int row0 = u.pm * BM + wr * 64 + fr, col0 = (u.pn & 7) * BM + wc * 32 + 8 * fq;
        float rs[2][4]; load_rstd(SSQ, row0, rs);
#pragma unroll
        for (int ai = 0; ai < 2; ++ai)
#pragma unroll
            for (int m = 0; m < 4; ++m) { const size_t ro = (size_t)(row0 + ai * HALF + m * 16) * D + col0;
#pragma unroll
                for (int bj = 0; bj < 2; ++bj) { const f32x4 v0 = acc[ai][bj][m][0] * rs[ai][m], v1 = acc[ai][bj][m][1] * rs[ai][m]; const size_t o = ro + bj * HALF;
                    if (grp == 0) { u32x4 w; w.x = pk2(gelu_tanh_(v0[0]), gelu_tanh_(v0[1])); w.y = pk2(gelu_tanh_(v0[2]), gelu_tanh_(v0[3])); w.z = pk2(gelu_tanh_(v1[0]), gelu_tanh_(v1[1])); w.w = pk2(gelu_tanh_(v1[2]), gelu_tanh_(v1[3]));
                        *(u32x4*)(GBR + o) = w; }
                    else { u32x4 w; w.x = pk2(v0[0], v0[1]); w.y = pk2(v0[2], v0[3]); w.z = pk2(v1[0], v1[1]); w.w = pk2(v1[2], v1[3]); *(u32x4*)(UR + o) = w; } } }
    }
};
struct EpiLruGate {
    static constexpr bool PERM = true;
    const bf16* UC; const float* ba; const float* bx; const float* c8; bf16* LA; bf16* INP;
    __device__ __forceinline__ void operator()(const Acc& acc, const Unit& u, int wr, int wc, int fr, int fq) const {
        const int row0 = u.pm * BM + wr * 64 + fr, ch = u.z * 256 + (u.pn & 1) * HALF + wc * 32 + 8 * fq;
        const f32x4 vba[2] = {*(const f32x4*)(ba + ch), *(const f32x4*)(ba + ch + 4)}, vbx[2] = {*(const f32x4*)(bx + ch), *(const f32x4*)(bx + ch + 4)}, vc8[2] = {*(const f32x4*)(c8 + ch), *(const f32x4*)(c8 + ch + 4)};
#pragma unroll
        for (int ai = 0; ai < 2; ++ai)
#pragma unroll
            for (int m = 0; m < 4; ++m) { const size_t o = (size_t)(row0 + ai * HALF + m * 16) * D + ch;
                const u32x4 uw = *(const u32x4*)(UC + o); const float uu[8] = {bflo(uw.x), bfhi(uw.x), bflo(uw.y), bfhi(uw.y), bflo(uw.z), bfhi(uw.z), bflo(uw.w), bfhi(uw.w)};
                float av[8], iv[8];
#pragma unroll
                for (int n = 0; n < 2; ++n) { const f32x4 pa = acc[ai][0][m][n] + vba[n], px = acc[ai][1][m][n] + vbx[n];
#pragma unroll
                    for (int j = 0; j < 4; ++j) { const float r = sigmoidf_(pa[j]), ig = sigmoidf_(px[j]); const float la = -vc8[n][j] * r;
                        const float x2 = -2.0f * la;
                        const float om = x2 < 0.02f ? x2 * (1.0f - 0.5f * x2 + x2 * x2 * 0.16666667f) : 1.0f - __expf(-x2);
                        const float mult = __builtin_amdgcn_sqrtf(fmaxf(om, 0.0f)); av[4 * n + j] = la; iv[4 * n + j] = mult * (ig * uu[4 * n + j]); } }
                { u32x4 wa, wi; wa.x = pk2(av[0], av[1]); wa.y = pk2(av[2], av[3]); wa.z = pk2(av[4], av[5]); wa.w = pk2(av[6], av[7]);
                    wi.x = pk2(iv[0], iv[1]); wi.y = pk2(iv[2], iv[3]); wi.z = pk2(iv[4], iv[5]); wi.w = pk2(iv[6], iv[7]); *(u32x4*)(LA + o) = wa; *(u32x4*)(INP + o) = wi; } asm volatile("" ::: "memory"); }
    }
};
struct EpiF32Z {
    static constexpr bool PERM = false;
    float* S; float scale;
    __device__ __forceinline__ void operator()(const Acc& acc, const Unit& u, int wr, int wc, int fr, int fq) const {
        float* base = S + (size_t)u.z * SEQ * NMEM; const int row0 = u.pm * BM + wr * 64 + fr, col0 = wc * 32 + 4 * fq;
#pragma unroll
        for (int ai = 0; ai < 2; ++ai)
#pragma unroll
            for (int m = 0; m < 4; ++m) { float* rowp = base + (size_t)(row0 + ai * HALF + m * 16) * NMEM + col0;
#pragma unroll
                for (int bj = 0; bj < 2; ++bj)
#pragma unroll
                    for (int n = 0; n < 2; ++n) *(f32x4*)(rowp + bj * HALF + n * 16) = acc[ai][bj][m][n] * scale; }
    }
};

struct GtSched { const char* Kall; const char* Wq; int G, c, L0, L1;
    __device__ bool next(int i, Unit& u) const { const int L = L0 + i * G + c; if (c < 0 || L >= L1) return false; u.pm = 0; u.pn = L & 7; u.z = L >> 3; return true; }
    __device__ __forceinline__ const char* a_ptr(const Unit& u) const { const int l = u.z >> 4, b = (u.z >> 2) & 3, h = u.z & 3; return Kall + ((size_t)b * NMEM * 4 * D + (size_t)l * D + h * XA_D) * 2; }
    __device__ __forceinline__ const char* b_ptr(const Unit& u) const { const int l = u.z >> 4, h = u.z & 3; return Wq + ((size_t)l * D * D + (size_t)u.pn * 256 * D + h * XA_D) * 2; }
};
struct UtSched { const char* Wo; const char* Vall; int G, c, L0, L1;
    __device__ bool next(int i, Unit& u) const { const int L = L0 + i * G + c; if (c < 0 || L >= L1) return false; u.pm = L & 7; u.pn = 0; u.z = L >> 3; return true; }
    __device__ __forceinline__ const char* a_ptr(const Unit& u) const { const int l = u.z >> 4, h = u.z & 3; return Wo + ((size_t)l * D * D + (size_t)u.pm * 256 * D + h * XA_D) * 2; }
    __device__ __forceinline__ const char* b_ptr(const Unit& u) const { const int l = u.z >> 4, b = (u.z >> 2) & 3, h = u.z & 3; return Vall + ((size_t)b * NMEM * 4 * D + (size_t)l * D + h * XA_D) * 2; }
};
struct ScSched { const char* XBp; const char* GTl; int G, c;
    __device__ bool next(int i, Unit& u) const { const int L = i * G + c; if (L >= 16 * 8) return false; u.pm = L & 7; u.pn = 0; u.z = L >> 3; return true; }
    __device__ __forceinline__ const char* a_ptr(const Unit& u) const { return XBp + ((size_t)(u.z >> 2) * SEQ + (size_t)u.pm * 256) * D * 2; }
    __device__ __forceinline__ const char* b_ptr(const Unit& u) const { return GTl + (size_t)u.z * NMEM * D * 2; }
};
struct OneSched {
    const char* A; const char* B; Unit u0;
    __device__ bool next(int i, Unit& u) const { if (i > 0) return false; u = u0; return true; }
    __device__ __forceinline__ const char* a_ptr(const Unit&) const { return A; }
    __device__ __forceinline__ const char* b_ptr(const Unit&) const { return B; }
};
struct EpiSoftmax {
    static constexpr bool PERM = true;
    bf16* Pall; float scale0; LAS unsigned char* lds; const float* SSQ;
    __device__ __forceinline__ void operator()(const Acc& acc, const Unit& u, int wr, int wc, int fr, int fq) const {
        LAS float* rmax = (LAS float*)(lds + STAGE_BYTES); LAS float* rsum = rmax + 1024;
        const int growb = (u.z >> 2) * SEQ + u.pm * BM; bf16* P = Pall + (size_t)growb * (4 * NMEM) + (u.z & 3) * NMEM;
        float rs[2][4]; load_rstd(SSQ, growb + wr * 64 + fr, rs);
        float mx[2][4];
#pragma unroll
        for (int ai = 0; ai < 2; ++ai)
#pragma unroll
            for (int m = 0; m < 4; ++m) { float v = -3.0e38f;
#pragma unroll
                for (int bj = 0; bj < 2; ++bj)
#pragma unroll
                    for (int n = 0; n < 2; ++n) { const f32x4 a = acc[ai][bj][m][n]; v = fmaxf(v, fmaxf(fmaxf(a[0], a[1]), fmaxf(a[2], a[3]))); }
                v = fmaxf(v, __shfl_xor(v, 16)); v = fmaxf(v, __shfl_xor(v, 32));
                if (fq == 0) rmax[(ai * HALF + wr * 64 + m * 16 + fr) * 4 + wc] = v; }
        asm volatile("s_waitcnt lgkmcnt(0)" ::: "memory"); __builtin_amdgcn_s_barrier(); asm volatile("" ::: "memory");
#pragma unroll
        for (int ai = 0; ai < 2; ++ai)
#pragma unroll
            for (int m = 0; m < 4; ++m) { const int rl = ai * HALF + wr * 64 + m * 16 + fr; const f32x4 r = *(const LAS f32x4*)(rmax + rl * 4); const float mxa = fmaxf(fmaxf(r[0], r[1]), fmaxf(r[2], r[3])); mx[ai][m] = mxa; const float scale = scale0 * rs[ai][m];
                float s = 0.f;
#pragma unroll
                for (int bj = 0; bj < 2; ++bj)
#pragma unroll
                    for (int n = 0; n < 2; ++n) { const f32x4 a = acc[ai][bj][m][n]; s += (__expf((a[0] - mxa) * scale) + __expf((a[1] - mxa) * scale)) + (__expf((a[2] - mxa) * scale) + __expf((a[3] - mxa) * scale)); }
                s += __shfl_xor(s, 16); s += __shfl_xor(s, 32);
                if (fq == 0) rsum[rl * 4 + wc] = s; }
        asm volatile("s_waitcnt lgkmcnt(0)" ::: "memory"); __builtin_amdgcn_s_barrier(); asm volatile("" ::: "memory");
#pragma unroll
        for (int ai = 0; ai < 2; ++ai)
#pragma unroll
            for (int m = 0; m < 4; ++m) { const int rl = ai * HALF + wr * 64 + m * 16 + fr; const f32x4 r = *(const LAS f32x4*)(rsum + rl * 4); const float inv = 1.0f / ((r[0] + r[1]) + (r[2] + r[3])); const float mxa = mx[ai][m]; const float scale = scale0 * rs[ai][m];
                bf16* rowp = P + (size_t)rl * (4 * NMEM) + wc * 32 + 8 * fq;
#pragma unroll
                for (int bj = 0; bj < 2; ++bj) { const f32x4 a0 = acc[ai][bj][m][0], a1 = acc[ai][bj][m][1];
                    u32x4 w; w.x = pk2(__expf((a0[0] - mxa) * scale) * inv, __expf((a0[1] - mxa) * scale) * inv); w.y = pk2(__expf((a0[2] - mxa) * scale) * inv, __expf((a0[3] - mxa) * scale) * inv);
                    w.z = pk2(__expf((a1[0] - mxa) * scale) * inv, __expf((a1[1] - mxa) * scale) * inv); w.w = pk2(__expf((a1[2] - mxa) * scale) * inv, __expf((a1[3] - mxa) * scale) * inv);
                    *(u32x4*)(rowp + bj * HALF) = w; } }
        asm volatile("s_waitcnt lgkmcnt(0)" ::: "memory"); __builtin_amdgcn_s_barrier(); asm volatile("" ::: "memory");
    }
};

template <class Epi, class Sched, class MkEpi, bool ALIGN_EPI = true, bool SP2 = true>
__device__ __forceinline__ void gemm_phase_(LAS unsigned char* lds, const int tid, const int lda, const int ldb, const int K, const Sched& S, const MkEpi& mk) {
    const int wid = __builtin_amdgcn_readfirstlane(tid >> 6), lane = tid & 63, wr = wid >> 2, wc = wid & 3, fr = lane & 15, fq = lane >> 4;
    int nt = K / BK; asm volatile("" : "+s"(nt));
    unsigned voffA[2], voffB[2];
#pragma unroll
    for (int i = 0; i < 2; ++i) { int R, C; stage_rc(tid * 16 + i * 8192, R, C); const int Rb = Epi::PERM ? ((R & ~31) + perm32(R & 31)) : R;
        voffA[i] = (unsigned)(R * lda + C) * 2u; voffB[i] = (unsigned)(Rb * ldb + C) * 2u; }
    constexpr unsigned kstep = BK * 2;
    const unsigned hstepA = (unsigned)(HALF * lda * 2), hstepB = (unsigned)(HALF * ldb * 2);
    const unsigned ldsw = (unsigned)wid * 1024u;
    const int aoff = lds_byte(wr * 64 + fr, fq * 8), boff = lds_byte(wc * 32 + fr, fq * 8);
#define PG8_SA(b, h) (((b) * 2 + (h)) * HTB)
#define PG8_SB(b, h) ((4 + (b) * 2 + (h)) * HTB)
#define PG8_STAGE(bufoff, gbase, voff) do { _Pragma("unroll") for (int _i = 0; _i < 2; ++_i) \
        __builtin_amdgcn_global_load_lds((const unsigned*)((const char*)(gbase) + (voff)[_i]), (LAS unsigned*)(lds + (bufoff) + ldsw + _i * 8192), 16, 0, 0); } while (0)
#define PG8_LDA(dst, b, h) do { _Pragma("unroll") for (int m = 0; m < 4; ++m) _Pragma("unroll") for (int k = 0; k < 2; ++k) dst[m][k] = *(const LAS bf16x8*)(lds + PG8_SA(b, h) + aoff + m * 2048 + k * 1024); } while (0)
#define PG8_LDB(dst, b, h) do { _Pragma("unroll") for (int n = 0; n < 2; ++n) _Pragma("unroll") for (int k = 0; k < 2; ++k) dst[n][k] = *(const LAS bf16x8*)(lds + PG8_SB(b, h) + boff + n * 2048 + k * 1024); } while (0)
#define PG8_MMA(ai, bj, At, Bt) do { __builtin_amdgcn_s_setprio(1); _Pragma("unroll") for (int m = 0; m < 4; ++m) _Pragma("unroll") for (int n = 0; n < 2; ++n) _Pragma("unroll") for (int k = 0; k < 2; ++k) \
        acc[ai][bj][m][n] = __builtin_amdgcn_mfma_f32_16x16x32_bf16(Bt[n][k], At[m][k], acc[ai][bj][m][n], 0, 0, 0); __builtin_amdgcn_s_setprio(0); } while (0)
#define PG8_WAIT_V(n) asm volatile("s_waitcnt vmcnt(" #n ")" ::: "memory")
#define PG8_WAIT_L(n) asm volatile("s_waitcnt lgkmcnt(" #n ")" ::: "memory")
#define PG8_BAR __builtin_amdgcn_s_barrier()
#define PG8_SCHED __builtin_amdgcn_sched_barrier(0)
    Unit cur, nxt; int ui = 0;
    if (!S.next(0, cur)) return;
    f32x4 acc[2][2][4][2];
#pragma unroll
    for (int a = 0; a < 2; ++a)
#pragma unroll
        for (int b = 0; b < 2; ++b)
#pragma unroll
            for (int m = 0; m < 4; ++m)
#pragma unroll
                for (int n = 0; n < 2; ++n) acc[a][b][m][n] = (f32x4){0.f, 0.f, 0.f, 0.f};
    bf16x8 At[4][2], B0[2][2], B1[2][2];
    const char* cA = S.a_ptr(cur); const char* cB = S.b_ptr(cur);
    if constexpr (SP2) {
        PG8_STAGE(PG8_SB(0, 0), cB, voffB); PG8_STAGE(PG8_SB(0, 1), cB + hstepB, voffB); PG8_STAGE(PG8_SA(0, 0), cA, voffA); PG8_STAGE(PG8_SA(0, 1), cA + hstepA, voffA);
        if (wr == 1) PG8_BAR;
        PG8_WAIT_V(2); PG8_BAR;
        PG8_STAGE(PG8_SB(1, 0), cB + kstep, voffB); PG8_STAGE(PG8_SA(1, 0), cA + kstep, voffA); PG8_STAGE(PG8_SB(1, 1), cB + hstepB + kstep, voffB);
        PG8_WAIT_V(6); PG8_BAR;
    } else {
        PG8_STAGE(PG8_SB(0, 0), cB, voffB); PG8_STAGE(PG8_SA(0, 0), cA, voffA); PG8_STAGE(PG8_SB(0, 1), cB + hstepB, voffB); PG8_STAGE(PG8_SA(0, 1), cA + hstepA, voffA);
        if (wr == 1) PG8_BAR;
        PG8_WAIT_V(4); PG8_BAR;
        PG8_STAGE(PG8_SB(1, 0), cB + kstep, voffB); PG8_STAGE(PG8_SA(1, 0), cA + kstep, voffA); PG8_STAGE(PG8_SB(1, 1), cB + hstepB + kstep, voffB);
        PG8_WAIT_V(6); PG8_BAR;
    }
    for (;;) {
        const bool has_next = S.next(ui + 1, nxt);
        if (!has_next) nxt = cur;
        const char* nA = S.a_ptr(nxt); const char* nB = S.b_ptr(nxt);
        for (int t = 0; t < nt; t += 2) {
            const bool last = (t == nt - 2);
            const char* a1 = cA + (size_t)(t + 1) * kstep;
            const char* a2 = last ? nA : cA + (size_t)(t + 2) * kstep; const char* b2 = last ? nB : cB + (size_t)(t + 2) * kstep;
            const char* a3 = a2 + kstep; const char* b3 = b2 + kstep;
            if constexpr (SP2) {
            PG8_LDB(B0, 0, 0); PG8_LDB(B1, 0, 1); PG8_SCHED; PG8_LDA(At, 0, 0); PG8_STAGE(PG8_SA(1, 1), a1 + hstepA, voffA);
            PG8_WAIT_V(8); PG8_WAIT_L(0); PG8_BAR; PG8_MMA(0, 0, At, B0); PG8_MMA(0, 1, At, B1); PG8_BAR; PG8_SCHED;
            PG8_LDA(At, 0, 1); PG8_STAGE(PG8_SB(0, 0), b2, voffB); PG8_STAGE(PG8_SB(0, 1), b2 + hstepB, voffB); PG8_STAGE(PG8_SA(0, 0), a2, voffA);
            PG8_WAIT_V(8); PG8_WAIT_L(0); PG8_BAR; PG8_MMA(1, 0, At, B0); PG8_MMA(1, 1, At, B1); PG8_BAR; PG8_SCHED;
            PG8_LDB(B0, 1, 0); PG8_LDB(B1, 1, 1); PG8_SCHED; PG8_LDA(At, 1, 0); PG8_STAGE(PG8_SA(0, 1), a2 + hstepA, voffA);
            PG8_WAIT_V(8); PG8_WAIT_L(0); PG8_BAR; PG8_MMA(0, 0, At, B0); PG8_MMA(0, 1, At, B1); PG8_BAR; PG8_SCHED;
            PG8_LDA(At, 1, 1); PG8_STAGE(PG8_SB(1, 0), b3, voffB); PG8_STAGE(PG8_SB(1, 1), b3 + hstepB, voffB); PG8_STAGE(PG8_SA(1, 0), a3, voffA);
            PG8_WAIT_V(8); PG8_WAIT_L(0); PG8_BAR; PG8_MMA(1, 0, At, B0); PG8_MMA(1, 1, At, B1); PG8_BAR; PG8_SCHED;
            } else {
            PG8_LDB(B0, 0, 0); PG8_SCHED; PG8_LDA(At, 0, 0); PG8_STAGE(PG8_SA(1, 1), a1 + hstepA, voffA);
            PG8_WAIT_L(8); PG8_BAR; PG8_WAIT_L(0); PG8_MMA(0, 0, At, B0); PG8_BAR; PG8_SCHED;
            PG8_LDB(B1, 0, 1); PG8_STAGE(PG8_SB(0, 0), b2, voffB);
            PG8_BAR; PG8_WAIT_L(0); PG8_MMA(0, 1, At, B1); PG8_BAR;
            PG8_LDA(At, 0, 1); PG8_STAGE(PG8_SA(0, 0), a2, voffA);
            PG8_BAR; PG8_WAIT_L(0); PG8_MMA(1, 0, At, B0); PG8_BAR; PG8_SCHED;
            PG8_STAGE(PG8_SB(0, 1), b2 + hstepB, voffB);
            PG8_WAIT_V(6); PG8_BAR; PG8_MMA(1, 1, At, B1); PG8_BAR;
            PG8_LDB(B0, 1, 0); PG8_SCHED; PG8_LDA(At, 1, 0); PG8_STAGE(PG8_SA(0, 1), a2 + hstepA, voffA);
            PG8_WAIT_L(8); PG8_BAR; PG8_WAIT_L(0); PG8_MMA(0, 0, At, B0); PG8_BAR; PG8_SCHED;
            PG8_LDB(B1, 1, 1); PG8_STAGE(PG8_SB(1, 0), b3, voffB);
            PG8_BAR; PG8_WAIT_L(0); PG8_MMA(0, 1, At, B1); PG8_BAR;
            PG8_LDA(At, 1, 1); PG8_STAGE(PG8_SA(1, 0), a3, voffA);
            PG8_BAR; PG8_WAIT_L(0); PG8_MMA(1, 0, At, B0); PG8_BAR; PG8_SCHED;
            PG8_STAGE(PG8_SB(1, 1), b3 + hstepB, voffB);
            PG8_WAIT_V(6); PG8_BAR; PG8_MMA(1, 1, At, B1); PG8_BAR;
            }
        }
        if constexpr (ALIGN_EPI) { if (wr == 0) PG8_BAR; }
        { asm volatile("" ::: "memory"); const Epi E = mk(); E(acc, cur, wr, wc, fr, fq); }
        if (!has_next) break;
#pragma unroll
        for (int a = 0; a < 2; ++a)
#pragma unroll
            for (int b = 0; b < 2; ++b)
#pragma unroll
                for (int m = 0; m < 4; ++m)
#pragma unroll
                    for (int n = 0; n < 2; ++n) acc[a][b][m][n] = (f32x4){0.f, 0.f, 0.f, 0.f};
        cur = nxt; cA = nA; cB = nB; ++ui;
        if constexpr (ALIGN_EPI) { if (wr == 1) PG8_BAR; }
    }
    PG8_WAIT_V(0);
    if constexpr (!ALIGN_EPI) { if (wr == 0) PG8_BAR; }
    PG8_BAR;
#undef PG8_SA
#undef PG8_SB
#undef PG8_STAGE
#undef PG8_LDA
#undef PG8_LDB
#undef PG8_MMA
#undef PG8_WAIT_V
#undef PG8_WAIT_L
#undef PG8_BAR
#undef PG8_SCHED
}
template <class MkEpi, class Sched> __device__ __forceinline__ void gemm_phase(LAS unsigned char* lds, const int tid, const int lda, const int ldb, const int K, const Sched& S, const MkEpi& mk) {
    gemm_phase_<decltype(mk()), Sched, MkEpi>(lds, tid, lda, ldb, K, S, mk); }
}

#define XB_TMO      128
#define XB_XCNT(j)  (256  + 64 * (j))
#define XB_XSUB(j)  (1280 + 64 * (j))
#define XB_XGEN(j)  (2304 + 64 * (j))
#define XB_TOP      3328
#define XB_TOPGEN   3392
#define XCD_BAR_WORDS 3456
#define XB_SPIN_CAP (1u << 18)

__device__ __forceinline__ unsigned xb_ld(unsigned* p)              { return __hip_atomic_load(p, __ATOMIC_RELAXED, __HIP_MEMORY_SCOPE_AGENT); }
__device__ __forceinline__ unsigned xb_add(unsigned* p, unsigned v) { return __hip_atomic_fetch_add(p, v, __ATOMIC_RELAXED, __HIP_MEMORY_SCOPE_AGENT); }
__device__ __forceinline__ unsigned xb_xcc_id() { return (unsigned)__builtin_amdgcn_s_getreg((3 << 11) | 20) & 0xFu; }
#define XB_SPIN(cond, bar) do { unsigned _sp = 0; while (cond) { __builtin_amdgcn_s_sleep(1); \
    if ((++_sp & 255u) == 0u) { if (xb_ld(&(bar)[XB_TMO])) break; if (_sp > XB_SPIN_CAP) { atomicAdd(&(bar)[XB_TMO], 1u); break; } } } } while (0)

struct XcdBarrier { unsigned* bar; unsigned x; volatile LAS unsigned* st; };

__device__ __forceinline__ XcdBarrier xcd_barrier_post(unsigned* bar, volatile LAS unsigned* st) {
    XcdBarrier b; b.bar = bar; b.x = xb_xcc_id(); b.st = st;
    if (threadIdx.x == 0) (void)xb_add(&bar[XB_XCNT(b.x)], 1u);
    return b;
}
__device__ __forceinline__ void xcd_barrier_complete(unsigned* bar, unsigned x, unsigned& nloc, unsigned& nx, const unsigned G) {
    unsigned sum, cnt, mine, sp = 0u;
    for (;;) {
        sum = 0u; cnt = 0u; mine = 0u;
#pragma unroll
        for (unsigned j = 0; j < 16; ++j) { const unsigned c = xb_ld(&bar[XB_XCNT(j)]); sum += c; cnt += (c > 0u) ? 1u : 0u; mine = (j == x) ? c : mine; }
        if (sum == G) break;
        __builtin_amdgcn_s_sleep(1);
        if ((++sp & 255u) == 0u) { if (xb_ld(&bar[XB_TMO])) break; if (sp > XB_SPIN_CAP) { atomicAdd(&bar[XB_TMO], 1u); break; } }
    }
    nloc = mine > 0u ? mine : 1u; nx = cnt > 0u ? cnt : 1u;
}
__device__ __forceinline__ void xcd_barrier(const XcdBarrier& b, const int tid, const unsigned G) {
    asm volatile("s_waitcnt vmcnt(0)" ::: "memory");
    __syncthreads();
    if (tid == 0) {
        unsigned* bar = b.bar;
        __builtin_amdgcn_s_waitcnt(0);
        unsigned nloc = b.st[0], nx = b.st[1];
        if (nloc == 0u) { xcd_barrier_complete(bar, b.x, nloc, nx, G); b.st[0] = nloc; b.st[1] = nx; }
        const unsigned old = xb_add(&bar[XB_XSUB(b.x)], 1u);
        const unsigned gen = old / nloc;
        if (old + 1u == (gen + 1u) * nloc) {
            __builtin_amdgcn_fence(__ATOMIC_RELEASE, "agent");
            asm volatile("s_waitcnt vmcnt(0)" ::: "memory");
            const unsigned og = xb_add(&bar[XB_TOP], 1u);
            const unsigned tg = og / nx;
            if (og + 1u == (tg + 1u) * nx) xb_add(&bar[XB_TOPGEN], 1u);
            else XB_SPIN(xb_ld(&bar[XB_TOPGEN]) == tg, bar);
            __builtin_amdgcn_fence(__ATOMIC_ACQUIRE, "agent");
            xb_add(&bar[XB_XGEN(b.x)], 1u);
            asm volatile("s_waitcnt vmcnt(0)" ::: "memory");
        } else {
            XB_SPIN(xb_ld(&bar[XB_XGEN(b.x)]) == gen, bar);
            __builtin_amdgcn_fence(__ATOMIC_ACQUIRE, "agent");
            asm volatile("s_waitcnt vmcnt(0)" ::: "memory");
        }
    }
    __syncthreads();
}

constexpr size_t MiB = 1u << 20;
constexpr size_t SZ_MD_BF = (size_t)M * D * 2, SZ_MD_F = (size_t)M * D * 4;
constexpr size_t WS_CTL = 0, CTL_BYTES = 1 * MiB;
constexpr size_t WS_X    = WS_CTL + CTL_BYTES;
constexpr size_t WS_HB   = WS_X + SZ_MD_F;
constexpr size_t WS_ACT  = WS_HB + SZ_MD_BF;
constexpr size_t WS_P0   = WS_ACT + (size_t)M * DFF * 2;
constexpr size_t WS_P1   = WS_P0 + 192 * MiB;
constexpr size_t WS_YB   = WS_P1 + 3 * SZ_MD_F;
constexpr size_t WS_QB2  = WS_YB + SZ_MD_BF;
constexpr size_t WS_SC   = WS_QB2 + SZ_MD_BF;
constexpr size_t WS_PB   = WS_SC + (size_t)16 * SEQ * NMEM * 4;
constexpr size_t WS_OB   = WS_PB + (size_t)16 * SEQ * NMEM * 2;
constexpr size_t WS_KALL = WS_OB + SZ_MD_BF;
constexpr size_t WS_VT   = WS_KALL + (size_t)MMEM * 4 * D * 2;
constexpr size_t WS_MEMN = WS_VT + (size_t)MMEM * 4 * D * 2;
constexpr size_t WS_MISC = WS_MEMN + (size_t)MMEM * D * 2;
constexpr size_t MISC_LB = 0, MISC_C8 = 4 * 2048 * 4, MISC_SSQ = MISC_C8 + 2048 * 4, MISC_GATES = MISC_SSQ + (size_t)M * 8 * 4, MISC_MLWG = MISC_GATES + (size_t)M * 16 * 4, MISC_BYTES = 1 * MiB;
static_assert(MISC_MLWG + 16 * 2048 * 4 <= MISC_BYTES, "misc");
constexpr int ML_NPAD = 6400;
constexpr size_t SZ_WGU = (size_t)NGU * D * 2, SZ_WDN = (size_t)D * DFF * 2, SZ_WDD = (size_t)D * D * 2;
constexpr size_t WS_WGU  = WS_MISC + MISC_BYTES;
constexpr size_t WS_WDN  = WS_WGU + 8 * SZ_WGU;
constexpr size_t WS_WQ   = WS_WDN + 8 * SZ_WDN;
constexpr size_t WS_WO   = WS_WQ + 4 * SZ_WDD;
constexpr size_t WS_WK   = WS_WO + 4 * SZ_WDD;
constexpr size_t WS_WV   = WS_WK + 4 * SZ_WDD;
constexpr size_t WS_HGIN = WS_WV + 4 * SZ_WDD;
constexpr size_t WS_HGOUT = WS_HGIN + 2 * 4 * SZ_WDD;
constexpr size_t WS_LRUIN = WS_HGOUT + 2 * SZ_WDD;
constexpr size_t WS_LRUG = WS_LRUIN + 2 * SZ_WDD;
constexpr size_t WS_LRUOUT = WS_LRUG + (size_t)4096 * 256 * 2;
constexpr size_t WS_MLIN = WS_LRUOUT + SZ_WDD;
constexpr size_t WS_MLOUT = WS_MLIN + (size_t)ML_NPAD * D * 2;
constexpr size_t WS_GT   = WS_MLOUT + SZ_WDD;
constexpr size_t WS_UT   = WS_GT + (size_t)4 * 16 * NMEM * D * 2;
constexpr size_t WS_END  = WS_UT + (size_t)4 * 4 * D * 4 * NMEM * 2;

constexpr int NWAVES = 8, NT = NWAVES * 64;

struct Args {
    const float* in[27]; float* out; unsigned char* ws; int ph_lo, ph_hi;
};
enum { I_X = 0, I_MEM, I_MEMG, I_NORMG, I_FINALG, I_WGU, I_WDN, I_XAQ, I_XAKV, I_XAO, I_HGLB, I_HGIN, I_HGG, I_HGOUT,
       I_LRUIN, I_CONVW, I_CONVB, I_LRUWA, I_LRUBA, I_LRUWX, I_LRUBX, I_LRULAM, I_LRUOUT, I_MLIN, I_MLBIF, I_MLG, I_MLOUT };

struct Frame { LAS unsigned char* lds; int tid, lane, wave, G, bid, gw, NGW;
    template <class T> __device__ __forceinline__ T* ptr(int i) const { const u32x2 v = *(const LAS u32x2*)(lds + CTRL + 64 + 8 * i);
        const unsigned lo = __builtin_amdgcn_readfirstlane(v.x), hi = __builtin_amdgcn_readfirstlane(v.y); return (T*)(((unsigned long long)hi << 32) | lo); }
    __device__ __forceinline__ const float* in(int i) const { return ptr<const float>(i); }
    __device__ __forceinline__ float* out() const { return ptr<float>(27); }
    __device__ __forceinline__ unsigned char* ws() const { return ptr<unsigned char>(28); }
};
__device__ __forceinline__ unsigned hw_wave_key() { return (unsigned)__builtin_amdgcn_s_getreg((12 - 1) << 11 | 4) & 0xfffu; }

struct CvtJob { const float* W; bf16* WT; const float* gk; int K, ldw, nrows, off, gu, nvalid; };
__device__ __forceinline__ void convert_job_rt(const Frame& F, int& rot, const CvtJob& j, const int num0 = 0, const int num1 = 8) {
    const int nnb = j.nrows / 64, nkb = j.K / 64, nitems = nnb * nkb; const int cg = F.lane & 15, kg = F.lane >> 4;
    const int i0 = (nitems * num0) >> 3, i1 = (nitems * num1) >> 3, nrange = i1 - i0;
    int q = F.gw - rot; if (q < 0) q += F.NGW;
    for (; q < nrange; q += F.NGW) { const int it = i0 + q;
        const int kb = it / nnb, nb = it % nnb, k0 = kb * 64, n0 = nb * 64; int sc = j.off + n0;
        if (j.gu) { const int pn = n0 >> 8, r = n0 & 255; sc = (r >> 7) * DFF + 128 * pn + (r & 127); }
        const bool ok = (sc + 4 * cg + 3) < j.nvalid; const float* src = j.W + (size_t)(k0 + 16 * kg) * j.ldw + (ok ? sc + 4 * cg : 0);
        f32x4 v[16];
#pragma unroll
        for (int i = 0; i < 16; ++i) v[i] = __builtin_nontemporal_load((const f32x4*)(src + (size_t)i * j.ldw));
        if (j.gk) { const f32x4* gp = (const f32x4*)(j.gk + k0 + 16 * kg);
#pragma unroll
            for (int q = 0; q < 4; ++q) { const f32x4 g = gp[q]; v[4 * q] *= g[0]; v[4 * q + 1] *= g[1]; v[4 * q + 2] *= g[2]; v[4 * q + 3] *= g[3]; } }
        if (!ok) {
#pragma unroll
            for (int i = 0; i < 16; ++i) v[i] = (f32x4){0.f, 0.f, 0.f, 0.f}; }
#pragma unroll
        for (int c = 0; c < 4; ++c) { bf16* dst = j.WT + (size_t)(n0 + 4 * cg + c) * j.K + k0 + 16 * kg;
            u32x4 lo, hi; lo.x = pk2(v[0][c], v[1][c]); lo.y = pk2(v[2][c], v[3][c]); lo.z = pk2(v[4][c], v[5][c]); lo.w = pk2(v[6][c], v[7][c]);
            hi.x = pk2(v[8][c], v[9][c]); hi.y = pk2(v[10][c], v[11][c]); hi.z = pk2(v[12][c], v[13][c]); hi.w = pk2(v[14][c], v[15][c]);
            *(u32x4*)dst = lo; *(u32x4*)(dst + 8) = hi; }
    }
    rot = (rot + nrange) % F.NGW;
}
struct MapPlain { int off; __device__ int operator()(int nb) const { return off + 64 * nb; } };
struct MapGU { __device__ int operator()(int nb) const { const int n = 64 * nb, pn = n >> 8, r = n & 255; return (r >> 7) * DFF + 128 * pn + (r & 127); } };

__device__ __forceinline__ void x_to_stream(const Frame& F, const float* x, bf16* XB, float* SSQ) {
    for (int row = F.gw; row < M; row += F.NGW) {
        const f32x4* xr = (const f32x4*)(x + (size_t)row * D) + F.lane; u32x2* o8 = (u32x2*)(XB + (size_t)row * D) + F.lane; float ss = 0.f;
#pragma unroll
        for (int j = 0; j < 8; ++j) { const f32x4 v = xr[64 * j]; ss += (v[0] * v[0] + v[1] * v[1]) + (v[2] * v[2] + v[3] * v[3]); u32x2 w; w.x = pk2(v[0], v[1]); w.y = pk2(v[2], v[3]); o8[64 * j] = w; }
        ss = wave_sum(ss);
        if (F.lane < 8) SSQ[(size_t)row * 8 + F.lane] = F.lane == 0 ? ss : 0.f;
    }
}
__device__ __forceinline__ void ml_gates_rows(const Frame& F, const bf16* XB, const float* SSQ, const bf16* wg, float* gates) {
    if (F.wave >= 2) return;
    const int lr = F.lane & 15, lq = F.lane >> 4;
    for (int tile = F.wave * F.G + F.bid; tile < M / 16; tile += 2 * F.G) {
        const int row0 = tile * 16;
        const bf16* ap = XB + (size_t)(row0 + lr) * D + 8 * lq; const bf16* bp = wg + (size_t)lr * D + 8 * lq;
        f32x4 acc = {0.f, 0.f, 0.f, 0.f};
        for (int k0 = 0; k0 < D; k0 += 256) { bf16x8 a[8], b[8];
#pragma unroll
            for (int j = 0; j < 8; ++j) { a[j] = *(const bf16x8*)(ap + k0 + 32 * j); b[j] = *(const bf16x8*)(bp + k0 + 32 * j); }
#pragma unroll
            for (int j = 0; j < 8; ++j) acc = __builtin_amdgcn_mfma_f32_16x16x32_bf16(a[j], b[j], acc, 0, 0, 0); }
#pragma unroll
        for (int r = 0; r < 4; ++r) { const int row = row0 + 4 * lq + r; const f32x4 s0 = *(const f32x4*)(SSQ + (size_t)row * 8), s1 = *(const f32x4*)(SSQ + (size_t)row * 8 + 4);
            const float rstd = 1.0f / sqrtf((((s0[0] + s0[1]) + (s0[2] + s0[3])) + ((s1[0] + s1[1]) + (s1[2] + s1[3]))) * (1.0f / D) + EPS);
            gates[(size_t)row * 16 + lr] = acc[r] * rstd; }
    }
}
__device__ __forceinline__ void final_norm_bf(const Frame& F, const bf16* XB, const float* SSQ, const float* g, float* out) {
    for (int row = F.gw; row < M; row += F.NGW) {
        const f32x4 a = *(const f32x4*)(SSQ + (size_t)row * 8), b = *(const f32x4*)(SSQ + (size_t)row * 8 + 4);
        const float rstd = 1.0f / sqrtf((((a[0] + a[1]) + (a[2] + a[3])) + ((b[0] + b[1]) + (b[2] + b[3]))) * (1.0f / D) + EPS);
        const u32x2* xr = (const u32x2*)(XB + (size_t)row * D) + F.lane; f32x4* o = (f32x4*)(out + (size_t)row * D) + F.lane;
#pragma unroll
        for (int j = 0; j < 8; ++j) { const u32x2 w = xr[64 * j]; const f32x4 gg = ((const f32x4*)g)[F.lane + 64 * j]; o[64 * j] = (f32x4){bflo(w.x), bfhi(w.x), bflo(w.y), bfhi(w.y)} * rstd * gg; }
    }
}
template <bool GATES>
__device__ __forceinline__ void norm_rows(const Frame& F, const float* x, const float* g, bf16* out, int nrows, const float* wg, float* gates) {
    for (int row = F.gw; row < nrows; row += F.NGW) {
        const f32x4* xr = (const f32x4*)(x + (size_t)row * D) + F.lane;
        f32x4 v[8]; float ss = 0.f;
#pragma unroll
        for (int j = 0; j < 8; ++j) { v[j] = xr[64 * j]; ss += (v[j][0] * v[j][0] + v[j][1] * v[j][1]) + (v[j][2] * v[j][2] + v[j][3] * v[j][3]); }
        ss = wave_sum(ss);
        const float rstd = 1.0f / sqrtf(ss * (1.0f / D) + EPS);
        u32x2* o8 = (u32x2*)(out + (size_t)row * D) + F.lane;
#pragma unroll
        for (int j = 0; j < 8; ++j) { const f32x4 gg = ((const f32x4*)g)[F.lane + 64 * j]; v[j] = v[j] * rstd * gg; u32x2 w; w.x = pk2(v[j][0], v[j][1]); w.y = pk2(v[j][2], v[j][3]); o8[64 * j] = w; }
        if constexpr (GATES) {
            for (int c = 0; c < 16; ++c) { const f32x4* wr_ = (const f32x4*)(wg + (size_t)c * D) + F.lane; float s = 0.f;
#pragma unroll
                for (int j = 0; j < 8; ++j) { const f32x4 w4 = wr_[64 * j]; s += (v[j][0] * w4[0] + v[j][1] * w4[1]) + (v[j][2] * w4[2] + v[j][3] * w4[3]); }
                s = wave_sum(s); if (F.lane == 0) gates[(size_t)row * 16 + c] = s; }
        }
    }
}
__device__ __forceinline__ void final_norm(const Frame& F, const float* x, const float* g, float* out) {
    for (int row = F.gw; row < M; row += F.NGW) {
        const f32x4* xr = (const f32x4*)(x + (size_t)row * D) + F.lane;
        f32x4 v[8]; float ss = 0.f;
#pragma unroll
        for (int j = 0; j < 8; ++j) { v[j] = xr[64 * j]; ss += (v[j][0] * v[j][0] + v[j][1] * v[j][1]) + (v[j][2] * v[j][2] + v[j][3] * v[j][3]); }
        ss = wave_sum(ss);
        const float rstd = 1.0f / sqrtf(ss * (1.0f / D) + EPS);
        f32x4* o = (f32x4*)(out + (size_t)row * D) + F.lane;
#pragma unroll
        for (int j = 0; j < 8; ++j) { const f32x4 gg = ((const f32x4*)g)[F.lane + 64 * j]; o[64 * j] = v[j] * rstd * gg; }
    }
}

template <bool ML>
__device__ __forceinline__ void recur_phase(const Frame& F, const bf16* QB, const float* LF, const bf16* KB, const bf16* VB, const bf16* PB, const float* gates, const float* bif, float* OF) {
    constexpr int H = ML ? ML_H : HG_H, DV = ML ? ML_DV : HG_D, NVS = DV / 32, TB = 32;
    LAS float* AL = (LAS float*)F.lds; LAS float* KA = AL + TB * 128; LAS float* QQ = KA + TB * 128; LAS float* VV = QQ + TB * 128; LAS float* OO = VV + TB * 32;
    const int dg = F.lane & 15, vsub = F.lane >> 4, vloc = F.wave * 4 + vsub;
    for (int unit = F.bid; unit < BATCH * H * NVS; unit += F.G) {
        const int b = unit / (H * NVS), h = (unit / NVS) % H, vs = unit % NVS;
        float S[8], Nn[8];
#pragma unroll
        for (int i = 0; i < 8; ++i) { S[i] = 0.f; Nn[i] = 0.f; }
        float bi_ = 0.f, bf_ = 0.f; if constexpr (ML) { bi_ = bif[h]; bf_ = bif[8 + h]; }
        for (int t0 = 0; t0 < SEQ; t0 += TB) {
            __syncthreads();
            { const int t = F.tid >> 4, d8 = (F.tid & 15) * 8; const size_t row = (size_t)b * SEQ + t0 + t;
                float al[8], ka[8], qq[8];
                if constexpr (!ML) {
                    const f32x4 l0 = *(const f32x4*)(LF + row * D + h * 128 + d8), l1 = *(const f32x4*)(LF + row * D + h * 128 + d8 + 4);
                    const u32x4 kw = *(const u32x4*)(KB + row * D + h * 128 + d8), qw = *(const u32x4*)(QB + row * D + h * 128 + d8);
                    const float lf[8] = {l0[0], l0[1], l0[2], l0[3], l1[0], l1[1], l1[2], l1[3]};
#pragma unroll
                    for (int i = 0; i < 8; ++i) al[i] = __expf(lf[i]);
                    ka[0] = bflo(kw.x); ka[1] = bfhi(kw.x); ka[2] = bflo(kw.y); ka[3] = bfhi(kw.y); ka[4] = bflo(kw.z); ka[5] = bfhi(kw.z); ka[6] = bflo(kw.w); ka[7] = bfhi(kw.w);
                    qq[0] = bflo(qw.x); qq[1] = bfhi(qw.x); qq[2] = bflo(qw.y); qq[3] = bfhi(qw.y); qq[4] = bflo(qw.z); qq[5] = bfhi(qw.z); qq[6] = bflo(qw.w); qq[7] = bfhi(qw.w);
                } else {
                    const float fg = gates[row * 16 + 8 + h] + bf_, ig = gates[row * 16 + h] + bi_;
                    const float a_ = 1.0f / (1.0f + expf(-15.0f * tanhf(fg * (1.0f / 15.0f))));
                    const float ei = expf(15.0f * tanhf(ig * (1.0f / 15.0f))) * 0.08838834764831845f;
                    const u32x4 qw = *(const u32x4*)(PB + row * ML_PROJ + h * 128 + d8), kw = *(const u32x4*)(PB + row * ML_PROJ + 1024 + h * 128 + d8);
#pragma unroll
                    for (int i = 0; i < 8; ++i) al[i] = a_;
                    ka[0] = bflo(kw.x) * ei; ka[1] = bfhi(kw.x) * ei; ka[2] = bflo(kw.y) * ei; ka[3] = bfhi(kw.y) * ei; ka[4] = bflo(kw.z) * ei; ka[5] = bfhi(kw.z) * ei; ka[6] = bflo(kw.w) * ei; ka[7] = bfhi(kw.w) * ei;
                    qq[0] = bflo(qw.x); qq[1] = bfhi(qw.x); qq[2] = bflo(qw.y); qq[3] = bfhi(qw.y); qq[4] = bflo(qw.z); qq[5] = bfhi(qw.z); qq[6] = bflo(qw.w); qq[7] = bfhi(qw.w);
                }
                *(LAS f32x4*)(AL + t * 128 + d8) = (f32x4){al[0], al[1], al[2], al[3]}; *(LAS f32x4*)(AL + t * 128 + d8 + 4) = (f32x4){al[4], al[5], al[6], al[7]};
                *(LAS f32x4*)(KA + t * 128 + d8) = (f32x4){ka[0], ka[1], ka[2], ka[3]}; *(LAS f32x4*)(KA + t * 128 + d8 + 4) = (f32x4){ka[4], ka[5], ka[6], ka[7]};
                *(LAS f32x4*)(QQ + t * 128 + d8) = (f32x4){qq[0], qq[1], qq[2], qq[3]}; *(LAS f32x4*)(QQ + t * 128 + d8 + 4) = (f32x4){qq[4], qq[5], qq[6], qq[7]};
                if (F.tid < 256) { const int tv = F.tid >> 3, v4 = (F.tid & 7) * 4; const size_t rv = (size_t)b * SEQ + t0 + tv;
                    const u32x2 vw = ML ? *(const u32x2*)(PB + rv * ML_PROJ + 2048 + h * 256 + vs * 32 + v4) : *(const u32x2*)(VB + rv * D + h * 128 + vs * 32 + v4);
                    *(LAS f32x4*)(VV + tv * 32 + v4) = (f32x4){bflo(vw.x), bfhi(vw.x), bflo(vw.y), bfhi(vw.y)}; }
            }
            __syncthreads();
#pragma unroll 4
            for (int t = 0; t < TB; ++t) {
                const f32x4 a0 = *(const LAS f32x4*)(AL + t * 128 + dg * 8), a1 = *(const LAS f32x4*)(AL + t * 128 + dg * 8 + 4);
                const f32x4 k0 = *(const LAS f32x4*)(KA + t * 128 + dg * 8), k1 = *(const LAS f32x4*)(KA + t * 128 + dg * 8 + 4);
                const f32x4 q0 = *(const LAS f32x4*)(QQ + t * 128 + dg * 8), q1 = *(const LAS f32x4*)(QQ + t * 128 + dg * 8 + 4);
                const float vv = VV[t * 32 + vloc];
                const float al[8] = {a0[0], a0[1], a0[2], a0[3], a1[0], a1[1], a1[2], a1[3]}, ka[8] = {k0[0], k0[1], k0[2], k0[3], k1[0], k1[1], k1[2], k1[3]}, qq[8] = {q0[0], q0[1], q0[2], q0[3], q1[0], q1[1], q1[2], q1[3]};
                float po = 0.f, pd = 0.f;
#pragma unroll
                for (int i = 0; i < 8; ++i) { S[i] = al[i] * S[i] + ka[i] * vv; po += S[i] * qq[i]; if constexpr (ML) { Nn[i] = al[i] * Nn[i] + ka[i]; pd += Nn[i] * qq[i]; } }
#pragma unroll
                for (int o = 1; o < 16; o <<= 1) { po += __shfl_xor(po, o); if constexpr (ML) pd += __shfl_xor(pd, o); }
                if (dg == 0) { float r = po; if constexpr (ML) r = po / fmaxf(fabsf(pd), 1.0f); OO[t * 32 + vloc] = r; }
            }
            __syncthreads();
            if (F.tid < 256) { const int tv = F.tid >> 3, v4 = (F.tid & 7) * 4; const size_t rv = (size_t)b * SEQ + t0 + tv;
                *(f32x4*)(OF + rv * D + h * DV + vs * 32 + v4) = *(const LAS f32x4*)(OO + tv * 32 + v4); }
        }
    }
}
namespace ck {
constexpr int SK = 136, SS = 72;
constexpr int O_QH = 0, O_KH = O_QH + 64 * SK * 2, O_QE = O_KH + 160 * SK * 2, O_KET = O_QE + 64 * SK * 2, O_VT = O_KET + 128 * SS * 2, O_P = O_VT + 48 * SS * 2,
              O_SB = O_P + 64 * SS * 2, O_EBC = O_SB + 48 * SK * 2, O_TOT = O_EBC + 512, O_GT = O_TOT + 2048, O_END = O_GT + 2048 + 2 * 1280;
static_assert(O_END <= CTRL, "chunk LDS map");
__device__ __forceinline__ f32x4 mm(const LAS bf16* A, int sa, int ar, const LAS bf16* B, int sb, int br, int ksteps, f32x4 acc, int lane) {
    const int r = lane & 15, q8 = (lane >> 4) * 8;
    const LAS bf16* ap = A + (ar + r) * sa + q8; const LAS bf16* bp = B + (br + r) * sb + q8;
    for (int ks = 0; ks < ksteps; ++ks) { const bf16x8 a = *(const LAS bf16x8*)(ap + ks * 32), b = *(const LAS bf16x8*)(bp + ks * 32);
        acc = __builtin_amdgcn_mfma_f32_16x16x32_bf16(a, b, acc, 0, 0, 0); }
    return acc;
}
__device__ __forceinline__ bf16 f2bf(float x) { return (bf16)(pk2(x, x) & 0xffffu); }
__device__ __forceinline__ float bf2f(unsigned short x) { return __uint_as_float((unsigned)x << 16); }
__device__ __forceinline__ void tile_of(int tile, int& qi, int& kj) {
    qi = tile < 1 ? 0 : (tile < 3 ? 1 : (tile < 6 ? 2 : 3)); kj = tile - (qi * (qi + 1)) / 2; }

__device__ __forceinline__ void store_pairs(bf16* op, const f32x4& v, int lr) {
    const bool odd = lr & 1;
    const float r01 = __shfl_xor(odd ? v[0] : v[1], 1), r23 = __shfl_xor(odd ? v[2] : v[3], 1);
    const unsigned w01 = odd ? pk2(r01, v[1]) : pk2(v[0], r01), w23 = odd ? pk2(r23, v[3]) : pk2(v[2], r23);
    *(GAS unsigned*)(op + (size_t)(odd ? 1 : 0) * D) = w01; *(GAS unsigned*)(op + (size_t)(odd ? 3 : 2) * D) = w23;
}
template <int NSL, bool ML>
__device__ __forceinline__ void headnorm_tail(const Frame& F, const bf16* OF, float* SSQP, unsigned* cnt, const int b, const int col0, const int slot0, const int vs,
                                              const bf16* gate, const int ldg, const int gcol0, const float* gain, bf16* Y) {
    constexpr float INV_HD = 1.0f / (NSL * 32);
    const int q = F.tid & 3, r0 = F.tid >> 2;
    asm volatile("s_waitcnt vmcnt(0)" ::: "memory"); __syncthreads();
    const size_t rowb = (size_t)b * SEQ + r0;
#pragma unroll
    for (int i0 = 0; i0 < 16; i0 += 8) { u32x4 w[8];
#pragma unroll
        for (int i = 0; i < 8; ++i) w[i] = *(GAS const u32x4*)(OF + (rowb + 128 * (i0 + i)) * D + col0 + 8 * q);
#pragma unroll
        for (int i = 0; i < 8; ++i) {
            const float a0 = bflo(w[i].x), a1 = bfhi(w[i].x), a2 = bflo(w[i].y), a3 = bfhi(w[i].y), a4 = bflo(w[i].z), a5 = bfhi(w[i].z), a6 = bflo(w[i].w), a7 = bfhi(w[i].w);
            float ss = ((a0 * a0 + a1 * a1) + (a2 * a2 + a3 * a3)) + ((a4 * a4 + a5 * a5) + (a6 * a6 + a7 * a7));
            ss += __shfl_xor(ss, 1); ss += __shfl_xor(ss, 2);
            if (q == 0) *(GAS float*)(SSQP + (rowb + 128 * (i0 + i)) * 64 + slot0 + vs) = ss; } }
    asm volatile("s_waitcnt vmcnt(0)" ::: "memory"); __syncthreads();
    if (F.tid == 0) { __builtin_amdgcn_fence(__ATOMIC_RELEASE, "agent"); asm volatile("s_waitcnt vmcnt(0)" ::: "memory"); (void)xb_add(cnt, 1u);
        unsigned sp = 0u; while (xb_ld(cnt) < (unsigned)NSL) { __builtin_amdgcn_s_sleep(1); if (++sp > (1u << 24)) break; }
        __builtin_amdgcn_fence(__ATOMIC_ACQUIRE, "agent"); asm volatile("s_waitcnt vmcnt(0)" ::: "memory"); }
    __syncthreads();
    const f32x4 g0 = *(GAS const f32x4*)(gain + 8 * q), g1 = *(GAS const f32x4*)(gain + 8 * q + 4);
#pragma unroll
    for (int i0 = 0; i0 < 16; i0 += 4) {
        u32x4 w[4], gw[4]; f32x4 p0[4], p1[4];
#pragma unroll
        for (int j = 0; j < 4; ++j) { const size_t row = rowb + 128 * (i0 + j);
            w[j] = *(GAS const u32x4*)(OF + row * D + col0 + 8 * q); gw[j] = *(GAS const u32x4*)(gate + row * ldg + gcol0 + 8 * q);
            p0[j] = *(GAS const f32x4*)(SSQP + row * 64 + slot0); if constexpr (NSL == 8) p1[j] = *(GAS const f32x4*)(SSQP + row * 64 + slot0 + 4); else p1[j] = (f32x4){0.f, 0.f, 0.f, 0.f}; }
#pragma unroll
        for (int j = 0; j < 4; ++j) { const size_t row = rowb + 128 * (i0 + j);
            const float tot = ((p0[j][0] + p0[j][1]) + (p0[j][2] + p0[j][3])) + ((p1[j][0] + p1[j][1]) + (p1[j][2] + p1[j][3]));
            const float rstd = 1.0f / sqrtf(tot * INV_HD + EPS);
            float gg[8] = {bflo(gw[j].x), bfhi(gw[j].x), bflo(gw[j].y), bfhi(gw[j].y), bflo(gw[j].z), bfhi(gw[j].z), bflo(gw[j].w), bfhi(gw[j].w)};
            if constexpr (ML) {
#pragma unroll
                for (int e = 0; e < 8; ++e) gg[e] = sigmoidf_(gg[e]); }
            const f32x4 a = (f32x4){bflo(w[j].x), bfhi(w[j].x), bflo(w[j].y), bfhi(w[j].y)} * rstd * g0, c = (f32x4){bflo(w[j].z), bfhi(w[j].z), bflo(w[j].w), bfhi(w[j].w)} * rstd * g1;
            u32x4 o; o.x = pk2(a[0] * gg[0], a[1] * gg[1]); o.y = pk2(a[2] * gg[2], a[3] * gg[3]); o.z = pk2(c[0] * gg[4], c[1] * gg[5]); o.w = pk2(c[2] * gg[6], c[3] * gg[7]);
            *(GAS u32x4*)(Y + row * D + col0 + 8 * q) = o; } }
}
__device__ __forceinline__ void hg_chunk_phase(const Frame& F, const bf16* QB, const bf16* LF, const bf16* KB, const bf16* VB, bf16* OF, const bf16* GB, const float* gn, bf16* Y, float* SSQP, unsigned* hcnt) {
    LAS bf16* QH = (LAS bf16*)(F.lds + O_QH); LAS bf16* KH = (LAS bf16*)(F.lds + O_KH); LAS bf16* QE = (LAS bf16*)(F.lds + O_QE); LAS bf16* KET = (LAS bf16*)(F.lds + O_KET);
    LAS bf16* VT = (LAS bf16*)(F.lds + O_VT); LAS bf16* P = (LAS bf16*)(F.lds + O_P); LAS bf16* SB = (LAS bf16*)(F.lds + O_SB);
    LAS float* EBC = (LAS float*)(F.lds + O_EBC); LAS float* TOT = (LAS float*)(F.lds + O_TOT);
    const int tid = F.tid, lane = F.lane, w = F.wave, lq = lane >> 4, lr = lane & 15;
    const int g = w, i = g >> 1, d2 = 2 * lane, sv = tid >> 3, v4 = (tid & 7) * 4;
    for (int unit = F.bid; unit < 256; unit += F.G) {
        const int xk = unit >> 3, vs = xk & 3, gq = (xk >> 2) * 8 + (unit & 7); const int b = gq >> 4, h = gq & 15;
        __syncthreads();
        for (int e = tid; e < 64 * SS / 2; e += NT) ((LAS unsigned*)P)[e] = 0u;
        for (int e = tid; e < 48 * SK / 2; e += NT) ((LAS unsigned*)SB)[e] = 0u;
        f32x4 S0 = {0.f, 0.f, 0.f, 0.f}, S1 = {0.f, 0.f, 0.f, 0.f};
        unsigned lfA[8], lfB[8]; unsigned qvA[8], qvB[8]; u32x2 vvA, vvB;
        const size_t colb = (size_t)h * 128 + d2, colv = (size_t)h * 128 + vs * 32 + v4;
        auto load = [&](unsigned (&lfw)[8], unsigned (&qv)[8], u32x2& vv, const int cc) { const size_t r0 = (size_t)b * SEQ + (size_t)cc * 64 + 8 * g;
#pragma unroll
            for (int tt = 0; tt < 8; ++tt) { lfw[tt] = *(const unsigned*)(LF + (r0 + tt) * D + colb); qv[tt] = *(const unsigned*)(QB + (r0 + tt) * D + colb); }
            vv = *(const u32x2*)(VB + ((size_t)b * SEQ + (size_t)cc * 64 + sv) * D + colv); };
        load(lfA, qvA, vvA, 0); load(lfB, qvB, vvB, 1);
        auto step = [&](unsigned (&lfw)[8], unsigned (&qv)[8], u32x2& vv, const int c) {
            f32x2 lf[8], loc[8]; { f32x2 run = {0.f, 0.f};
#pragma unroll
                for (int tt = 0; tt < 8; ++tt) { lf[tt] = (f32x2){bflo(lfw[tt]), bfhi(lfw[tt])}; run += lf[tt]; loc[tt] = run; }
                *(LAS f32x2*)(TOT + g * 128 + d2) = run; }
            __syncthreads();
            { u32x2 s0, s1; s0.x = pk2(S0[0], S0[1]); s0.y = pk2(S0[2], S0[3]); s1.x = pk2(S1[0], S1[1]); s1.y = pk2(S1[2], S1[3]);
                *(LAS u32x2*)(SB + lr * SK + 16 * w + 4 * lq) = s0; *(LAS u32x2*)(SB + (16 + lr) * SK + 16 * w + 4 * lq) = s1; }
            f32x2 tg[8];
#pragma unroll
            for (int j = 0; j < 8; ++j) tg[j] = *(const LAS f32x2*)(TOT + j * 128 + d2);
            f32x2 Pf[4]; Pf[0] = (f32x2){0.f, 0.f}; Pf[1] = tg[0] + tg[1]; Pf[2] = Pf[1] + tg[2] + tg[3]; Pf[3] = Pf[2] + tg[4] + tg[5]; const f32x2 bC = Pf[3] + tg[6] + tg[7];
            const f32x2 Pi = i == 0 ? Pf[0] : (i == 1 ? Pf[1] : (i == 2 ? Pf[2] : Pf[3]));
            const f32x2 half = (g & 1) ? (g == 1 ? tg[0] : (g == 3 ? tg[2] : (g == 5 ? tg[4] : tg[6]))) : (f32x2){0.f, 0.f};
            const f32x2 eP = {__expf(Pi.x), __expf(Pi.y)}; const f32x2 eC = {__expf(bC.x - Pi.x), __expf(bC.y - Pi.y)};
            f32x2 fac[4];
#pragma unroll
            for (int ip = 0; ip < 4; ++ip) fac[ip] = (f32x2){__expf(Pf[ip].x - Pi.x), __expf(Pf[ip].y - Pi.y)};
            const int koff[4] = {0, 16, 48, 96};
            unsigned ke0[4], ke1[4];
#pragma unroll
            for (int tt = 0; tt < 8; ++tt) { const int t = 8 * g + tt; const f32x2 lo = loc[tt] + half;
                const float q0 = bflo(qv[tt]), q1 = bfhi(qv[tt]), k0 = 1.0f - __expf(lf[tt].x), k1 = 1.0f - __expf(lf[tt].y);
                const float e0 = __expf(fmaxf(lo.x, -80.f)), e1 = __expf(fmaxf(lo.y, -80.f));
                const float kr0 = k0 * __builtin_amdgcn_rcpf(e0), kr1 = k1 * __builtin_amdgcn_rcpf(e1);
                *(LAS unsigned*)(QH + t * SK + d2) = pk2(q0 * e0, q1 * e1); *(LAS unsigned*)(QE + t * SK + d2) = pk2(q0 * e0 * eP.x, q1 * e1 * eP.y);
#pragma unroll
                for (int ip = 0; ip < 4; ++ip) if (ip >= i) *(LAS unsigned*)(KH + (koff[ip] + t) * SK + d2) = pk2(kr0 * fac[ip].x, kr1 * fac[ip].y);
                const float c0 = kr0 * eC.x, c1 = kr1 * eC.y;
                if (tt & 1) { ke0[tt >> 1] = pk2(__uint_as_float(ke0[tt >> 1]), c0); ke1[tt >> 1] = pk2(__uint_as_float(ke1[tt >> 1]), c1); } else { ke0[tt >> 1] = __float_as_uint(c0); ke1[tt >> 1] = __float_as_uint(c1); } }
            *(LAS u32x4*)(KET + d2 * SS + 8 * g) = (u32x4){ke0[0], ke0[1], ke0[2], ke0[3]}; *(LAS u32x4*)(KET + (d2 + 1) * SS + 8 * g) = (u32x4){ke1[0], ke1[1], ke1[2], ke1[3]};
            if (g == 0) *(LAS f32x2*)(EBC + d2) = (f32x2){__expf(bC.x), __expf(bC.y)};
            VT[(v4 + 0) * SS + sv] = (bf16)(vv.x & 0xffffu); VT[(v4 + 1) * SS + sv] = (bf16)(vv.x >> 16); VT[(v4 + 2) * SS + sv] = (bf16)(vv.y & 0xffffu); VT[(v4 + 3) * SS + sv] = (bf16)(vv.y >> 16);
            if (c + 2 < SEQ / 64) load(lfw, qv, vv, c + 2);
            __syncthreads();
            for (int tile = w; tile < 10; tile += 8) { int qi, kj; tile_of(tile, qi, kj);
                f32x4 acc = {0.f, 0.f, 0.f, 0.f}; acc = mm(QH, SK, 16 * qi, KH, SK, koff[qi] + 16 * kj, 4, acc, lane);
#pragma unroll
                for (int r = 0; r < 4; ++r) { const int tl = 4 * lq + r; const float val = (qi != kj || lr <= tl) ? acc[r] : 0.f; P[(16 * qi + tl) * SS + 16 * kj + lr] = f2bf(val); } }
            __syncthreads();
            { const int tq = w & 3, nv = w >> 2; f32x4 acc = {0.f, 0.f, 0.f, 0.f};
                acc = mm(P, SS, 16 * tq, VT, SS, 16 * nv, tq < 2 ? 1 : 2, acc, lane);
                acc = mm(QE, SK, 16 * tq, SB, SK, 16 * nv, 4, acc, lane);
                bf16* op = OF + ((size_t)b * SEQ + c * 64 + 16 * tq + 4 * lq) * D + h * 128 + vs * 32 + 16 * nv + (lr & ~1);
                store_pairs(op, acc, lr); }
            { f32x4 U0 = {0.f, 0.f, 0.f, 0.f}, U1 = {0.f, 0.f, 0.f, 0.f}; U0 = mm(KET, SS, 16 * w, VT, SS, 0, 2, U0, lane); U1 = mm(KET, SS, 16 * w, VT, SS, 16, 2, U1, lane);
                const f32x4 dec = *(const LAS f32x4*)(EBC + 16 * w + 4 * lq); S0 = S0 * dec + U0; S1 = S1 * dec + U1; }
        };
        for (int c = 0; c < SEQ / 64; c += 2) { step(lfA, qvA, vvA, c); step(lfB, qvB, vvB, c + 1); }
        if (hcnt) headnorm_tail<4, false>(F, OF, SSQP, hcnt + b * 16 + h, b, h * 128 + vs * 32, h * 4, vs, GB, D, h * 128 + vs * 32, gn + vs * 32, Y);
    }
}

constexpr int A_QH = 0, A_KH = A_QH + 64 * SK * 2, A_IMG = A_KH + 160 * SK * 2;
constexpr int I_QE = 0, I_KET = I_QE + 64 * SK * 2, I_P = I_KET + 128 * SS * 2, I_EBC = I_P + 64 * SS * 2, I_VT = I_EBC + 512, IMG_BYTES = I_VT + 128 * SS * 2;
constexpr int A_TOT = A_IMG + IMG_BYTES, A_END = A_TOT + 4096;
constexpr int B_VT = I_VT, B_SB = B_VT + 32 * SS * 2, B_BUF = B_SB + 32 * SK * 2;
static_assert(IMG_BYTES == 64000 && A_END <= CTRL && 2 * B_BUF <= CTRL, "hg stage LDS maps");
__device__ __forceinline__ void hg_prep_phase(const Frame& F, const bf16* QB, const bf16* LF, const bf16* VB, unsigned char* IMG) {
    LAS bf16* QH = (LAS bf16*)(F.lds + A_QH); LAS bf16* KH = (LAS bf16*)(F.lds + A_KH); LAS bf16* QE = (LAS bf16*)(F.lds + A_IMG + I_QE); LAS bf16* KET = (LAS bf16*)(F.lds + A_IMG + I_KET);
    LAS bf16* VT = (LAS bf16*)(F.lds + A_IMG + I_VT); LAS bf16* P = (LAS bf16*)(F.lds + A_IMG + I_P); LAS float* EBC = (LAS float*)(F.lds + A_IMG + I_EBC); LAS float* TOT = (LAS float*)(F.lds + A_TOT);
    const int tid = F.tid, lane = F.lane, w = F.wave, lq = lane >> 4, lr = lane & 15;
    const int g = w, i = g >> 1, d2 = 2 * lane, sv = tid >> 3, vc = (tid & 7) * 16;
    constexpr int NITEM = BATCH * 16 * (SEQ / 64);
    __syncthreads();
    for (int e = tid; e < 64 * SS / 2; e += NT) ((LAS unsigned*)P)[e] = 0u;
    unsigned lfA[8], lfB[8], qvA[8], qvB[8];
    auto load = [&](unsigned (&lfw)[8], unsigned (&qv)[8], const int item) { const int c = item & 31, gq = item >> 5, b = gq >> 4, h = gq & 15;
        const size_t r0 = (size_t)b * SEQ + (size_t)c * 64 + 8 * g, colb = (size_t)h * 128 + d2;
#pragma unroll
        for (int tt = 0; tt < 8; ++tt) { lfw[tt] = *(GAS const unsigned*)(LF + (r0 + tt) * D + colb); qv[tt] = *(GAS const unsigned*)(QB + (r0 + tt) * D + colb); }
};
    const int first = F.bid, stride = F.G;
    if (first < NITEM) load(lfA, qvA, first);
    if (first + stride < NITEM) load(lfB, qvB, first + stride);
    auto step = [&](unsigned (&lfw)[8], unsigned (&qv)[8], const int item) {
        f32x2 lf[8], loc[8]; { f32x2 run = {0.f, 0.f};
#pragma unroll
            for (int tt = 0; tt < 8; ++tt) { lf[tt] = (f32x2){bflo(lfw[tt]), bfhi(lfw[tt])}; run += lf[tt]; loc[tt] = run; }
            *(LAS f32x2*)(TOT + g * 128 + d2) = run; }
        __syncthreads();
        f32x2 tg[8];
#pragma unroll
        for (int j = 0; j < 8; ++j) tg[j] = *(const LAS f32x2*)(TOT + j * 128 + d2);
        f32x2 Pf[4]; Pf[0] = (f32x2){0.f, 0.f}; Pf[1] = tg[0] + tg[1]; Pf[2] = Pf[1] + tg[2] + tg[3]; Pf[3] = Pf[2] + tg[4] + tg[5]; const f32x2 bC = Pf[3] + tg[6] + tg[7];
        const f32x2 Pi = i == 0 ? Pf[0] : (i == 1 ? Pf[1] : (i == 2 ? Pf[2] : Pf[3]));
        const f32x2 half = (g & 1) ? (g == 1 ? tg[0] : (g == 3 ? tg[2] : (g == 5 ? tg[4] : tg[6]))) : (f32x2){0.f, 0.f};
        const f32x2 eP = {__expf(Pi.x), __expf(Pi.y)}; const f32x2 eC = {__expf(bC.x - Pi.x), __expf(bC.y - Pi.y)};
        f32x2 fac[4];
#pragma unroll
        for (int ip = 0; ip < 4; ++ip) fac[ip] = (f32x2){__expf(Pf[ip].x - Pi.x), __expf(Pf[ip].y - Pi.y)};
        const int koff[4] = {0, 16, 48, 96};
        unsigned ke0[4], ke1[4];
#pragma unroll
        for (int tt = 0; tt < 8; ++tt) { const int t = 8 * g + tt; const f32x2 lo = loc[tt] + half;
            const float q0 = bflo(qv[tt]), q1 = bfhi(qv[tt]), k0 = 1.0f - __expf(lf[tt].x), k1 = 1.0f - __expf(lf[tt].y);
            const float e0 = __expf(fmaxf(lo.x, -80.f)), e1 = __expf(fmaxf(lo.y, -80.f));
            const float kr0 = k0 * __builtin_amdgcn_rcpf(e0), kr1 = k1 * __builtin_amdgcn_rcpf(e1);
            *(LAS unsigned*)(QH + t * SK + d2) = pk2(q0 * e0, q1 * e1); *(LAS unsigned*)(QE + t * SK + d2) = pk2(q0 * e0 * eP.x, q1 * e1 * eP.y);
#pragma unroll
            for (int ip = 0; ip < 4; ++ip) if (ip >= i) *(LAS unsigned*)(KH + (koff[ip] + t) * SK + d2) = pk2(kr0 * fac[ip].x, kr1 * fac[ip].y);
            const float c0 = kr0 * eC.x, c1 = kr1 * eC.y;
            if (tt & 1) { ke0[tt >> 1] = pk2(__uint_as_float(ke0[tt >> 1]), c0); ke1[tt >> 1] = pk2(__uint_as_float(ke1[tt >> 1]), c1); } else { ke0[tt >> 1] = __float_as_uint(c0); ke1[tt >> 1] = __float_as_uint(c1); } }
        *(LAS u32x4*)(KET + d2 * SS + 8 * g) = (u32x4){ke0[0], ke0[1], ke0[2], ke0[3]}; *(LAS u32x4*)(KET + (d2 + 1) * SS + 8 * g) = (u32x4){ke1[0], ke1[1], ke1[2], ke1[3]};
        if (g == 0) *(LAS f32x2*)(EBC + d2) = (f32x2){__expf(bC.x), __expf(bC.y)};
        load(lfw, qv, item + 2 * stride < NITEM ? item + 2 * stride : item);
        __syncthreads();
        for (int tile = w; tile < 10; tile += 8) { int qi, kj; tile_of(tile, qi, kj);
            f32x4 acc = {0.f, 0.f, 0.f, 0.f}; acc = mm(QH, SK, 16 * qi, KH, SK, koff[qi] + 16 * kj, 4, acc, lane);
#pragma unroll
            for (int r = 0; r < 4; ++r) { const int tl = 4 * lq + r; const float val = (qi != kj || lr <= tl) ? acc[r] : 0.f; P[(16 * qi + tl) * SS + 16 * kj + lr] = f2bf(val); } }
        __syncthreads();
        { unsigned char* img = IMG + (size_t)item * IMG_BYTES;
            for (int o = tid * 16; o < I_VT; o += NT * 16) *(GAS u32x4*)(img + o) = *(const LAS u32x4*)(F.lds + A_IMG + o); }
    };
    for (int item = first; item < NITEM; item += 2 * stride) { step(lfA, qvA, item); if (item + stride < NITEM) step(lfB, qvB, item + stride); }
}
__device__ __forceinline__ void hg_scan_phase(const Frame& F, const unsigned char* IMG, const bf16* VB, bf16* OF, const bf16* GB, const float* gn, bf16* Y, float* SSQP, unsigned* hcnt) {
    const int tid = F.tid, lane = F.lane, w = F.wave, lq = lane >> 4, lr = lane & 15;
    for (int unit = F.bid; unit < 256; unit += F.G) {
        const int xk = unit >> 3, vs = xk & 3, gq = (xk >> 2) * 8 + (unit & 7); const int b = gq >> 4, h = gq & 15;
        __syncthreads();
        f32x4 S0 = {0.f, 0.f, 0.f, 0.f}, S1 = {0.f, 0.f, 0.f, 0.f};
        constexpr int NC = I_VT / 16;
        const int p5 = tid + 5 * NT; const bool ok5 = p5 < NC; const int s5 = ok5 ? p5 * 16 : 0;
        const int sv = tid >> 3, v4 = (tid & 7) * 4; const size_t colv = (size_t)h * 128 + vs * 32 + v4;
        u32x4 rA[7], rB[7];
        auto load = [&](u32x4 (&r)[7], const int c) { const unsigned char* img = IMG + (size_t)(gq * 32 + c) * IMG_BYTES;
#pragma unroll
            for (int k = 0; k < 5; ++k) r[k] = *(GAS const u32x4*)(img + (tid + k * NT) * 16);
            r[5] = *(GAS const u32x4*)(img + s5); { const u32x2 vv = *(GAS const u32x2*)(VB + ((size_t)b * SEQ + (size_t)c * 64 + sv) * D + colv); r[6] = (u32x4){vv.x, vv.y, 0u, 0u}; } };
        load(rA, 0); load(rB, 1);
        auto step = [&](u32x4 (&r)[7], const int c) {
            LAS unsigned char* buf = F.lds + (c & 1) * B_BUF;
            LAS bf16* QE = (LAS bf16*)(buf + I_QE); LAS bf16* KET = (LAS bf16*)(buf + I_KET); LAS bf16* P = (LAS bf16*)(buf + I_P); LAS float* EBC = (LAS float*)(buf + I_EBC);
            LAS bf16* VT = (LAS bf16*)(buf + B_VT); LAS bf16* SB = (LAS bf16*)(buf + B_SB);
#pragma unroll
            for (int k = 0; k < 5; ++k) *(LAS u32x4*)(buf + (tid + k * NT) * 16) = r[k];
            if (ok5) *(LAS u32x4*)(buf + s5) = r[5];
            VT[(v4 + 0) * SS + sv] = (bf16)(r[6].x & 0xffffu); VT[(v4 + 1) * SS + sv] = (bf16)(r[6].x >> 16); VT[(v4 + 2) * SS + sv] = (bf16)(r[6].y & 0xffffu); VT[(v4 + 3) * SS + sv] = (bf16)(r[6].y >> 16);
            { u32x2 s0, s1; s0.x = pk2(S0[0], S0[1]); s0.y = pk2(S0[2], S0[3]); s1.x = pk2(S1[0], S1[1]); s1.y = pk2(S1[2], S1[3]);
                *(LAS u32x2*)(SB + lr * SK + 16 * w + 4 * lq) = s0; *(LAS u32x2*)(SB + (16 + lr) * SK + 16 * w + 4 * lq) = s1; }
            load(r, c + 2 < SEQ / 64 ? c + 2 : SEQ / 64 - 1);
            __syncthreads();
            { const int tq = w & 3, nv = w >> 2; f32x4 acc = {0.f, 0.f, 0.f, 0.f};
                acc = mm(P, SS, 16 * tq, VT, SS, 16 * nv, tq < 2 ? 1 : 2, acc, lane);
                acc = mm(QE, SK, 16 * tq, SB, SK, 16 * nv, 4, acc, lane);
                bf16* op = OF + ((size_t)b * SEQ + c * 64 + 16 * tq + 4 * lq) * D + h * 128 + vs * 32 + 16 * nv + (lr & ~1);
                store_pairs(op, acc, lr); }
            { f32x4 U0 = {0.f, 0.f, 0.f, 0.f}, U1 = {0.f, 0.f, 0.f, 0.f}; U0 = mm(KET, SS, 16 * w, VT, SS, 0, 2, U0, lane); U1 = mm(KET, SS, 16 * w, VT, SS, 16, 2, U1, lane);
                const f32x4 dec = *(const LAS f32x4*)(EBC + 16 * w + 4 * lq); S0 = S0 * dec + U0; S1 = S1 * dec + U1; }
        };
        for (int c = 0; c < SEQ / 64; c += 2) { step(rA, c); step(rB, c + 1); }
        if (hcnt) headnorm_tail<4, false>(F, OF, SSQP, hcnt + b * 16 + h, b, h * 128 + vs * 32, h * 4, vs, GB, D, h * 128 + vs * 32, gn + vs * 32, Y);
    }
}

__device__ __forceinline__ void ml_chunk_phase(const Frame& F, const bf16* PB, const float* gates, const float* bif, bf16* OF, const float* gn, bf16* Y, float* SSQP, unsigned* hcnt) {
    LAS bf16* QH = (LAS bf16*)(F.lds + O_QH); LAS bf16* KH = (LAS bf16*)(F.lds + O_KH); LAS bf16* KET = (LAS bf16*)(F.lds + O_KET);
    LAS bf16* VT = (LAS bf16*)(F.lds + O_VT); LAS bf16* P = (LAS bf16*)(F.lds + O_P); LAS bf16* SB = (LAS bf16*)(F.lds + O_SB);
    LAS float* GT0 = (LAS float*)(F.lds + O_GT + 2048);
    const int tid = F.tid, lane = F.lane, w = F.wave, lq = lane >> 4, lr = lane & 15;
    const int g = w, d2 = 2 * lane, sv = tid >> 3, v4 = (tid & 7) * 4;
    constexpr float S128 = 0.08838834764831845f;
    for (int unit = F.bid; unit < 256; unit += F.G) {
        const int xk = unit >> 3, vs = xk & 7, gq = (xk >> 3) * 8 + (unit & 7); const int b = gq >> 3, h = gq & 7;
        const float bi_ = *(GAS const float*)(bif + h), bf_ = *(GAS const float*)(bif + 8 + h);
        __syncthreads();
        for (int e = tid; e < 64 * SS / 2; e += NT) ((LAS unsigned*)P)[e] = 0u;
        for (int e = tid; e < 48 * SK / 2; e += NT) ((LAS unsigned*)SB)[e] = 0u;
        for (int e = tid; e < 16 * SS; e += NT) VT[32 * SS + e] = (e < 64) ? (bf16)0x3F80u : (bf16)0u;
        f32x4 S0 = {0.f, 0.f, 0.f, 0.f}, S1 = {0.f, 0.f, 0.f, 0.f}, S2 = {0.f, 0.f, 0.f, 0.f};
        unsigned qvA[8], kvA[8], qvB[8], kvB[8]; u32x2 vvA, vvB; float giA = 0.f, gfA = 0.f, giB = 0.f, gfB = 0.f;
        const size_t colq = (size_t)h * 128 + d2, colv = (size_t)2048 + h * 256 + vs * 32 + v4;
        auto load = [&](unsigned (&qv)[8], unsigned (&kv)[8], u32x2& vv, float& gi, float& gf, const int cc) { const size_t r0 = (size_t)b * SEQ + (size_t)cc * 64 + 8 * g;
#pragma unroll
            for (int tt = 0; tt < 8; ++tt) { qv[tt] = *(GAS const unsigned*)(PB + (r0 + tt) * ML_PROJ + colq); kv[tt] = *(GAS const unsigned*)(PB + (r0 + tt) * ML_PROJ + 1024 + colq); }
            vv = *(GAS const u32x2*)(PB + ((size_t)b * SEQ + (size_t)cc * 64 + sv) * ML_PROJ + colv);
            gi = *(GAS const float*)(gates + ((size_t)b * SEQ + (size_t)cc * 64 + lane) * 16 + h); gf = *(GAS const float*)(gates + ((size_t)b * SEQ + (size_t)cc * 64 + lane) * 16 + 8 + h); };
        load(qvA, kvA, vvA, giA, gfA, 0); load(qvB, kvB, vvB, giB, gfB, 1);
        auto step = [&](unsigned (&qv)[8], unsigned (&kv)[8], u32x2& vv, float& gi, float& gf, const int c) {
            LAS float* BT = GT0 + (c & 1) * 320; LAS float* WI = BT + 64; LAS float* WK = WI + 64; LAS float* EB = WK + 64; LAS float* EC = EB + 64;
            if (w == 0) {
                const float it = 15.0f * tanhf((gi + bi_) * (1.0f / 15.0f)); const float y = 15.0f * tanhf((gf + bf_) * (1.0f / 15.0f));
                const float lfv = -(fmaxf(-y, 0.f) + log1pf(expf(-fabsf(y))));
                float bt = lfv;
#pragma unroll
                for (int o = 1; o < 64; o <<= 1) { const float up = __shfl_up(bt, o); if (lane >= o) bt += up; }
                const float bC = __shfl(bt, 63);
                BT[lane] = bt; WI[lane] = it - bt; WK[lane] = __expf(bC - bt + it) * S128; EB[lane] = __expf(bt); if (lane == 0) EC[0] = __expf(bC);
            }
            __syncthreads();
            { u32x2 s0, s1, s2; s0.x = pk2(S0[0], S0[1]); s0.y = pk2(S0[2], S0[3]); s1.x = pk2(S1[0], S1[1]); s1.y = pk2(S1[2], S1[3]); s2.x = pk2(S2[0], S2[1]); s2.y = pk2(S2[2], S2[3]);
                *(LAS u32x2*)(SB + lr * SK + 16 * w + 4 * lq) = s0; *(LAS u32x2*)(SB + (16 + lr) * SK + 16 * w + 4 * lq) = s1; *(LAS u32x2*)(SB + (32 + lr) * SK + 16 * w + 4 * lq) = s2; }
            { unsigned ke0[4], ke1[4];
#pragma unroll
                for (int tt = 0; tt < 8; ++tt) { const int t = 8 * g + tt; *(LAS unsigned*)(QH + t * SK + d2) = qv[tt]; *(LAS unsigned*)(KH + t * SK + d2) = kv[tt];
                    const float wk = WK[t]; const float c0 = bflo(kv[tt]) * wk, c1 = bfhi(kv[tt]) * wk;
                    if (tt & 1) { ke0[tt >> 1] = pk2(__uint_as_float(ke0[tt >> 1]), c0); ke1[tt >> 1] = pk2(__uint_as_float(ke1[tt >> 1]), c1); } else { ke0[tt >> 1] = __float_as_uint(c0); ke1[tt >> 1] = __float_as_uint(c1); } }
                *(LAS u32x4*)(KET + d2 * SS + 8 * g) = (u32x4){ke0[0], ke0[1], ke0[2], ke0[3]}; *(LAS u32x4*)(KET + (d2 + 1) * SS + 8 * g) = (u32x4){ke1[0], ke1[1], ke1[2], ke1[3]}; }
            VT[(v4 + 0) * SS + sv] = (bf16)(vv.x & 0xffffu); VT[(v4 + 1) * SS + sv] = (bf16)(vv.x >> 16); VT[(v4 + 2) * SS + sv] = (bf16)(vv.y & 0xffffu); VT[(v4 + 3) * SS + sv] = (bf16)(vv.y >> 16);
            load(qv, kv, vv, gi, gf, c + 2 < SEQ / 64 ? c + 2 : SEQ / 64 - 1);
            __syncthreads();
            for (int tile = w; tile < 10; tile += 8) { int qi, kj; tile_of(tile, qi, kj);
                f32x4 acc = {0.f, 0.f, 0.f, 0.f}; acc = mm(QH, SK, 16 * qi, KH, SK, 16 * kj, 4, acc, lane);
                const float wis = WI[16 * kj + lr];
#pragma unroll
                for (int r = 0; r < 4; ++r) { const int tl = 4 * lq + r; const float wgt = __expf(BT[16 * qi + tl] + wis) * S128;
                    const float val = (qi != kj || lr <= tl) ? acc[r] * wgt : 0.f; P[(16 * qi + tl) * SS + 16 * kj + lr] = f2bf(val); } }
            __syncthreads();
            { const int tq = w & 3, nv = w >> 2, ksn = tq < 2 ? 1 : 2; f32x4 num = {0.f, 0.f, 0.f, 0.f}, den = num, qs = num, qn = num;
                num = mm(P, SS, 16 * tq, VT, SS, 16 * nv, ksn, num, lane); den = mm(P, SS, 16 * tq, VT, SS, 32, ksn, den, lane);
                qs = mm(QH, SK, 16 * tq, SB, SK, 16 * nv, 4, qs, lane); qn = mm(QH, SK, 16 * tq, SB, SK, 32, 4, qn, lane);
                const f32x4 eb = *(const LAS f32x4*)(EB + 16 * tq + 4 * lq);
                bf16* op = OF + ((size_t)b * SEQ + c * 64 + 16 * tq + 4 * lq) * D + h * 256 + vs * 32 + 16 * nv + (lr & ~1); f32x4 hv;
#pragma unroll
                for (int r = 0; r < 4; ++r) { const float nm = num[r] + eb[r] * qs[r]; float dn = den[r] + eb[r] * qn[r]; dn = __shfl(dn, lane & 48);
                    hv[r] = nm / fmaxf(fabsf(dn), 1.0f); }
                store_pairs(op, hv, lr); }
            { f32x4 U0 = {0.f, 0.f, 0.f, 0.f}, U1 = U0, U2 = U0; U0 = mm(KET, SS, 16 * w, VT, SS, 0, 2, U0, lane); U1 = mm(KET, SS, 16 * w, VT, SS, 16, 2, U1, lane); U2 = mm(KET, SS, 16 * w, VT, SS, 32, 2, U2, lane);
                const float dec = EC[0]; S0 = S0 * dec + U0; S1 = S1 * dec + U1; S2 = S2 * dec + U2; }
        };
        for (int c = 0; c < SEQ / 64; c += 2) { step(qvA, kvA, vvA, giA, gfA, c); step(qvB, kvB, vvB, giB, gfB, c + 1); }
        if (hcnt) headnorm_tail<8, true>(F, OF, SSQP, hcnt + b * 8 + h, b, h * 256 + vs * 32, h * 8, vs, PB, ML_PROJ, 4096 + h * 256 + vs * 32, gn + vs * 32, Y);
    }
}

constexpr int MA_KH = 0, MA_IMG = MA_KH + 64 * SK * 2, ML_IMG_BYTES = I_VT + 256 * SS * 2, MA_GS = MA_IMG + ML_IMG_BYTES, MA_END = MA_GS + 2 * 1280;
constexpr int MB_VT = I_VT, MB_SB = MB_VT + 48 * SS * 2, MB_BUF = MB_SB + 48 * SK * 2;
static_assert(MA_END <= CTRL && 2 * MB_BUF <= CTRL, "ml stage LDS maps");
__device__ __forceinline__ void ml_prep_phase(const Frame& F, const bf16* PB, const float* gates, const float* bif, unsigned char* IMG) {
    LAS bf16* KH = (LAS bf16*)(F.lds + MA_KH); LAS bf16* QH = (LAS bf16*)(F.lds + MA_IMG + I_QE); LAS bf16* KET = (LAS bf16*)(F.lds + MA_IMG + I_KET);
    LAS bf16* VT = (LAS bf16*)(F.lds + MA_IMG + I_VT); LAS bf16* P = (LAS bf16*)(F.lds + MA_IMG + I_P); LAS float* EBI = (LAS float*)(F.lds + MA_IMG + I_EBC);
    const int tid = F.tid, lane = F.lane, w = F.wave, lq = lane >> 4, lr = lane & 15;
    const int g = w, d2 = 2 * lane, tp = tid >> 4, vc = (tid & 15) * 16;
    constexpr float S128 = 0.08838834764831845f;
    constexpr int NITEM = BATCH * 8 * (SEQ / 64);
    __syncthreads();
    for (int e = tid; e < 64 * SS / 2; e += NT) ((LAS unsigned*)P)[e] = 0u;
    unsigned qvA[8], kvA[8], qvB[8], kvB[8]; float giA = 0.f, gfA = 0.f, giB = 0.f, gfB = 0.f;
    auto load = [&](unsigned (&qv)[8], unsigned (&kv)[8], float& gi, float& gf, const int item) { const int c = item & 31, gq = item >> 5, b = gq >> 3, h = gq & 7;
        const size_t r0 = (size_t)b * SEQ + (size_t)c * 64 + 8 * g, colq = (size_t)h * 128 + d2;
#pragma unroll
        for (int tt = 0; tt < 8; ++tt) { qv[tt] = *(GAS const unsigned*)(PB + (r0 + tt) * ML_PROJ + colq); kv[tt] = *(GAS const unsigned*)(PB + (r0 + tt) * ML_PROJ + 1024 + colq); }
        const size_t gr = ((size_t)b * SEQ + (size_t)c * 64 + lane) * 16 + h; gi = *(GAS const float*)(gates + gr) + *(GAS const float*)(bif + h); gf = *(GAS const float*)(gates + gr + 8) + *(GAS const float*)(bif + 8 + h); };
    const int first = F.bid, stride = F.G;
    if (first < NITEM) load(qvA, kvA, giA, gfA, first);
    if (first + stride < NITEM) load(qvB, kvB, giB, gfB, first + stride);
    int par = 0;
    auto step = [&](unsigned (&qv)[8], unsigned (&kv)[8], float& gi, float& gf, const int item) {
        LAS float* BT = (LAS float*)(F.lds + MA_GS) + par * 320; LAS float* WI = BT + 64; LAS float* WK = WI + 64; LAS float* EB = WK + 64; LAS float* EC = EB + 64;
        if (w == 0) {
            const float it = 15.0f * tanhf(gi * (1.0f / 15.0f)); const float y = 15.0f * tanhf(gf * (1.0f / 15.0f));
            const float lfv = -(fmaxf(-y, 0.f) + log1pf(expf(-fabsf(y))));
            float bt = lfv;
#pragma unroll
            for (int o = 1; o < 64; o <<= 1) { const float up = __shfl_up(bt, o); if (lane >= o) bt += up; }
            const float bC = __shfl(bt, 63);
            BT[lane] = bt; WI[lane] = it - bt; WK[lane] = __expf(bC - bt + it) * S128; EB[lane] = __expf(bt); if (lane == 0) EC[0] = __expf(bC);
        }
        __syncthreads();
        if (w == 0) { EBI[lane] = EB[lane]; if (lane == 0) EBI[64] = EC[0]; }
        { unsigned ke0[4], ke1[4];
#pragma unroll
            for (int tt = 0; tt < 8; ++tt) { const int t = 8 * g + tt; *(LAS unsigned*)(QH + t * SK + d2) = qv[tt]; *(LAS unsigned*)(KH + t * SK + d2) = kv[tt];
                const float wk = WK[t]; const float c0 = bflo(kv[tt]) * wk, c1 = bfhi(kv[tt]) * wk;
                if (tt & 1) { ke0[tt >> 1] = pk2(__uint_as_float(ke0[tt >> 1]), c0); ke1[tt >> 1] = pk2(__uint_as_float(ke1[tt >> 1]), c1); } else { ke0[tt >> 1] = __float_as_uint(c0); ke1[tt >> 1] = __float_as_uint(c1); } }
            *(LAS u32x4*)(KET + d2 * SS + 8 * g) = (u32x4){ke0[0], ke0[1], ke0[2], ke0[3]}; *(LAS u32x4*)(KET + (d2 + 1) * SS + 8 * g) = (u32x4){ke1[0], ke1[1], ke1[2], ke1[3]}; }
        load(qv, kv, gi, gf, item + 2 * stride < NITEM ? item + 2 * stride : item);
        __syncthreads();
        for (int tile = w; tile < 10; tile += 8) { int qi, kj; tile_of(tile, qi, kj);
            f32x4 acc = {0.f, 0.f, 0.f, 0.f}; acc = mm(QH, SK, 16 * qi, KH, SK, 16 * kj, 4, acc, lane);
            const float wis = WI[16 * kj + lr];
#pragma unroll
            for (int r = 0; r < 4; ++r) { const int tl = 4 * lq + r; const float wgt = __expf(BT[16 * qi + tl] + wis) * S128;
                const float val = (qi != kj || lr <= tl) ? acc[r] * wgt : 0.f; P[(16 * qi + tl) * SS + 16 * kj + lr] = f2bf(val); } }
        __syncthreads();
        { unsigned char* img = IMG + (size_t)item * ML_IMG_BYTES;
            for (int o = tid * 16; o < I_VT; o += NT * 16) *(GAS u32x4*)(img + o) = *(const LAS u32x4*)(F.lds + MA_IMG + o); }
        par ^= 1;
    };
    for (int item = first; item < NITEM; item += 2 * stride) { step(qvA, kvA, giA, gfA, item); if (item + stride < NITEM) step(qvB, kvB, giB, gfB, item + stride); }
}
__device__ __forceinline__ void ml_scan_phase(const Frame& F, const unsigned char* IMG, bf16* OF, const bf16* PB, const float* gn, bf16* Y, float* SSQP, unsigned* hcnt) {
    const int tid = F.tid, lane = F.lane, w = F.wave, lq = lane >> 4, lr = lane & 15;
    for (int unit = F.bid; unit < 256; unit += F.G) {
        const int xk = unit >> 3, vs = xk & 7, gq = (xk >> 3) * 8 + (unit & 7); const int b = gq >> 3, h = gq & 7;
        __syncthreads();
#pragma unroll
        for (int bb = 0; bb < 2; ++bb) { LAS bf16* VTb = (LAS bf16*)(F.lds + bb * MB_BUF + MB_VT);
            for (int e = tid; e < 16 * SS; e += NT) VTb[32 * SS + e] = (e < 64) ? (bf16)0x3F80u : (bf16)0u; }
        f32x4 S0 = {0.f, 0.f, 0.f, 0.f}, S1 = {0.f, 0.f, 0.f, 0.f}, S2 = {0.f, 0.f, 0.f, 0.f};
        constexpr int NC = I_VT / 16;
        const int p5 = tid + 5 * NT; const bool ok5 = p5 < NC; const int s5 = ok5 ? p5 * 16 : 0;
        const int sv = tid >> 3, v4 = (tid & 7) * 4; const size_t colv = (size_t)2048 + h * 256 + vs * 32 + v4;
        u32x4 rA[7], rB[7];
        auto load = [&](u32x4 (&r)[7], const int c) { const unsigned char* img = IMG + (size_t)(gq * 32 + c) * ML_IMG_BYTES;
#pragma unroll
            for (int k = 0; k < 5; ++k) r[k] = *(GAS const u32x4*)(img + (tid + k * NT) * 16);
            r[5] = *(GAS const u32x4*)(img + s5); { const u32x2 vv = *(GAS const u32x2*)(PB + ((size_t)b * SEQ + (size_t)c * 64 + sv) * ML_PROJ + colv); r[6] = (u32x4){vv.x, vv.y, 0u, 0u}; } };
        load(rA, 0); load(rB, 1);
        auto step = [&](u32x4 (&r)[7], const int c) {
            LAS unsigned char* buf = F.lds + (c & 1) * MB_BUF;
            LAS bf16* QH = (LAS bf16*)(buf + I_QE); LAS bf16* KET = (LAS bf16*)(buf + I_KET); LAS bf16* P = (LAS bf16*)(buf + I_P); LAS float* EB = (LAS float*)(buf + I_EBC);
            LAS bf16* VT = (LAS bf16*)(buf + MB_VT); LAS bf16* SB = (LAS bf16*)(buf + MB_SB);
#pragma unroll
            for (int k = 0; k < 5; ++k) *(LAS u32x4*)(buf + (tid + k * NT) * 16) = r[k];
            if (ok5) *(LAS u32x4*)(buf + s5) = r[5];
            VT[(v4 + 0) * SS + sv] = (bf16)(r[6].x & 0xffffu); VT[(v4 + 1) * SS + sv] = (bf16)(r[6].x >> 16); VT[(v4 + 2) * SS + sv] = (bf16)(r[6].y & 0xffffu); VT[(v4 + 3) * SS + sv] = (bf16)(r[6].y >> 16);
            { u32x2 s0, s1, s2; s0.x = pk2(S0[0], S0[1]); s0.y = pk2(S0[2], S0[3]); s1.x = pk2(S1[0], S1[1]); s1.y = pk2(S1[2], S1[3]); s2.x = pk2(S2[0], S2[1]); s2.y = pk2(S2[2], S2[3]);
                *(LAS u32x2*)(SB + lr * SK + 16 * w + 4 * lq) = s0; *(LAS u32x2*)(SB + (16 + lr) * SK + 16 * w + 4 * lq) = s1; *(LAS u32x2*)(SB + (32 + lr) * SK + 16 * w + 4 * lq) = s2; }
            load(r, c + 2 < SEQ / 64 ? c + 2 : SEQ / 64 - 1);
            __syncthreads();
            { const int tq = w & 3, nv = w >> 2, ksn = tq < 2 ? 1 : 2; f32x4 num = {0.f, 0.f, 0.f, 0.f}, den = num, qs = num, qn = num;
                num = mm(P, SS, 16 * tq, VT, SS, 16 * nv, ksn, num, lane); den = mm(P, SS, 16 * tq, VT, SS, 32, ksn, den, lane);
                qs = mm(QH, SK, 16 * tq, SB, SK, 16 * nv, 4, qs, lane); qn = mm(QH, SK, 16 * tq, SB, SK, 32, 4, qn, lane);
                const f32x4 eb = *(const LAS f32x4*)(EB + 16 * tq + 4 * lq);
                bf16* op = OF + ((size_t)b * SEQ + c * 64 + 16 * tq + 4 * lq) * D + h * 256 + vs * 32 + 16 * nv + (lr & ~1); f32x4 hv;
#pragma unroll
                for (int r4 = 0; r4 < 4; ++r4) { const float nm = num[r4] + eb[r4] * qs[r4]; float dn = den[r4] + eb[r4] * qn[r4]; dn = __shfl(dn, lane & 48);
                    hv[r4] = nm / fmaxf(fabsf(dn), 1.0f); }
                store_pairs(op, hv, lr); }
            { f32x4 U0 = {0.f, 0.f, 0.f, 0.f}, U1 = U0, U2 = U0; U0 = mm(KET, SS, 16 * w, VT, SS, 0, 2, U0, lane); U1 = mm(KET, SS, 16 * w, VT, SS, 16, 2, U1, lane); U2 = mm(KET, SS, 16 * w, VT, SS, 32, 2, U2, lane);
                const float dec = EB[64]; S0 = S0 * dec + U0; S1 = S1 * dec + U1; S2 = S2 * dec + U2; }
        };
        for (int c = 0; c < SEQ / 64; c += 2) { step(rA, c); step(rB, c + 1); }
        if (hcnt) headnorm_tail<8, true>(F, OF, SSQP, hcnt + b * 8 + h, b, h * 256 + vs * 32, h * 8, vs, PB, ML_PROJ, 4096 + h * 256 + vs * 32, gn + vs * 32, Y);
    }
}
}

template <bool ML>
__device__ __forceinline__ void headnorm_rows(const Frame& F, const bf16* OF, const float* gn, const bf16* gate, int ldg, bf16* Y) {
    constexpr int HD = ML ? 256 : 128, LPH = HD / 32;
    for (int row = F.gw; row < M; row += F.NGW) {
        const u32x4* p = (const u32x4*)(OF + (size_t)row * D + F.lane * 32);
        f32x4 v[8]; float ss = 0.f;
#pragma unroll
        for (int j = 0; j < 4; ++j) { const u32x4 w = p[j]; v[2 * j] = (f32x4){bflo(w.x), bfhi(w.x), bflo(w.y), bfhi(w.y)}; v[2 * j + 1] = (f32x4){bflo(w.z), bfhi(w.z), bflo(w.w), bfhi(w.w)}; }
#pragma unroll
        for (int j = 0; j < 8; ++j) ss += (v[j][0] * v[j][0] + v[j][1] * v[j][1]) + (v[j][2] * v[j][2] + v[j][3] * v[j][3]);
#pragma unroll
        for (int o = 1; o < LPH; o <<= 1) ss += __shfl_xor(ss, o);
        const float rstd = 1.0f / sqrtf(ss * (1.0f / HD) + EPS);
        const int cih = (F.lane * 32) % HD;
        const u32x4* gp = (const u32x4*)(gate + (size_t)row * ldg + F.lane * 32);
        u32x4* yp = (u32x4*)(Y + (size_t)row * D + F.lane * 32);
#pragma unroll
        for (int j = 0; j < 4; ++j) { const u32x4 gw = gp[j]; const f32x4 g0 = *(GAS const f32x4*)(gn + cih + 8 * j), g1 = *(GAS const f32x4*)(gn + cih + 8 * j + 4);
            float gg[8] = {bflo(gw.x), bfhi(gw.x), bflo(gw.y), bfhi(gw.y), bflo(gw.z), bfhi(gw.z), bflo(gw.w), bfhi(gw.w)};
            if constexpr (ML) {
#pragma unroll
                for (int i = 0; i < 8; ++i) gg[i] = sigmoidf_(gg[i]); }
            const f32x4 a = v[2 * j] * rstd * g0, c = v[2 * j + 1] * rstd * g1;
            u32x4 w; w.x = pk2(a[0] * gg[0], a[1] * gg[1]); w.y = pk2(a[2] * gg[2], a[3] * gg[3]); w.z = pk2(c[0] * gg[4], c[1] * gg[5]); w.w = pk2(c[2] * gg[6], c[3] * gg[7]);
            yp[j] = w; }
    }
}
__device__ __forceinline__ void lru_conv(const Frame& F, const bf16* UR, const float* cw, const float* cb, bf16* UCB) {
    constexpr int total = (M / 4) * (D / 8);
    const int first = F.bid * NT + F.tid, c8 = (first % (D / 8)) * 8;
    f32x4 w0[4], w1[4];
#pragma unroll
    for (int j = 0; j < 4; ++j) { w0[j] = *(GAS const f32x4*)(cw + j * D + c8); w1[j] = *(GAS const f32x4*)(cw + j * D + c8 + 4); }
    const f32x4 b0 = *(GAS const f32x4*)(cb + c8), b1 = *(GAS const f32x4*)(cb + c8 + 4);
    for (int idx = first; idx < total; idx += F.G * NT) {
        const int row0 = (idx / (D / 8)) * 4, t0 = row0 % SEQ;
        u32x4 u[7];
#pragma unroll
        for (int i = 0; i < 7; ++i) { u[i] = (u32x4){0u, 0u, 0u, 0u}; if (i >= 3 || t0 > 0) u[i] = *(GAS const u32x4*)(UR + (size_t)(row0 + i - 3) * D + c8); }
#pragma unroll
        for (int o = 0; o < 4; ++o) { f32x4 a0 = b0, a1 = b1;
#pragma unroll
            for (int j = 0; j < 4; ++j) { const u32x4 v = u[o + j];
                a0 += w0[j] * (f32x4){bflo(v.x), bfhi(v.x), bflo(v.y), bfhi(v.y)}; a1 += w1[j] * (f32x4){bflo(v.z), bfhi(v.z), bflo(v.w), bfhi(v.w)}; }
            u32x4 w; w.x = pk2(a0[0], a0[1]); w.y = pk2(a0[2], a0[3]); w.z = pk2(a1[0], a1[1]); w.w = pk2(a1[2], a1[3]);
            *(GAS u32x4*)(UCB + (size_t)(row0 + o) * D + c8) = w; }
    }
}
__device__ __forceinline__ void lru_scan(const Frame& F, const bf16* LA, const bf16* INP, const bf16* GBR, bf16* Y) {
    LAS float* CP = (LAS float*)F.lds; LAS float* CH = CP + 128 * 32; LAS float* QP = CH + 128 * 32; LAS float* QH = QP + 16 * 32; LAS float* HC = QH + 16 * 32;
    const int seg = F.tid >> 2, q = F.tid & 3, ch = F.tid & 31, part = F.tid >> 5;
    for (int unit = F.bid; unit < BATCH * 64; unit += F.G) {
        const int b = unit >> 6;
        __syncthreads();
        if (F.tid < 32) HC[F.tid] = 0.f;
        for (int half = 0; half < 2; ++half) {
            const size_t base = ((size_t)b * SEQ + half * (SEQ / 2) + seg * 8) * D + (unit & 63) * 32 + 8 * q;
            u32x4 la[8], xi[8];
#pragma unroll
            for (int j = 0; j < 8; ++j) { la[j] = *(GAS const u32x4*)(LA + base + (size_t)j * D); xi[j] = *(GAS const u32x4*)(INP + base + (size_t)j * D); }
            float sl[8], h[8];
#pragma unroll
            for (int e = 0; e < 8; ++e) { sl[e] = 0.f; h[e] = 0.f; }
#pragma unroll
            for (int j = 0; j < 8; ++j) {
                const float l8[8] = {bflo(la[j].x), bfhi(la[j].x), bflo(la[j].y), bfhi(la[j].y), bflo(la[j].z), bfhi(la[j].z), bflo(la[j].w), bfhi(la[j].w)};
                const float x8[8] = {bflo(xi[j].x), bfhi(xi[j].x), bflo(xi[j].y), bfhi(xi[j].y), bflo(xi[j].z), bfhi(xi[j].z), bflo(xi[j].w), bfhi(xi[j].w)};
#pragma unroll
                for (int e = 0; e < 8; ++e) { h[e] = __expf(l8[e]) * h[e] + x8[e]; sl[e] += l8[e]; } }
            __syncthreads();
            *(LAS f32x4*)(CP + seg * 32 + 8 * q) = (f32x4){__expf(sl[0]), __expf(sl[1]), __expf(sl[2]), __expf(sl[3])}; *(LAS f32x4*)(CP + seg * 32 + 8 * q + 4) = (f32x4){__expf(sl[4]), __expf(sl[5]), __expf(sl[6]), __expf(sl[7])};
            *(LAS f32x4*)(CH + seg * 32 + 8 * q) = (f32x4){h[0], h[1], h[2], h[3]}; *(LAS f32x4*)(CH + seg * 32 + 8 * q + 4) = (f32x4){h[4], h[5], h[6], h[7]};
            __syncthreads();
            { float p = 1.f, hh = 0.f;
#pragma unroll
                for (int s = 0; s < 8; ++s) { const float cp = CP[(part * 8 + s) * 32 + ch], cv = CH[(part * 8 + s) * 32 + ch]; hh = cp * hh + cv; p *= cp; }
                QP[part * 32 + ch] = p; QH[part * 32 + ch] = hh; }
            __syncthreads();
            { float carry = HC[ch];
                for (int s = 0; s < part; ++s) carry = QP[s * 32 + ch] * carry + QH[s * 32 + ch];
#pragma unroll
                for (int s = 0; s < 8; ++s) { const int o = (part * 8 + s) * 32 + ch; const float cp = CP[o], cv = CH[o]; CH[o] = carry; carry = cp * carry + cv; }
                __syncthreads();
                if (part == 15) HC[ch] = carry; }
            { const f32x4 c0 = *(const LAS f32x4*)(CH + seg * 32 + 8 * q), c1 = *(const LAS f32x4*)(CH + seg * 32 + 8 * q + 4);
                h[0] = c0[0]; h[1] = c0[1]; h[2] = c0[2]; h[3] = c0[3]; h[4] = c1[0]; h[5] = c1[1]; h[6] = c1[2]; h[7] = c1[3]; }
            u32x4 gg[8];
#pragma unroll
            for (int j = 0; j < 8; ++j) gg[j] = *(GAS const u32x4*)(GBR + base + (size_t)j * D);
#pragma unroll
            for (int j = 0; j < 8; ++j) { const u32x4 lw = la[j], xw = xi[j], gw = gg[j];
                const float l8[8] = {bflo(lw.x), bfhi(lw.x), bflo(lw.y), bfhi(lw.y), bflo(lw.z), bfhi(lw.z), bflo(lw.w), bfhi(lw.w)};
                const float x8[8] = {bflo(xw.x), bfhi(xw.x), bflo(xw.y), bfhi(xw.y), bflo(xw.z), bfhi(xw.z), bflo(xw.w), bfhi(xw.w)};
                const float g8[8] = {bflo(gw.x), bfhi(gw.x), bflo(gw.y), bfhi(gw.y), bflo(gw.z), bfhi(gw.z), bflo(gw.w), bfhi(gw.w)};
                float y[8];
#pragma unroll
                for (int e = 0; e < 8; ++e) { h[e] = __expf(l8[e]) * h[e] + x8[e]; y[e] = g8[e] * h[e]; }
                u32x4 w; w.x = pk2(y[0], y[1]); w.y = pk2(y[2], y[3]); w.z = pk2(y[4], y[5]); w.w = pk2(y[6], y[7]);
                *(GAS u32x4*)(Y + base + (size_t)j * D) = w; }
        }
    }
}
__device__ __forceinline__ void softmax_rows(const Frame& F, const float* S, bf16* P) {
    for (int row = F.gw; row < 16 * SEQ; row += F.NGW) {
        const f32x4 s = ((const f32x4*)(S + (size_t)row * NMEM))[F.lane];
        const float mx = wave_max(fmaxf(fmaxf(s[0], s[1]), fmaxf(s[2], s[3])));
        const f32x4 e = {__expf(s[0] - mx), __expf(s[1] - mx), __expf(s[2] - mx), __expf(s[3] - mx)};
        const float inv = 1.0f / wave_sum((e[0] + e[1]) + (e[2] + e[3]));
        u32x2 w; w.x = pk2(e[0] * inv, e[1] * inv); w.y = pk2(e[2] * inv, e[3] * inv); ((u32x2*)(P + (size_t)row * NMEM))[F.lane] = w;
    }
}


__device__ __forceinline__ int uni(int v) { return __builtin_amdgcn_readfirstlane(v); }
__device__ __forceinline__ Frame make_frame(unsigned ldsb) {
    Frame F; F.lds = (LAS unsigned char*)(size_t)__builtin_amdgcn_readfirstlane(ldsb);
    F.lane = (int)__builtin_amdgcn_mbcnt_hi(~0u, __builtin_amdgcn_mbcnt_lo(~0u, 0u));
    const unsigned key = hw_wave_key(); int w = 0;
#pragma unroll
    for (int i = 1; i < NWAVES; ++i) { const unsigned k = __builtin_amdgcn_readfirstlane(*(const LAS unsigned*)(F.lds + CTRL + 16 + 4 * i)); w = (k == key) ? i : w; }
    F.wave = w; F.tid = w * 64 + F.lane;
    F.bid = __builtin_amdgcn_readfirstlane(*(const LAS int*)(F.lds + CTRL + 48)); F.G = __builtin_amdgcn_readfirstlane(*(const LAS int*)(F.lds + CTRL + 52));
    F.gw = F.bid * NWAVES + F.wave; F.NGW = F.G * NWAVES; return F;
}
__device__ __forceinline__ void phase_end(const unsigned ldsb, int bar_) {
    if (uni(bar_)) { asm volatile("" ::: "memory"); const Frame F = make_frame(ldsb); XcdBarrier b; b.bar = (unsigned*)(F.ws() + WS_CTL); b.x = xb_xcc_id(); b.st = (volatile LAS unsigned*)(F.lds + CTRL); xcd_barrier(b, F.tid, (unsigned)F.G); }
}
#define PHASE_FN static __device__ __noinline__ __attribute__((not_tail_called)) void
#define PHASE_FN_G static __device__ __forceinline__ void

__device__ __forceinline__ int cvt_njobs(int l, int part) { return part == 0 ? ((l % 3) == 1 ? 2 + 1 + 32 : 2 + 1) : 3; }
__device__ __forceinline__ CvtJob cvt_job(const Frame& F, int l, int part, int j) {
    unsigned char* ws = F.ws(); const float* ng = F.in(I_NORMG); const int kind = l % 3, idx = l / 3;
    CvtJob J; J.gk = nullptr; J.off = 0; J.gu = 0; J.nvalid = 1 << 30;
    if (j == 0) { J.W = F.in(I_WGU) + (size_t)(l * 2 + part) * D * NGU; J.WT = (bf16*)(ws + WS_WGU + (size_t)(l * 2 + part) * SZ_WGU); J.K = D; J.ldw = NGU; J.nrows = NGU; J.gu = 1; J.gk = ng + ((size_t)l * 4 + (part ? 3 : 0)) * D; return J; }
    if (j == 1) { J.W = F.in(I_WDN) + (size_t)(l * 2 + part) * DFF * D; J.WT = (bf16*)(ws + WS_WDN + (size_t)(l * 2 + part) * SZ_WDN); J.K = DFF; J.ldw = D; J.nrows = D; return J; }
    if (part == 1) { J.K = D; J.ldw = D; J.nrows = D;
        if (kind == 0) { J.W = F.in(I_HGOUT) + (size_t)idx * D * D; J.WT = (bf16*)(ws + WS_HGOUT + (size_t)idx * SZ_WDD); }
        else if (kind == 1) { J.W = F.in(I_LRUOUT); J.WT = (bf16*)(ws + WS_LRUOUT); }
        else { J.W = F.in(I_MLOUT); J.WT = (bf16*)(ws + WS_MLOUT); }
        return J; }
    J.gk = ng + ((size_t)l * 4 + 1) * D; J.K = D;
    if (kind == 0) { J.W = F.in(I_HGIN) + (size_t)idx * D * 4 * D; J.WT = (bf16*)(ws + WS_HGIN + (size_t)idx * 4 * SZ_WDD); J.ldw = 4 * D; J.nrows = 4 * D; return J; }
    if (kind == 2) { J.W = F.in(I_MLIN); J.WT = (bf16*)(ws + WS_MLIN); J.ldw = ML_IN; J.nrows = ML_PROJ; return J; }
    if (j == 2) { J.W = F.in(I_LRUIN); J.WT = (bf16*)(ws + WS_LRUIN); J.ldw = 2 * D; J.nrows = 2 * D; return J; }
    { const int q = j - 3, g = q >> 4, blk = (q >> 1) & 7, jj = q & 1;
        J.gk = nullptr; J.W = F.in(g ? I_LRUWX : I_LRUWA) + (size_t)blk * 256 * 256; J.WT = (bf16*)(ws + WS_LRUG) + (size_t)(blk * 512 + jj * 256 + g * 128) * 256; J.K = 256; J.ldw = 256; J.nrows = 128; J.off = jj * 128; return J; }
}
__device__ __forceinline__ void convert_set(const Frame& F, int& rot, int l, int part, int num0 = 0, int num1 = 8) {
    const int nj = cvt_njobs(l, part);
    for (int j = 0; j < nj; ++j) { const CvtJob J = cvt_job(F, l, part, j); convert_job_rt(F, rot, J, num0, num1); }
}
constexpr int CVT_SC = 3;
PHASE_FN_G ph_prologue(unsigned ldsb, int bar_) {
    const Frame F = make_frame(ldsb);
    unsigned char* ws = F.ws(); int rot = 0;
    convert_set(F, rot, 0, 0);
    for (int l = 0; l < DEPTH; ++l) for (int kv = 0; kv < 2; ++kv) { CvtJob J; J.gk = nullptr; J.gu = 0; J.nvalid = 1 << 30; J.K = D; J.ldw = 2 * D; J.nrows = D; J.off = kv * D;
        J.W = F.in(I_XAKV) + (size_t)l * D * 2 * D; J.WT = (bf16*)(ws + (kv ? WS_WV : WS_WK) + (size_t)l * SZ_WDD); convert_job_rt(F, rot, J); }
    for (int l = 0; l < DEPTH; ++l) { CvtJob J; J.gk = nullptr; J.gu = 0; J.nvalid = 1 << 30; J.K = D; J.ldw = D; J.nrows = D; J.off = 0;
        J.W = F.in(I_XAO) + (size_t)l * D * D; J.WT = (bf16*)(ws + WS_WO + (size_t)l * SZ_WDD); convert_job_rt(F, rot, J); }
    { const float* wq = F.in(I_XAQ); const float* ngq = F.in(I_NORMG); bf16* wqn = (bf16*)(ws + WS_WQ);
      for (size_t i = (size_t)F.bid * NT + F.tid; i < (size_t)DEPTH * D * D / 8; i += (size_t)F.G * NT) { const size_t e = i * 8; const int l = (int)(e / ((size_t)D * D)), d = (int)((e / D) % D);
          const float g = ngq[((size_t)l * 4 + 2) * D + d]; const f32x4 a = __builtin_nontemporal_load((const f32x4*)(wq + e)), b = __builtin_nontemporal_load((const f32x4*)(wq + e + 4));
          u32x4 w; w.x = pk2(a[0] * g, a[1] * g); w.y = pk2(a[2] * g, a[3] * g); w.z = pk2(b[0] * g, b[1] * g); w.w = pk2(b[2] * g, b[3] * g); *(u32x4*)(wqn + e) = w; } }
    float* misc = (float*)(ws + WS_MISC);
    const int gt = F.bid * NT + F.tid, GT = F.G * NT;
    const float* hglb = F.in(I_HGLB); const float* lamp = F.in(I_LRULAM);
    for (int c = gt; c < 2048; c += GT) {
        const float p0 = hglb[c], p1 = hglb[2048 + c], p2 = hglb[4096 + c], p3 = hglb[6144 + c];
        const float mx = fmaxf(fmaxf(p0, p1), fmaxf(p2, p3)); const float e0 = expf(p0 - mx), e1 = expf(p1 - mx), e2 = expf(p2 - mx), e3 = expf(p3 - mx); const float inv = 1.0f / (e0 + e1 + e2 + e3);
        misc[MISC_LB / 4 + c] = 0.f; misc[MISC_LB / 4 + 2048 + c] = e1 * inv; misc[MISC_LB / 4 + 4096 + c] = (e1 + e2) * inv; misc[MISC_LB / 4 + 6144 + c] = (e1 + e2 + e3) * inv;
        const float lam = lamp[c]; const float sp = fmaxf(-lam, 0.f) + log1pf(expf(-fabsf(lam)));
        misc[MISC_C8 / 4 + c] = 8.0f * sp;
    }
    { const float* mlin = F.in(I_MLIN); const float* g21 = F.in(I_NORMG) + ((size_t)2 * 4 + 1) * D;
      bf16* wgb = (bf16*)(misc + MISC_MLWG / 4);
      for (int i = gt; i < 16 * 2048; i += GT) { const int c = i >> 11, k = i & 2047; const float w_ = g21[k] * mlin[(size_t)k * ML_IN + ML_PROJ + c]; wgb[i] = (bf16)(pk2(w_, w_) & 0xffffu); } }
    x_to_stream(F, F.in(I_X), (bf16*)(ws + WS_HB), misc + MISC_SSQ / 4);
    norm_rows<false>(F, F.in(I_MEM), F.in(I_MEMG), (bf16*)(ws + WS_MEMN), MMEM, nullptr, nullptr);
    phase_end(ldsb, bar_);
}

enum { NRM_FFN1 = 0, NRM_MIX = 1, NRM_ATT = 2, NRM_FFN2 = 3 };
PHASE_FN ph_final(unsigned ldsb) { const Frame F = make_frame(ldsb); unsigned char* ws = F.ws();
    if (X_F32) final_norm(F, (const float*)(ws + WS_X), F.in(I_FINALG), F.out()); else final_norm_bf(F, (const bf16*)(ws + WS_HB), (const float*)(ws + WS_MISC) + MISC_SSQ / 4, F.in(I_FINALG), F.out()); }
constexpr size_t CTL_HCNT = 32768;
constexpr size_t HG_IMG_OFF = 64 * MiB;
static_assert(HG_IMG_OFF + (size_t)BATCH * 16 * (SEQ / 64) * ck::IMG_BYTES <= 192 * MiB, "hg images");
PHASE_FN_G ph_hg_prep(unsigned ldsb, int bar_) { const Frame F = make_frame(ldsb); unsigned char* ws = F.ws();
    bf16* QB = (bf16*)(ws + WS_P0); bf16* VB = QB + (size_t)2 * M * D; const bf16* LF = (const bf16*)(ws + WS_P1);
    ck::hg_prep_phase(F, QB, LF, VB, ws + WS_P1 + HG_IMG_OFF); phase_end(ldsb, bar_); }
PHASE_FN_G ph_hg_recur(unsigned ldsb, int l_, int bar_) { const Frame F = make_frame(ldsb); unsigned char* ws = F.ws(); const int l = uni(l_);
    bf16* GB = (bf16*)(ws + WS_P0) + (size_t)3 * M * D; bf16* OF = (bf16*)(ws + WS_P1) + (size_t)M * D;
    const bool fuse = FUSE_TAIL && F.G >= 256;
    ck::hg_scan_phase(F, ws + WS_P1 + HG_IMG_OFF, (const bf16*)(ws + WS_P0) + (size_t)2 * M * D, OF, GB, F.in(I_HGG) + (l / 3) * HG_D, (bf16*)(ws + WS_YB), (float*)(ws + WS_SC), fuse ? (unsigned*)(ws + WS_CTL + CTL_HCNT) + l * 64 : nullptr); phase_end(ldsb, bar_); }
PHASE_FN ph_hg_norm(unsigned ldsb, int idx_, int bar_) { const Frame F = make_frame(ldsb); unsigned char* ws = F.ws(); const int idx = uni(idx_); if (FUSE_TAIL && F.G >= 256) return;
    bf16* GB = (bf16*)(ws + WS_P0) + (size_t)3 * M * D; const bf16* OF = (const bf16*)(ws + WS_P1) + (size_t)M * D;
    headnorm_rows<false>(F, OF, F.in(I_HGG) + idx * HG_D, GB, D, (bf16*)(ws + WS_YB)); phase_end(ldsb, bar_); }
static_assert(HG_IMG_OFF + (size_t)BATCH * 8 * (SEQ / 64) * ck::ML_IMG_BYTES <= 192 * MiB, "ml images");
PHASE_FN_G ph_ml_prep(unsigned ldsb, int bar_) { const Frame F = make_frame(ldsb); unsigned char* ws = F.ws();
    ck::ml_prep_phase(F, (const bf16*)(ws + WS_P0), (const float*)(ws + WS_MISC) + MISC_GATES / 4, F.in(I_MLBIF), ws + WS_P1 + HG_IMG_OFF); phase_end(ldsb, bar_); }
PHASE_FN_G ph_ml_recur(unsigned ldsb, int l_, int bar_) { const Frame F = make_frame(ldsb); unsigned char* ws = F.ws(); const int l = uni(l_); const bool fuse = FUSE_TAIL && F.G >= 256;
    ck::ml_scan_phase(F, ws + WS_P1 + HG_IMG_OFF, (bf16*)(ws + WS_P1), (const bf16*)(ws + WS_P0), F.in(I_MLG), (bf16*)(ws + WS_YB), (float*)(ws + WS_SC), fuse ? (unsigned*)(ws + WS_CTL + CTL_HCNT) + l * 64 : nullptr); phase_end(ldsb, bar_); }
PHASE_FN ph_ml_gates(unsigned ldsb, int bar_) { const Frame F = make_frame(ldsb); unsigned char* ws = F.ws(); const float* misc = (const float*)(ws + WS_MISC);
    ml_gates_rows(F, (const bf16*)(ws + WS_HB), misc + MISC_SSQ / 4, (const bf16*)(misc + MISC_MLWG / 4), (float*)(ws + WS_MISC) + MISC_GATES / 4); phase_end(ldsb, bar_); }
PHASE_FN ph_ml_norm(unsigned ldsb, int bar_) { const Frame F = make_frame(ldsb); unsigned char* ws = F.ws(); if (FUSE_TAIL && F.G >= 256) return;
    headnorm_rows<true>(F, (const bf16*)(ws + WS_P1), F.in(I_MLG), (const bf16*)(ws + WS_P0) + 4096, ML_PROJ, (bf16*)(ws + WS_YB)); phase_end(ldsb, bar_); }
PHASE_FN ph_lru_conv(unsigned ldsb, int bar_) { const Frame F = make_frame(ldsb); unsigned char* ws = F.ws();
    lru_conv(F, (const bf16*)(ws + WS_P1), F.in(I_CONVW), F.in(I_CONVB), (bf16*)(ws + WS_P0) + (size_t)M * D); phase_end(ldsb, bar_); }
PHASE_FN ph_lru_scan(unsigned ldsb, int bar_) { const Frame F = make_frame(ldsb); unsigned char* ws = F.ws();
    lru_scan(F, (const bf16*)(ws + WS_P1) + (size_t)4 * M * D, (const bf16*)(ws + WS_P1) + (size_t)2 * M * D, (const bf16*)(ws + WS_P0), (bf16*)(ws + WS_YB)); phase_end(ldsb, bar_); }
PHASE_FN ph_softmax(unsigned ldsb, int bar_) { const Frame F = make_frame(ldsb); unsigned char* ws = F.ws(); softmax_rows(F, (const float*)(ws + WS_SC), (bf16*)(ws + WS_PB)); phase_end(ldsb, bar_); }

PHASE_FN_G ph_gemm_kv(unsigned ldsb, int bar_) {
    const Frame F = make_frame(ldsb); unsigned char* ws = F.ws(); const int half = F.G >> 1;
    if (F.bid < half) { pg8::PlainSched<D, D, MMEM, 4 * D> S; S.gsub = half; S.coff = 0; S.init(F.lds, ws + WS_MEMN, ws + WS_WK);
        auto E = [=]() { const Frame F2 = make_frame(ldsb); unsigned char* ws = F2.ws(); return pg8::EpiBf16P{(bf16*)(ws + WS_KALL), 4 * D, 0, 0, 1.f, nullptr}; };
        pg8::gemm_phase(F.lds, F.tid, D, D, D, S, E); }
    else { pg8::PlainSched<D, D, MMEM, 4 * D> S; S.gsub = F.G - half; S.coff = half; S.init(F.lds, ws + WS_MEMN, ws + WS_WV);
        auto E = [=]() { const Frame F2 = make_frame(ldsb); unsigned char* ws = F2.ws(); return pg8::EpiBf16P{(bf16*)(ws + WS_VT), 4 * D, 0, 0, 1.f, nullptr}; };
        pg8::gemm_phase(F.lds, F.tid, D, D, D, S, E); }
    phase_end(ldsb, bar_);
}
PHASE_FN_G ph_gemm_mlin(unsigned ldsb, int bar_) {
    const Frame F = make_frame(ldsb); unsigned char* ws = F.ws();
    pg8::PlainSched<D, D, M, ML_PROJ> S; S.init(F.lds, ws + WS_HB, ws + WS_MLIN); auto E = [=]() { const Frame F2 = make_frame(ldsb); unsigned char* ws = F2.ws(); (void)ws; return pg8::EpiBf16P{(bf16*)(ws + WS_P0), ML_PROJ, 0, 0, 1.f, (const float*)(ws + WS_MISC) + MISC_SSQ / 4}; };
    pg8::gemm_phase(F.lds, F.tid, D, D, D, S, E); phase_end(ldsb, bar_);
}
PHASE_FN_G ph_gemm_qproj(unsigned ldsb, int l_, int bar_) {
    const Frame F = make_frame(ldsb); const int l = uni(l_); unsigned char* ws = F.ws();
    pg8::PlainSched<D, D, M, D> S; S.init(F.lds, ws + WS_HB, ws + WS_WQ + (size_t)l * SZ_WDD); auto E = [=]() { const Frame F2 = make_frame(ldsb); unsigned char* ws = F2.ws(); (void)ws; return pg8::EpiBf16P{(bf16*)(ws + WS_QB2), D, 0, 0, 1.f, (const float*)(ws + WS_MISC) + MISC_SSQ / 4}; };
    pg8::gemm_phase(F.lds, F.tid, D, D, D, S, E); phase_end(ldsb, bar_);
}
PHASE_FN_G ph_gemm_dn(unsigned ldsb, int l_, int f_, int bar_) {
    const Frame F = make_frame(ldsb); const int l = uni(l_), f = uni(f_) & 1; const float dsc = uni(f_) >= 2 ? 0.0f : 0.5f; unsigned char* ws = F.ws();
    pg8::PlainSched<DFF, DFF, M, D> S; S.init(F.lds, ws + WS_ACT, ws + WS_WDN + (size_t)(l * 2 + f) * SZ_WDN); auto E = [=]() { const Frame F2 = make_frame(ldsb); unsigned char* ws = F2.ws(); (void)ws; float* X = (float*)(ws + WS_X); const float* xin = (l == 0 && f == 0) ? F2.in(I_X) : X; return pg8::EpiResid{xin, X, (bf16*)(ws + WS_HB), (float*)(ws + WS_MISC) + MISC_SSQ / 4, dsc, F2.lds, F2.tid}; };
    pg8::gemm_phase(F.lds, F.tid, DFF, DFF, DFF, S, E); phase_end(ldsb, bar_);
}
enum { GR_MIXOUT = 0, GR_OPROJ, GR_PROBE0 };
PHASE_FN_G ph_gemm_resid(unsigned ldsb, int which_, int l_, int bar_) {
    const Frame F = make_frame(ldsb); const int which = uni(which_), l = uni(l_); unsigned char* ws = F.ws();
    const int kind = l % 3, idx = l / 3;
    const size_t wo = which == GR_OPROJ ? WS_WO + (size_t)l * SZ_WDD : (kind == 0 ? WS_HGOUT + (size_t)idx * SZ_WDD : (kind == 1 ? WS_LRUOUT : WS_MLOUT));
    const size_t ao = which == GR_OPROJ ? WS_OB : WS_YB; const float rs_ = which == GR_PROBE0 ? 0.0f : 1.0f;
    pg8::PlainSched<D, D, M, D> S; S.init(F.lds, ws + ao, ws + wo); auto E = [=]() { const Frame F2 = make_frame(ldsb); unsigned char* ws = F2.ws(); (void)ws; float* X = (float*)(ws + WS_X); return pg8::EpiResid{X, X, (bf16*)(ws + WS_HB), (float*)(ws + WS_MISC) + MISC_SSQ / 4, rs_, F2.lds, F2.tid}; };
    pg8::gemm_phase(F.lds, F.tid, D, D, D, S, E); phase_end(ldsb, bar_);
}
PHASE_FN_G ph_gemm_gu(unsigned ldsb, int l_, int f_, int bar_) {
    const Frame F = make_frame(ldsb); const int l = uni(l_), f = uni(f_); unsigned char* ws = F.ws();
    pg8::PlainSched<D, D, M, NGU> S; S.init(F.lds, ws + WS_HB, ws + WS_WGU + (size_t)(l * 2 + f) * SZ_WGU); auto E = [=]() { const Frame F2 = make_frame(ldsb); unsigned char* ws = F2.ws(); (void)ws; return pg8::EpiSwiGLU{(bf16*)(ws + WS_ACT), (const float*)(ws + WS_MISC) + MISC_SSQ / 4}; };
    pg8::gemm_phase(F.lds, F.tid, D, D, D, S, E);
    { constexpr int NU = (M / 256) * (NGU / 256); const int rounds = (NU + F.G - 1) / F.G, busy = NU - (rounds - 1) * F.G;
        const int nl = f ? l + 1 : l, np = f ? 0 : 1;
        if (nl < DEPTH && F.bid >= busy && busy < F.G) { Frame Fc = F; Fc.gw = (F.bid - busy) * NWAVES + F.wave; Fc.NGW = (F.G - busy) * NWAVES; int rot = 0; convert_set(Fc, rot, nl, np); } }
    phase_end(ldsb, bar_);
}
PHASE_FN_G ph_gemm_hgin(unsigned ldsb, int l_, int bar_) {
    const Frame F = make_frame(ldsb); const int l = uni(l_), idx = l / 3; unsigned char* ws = F.ws();
    pg8::PlainSched<D, D, M, 4 * D> S; S.init(F.lds, ws + WS_HB, ws + WS_HGIN + (size_t)idx * 4 * SZ_WDD);
    auto E = [=]() { const Frame F2 = make_frame(ldsb); unsigned char* ws = F2.ws(); (void)ws; return pg8::EpiHgIn{(bf16*)(ws + WS_P0), (bf16*)(ws + WS_P1), (const float*)(ws + WS_MISC) + MISC_LB / 4 + l * 2048, (const float*)(ws + WS_MISC) + MISC_SSQ / 4}; };
    pg8::gemm_phase(F.lds, F.tid, D, D, D, S, E); phase_end(ldsb, bar_);
}
PHASE_FN_G ph_gemm_lruin(unsigned ldsb, int bar_) {
    const Frame F = make_frame(ldsb); unsigned char* ws = F.ws();
    pg8::PlainSched<D, D, M, 2 * D> S; S.init(F.lds, ws + WS_HB, ws + WS_LRUIN); auto E = [=]() { const Frame F2 = make_frame(ldsb); unsigned char* ws = F2.ws(); (void)ws; return pg8::EpiLruIn{(bf16*)(ws + WS_P0), (bf16*)(ws + WS_P1), (const float*)(ws + WS_MISC) + MISC_SSQ / 4}; };
    pg8::gemm_phase(F.lds, F.tid, D, D, D, S, E); phase_end(ldsb, bar_);
}
PHASE_FN_G ph_gemm_lrugate(unsigned ldsb, int bar_) {
    const Frame F = make_frame(ldsb); unsigned char* ws = F.ws();
    bf16* UCB = (bf16*)(ws + WS_P0) + (size_t)M * D;
    pg8::PlainSched<D, 256, M, 4096, 1, 512> S; S.init(F.lds, UCB, ws + WS_LRUG);
    auto E = [=]() { const Frame F2 = make_frame(ldsb); unsigned char* ws = F2.ws(); (void)ws; bf16* P1b = (bf16*)(ws + WS_P1); return pg8::EpiLruGate{(const bf16*)(ws + WS_P0) + (size_t)M * D, F2.in(I_LRUBA), F2.in(I_LRUBX), (const float*)(ws + WS_MISC) + MISC_C8 / 4, P1b + (size_t)4 * M * D, P1b + (size_t)2 * M * D}; };
    pg8::gemm_phase(F.lds, F.tid, D, 256, 256, S, E); phase_end(ldsb, bar_);
}
PHASE_FN_G ph_gemm_scores(unsigned ldsb, int l_, int bar_) {
    const Frame F = make_frame(ldsb); const int l = uni(l_); unsigned char* ws = F.ws();
    pg8::BatchSched S; S.init(F.lds, ws + WS_QB2, ws + WS_KALL + (size_t)l * D * 2);
    S.a_b = SEQ * D * 2; S.a_h = XA_D * 2; S.a_pm = 256 * D * 2; S.b_b = NMEM * 4 * D * 2; S.b_h = XA_D * 2; S.b_pn = 0; S.nM = SEQ / 256; S.nN = 1; S.nwg = 16 * S.nM;
    auto E = [=]() { const Frame F2 = make_frame(ldsb); unsigned char* ws = F2.ws(); (void)ws; return pg8::EpiF32Z{(float*)(ws + WS_SC), 0.044194173824159216f}; };
    pg8::gemm_phase(F.lds, F.tid, D, 4 * D, XA_D, S, E);
    phase_end(ldsb, bar_);
}
PHASE_FN_G ph_gemm_pv(unsigned ldsb, int l_, int bar_) {
    const Frame F = make_frame(ldsb); const int l = uni(l_); unsigned char* ws = F.ws();
    pg8::BatchSched S; S.init(F.lds, ws + WS_PB, ws + WS_VT + (size_t)l * D * MMEM * 2);
    S.a_b = 4 * SEQ * NMEM * 2; S.a_h = SEQ * NMEM * 2; S.a_pm = 256 * NMEM * 2; S.b_b = NMEM * 2; S.b_h = XA_D * MMEM * 2; S.b_pn = 256 * MMEM * 2; S.nM = SEQ / 256; S.nN = 2; S.nwg = 16 * S.nM * 2;
    auto E = [=]() { const Frame F2 = make_frame(ldsb); unsigned char* ws = F2.ws(); (void)ws; return pg8::EpiBf16P{(bf16*)(ws + WS_OB), D, (size_t)SEQ * D, XA_D, 1.f, nullptr}; };
    pg8::gemm_phase(F.lds, F.tid, NMEM, MMEM, NMEM, S, E);
    phase_end(ldsb, bar_);
}

PHASE_FN_G ph_attn(unsigned ldsb, int l_, int bar_) {
    const Frame F = make_frame(ldsb); const int l = uni(l_); unsigned char* ws = F.ws();
    for (int u = F.bid; u < 256; u += F.G) {
        const int z = u >> 4, pm = (u >> 1) & 7, pn = u & 1, b = z >> 2, h = z & 3;
        bf16* Pc = (bf16*)(ws + (pn ? WS_SC : WS_PB)) + ((size_t)z * SEQ + pm * 256) * NMEM;
        { pg8::OneSched S; S.A = (const char*)((const bf16*)(ws + WS_QB2) + ((size_t)b * SEQ + pm * 256) * D + h * XA_D); S.B = (const char*)((const bf16*)(ws + WS_KALL) + (size_t)b * NMEM * 4 * D + (size_t)l * D + h * XA_D); S.u0 = pg8::Unit{pm, 0, z};
          auto E = [=]() { const Frame F2 = make_frame(ldsb); return pg8::EpiSoftmax{Pc, 0.044194173824159216f, F2.lds}; };
          pg8::gemm_phase(F.lds, F.tid, D, 4 * D, XA_D, S, E); }
        if (F.tid == 0) __builtin_amdgcn_fence(__ATOMIC_ACQUIRE, "agent");
        asm volatile("s_waitcnt vmcnt(0)" ::: "memory"); __syncthreads();
        { pg8::OneSched S; S.A = (const char*)Pc; S.B = (const char*)((const bf16*)(ws + WS_VT) + ((size_t)l * D + h * XA_D + pn * 256) * MMEM + b * NMEM); S.u0 = pg8::Unit{pm, pn, z};
          auto E = [=]() { const Frame F2 = make_frame(ldsb); unsigned char* ws2 = F2.ws(); return pg8::EpiBf16P{(bf16*)(ws2 + WS_OB), D, (size_t)SEQ * D, XA_D, 1.f, nullptr}; };
          pg8::gemm_phase(F.lds, F.tid, NMEM, MMEM, NMEM, S, E); }
    }
    phase_end(ldsb, bar_);
}

__device__ __forceinline__ void gtut_units(const Frame& F, const unsigned ldsb, int la, int lb, int gsub, int coff, int coff_ut) {
    unsigned char* ws = F.ws(); const int c = (F.bid >= coff && F.bid < coff + gsub) ? F.bid - coff : -1, cu = (F.bid >= coff_ut && F.bid < coff_ut + gsub) ? F.bid - coff_ut : -1;
    { pg8::GtSched S{(const char*)(ws + WS_KALL), (const char*)(ws + WS_WQ), gsub, c, la * 128, lb * 128};
      auto E = [=]() { const Frame F2 = make_frame(ldsb); unsigned char* ws2 = F2.ws(); return pg8::EpiBf16P{(bf16*)(ws2 + WS_GT), D, (size_t)4 * NMEM * D, (size_t)NMEM * D, 1.f, nullptr}; };
      pg8::gemm_phase(F.lds, F.tid, 4 * D, D, XA_D, S, E); }
    { pg8::UtSched S{(const char*)(ws + WS_WO), (const char*)(ws + WS_VT), gsub, cu, la * 128, lb * 128};
      auto E = [=]() { const Frame F2 = make_frame(ldsb); unsigned char* ws2 = F2.ws(); return pg8::EpiBf16P{(bf16*)(ws2 + WS_UT), 4 * NMEM, (size_t)D * 4 * NMEM, (size_t)NMEM, 1.f, nullptr}; };
      pg8::gemm_phase(F.lds, F.tid, D, 4 * D, XA_D, S, E); }
}
PHASE_FN_G ph_gemm_gtut(unsigned ldsb, int bar_) {
    const Frame F = make_frame(ldsb); if (F.G >= 256) gtut_units(F, ldsb, 0, 1, 128, 0, 128); else gtut_units(F, ldsb, 0, 1, F.G, 0, 0);
    phase_end(ldsb, bar_);
}
PHASE_FN_G ph_attn_scores(unsigned ldsb, int l_, int bar_) {
    const Frame F = make_frame(ldsb); const int l = uni(l_); unsigned char* ws = F.ws();
    pg8::ScSched S{(const char*)(ws + WS_HB), (const char*)(ws + WS_GT) + (size_t)l * 16 * NMEM * D * 2, F.G, F.bid};
    auto E = [=]() { const Frame F2 = make_frame(ldsb); unsigned char* ws2 = F2.ws(); return pg8::EpiSoftmax{(bf16*)(ws2 + WS_PB), 0.044194173824159216f, F2.lds, (const float*)(ws2 + WS_MISC) + MISC_SSQ / 4}; };
    pg8::gemm_phase(F.lds, F.tid, D, D, D, S, E);
    if (l + 1 < DEPTH) gtut_units(F, ldsb, l + 1, l + 2, F.G > 128 ? F.G - 128 : F.G, F.G > 128 ? 128 : 0, F.G > 128 ? 128 : 0);
    phase_end(ldsb, bar_);
}
PHASE_FN_G ph_gemm_attnout(unsigned ldsb, int l_, int bar_) {
    const Frame F = make_frame(ldsb); const int l = uni(l_); unsigned char* ws = F.ws();
    pg8::PlainSched<4 * NMEM, 4 * NMEM, M, D, 30, 0, 3, (unsigned)(D * 4 * NMEM * 2)> S; S.init(F.lds, ws + WS_PB, ws + WS_UT + (size_t)l * 4 * D * 4 * NMEM * 2);
    auto E = [=]() { const Frame F2 = make_frame(ldsb); unsigned char* ws2 = F2.ws(); float* X = (float*)(ws2 + WS_X); return pg8::EpiResid{X, X, (bf16*)(ws2 + WS_HB), (float*)(ws2 + WS_MISC) + MISC_SSQ / 4, 1.0f, F2.lds, F2.tid}; };
    pg8::gemm_phase(F.lds, F.tid, 4 * NMEM, 4 * NMEM, 4 * NMEM, S, E);
    phase_end(ldsb, bar_);
}

constexpr int SLOTS = 20, PH_LAYER0 = 3, PH_FINAL = PH_LAYER0 + DEPTH * SLOTS, N_PHASES = PH_FINAL + 1;
enum { SL_NORM0 = 0, SL_GU1, SL_DN1, SL_NORM1, SL_MIXIN, SL_MIXA, SL_MIXB, SL_MIXC, SL_MIXD, SL_MIXOUT, SL_NORM2, SL_QPROJ, SL_SCORES, SL_SOFTMAX, SL_PV, SL_OPROJ, SL_NORM3, SL_GU2, SL_DN2, SL_SPARE };
__host__ __device__ constexpr bool phase_used(int ph) {
    if (ph < PH_LAYER0 || ph == PH_FINAL) return true;
    const int l = (ph - PH_LAYER0) / SLOTS, s = (ph - PH_LAYER0) % SLOTS, kind = l % 3;
    if (s == SL_SPARE || s == SL_QPROJ || s == SL_SOFTMAX || s == SL_PV || s == SL_NORM0 || s == SL_NORM1 || s == SL_NORM2 || s == SL_NORM3) return false;
    if (s == SL_MIXC) return true;
    if (s == SL_MIXD) return kind == 2;
    return true;
}
__device__ __forceinline__ int ctl_lo(unsigned ldsb) { return __builtin_amdgcn_readfirstlane(*(volatile LAS int*)((LAS unsigned char*)(size_t)ldsb + CTRL + 56)); }
__device__ __forceinline__ int ctl_hi(unsigned ldsb) { return __builtin_amdgcn_readfirstlane(*(volatile LAS int*)((LAS unsigned char*)(size_t)ldsb + CTRL + 60)); }
#ifndef PROBE_SEL
#define PROBE_SEL -1
#endif
#if PROBE_SEL >= 0
#ifndef PROBE_AMP
#define PROBE_AMP 4
#endif
__host__ __device__ constexpr int probe_cls(int k) { if (k < PH_LAYER0) return PROBE_SEL >= 20 ? 20 + k : 0; if (k >= PH_FINAL) return 8; const int s = (k - PH_LAYER0) % SLOTS;
    { const int l = (k - PH_LAYER0) / SLOTS, kind = l % 3;
      if (PROBE_SEL >= 10) { if (kind == 0 && s == SL_MIXA) return 10; if (kind == 0 && s == SL_MIXB) return 16; if (kind == 1 && s == SL_MIXA) return 11; if (kind == 1 && s == SL_MIXB) return 12; if (kind == 1 && s == SL_MIXC) return 13;
          if (kind == 2 && s == SL_MIXA) return 14; if (kind == 2 && s == SL_MIXB) return 15; if (kind == 2 && s == SL_MIXC) return 17; if (kind == 2 && s == SL_MIXD) return 18; if (kind == 0 && s == SL_MIXC) return 19; return 99; } }
    return (s == SL_GU1 || s == SL_GU2) ? 1 : (s == SL_DN1 || s == SL_DN2) ? 2 : s == SL_MIXIN ? 3 : (s == SL_MIXA || s == SL_MIXB || s == SL_MIXC || s == SL_MIXD) ? 4 : s == SL_MIXOUT ? 5 : s == SL_SCORES ? 6 : 7; }
__device__ __forceinline__ void probe_t0(unsigned ldsb) { const Frame F = make_frame(ldsb); if (F.tid == 0) *(volatile LAS unsigned long long*)(F.lds + CTRL + 320) = __builtin_amdgcn_s_memrealtime(); }
__device__ __forceinline__ void probe_t1(unsigned ldsb, int cls) { const Frame F = make_frame(ldsb); if (F.tid == 0 && cls == PROBE_SEL) { const unsigned long long t1 = __builtin_amdgcn_s_memrealtime(), t0 = *(volatile LAS unsigned long long*)(F.lds + CTRL + 320);
        *(volatile LAS unsigned*)(F.lds + CTRL + 328) = *(volatile LAS unsigned*)(F.lds + CTRL + 328) + (unsigned)(t1 - t0); } }
#define RUN(k, fn, ...) do { const int hi_ = ctl_hi(ldsb); if (ctl_lo(ldsb) <= (k) && (k) < hi_) { probe_t0(ldsb); fn(ldsb, ##__VA_ARGS__, ((k) + 1 < hi_) ? 1 : 0); probe_t1(ldsb, probe_cls(k)); } } while (0)
#else
#define RUN(k, fn, ...) do { const int hi_ = ctl_hi(ldsb); if (ctl_lo(ldsb) <= (k) && (k) < hi_) fn(ldsb, ##__VA_ARGS__, ((k) + 1 < hi_) ? 1 : 0); } while (0)
#endif

template <int L> __device__ __forceinline__ void run_layer(const unsigned ldsb) {
    constexpr int pb = PH_LAYER0 + L * SLOTS, kind = L % 3;
    RUN(pb + SL_GU1, ph_gemm_gu, L, 0);
    RUN(pb + SL_DN1, ph_gemm_dn, L, 0);
    if constexpr (kind == 0) {
        RUN(pb + SL_MIXIN, ph_gemm_hgin, L);
        RUN(pb + SL_MIXA, ph_hg_prep);
        RUN(pb + SL_MIXB, ph_hg_recur, L);
        RUN(pb + SL_MIXC, ph_hg_norm, L / 3);
    } else if constexpr (kind == 1) {
        RUN(pb + SL_MIXIN, ph_gemm_lruin);
        RUN(pb + SL_MIXA, ph_lru_conv);
        RUN(pb + SL_MIXB, ph_gemm_lrugate);
        RUN(pb + SL_MIXC, ph_lru_scan);
    } else {
        RUN(pb + SL_MIXIN, ph_gemm_mlin);
        RUN(pb + SL_MIXA, ph_ml_gates);
        RUN(pb + SL_MIXB, ph_ml_prep);
        RUN(pb + SL_MIXC, ph_ml_recur, L);
        RUN(pb + SL_MIXD, ph_ml_norm);
    }
    RUN(pb + SL_MIXOUT, ph_gemm_resid, GR_MIXOUT, L);
    RUN(pb + SL_SCORES, ph_attn_scores, L);
    RUN(pb + SL_OPROJ, ph_gemm_attnout, L);
    RUN(pb + SL_GU2, ph_gemm_gu, L, 1);
    RUN(pb + SL_DN2, ph_gemm_dn, L, 1);
}

__global__ void __launch_bounds__(NT, 2) fwd_kernel(Args args) {
    extern __shared__ __attribute__((aligned(16))) unsigned char lds_raw[];
    LAS unsigned char* lds = (LAS unsigned char*)lds_raw;
    const unsigned ldsb = (unsigned)(size_t)lds;
    {
        const int tid = threadIdx.x, lane = tid & 63, wave = tid >> 6;
        LAS unsigned* cw = (LAS unsigned*)(lds + CTRL);
        if (tid < 4) cw[tid] = 0u;
        if (tid == 0) cw[82] = 0u;
        if (lane == 0) cw[4 + wave] = hw_wave_key();
        if (tid == 0) { cw[12] = blockIdx.x; cw[13] = gridDim.x; cw[14] = (unsigned)args.ph_lo; cw[15] = (unsigned)args.ph_hi;
            LAS unsigned long long* ap = (LAS unsigned long long*)(lds + CTRL + 64);
#pragma unroll
            for (int i = 0; i < 27; ++i) ap[i] = (unsigned long long)args.in[i];
            ap[27] = (unsigned long long)args.out; ap[28] = (unsigned long long)args.ws; }
        __syncthreads();
        if (args.ph_hi - args.ph_lo > 1 && tid == 0) (void)xb_add(&((unsigned*)(args.ws + WS_CTL))[XB_XCNT(xb_xcc_id())], 1u);
    }
    RUN(0, ph_prologue);
    RUN(1, ph_gemm_kv);
    RUN(2, ph_gemm_gtut);
    run_layer<0>(ldsb); run_layer<1>(ldsb); run_layer<2>(ldsb); run_layer<3>(ldsb);
    { if (ctl_lo(ldsb) <= PH_FINAL && PH_FINAL < ctl_hi(ldsb)) ph_final(ldsb); }
#if PROBE_SEL >= 0
    { const Frame F = make_frame(ldsb); if (F.bid == 0) { __syncthreads(); const unsigned acc = *(volatile LAS unsigned*)(F.lds + CTRL + 328);
        const unsigned long long tend = __builtin_amdgcn_s_memrealtime() + (unsigned long long)acc * PROBE_AMP; while (__builtin_amdgcn_s_memrealtime() < tend) __builtin_amdgcn_s_sleep(8); } }
#endif
}

extern "C" void kernel_launch(void* const* d_in, const int* in_sizes, int n_in, void* d_out, int out_size, void* d_ws, size_t ws_size, hipStream_t stream) {
    static int grid = 0;
    if (grid == 0) {
        if (n_in != 27 || in_sizes[0] != M * D || out_size != M * D || ws_size < WS_END) { fprintf(stderr, "kernel_launch: unexpected shapes (n_in %d, in0 %d, out %d, ws %zu < %zu)\n", n_in, n_in > 0 ? in_sizes[0] : -1, out_size, ws_size, (size_t)WS_END); grid = -1; return; }
        int dev = 0, cus = 0, per_cu = 0;
        if (hipGetDevice(&dev) != hipSuccess || hipDeviceGetAttribute(&cus, hipDeviceAttributeMultiprocessorCount, dev) != hipSuccess) { grid = -1; return; }
        if (hipFuncSetAttribute((const void*)fwd_kernel, hipFuncAttributeMaxDynamicSharedMemorySize, LDS_BYTES) != hipSuccess) { fprintf(stderr, "kernel_launch: hipFuncSetAttribute failed\n"); grid = -1; return; }
        if (hipOccupancyMaxActiveBlocksPerMultiprocessor(&per_cu, (const void*)fwd_kernel, NT, LDS_BYTES) != hipSuccess || per_cu < 1) fprintf(stderr, "kernel_launch: occupancy query reports %d\n", per_cu);
        (void)hipGetLastError();
        grid = cus;
    }
    if (grid < 0) return;
    if (hipMemsetAsync((char*)d_ws + WS_CTL, 0, CTL_BYTES, stream) != hipSuccess) { fprintf(stderr, "kernel_launch: memset failed\n"); return; }
    Args a{};
    for (int i = 0; i < 27; ++i) a.in[i] = (const float*)d_in[i];
    a.out = (float*)d_out; a.ws = (unsigned char*)d_ws;
#if MK_ONE_LAUNCH
    a.ph_lo = 0; a.ph_hi = N_PHASES;
    hipLaunchKernelGGL(fwd_kernel, dim3(grid), dim3(NT), LDS_BYTES, stream, a);
#else
    for (int ph = 0; ph < N_PHASES; ++ph) { if (!phase_used(ph)) continue; a.ph_lo = ph; a.ph_hi = ph + 1;
        hipLaunchKernelGGL(fwd_kernel, dim3(grid), dim3(NT), LDS_BYTES, stream, a);
        const hipError_t le = hipPeekAtLastError(); if (le != hipSuccess) { fprintf(stderr, "kernel_launch: launch of phase %d failed: %s\n", ph, hipGetErrorName(le)); break; } }
#endif
}
```

```cpp
#include <hip/hip_runtime.h>
#include <cstdio>
#include <cstdint>

#ifndef X_F32
#define X_F32 0
#endif
#ifndef MK_ONE_LAUNCH
#define MK_ONE_LAUNCH 1
#define FUSE_TAIL 0
#ifndef FUSE_TAIL
#define FUSE_TAIL 1
#endif
#endif

#define LAS __attribute__((address_space(3)))
typedef unsigned short bf16;
typedef short bf16x8 __attribute__((ext_vector_type(8)));
typedef float f32x4 __attribute__((ext_vector_type(4)));
typedef float f32x2 __attribute__((ext_vector_type(2)));
typedef unsigned u32x4 __attribute__((ext_vector_type(4)));
typedef unsigned u32x2 __attribute__((ext_vector_type(2)));
#define GAS __attribute__((address_space(1)))

constexpr int BATCH = 4, SEQ = 2048, D = 2048, DEPTH = 4, M = BATCH * SEQ;
constexpr int NMEM = 256, MMEM = BATCH * NMEM;
constexpr int DFF = 5504, NGU = 2 * DFF;
constexpr int HG_H = 16, HG_D = 128;
constexpr int ML_H = 8, ML_DQK = 128, ML_DV = 256, ML_IN = 6160, ML_PROJ = 6144;
constexpr int XA_H = 4, XA_D = 512;
constexpr float EPS = 1e-6f;
constexpr int LDS_BYTES = 147456;
constexpr int CTRL = LDS_BYTES - 512;

__device__ __forceinline__ unsigned pk2(float lo, float hi) { unsigned r; asm volatile("v_cvt_pk_bf16_f32 %0, %1, %2" : "=v"(r) : "v"(lo), "v"(hi)); return r; }
__device__ __forceinline__ float bflo(unsigned w) { return __uint_as_float(w << 16); }
__device__ __forceinline__ float bfhi(unsigned w) { return __uint_as_float(w & 0xffff0000u); }
__device__ __forceinline__ float sigmoidf_(float x) { return __builtin_amdgcn_rcpf(1.0f + __expf(-x)); }
__device__ __forceinline__ float siluf_(float x) { return x * sigmoidf_(x); }
__device__ __forceinline__ float gelu_tanh_(float x) { const float u = 0.7978845608028654f * (x + 0.044715f * x * x * x); const float t = 1.0f - 2.0f * __builtin_amdgcn_rcpf(__expf(2.0f * u) + 1.0f); return 0.5f * x * (1.0f + t); }
__device__ __forceinline__ float wave_sum(float v) {
#pragma unroll
    for (int o = 1; o < 64; o <<= 1) v += __shfl_xor(v, o);
    return v;
}
__device__ __forceinline__ float wave_max(float v) {
#pragma unroll
    for (int o = 1; o < 64; o <<= 1) v = fmaxf(v, __shfl_xor(v, o));
    return v;
}

__device__ __forceinline__ int lds_ld_i32(LAS unsigned char* p) { return __builtin_amdgcn_readfirstlane(*(volatile LAS int*)p); }
__device__ __forceinline__ const char* lds_ld_ptr(LAS unsigned char* p) { const unsigned lo = __builtin_amdgcn_readfirstlane(*(volatile LAS unsigned*)p), hi = __builtin_amdgcn_readfirstlane(*(volatile LAS unsigned*)(p + 4)); return (const char*)(((unsigned long long)hi << 32) | lo); }

namespace pg8 {
constexpr int BM = 256, BK = 64, HALF = 128, HTB = HALF * BK * 2, STAGE_BYTES = 8 * HTB, NXCD = 8, WGM = 8;
__host__ __device__ __forceinline__ int lds_byte(int r, int c) { const int st = (r >> 4) * 2 + (c >> 5), rr = r & 15, cc = c & 31, ob = rr * 64 + cc * 2; return st * 1024 + (ob ^ (((ob >> 9) & 1) << 5)); }
__host__ __device__ __forceinline__ void stage_rc(int b, int& R, int& C) { const int st = b / 1024, sb = b % 1024, swz = sb ^ (((sb >> 9) & 1) << 5); R = (st >> 1) * 16 + swz / 64; C = (st & 1) * 32 + (swz % 64) / 2; }
__host__ __device__ __forceinline__ int perm32(int rho) { const int n = rho >> 4, i = rho & 15; return 8 * (i >> 2) + 4 * n + (i & 3); }

struct Unit { int pm, pn, z; };

template <int LDA, int LDB, int MROWS, int NCOLS, int ZSHIFT = 30, int AZ = 0, int BPMSHIFT = 30, unsigned BPMSTRIDE = 0>
struct PlainSched {
    static constexpr int nM = MROWS / BM, nN = NCOLS / BM, nwg = nM * nN; static constexpr unsigned a_tile = BM * LDA * 2, b_tile = BM * LDB * 2;
    LAS unsigned char* lds; int gsub = 0, coff = 0;
    __device__ void init(LAS unsigned char* lds_, const void* A_, const void* B_) { lds = lds_;
        *(volatile LAS unsigned long long*)(lds + CTRL + 304) = (unsigned long long)A_; *(volatile LAS unsigned long long*)(lds + CTRL + 312) = (unsigned long long)B_; __syncthreads(); }
    __device__ bool next(int i, Unit& u) const {
        const int G = gsub > 0 ? gsub : lds_ld_i32(lds + CTRL + 52), c = lds_ld_i32(lds + CTRL + 48) - coff;
        const int L = i * G + c; if (L >= nwg) return false;
        int wgid = L; { constexpr int q = nwg / NXCD, r = nwg % NXCD; const int xcd = wgid % NXCD, off = wgid / NXCD; wgid = (xcd < r ? xcd * (q + 1) : r * (q + 1) + (xcd - r) * q) + off; }
        constexpr int nig = WGM * nN; const int gid = wgid / nig, fm = gid * WGM, gsz = (nM - fm) < WGM ? (nM - fm) : WGM;
        u.pm = fm + ((wgid % nig) % gsz); u.pn = (wgid % nig) / gsz; u.z = u.pn >> ZSHIFT; return true;
    }
    __device__ __forceinline__ const char* a_ptr(const Unit& u) const { return lds_ld_ptr(lds + CTRL + 304) + (size_t)((unsigned)u.pm * a_tile) + (size_t)((unsigned)u.z * (unsigned)AZ); }
    __device__ __forceinline__ const char* b_ptr(const Unit& u) const { return lds_ld_ptr(lds + CTRL + 312) + (size_t)((unsigned)u.pn * b_tile) + (size_t)((unsigned)(u.pm >> BPMSHIFT) * BPMSTRIDE); }
};
struct BatchSched {
    LAS unsigned char* lds; unsigned a_b, a_h, a_pm, b_b, b_h, b_pn; int nM, nN, nwg;
    __device__ void init(LAS unsigned char* lds_, const void* A_, const void* B_) { lds = lds_;
        *(volatile LAS unsigned long long*)(lds + CTRL + 304) = (unsigned long long)A_; *(volatile LAS unsigned long long*)(lds + CTRL + 312) = (unsigned long long)B_; __syncthreads(); }
    __device__ bool next(int i, Unit& u) const {
        const int G = lds_ld_i32(lds + CTRL + 52), c = lds_ld_i32(lds + CTRL + 48);
        const int L = i * G + c; if (L >= nwg) return false;
        const int per = nM * nN, z = L / per, r = L % per; u.pm = r % nM; u.pn = r / nM; u.z = z;
        return true;
    }
    __device__ __forceinline__ const char* a_ptr(const Unit& u) const { return lds_ld_ptr(lds + CTRL + 304) + (size_t)((unsigned)(u.z >> 2) * a_b) + (size_t)((unsigned)(u.z & 3) * a_h) + (size_t)((unsigned)u.pm * a_pm); }
    __device__ __forceinline__ const char* b_ptr(const Unit& u) const { return lds_ld_ptr(lds + CTRL + 312) + (size_t)((unsigned)(u.z >> 2) * b_b) + (size_t)((unsigned)(u.z & 3) * b_h) + (size_t)((unsigned)u.pn * b_pn); }
};

typedef f32x4 Acc[2][2][4][2];

__device__ __forceinline__ void load_rstd(const float* SSQ, int row0, float (&rs)[2][4]) {
#pragma unroll
    for (int ai = 0; ai < 2; ++ai)
#pragma unroll
        for (int m = 0; m < 4; ++m) { const float* p = SSQ + (size_t)(row0 + ai * HALF + m * 16) * 8; const f32x4 a = *(const f32x4*)p, b = *(const f32x4*)(p + 4);
            rs[ai][m] = 1.0f / sqrtf((((a[0] + a[1]) + (a[2] + a[3])) + ((b[0] + b[1]) + (b[2] + b[3]))) * (1.0f / D) + EPS); }
}
struct EpiBf16P {
    static constexpr bool PERM = true;
    bf16* O; int ldc; size_t zb, zh; float scale; const float* SSQ; int cgrp = 0; size_t cgs = 0;
    __device__ __forceinline__ void operator()(const Acc& acc, const Unit& u, int wr, int wc, int fr, int fq) const {
        bf16* base = O + (size_t)(u.z >> 2) * zb + (size_t)(u.z & 3) * zh; int pnl = u.pn;
        if (cgrp > 0) { base += (size_t)(u.pn / cgrp) * cgs; pnl = u.pn % cgrp; }
        const int row0 = u.pm * BM + wr * 64 + fr, col0 = pnl * BM + wc * 32 + 8 * fq;
        float rs[2][4];
        if (SSQ) load_rstd(SSQ, row0, rs); else {
#pragma unroll
            for (int ai = 0; ai < 2; ++ai)
#pragma unroll
                for (int m = 0; m < 4; ++m) rs[ai][m] = 1.0f; }
#pragma unroll
        for (int ai = 0; ai < 2; ++ai)
#pragma unroll
            for (int m = 0; m < 4; ++m) { bf16* rowp = base + (size_t)(row0 + ai * HALF + m * 16) * ldc + col0; const float sc = scale * rs[ai][m];
#pragma unroll
                for (int bj = 0; bj < 2; ++bj) { const f32x4 v0 = acc[ai][bj][m][0] * sc, v1 = acc[ai][bj][m][1] * sc;
                    u32x4 w; w.x = pk2(v0[0], v0[1]); w.y = pk2(v0[2], v0[3]); w.z = pk2(v1[0], v1[1]); w.w = pk2(v1[2], v1[3]);
                    *(u32x4*)(rowp + bj * HALF) = w; } }
    }
};
struct EpiMlIn {
    static constexpr bool PERM = true;
    bf16* PB; float* GATES; const float* SSQ;
    __device__ __forceinline__ void operator()(const Acc& acc, const Unit& u, int wr, int wc, int fr, int fq) const {
        const int row0 = u.pm * BM + wr * 64 + fr, col0 = u.pn * BM + wc * 32 + 8 * fq;
        float rs[2][4]; load_rstd(SSQ, row0, rs);
        if (u.pn < 24) {
#pragma unroll
            for (int ai = 0; ai < 2; ++ai)
#pragma unroll
                for (int m = 0; m < 4; ++m) { bf16* rowp = PB + (size_t)(row0 + ai * HALF + m * 16) * ML_PROJ + col0; const float sc = rs[ai][m];
#pragma unroll
                    for (int bj = 0; bj < 2; ++bj) { const f32x4 v0 = acc[ai][bj][m][0] * sc, v1 = acc[ai][bj][m][1] * sc;
                        u32x4 w; w.x = pk2(v0[0], v0[1]); w.y = pk2(v0[2], v0[3]); w.z = pk2(v1[0], v1[1]); w.w = pk2(v1[2], v1[3]);
                        *(u32x4*)(rowp + bj * HALF) = w; } }
        } else if (wc == 0 && fq < 2) {
#pragma unroll
            for (int ai = 0; ai < 2; ++ai)
#pragma unroll
                for (int m = 0; m < 4; ++m) { float* gp = GATES + (size_t)(row0 + ai * HALF + m * 16) * 16 + 8 * fq; const float sc = rs[ai][m];
                    *(f32x4*)gp = acc[ai][0][m][0] * sc; *(f32x4*)(gp + 4) = acc[ai][0][m][1] * sc; }
        }
    }
};
struct EpiSwiGLU {
    static constexpr bool PERM = true;
    bf16* O; const float* SSQ;
    __device__ __forceinline__ void operator()(const Acc& acc, const Unit& u, int wr, int wc, int fr, int fq) const {
        const int row0 = u.pm * BM + wr * 64 + fr, col0 = u.pn * HALF + wc * 32 + 8 * fq;
        float rs[2][4]; load_rstd(SSQ, row0, rs);
#pragma unroll
        for (int ai = 0; ai < 2; ++ai)
#pragma unroll
            for (int m = 0; m < 4; ++m) { bf16* p = O + (size_t)(row0 + ai * HALF + m * 16) * DFF + col0; const float sc = rs[ai][m];
                const f32x4 g0 = acc[ai][0][m][0] * sc, g1 = acc[ai][0][m][1] * sc, u0 = acc[ai][1][m][0] * sc, u1 = acc[ai][1][m][1] * sc;
                u32x4 w; w.x = pk2(siluf_(g0[0]) * u0[0], siluf_(g0[1]) * u0[1]); w.y = pk2(siluf_(g0[2]) * u0[2], siluf_(g0[3]) * u0[3]);
                w.z = pk2(siluf_(g1[0]) * u1[0], siluf_(g1[1]) * u1[1]); w.w = pk2(siluf_(g1[2]) * u1[2], siluf_(g1[3]) * u1[3]);
                *(u32x4*)p = w; }
    }
};
template <bool XF32> struct EpiResidT {
    static constexpr bool PERM = true;
    const float* Xin; float* Xout; bf16* XB; float* SSQ; float scale; LAS unsigned char* lds; int tid;
    __device__ __forceinline__ void operator()(const Acc& acc, const Unit& u, int wr, int wc, int fr, int fq) const {
        typedef __attribute__((address_space(1))) const f32x4 gcf4; typedef __attribute__((address_space(1))) f32x4 gf4; typedef __attribute__((address_space(1))) u32x4 gu4;
        typedef __attribute__((address_space(1))) const float gcf; typedef __attribute__((address_space(1))) float gf; typedef __attribute__((address_space(1))) bf16 gb;
        gcf* xin = (gcf*)Xin; gf* xout = (gf*)Xout; gb* xb = (gb*)XB;
        const int row0 = u.pm * BM + wr * 64 + fr, col0 = u.pn * BM + wc * 32 + 8 * fq;
        LAS float* red = (LAS float*)(lds + STAGE_BYTES);
#pragma unroll
        for (int ai = 0; ai < 2; ++ai)
#pragma unroll
            for (int m = 0; m < 4; ++m) { const unsigned off = (unsigned)(row0 + ai * HALF + m * 16) * (unsigned)D + (unsigned)col0; float ss = 0.f;
#pragma unroll
                for (int bj = 0; bj < 2; ++bj) { const unsigned o = off + bj * HALF; f32x4 x0, x1;
                    if constexpr (XF32) { x0 = *(gcf4*)(xin + o); x1 = *(gcf4*)(xin + o + 4); }
                    else { const u32x4 w = *(const gu4*)(xb + o); x0 = (f32x4){bflo(w.x), bfhi(w.x), bflo(w.y), bfhi(w.y)}; x1 = (f32x4){bflo(w.z), bfhi(w.z), bflo(w.w), bfhi(w.w)}; }
                    x0 += acc[ai][bj][m][0] * scale; x1 += acc[ai][bj][m][1] * scale;
                    if constexpr (XF32) { *(gf4*)(xout + o) = x0; *(gf4*)(xout + o + 4) = x1; }
                    u32x4 w; w.x = pk2(x0[0], x0[1]); w.y = pk2(x0[2], x0[3]); w.z = pk2(x1[0], x1[1]); w.w = pk2(x1[2], x1[3]); *(gu4*)(xb + o) = w;
                    ss += ((x0[0] * x0[0] + x0[1] * x0[1]) + (x0[2] * x0[2] + x0[3] * x0[3])) + ((x1[0] * x1[0] + x1[1] * x1[1]) + (x1[2] * x1[2] + x1[3] * x1[3]));
                    asm volatile("" ::: "memory"); }
                ss += __shfl_xor(ss, 16); ss += __shfl_xor(ss, 32);
                if (fq == 0) red[(ai * HALF + wr * 64 + m * 16 + fr) * 4 + wc] = ss; }
        asm volatile("s_waitcnt lgkmcnt(0)" ::: "memory"); __builtin_amdgcn_s_barrier(); asm volatile("" ::: "memory");
        if (tid < 256) { const f32x4 r = *(const LAS f32x4*)(red + tid * 4); SSQ[(size_t)(u.pm * BM + tid) * 8 + u.pn] = (r[0] + r[1]) + (r[2] + r[3]); }
        asm volatile("s_waitcnt lgkmcnt(0)" ::: "memory"); __builtin_amdgcn_s_barrier(); asm volatile("" ::: "memory");
    }
};
typedef EpiResidT<(X_F32 != 0)> EpiResid;
struct EpiHgIn {
    static constexpr bool PERM = true;
    bf16* P0; bf16* LF; const float* lb; const float* SSQ;
    __device__ __forceinline__ void operator()(const Acc& acc, const Unit& u, int wr, int wc, int fr, int fq) const {
        const int grp = u.pn >> 3; const int row0 = u.pm * BM + wr * 64 + fr, col0 = (u.pn & 7) * BM + wc * 32 + 8 * fq;
        float rs[2][4]; load_rstd(SSQ, row0, rs);
        if (grp == 1) {
#pragma unroll
            for (int bj = 0; bj < 2; ++bj) {
                const f32x4 l0 = *(const f32x4*)(lb + col0 + bj * HALF), l1 = *(const f32x4*)(lb + col0 + bj * HALF + 4);
                const float lbv[8] = {l0[0], l0[1], l0[2], l0[3], l1[0], l1[1], l1[2], l1[3]};
#pragma unroll
                for (int ai = 0; ai < 2; ++ai)
#pragma unroll
                    for (int m = 0; m < 4; ++m) { const size_t o = (size_t)(row0 + ai * HALF + m * 16) * D + col0 + bj * HALF;
                        const f32x4 v0 = acc[ai][bj][m][0] * rs[ai][m], v1 = acc[ai][bj][m][1] * rs[ai][m];
                        const float a[8] = {v0[0], v0[1], v0[2], v0[3], v1[0], v1[1], v1[2], v1[3]};
                        float lf[8];
#pragma unroll
                        for (int j = 0; j < 8; ++j) { const float e = __expf(-a[j]); const float sg = __builtin_amdgcn_rcpf(1.0f + e); const float om = 1.0f - lbv[j];
                            const float f = lbv[j] + om * sg; lf[j] = __logf(fmaxf(f, 1e-12f)); }
                        { u32x4 w; w.x = pk2(lf[0], lf[1]); w.y = pk2(lf[2], lf[3]); w.z = pk2(lf[4], lf[5]); w.w = pk2(lf[6], lf[7]); *(u32x4*)(LF + o) = w; }
                        asm volatile("" ::: "memory"); }
            }
        } else {
            bf16* dst = P0 + (size_t)grp * M * D;
#pragma unroll
            for (int ai = 0; ai < 2; ++ai)
#pragma unroll
                for (int m = 0; m < 4; ++m) { const size_t ro = (size_t)(row0 + ai * HALF + m * 16) * D + col0;
#pragma unroll
                    for (int bj = 0; bj < 2; ++bj) { const f32x4 v0 = acc[ai][bj][m][0] * rs[ai][m], v1 = acc[ai][bj][m][1] * rs[ai][m];
                        float a[8] = {v0[0], v0[1], v0[2], v0[3], v1[0], v1[1], v1[2], v1[3]};
                        if (grp != 2) {
#pragma unroll
                            for (int j = 0; j < 8; ++j) a[j] = siluf_(a[j]); }
                        u32x4 w; w.x = pk2(a[0], a[1]); w.y = pk2(a[2], a[3]); w.z = pk2(a[4], a[5]); w.w = pk2(a[6], a[7]);
                        *(u32x4*)(dst + ro + bj * HALF) = w; }
                    asm volatile("" ::: "memory"); }
        }
    }
};
struct EpiLruIn {
    static constexpr bool PERM = true;
    bf16* GBR; bf16* UR; const float* SSQ;
    __device__ __forceinline__ void operator()(const Acc& acc, const Unit& u, int wr, int wc, int fr, int fq) const {
        const int grp = u.pn >> 3; const int row0 = u.pm * BM + wr * 64 + fr, col0 = (u.pn & 7) * BM + wc * 32 + 8 * fq;
        float rs[2][4]; load_rstd(SSQ, row0, rs);
#pragma unroll
        for (int ai = 0; ai < 2; ++ai)
#pragma unroll
            for (int m = 0; m < 4; ++m) { const size_t ro = (size_t)(row0 + ai * HALF + m * 16) * D + col0;
#pragma unroll
                for (int bj = 0; bj < 2; ++bj) { const f32x4 v0 = acc[ai][bj][m][0] * rs[ai][m], v1 = acc[ai][bj][m][1] * rs[ai][m]; const size_t o = ro + bj * HALF;
                    if (grp == 0) { u32x4 w; w.x = pk2(gelu_tanh_(v0[0]), gelu_tanh_(v0[1])); w.y = pk2(gelu_tanh_(v0[2]), gelu_tanh_(v0[3])); w.z = pk2(gelu_tanh_(v1[0]), gelu_tanh_(v1[1])); w.w = pk2(gelu_tanh_(v1[2]), gelu_tanh_(v1[3]));
                        *(u32x4*)(GBR + o) = w; }
                    else { u32x4 w; w.x = pk2(v0[0], v0[1]); w.y = pk2(v0[2], v0[3]); w.z = pk2(v1[0], v1[1]); w.w = pk2(v1[2], v1[3]); *(u32x4*)(UR + o) = w; } } }
    }
};
struct EpiLruGate {
    static constexpr bool PERM = true;
    const bf16* UC; const float* ba; const float* bx; const float* c8; bf16* LA; bf16* INP;
    __device__ __forceinline__ void operator()(const Acc& acc, const Unit& u, int wr, int wc, int fr, int fq) const {
        const int row0 = u.pm * BM + wr * 64 + fr, ch = u.z * 256 + (u.pn & 1) * HALF + wc * 32 + 8 * fq;
        const f32x4 vba[2] = {*(const f32x4*)(ba + ch), *(const f32x4*)(ba + ch + 4)}, vbx[2] = {*(const f32x4*)(bx + ch), *(const f32x4*)(bx + ch + 4)}, vc8[2] = {*(const f32x4*)(c8 + ch), *(const f32x4*)(c8 + ch + 4)};
#pragma unroll
        for (int ai = 0; ai < 2; ++ai)
#pragma unroll
            for (int m = 0; m < 4; ++m) { const size_t o = (size_t)(row0 + ai * HALF + m * 16) * D + ch;
                const u32x4 uw = *(const u32x4*)(UC + o); const float uu[8] = {bflo(uw.x), bfhi(uw.x), bflo(uw.y), bfhi(uw.y), bflo(uw.z), bfhi(uw.z), bflo(uw.w), bfhi(uw.w)};
                float av[8], iv[8];
#pragma unroll
                for (int n = 0; n < 2; ++n) { const f32x4 pa = acc[ai][0][m][n] + vba[n], px = acc[ai][1][m][n] + vbx[n];
#pragma unroll
                    for (int j = 0; j < 4; ++j) { const float r = sigmoidf_(pa[j]), ig = sigmoidf_(px[j]); const float la = -vc8[n][j] * r;
                        const float x2 = -2.0f * la;
                        const float om = x2 < 0.02f ? x2 * (1.0f - 0.5f * x2 + x2 * x2 * 0.16666667f) : 1.0f - __expf(-x2);
                        const float mult = __builtin_amdgcn_sqrtf(fmaxf(om, 0.0f)); av[4 * n + j] = la; iv[4 * n + j] = mult * (ig * uu[4 * n + j]); } }
                { u32x4 wa, wi; wa.x = pk2(av[0], av[1]); wa.y = pk2(av[2], av[3]); wa.z = pk2(av[4], av[5]); wa.w = pk2(av[6], av[7]);
                    wi.x = pk2(iv[0], iv[1]); wi.y = pk2(iv[2], iv[3]); wi.z = pk2(iv[4], iv[5]); wi.w = pk2(iv[6], iv[7]); *(u32x4*)(LA + o) = wa; *(u32x4*)(INP + o) = wi; } asm volatile("" ::: "memory"); }
    }
};
struct EpiF32Z {
    static constexpr bool PERM = false;
    float* S; float scale;
    __device__ __forceinline__ void operator()(const Acc& acc, const Unit& u, int wr, int wc, int fr, int fq) const {
        float* base = S + (size_t)u.z * SEQ * NMEM; const int row0 = u.pm * BM + wr * 64 + fr, col0 = wc * 32 + 4 * fq;
#pragma unroll
        for (int ai = 0; ai < 2; ++ai)
#pragma unroll
            for (int m = 0; m < 4; ++m) { float* rowp = base + (size_t)(row0 + ai * HALF + m * 16) * NMEM + col0;
#pragma unroll
                for (int bj = 0; bj < 2; ++bj)
#pragma unroll
                    for (int n = 0; n < 2; ++n) *(f32x4*)(rowp + bj * HALF + n * 16) = acc[ai][bj][m][n] * scale; }
    }
};

struct GtSched { const char* Kall; const char* Wq; int G, c, L0, L1;
    __device__ bool next(int i, Unit& u) const { const int L = L0 + i * G + c; if (c < 0 || L >= L1) return false; u.pm = 0; u.pn = L & 7; u.z = L >> 3; return true; }
    __device__ __forceinline__ const char* a_ptr(const Unit& u) const { const int l = u.z >> 4, b = (u.z >> 2) & 3, h = u.z & 3; return Kall + ((size_t)b * NMEM * 4 * D + (size_t)l * D + h * XA_D) * 2; }
    __device__ __forceinline__ const char* b_ptr(const Unit& u) const { const int l = u.z >> 4, h = u.z & 3; return Wq + ((size_t)l * D * D + (size_t)u.pn * 256 * D + h * XA_D) * 2; }
};
struct UtSched { const char* Wo; const char* Vall; int G, c, L0, L1;
    __device__ bool next(int i, Unit& u) const { const int L = L0 + i * G + c; if (c < 0 || L >= L1) return false; u.pm = L & 7; u.pn = 0; u.z = L >> 3; return true; }
    __device__ __forceinline__ const char* a_ptr(const Unit& u) const { const int l = u.z >> 4, h = u.z & 3; return Wo + ((size_t)l * D * D + (size_t)u.pm * 256 * D + h * XA_D) * 2; }
    __device__ __forceinline__ const char* b_ptr(const Unit& u) const { const int l = u.z >> 4, b = (u.z >> 2) & 3, h = u.z & 3; return Vall + ((size_t)b * NMEM * 4 * D + (size_t)l * D + h * XA_D) * 2; }
};
struct ScSched { const char* XBp; const char* GTl; int G, c;
    __device__ bool next(int i, Unit& u) const { const int L = i * G + c; if (L >= 16 * 8) return false; u.pm = L & 7; u.pn = 0; u.z = L >> 3; return true; }
    __device__ __forceinline__ const char* a_ptr(const Unit& u) const { return XBp + ((size_t)(u.z >> 2) * SEQ + (size_t)u.pm * 256) * D * 2; }
    __device__ __forceinline__ const char* b_ptr(const Unit& u) const { return GTl + (size_t)u.z * NMEM * D * 2; }
};
struct OneSched {
    const char* A; const char* B; Unit u0;
    __device__ bool next(int i, Unit& u) const { if (i > 0) return false; u = u0; return true; }
    __device__ __forceinline__ const char* a_ptr(const Unit&) const { return A; }
    __device__ __forceinline__ const char* b_ptr(const Unit&) const { return B; }
};
struct EpiSoftmax {
    static constexpr bool PERM = true;
    bf16* Pall; float scale0; LAS unsigned char* lds; const float* SSQ;
    __device__ __forceinline__ void operator()(const Acc& acc, const Unit& u, int wr, int wc, int fr, int fq) const {
        LAS float* rmax = (LAS float*)(lds + STAGE_BYTES); LAS float* rsum = rmax + 1024;
        const int growb = (u.z >> 2) * SEQ + u.pm * BM; bf16* P = Pall + (size_t)growb * (4 * NMEM) + (u.z & 3) * NMEM;
        float rs[2][4]; load_rstd(SSQ, growb + wr * 64 + fr, rs);
        float mx[2][4];
#pragma unroll
        for (int ai = 0; ai < 2; ++ai)
#pragma unroll
            for (int m = 0; m < 4; ++m) { float v = -3.0e38f;
#pragma unroll
                for (int bj = 0; bj < 2; ++bj)
#pragma unroll
                    for (int n = 0; n < 2; ++n) { const f32x4 a = acc[ai][bj][m][n]; v = fmaxf(v, fmaxf(fmaxf(a[0], a[1]), fmaxf(a[2], a[3]))); }
                v = fmaxf(v, __shfl_xor(v, 16)); v = fmaxf(v, __shfl_xor(v, 32));
                if (fq == 0) rmax[(ai * HALF + wr * 64 + m * 16 + fr) * 4 + wc] = v; }
        asm volatile("s_waitcnt lgkmcnt(0)" ::: "memory"); __builtin_amdgcn_s_barrier(); asm volatile("" ::: "memory");
#pragma unroll
        for (int ai = 0; ai < 2; ++ai)
#pragma unroll
            for (int m = 0; m < 4; ++m) { const int rl = ai * HALF + wr * 64 + m * 16 + fr; const f32x4 r = *(const LAS f32x4*)(rmax + rl * 4); const float mxa = fmaxf(fmaxf(r[0], r[1]), fmaxf(r[2], r[3])); mx[ai][m] = mxa; const float scale = scale0 * rs[ai][m];
                float s = 0.f;
#pragma unroll
                for (int bj = 0; bj < 2; ++bj)
#pragma unroll
                    for (int n = 0; n < 2; ++n) { const f32x4 a = acc[ai][bj][m][n]; s += (__expf((a[0] - mxa) * scale) + __expf((a[1] - mxa) * scale)) + (__expf((a[2] - mxa) * scale) + __expf((a[3] - mxa) * scale)); }
                s += __shfl_xor(s, 16); s += __shfl_xor(s, 32);
                if (fq == 0) rsum[rl * 4 + wc] = s; }
        asm volatile("s_waitcnt lgkmcnt(0)" ::: "memory"); __builtin_amdgcn_s_barrier(); asm volatile("" ::: "memory");
#pragma unroll
        for (int ai = 0; ai < 2; ++ai)
#pragma unroll
            for (int m = 0; m < 4; ++m) { const int rl = ai * HALF + wr * 64 + m * 16 + fr; const f32x4 r = *(const LAS f32x4*)(rsum + rl * 4); const float inv = 1.0f / ((r[0] + r[1]) + (r[2] + r[3])); const float mxa = mx[ai][m]; const float scale = scale0 * rs[ai][m];
                bf16* rowp = P + (size_t)rl * (4 * NMEM) + wc * 32 + 8 * fq;
#pragma unroll
                for (int bj = 0; bj < 2; ++bj) { const f32x4 a0 = acc[ai][bj][m][0], a1 = acc[ai][bj][m][1];
                    u32x4 w; w.x = pk2(__expf((a0[0] - mxa) * scale) * inv, __expf((a0[1] - mxa) * scale) * inv); w.y = pk2(__expf((a0[2] - mxa) * scale) * inv, __expf((a0[3] - mxa) * scale) * inv);
                    w.z = pk2(__expf((a1[0] - mxa) * scale) * inv, __expf((a1[1] - mxa) * scale) * inv); w.w = pk2(__expf((a1[2] - mxa) * scale) * inv, __expf((a1[3] - mxa) * scale) * inv);
                    *(u32x4*)(rowp + bj * HALF) = w; } }
        asm volatile("s_waitcnt lgkmcnt(0)" ::: "memory"); __builtin_amdgcn_s_barrier(); asm volatile("" ::: "memory");
    }
};

template <class Epi, class Sched, class MkEpi, bool ALIGN_EPI = true, bool SP2 = true>
__device__ __forceinline__ void gemm_phase_(LAS unsigned char* lds, const int tid, const int lda, const int ldb, const int K, const Sched& S, const MkEpi& mk) {
    const int wid = __builtin_amdgcn_readfirstlane(tid >> 6), lane = tid & 63, wr = wid >> 2, wc = wid & 3, fr = lane & 15, fq = lane >> 4;
    int nt = K / BK; asm volatile("" : "+s"(nt));
    unsigned voffA[2], voffB[2];
#pragma unroll
    for (int i = 0; i < 2; ++i) { int R, C; stage_rc(tid * 16 + i * 8192, R, C); const int Rb = Epi::PERM ? ((R & ~31) + perm32(R & 31)) : R;
        voffA[i] = (unsigned)(R * lda + C) * 2u; voffB[i] = (unsigned)(Rb * ldb + C) * 2u; }
    constexpr unsigned kstep = BK * 2;
    const unsigned hstepA = (unsigned)(HALF * lda * 2), hstepB = (unsigned)(HALF * ldb * 2);
    const unsigned ldsw = (unsigned)wid * 1024u;
    const int aoff = lds_byte(wr * 64 + fr, fq * 8), boff = lds_byte(wc * 32 + fr, fq * 8);
#define PG8_SA(b, h) (((b) * 2 + (h)) * HTB)
#define PG8_SB(b, h) ((4 + (b) * 2 + (h)) * HTB)
#define PG8_STAGE(bufoff, gbase, voff) do { _Pragma("unroll") for (int _i = 0; _i < 2; ++_i) \
        __builtin_amdgcn_global_load_lds((const unsigned*)((const char*)(gbase) + (voff)[_i]), (LAS unsigned*)(lds + (bufoff) + ldsw + _i * 8192), 16, 0, 0); } while (0)
#define PG8_LDA(dst, b, h) do { _Pragma("unroll") for (int m = 0; m < 4; ++m) _Pragma("unroll") for (int k = 0; k < 2; ++k) dst[m][k] = *(const LAS bf16x8*)(lds + PG8_SA(b, h) + aoff + m * 2048 + k * 1024); } while (0)
#define PG8_LDB(dst, b, h) do { _Pragma("unroll") for (int n = 0; n < 2; ++n) _Pragma("unroll") for (int k = 0; k < 2; ++k) dst[n][k] = *(const LAS bf16x8*)(lds + PG8_SB(b, h) + boff + n * 2048 + k * 1024); } while (0)
#define PG8_MMA(ai, bj, At, Bt) do { __builtin_amdgcn_s_setprio(1); _Pragma("unroll") for (int m = 0; m < 4; ++m) _Pragma("unroll") for (int n = 0; n < 2; ++n) _Pragma("unroll") for (int k = 0; k < 2; ++k) \
        acc[ai][bj][m][n] = __builtin_amdgcn_mfma_f32_16x16x32_bf16(Bt[n][k], At[m][k], acc[ai][bj][m][n], 0, 0, 0); __builtin_amdgcn_s_setprio(0); } while (0)
#define PG8_WAIT_V(n) asm volatile("s_waitcnt vmcnt(" #n ")" ::: "memory")
#define PG8_WAIT_L(n) asm volatile("s_waitcnt lgkmcnt(" #n ")" ::: "memory")
#define PG8_BAR __builtin_amdgcn_s_barrier()
#define PG8_SCHED __builtin_amdgcn_sched_barrier(0)
    Unit cur, nxt; int ui = 0;
    if (!S.next(0, cur)) return;
    f32x4 acc[2][2][4][2];
#pragma unroll
    for (int a = 0; a < 2; ++a)
#pragma unroll
        for (int b = 0; b < 2; ++b)
#pragma unroll
            for (int m = 0; m < 4; ++m)
#pragma unroll
                for (int n = 0; n < 2; ++n) acc[a][b][m][n] = (f32x4){0.f, 0.f, 0.f, 0.f};
    bf16x8 At[4][2], B0[2][2], B1[2][2];
    const char* cA = S.a_ptr(cur); const char* cB = S.b_ptr(cur);
    if constexpr (SP2) {
        PG8_STAGE(PG8_SB(0, 0), cB, voffB); PG8_STAGE(PG8_SB(0, 1), cB + hstepB, voffB); PG8_STAGE(PG8_SA(0, 0), cA, voffA); PG8_STAGE(PG8_SA(0, 1), cA + hstepA, voffA);
        if (wr == 1) PG8_BAR;
        PG8_WAIT_V(2); PG8_BAR;
        PG8_STAGE(PG8_SB(1, 0), cB + kstep, voffB); PG8_STAGE(PG8_SA(1, 0), cA + kstep, voffA); PG8_STAGE(PG8_SB(1, 1), cB + hstepB + kstep, voffB);
        PG8_WAIT_V(6); PG8_BAR;
    } else {
        PG8_STAGE(PG8_SB(0, 0), cB, voffB); PG8_STAGE(PG8_SA(0, 0), cA, voffA); PG8_STAGE(PG8_SB(0, 1), cB + hstepB, voffB); PG8_STAGE(PG8_SA(0, 1), cA + hstepA, voffA);
        if (wr == 1) PG8_BAR;
        PG8_WAIT_V(4); PG8_BAR;
        PG8_STAGE(PG8_SB(1, 0), cB + kstep, voffB); PG8_STAGE(PG8_SA(1, 0), cA + kstep, voffA); PG8_STAGE(PG8_SB(1, 1), cB + hstepB + kstep, voffB);
        PG8_WAIT_V(6); PG8_BAR;
    }
    for (;;) {
        const bool has_next = S.next(ui + 1, nxt);
        if (!has_next) nxt = cur;
        const char* nA = S.a_ptr(nxt); const char* nB = S.b_ptr(nxt);
        for (int t = 0; t < nt; t += 2) {
            const bool last = (t == nt - 2);
            const char* a1 = cA + (size_t)(t + 1) * kstep;
            const char* a2 = last ? nA : cA + (size_t)(t + 2) * kstep; const char* b2 = last ? nB : cB + (size_t)(t + 2) * kstep;
            const char* a3 = a2 + kstep; const char* b3 = b2 + kstep;
            if constexpr (SP2) {
            PG8_LDB(B0, 0, 0); PG8_LDB(B1, 0, 1); PG8_SCHED; PG8_LDA(At, 0, 0); PG8_STAGE(PG8_SA(1, 1), a1 + hstepA, voffA);
            PG8_WAIT_V(8); PG8_WAIT_L(0); PG8_BAR; PG8_MMA(0, 0, At, B0); PG8_MMA(0, 1, At, B1); PG8_BAR; PG8_SCHED;
            PG8_LDA(At, 0, 1); PG8_STAGE(PG8_SB(0, 0), b2, voffB); PG8_STAGE(PG8_SB(0, 1), b2 + hstepB, voffB); PG8_STAGE(PG8_SA(0, 0), a2, voffA);
            PG8_WAIT_V(8); PG8_WAIT_L(0); PG8_BAR; PG8_MMA(1, 0, At, B0); PG8_MMA(1, 1, At, B1); PG8_BAR; PG8_SCHED;
            PG8_LDB(B0, 1, 0); PG8_LDB(B1, 1, 1); PG8_SCHED; PG8_LDA(At, 1, 0); PG8_STAGE(PG8_SA(0, 1), a2 + hstepA, voffA);
            PG8_WAIT_V(8); PG8_WAIT_L(0); PG8_BAR; PG8_MMA(0, 0, At, B0); PG8_MMA(0, 1, At, B1); PG8_BAR; PG8_SCHED;
            PG8_LDA(At, 1, 1); PG8_STAGE(PG8_SB(1, 0), b3, voffB); PG8_STAGE(PG8_SB(1, 1), b3 + hstepB, voffB); PG8_STAGE(PG8_SA(1, 0), a3, voffA);
            PG8_WAIT_V(8); PG8_WAIT_L(0); PG8_BAR; PG8_MMA(1, 0, At, B0); PG8_MMA(1, 1, At, B1); PG8_BAR; PG8_SCHED;
            } else {
            PG8_LDB(B0, 0, 0); PG8_SCHED; PG8_LDA(At, 0, 0); PG8_STAGE(PG8_SA(1, 1), a1 + hstepA, voffA);
            PG8_WAIT_L(8); PG8_BAR; PG8_WAIT_L(0); PG8_MMA(0, 0, At, B0); PG8_BAR; PG8_SCHED;
            PG8_LDB(B1, 0, 1); PG8_STAGE(PG8_SB(0, 0), b2, voffB);
            PG8_BAR; PG8_WAIT_L(0); PG8_MMA(0, 1, At, B1); PG8_BAR;
            PG8_LDA(At, 0, 1); PG8_STAGE(PG8_SA(0, 0), a2, voffA);
            PG8_BAR; PG8_WAIT_L(0); PG8_MMA(1, 0, At, B0); PG8_BAR; PG8_SCHED;
            PG8_STAGE(PG8_SB(0, 1), b2 + hstepB, voffB);
            PG8_WAIT_V(6); PG8_BAR; PG8_MMA(1, 1, At, B1); PG8_BAR;
            PG8_LDB(B0, 1, 0); PG8_SCHED; PG8_LDA(At, 1, 0); PG8_STAGE(PG8_SA(0, 1), a2 + hstepA, voffA);
            PG8_WAIT_L(8); PG8_BAR; PG8_WAIT_L(0); PG8_MMA(0, 0, At, B0); PG8_BAR; PG8_SCHED;
            PG8_LDB(B1, 1, 1); PG8_STAGE(PG8_SB(1, 0), b3, voffB);
            PG8_BAR; PG8_WAIT_L(0); PG8_MMA(0, 1, At, B1); PG8_BAR;
            PG8_LDA(At, 1, 1); PG8_STAGE(PG8_SA(1, 0), a3, voffA);
            PG8_BAR; PG8_WAIT_L(0); PG8_MMA(1, 0, At, B0); PG8_BAR; PG8_SCHED;
            PG8_STAGE(PG8_SB(1, 1), b3 + hstepB, voffB);
            PG8_WAIT_V(6); PG8_BAR; PG8_MMA(1, 1, At, B1); PG8_BAR;
            }
        }
        if constexpr (ALIGN_EPI) { if (wr == 0) PG8_BAR; }
        { asm volatile("" ::: "memory"); const Epi E = mk(); E(acc, cur, wr, wc, fr, fq); }
        if (!has_next) break;
#pragma unroll
        for (int a = 0; a < 2; ++a)
#pragma unroll
            for (int b = 0; b < 2; ++b)
#pragma unroll
                for (int m = 0; m < 4; ++m)
#pragma unroll
                    for (int n = 0; n < 2; ++n) acc[a][b][m][n] = (f32x4){0.f, 0.f, 0.f, 0.f};
        cur = nxt; cA = nA; cB = nB; ++ui;
        if constexpr (ALIGN_EPI) { if (wr == 1) PG8_BAR; }
    }
    PG8_WAIT_V(0);
    if constexpr (!ALIGN_EPI) { if (wr == 0) PG8_BAR; }
    PG8_BAR;
#undef PG8_SA
#undef PG8_SB
#undef PG8_STAGE
#undef PG8_LDA
#undef PG8_LDB
#undef PG8_MMA
#undef PG8_WAIT_V
#undef PG8_WAIT_L
#undef PG8_BAR
#undef PG8_SCHED
}
template <class MkEpi, class Sched> __device__ __forceinline__ void gemm_phase(LAS unsigned char* lds, const int tid, const int lda, const int ldb, const int K, const Sched& S, const MkEpi& mk) {
    gemm_phase_<decltype(mk()), Sched, MkEpi>(lds, tid, lda, ldb, K, S, mk); }
}

#define XB_TMO      128
#define XB_XCNT(j)  (256  + 64 * (j))
#define XB_XSUB(j)  (1280 + 64 * (j))
#define XB_XGEN(j)  (2304 + 64 * (j))
#define XB_TOP      3328
#define XB_TOPGEN   3392
#define XCD_BAR_WORDS 3456
#define XB_SPIN_CAP (1u << 18)

__device__ __forceinline__ unsigned xb_ld(unsigned* p)              { return __hip_atomic_load(p, __ATOMIC_RELAXED, __HIP_MEMORY_SCOPE_AGENT); }
__device__ __forceinline__ unsigned xb_add(unsigned* p, unsigned v) { return __hip_atomic_fetch_add(p, v, __ATOMIC_RELAXED, __HIP_MEMORY_SCOPE_AGENT); }
__device__ __forceinline__ unsigned xb_xcc_id() { return (unsigned)__builtin_amdgcn_s_getreg((3 << 11) | 20) & 0xFu; }
#define XB_SPIN(cond, bar) do { unsigned _sp = 0; while (cond) { __builtin_amdgcn_s_sleep(1); \
    if ((++_sp & 255u) == 0u) { if (xb_ld(&(bar)[XB_TMO])) break; if (_sp > XB_SPIN_CAP) { atomicAdd(&(bar)[XB_TMO], 1u); break; } } } } while (0)

struct XcdBarrier { unsigned* bar; unsigned x; volatile LAS unsigned* st; };

__device__ __forceinline__ XcdBarrier xcd_barrier_post(unsigned* bar, volatile LAS unsigned* st) {
    XcdBarrier b; b.bar = bar; b.x = xb_xcc_id(); b.st = st;
    if (threadIdx.x == 0) (void)xb_add(&bar[XB_XCNT(b.x)], 1u);
    return b;
}
__device__ __forceinline__ void xcd_barrier_complete(unsigned* bar, unsigned x, unsigned& nloc, unsigned& nx, const unsigned G) {
    unsigned sum, cnt, mine, sp = 0u;
    for (;;) {
        sum = 0u; cnt = 0u; mine = 0u;
#pragma unroll
        for (unsigned j = 0; j < 16; ++j) { const unsigned c = xb_ld(&bar[XB_XCNT(j)]); sum += c; cnt += (c > 0u) ? 1u : 0u; mine = (j == x) ? c : mine; }
        if (sum == G) break;
        __builtin_amdgcn_s_sleep(1);
        if ((++sp & 255u) == 0u) { if (xb_ld(&bar[XB_TMO])) break; if (sp > XB_SPIN_CAP) { atomicAdd(&bar[XB_TMO], 1u); break; } }
    }
    nloc = mine > 0u ? mine : 1u; nx = cnt > 0u ? cnt : 1u;
}
__device__ __forceinline__ void xcd_barrier(const XcdBarrier& b, const int tid, const unsigned G) {
    asm volatile("s_waitcnt vmcnt(0)" ::: "memory");
    __syncthreads();
    if (tid == 0) {
        unsigned* bar = b.bar;
        __builtin_amdgcn_s_waitcnt(0);
        unsigned nloc = b.st[0], nx = b.st[1];
        if (nloc == 0u) { xcd_barrier_complete(bar, b.x, nloc, nx, G); b.st[0] = nloc; b.st[1] = nx; }
        const unsigned old = xb_add(&bar[XB_XSUB(b.x)], 1u);
        const unsigned gen = old / nloc;
        if (old + 1u == (gen + 1u) * nloc) {
            __builtin_amdgcn_fence(__ATOMIC_RELEASE, "agent");
            asm volatile("s_waitcnt vmcnt(0)" ::: "memory");
            const unsigned og = xb_add(&bar[XB_TOP], 1u);
            const unsigned tg = og / nx;
            if (og + 1u == (tg + 1u) * nx) xb_add(&bar[XB_TOPGEN], 1u);
            else XB_SPIN(xb_ld(&bar[XB_TOPGEN]) == tg, bar);
            __builtin_amdgcn_fence(__ATOMIC_ACQUIRE, "agent");
            xb_add(&bar[XB_XGEN(b.x)], 1u);
            asm volatile("s_waitcnt vmcnt(0)" ::: "memory");
        } else {
            XB_SPIN(xb_ld(&bar[XB_XGEN(b.x)]) == gen, bar);
            __builtin_amdgcn_fence(__ATOMIC_ACQUIRE, "agent");
            asm volatile("s_waitcnt vmcnt(0)" ::: "memory");
        }
    }
    __syncthreads();
}

constexpr size_t MiB = 1u << 20;
constexpr size_t SZ_MD_BF = (size_t)M * D * 2, SZ_MD_F = (size_t)M * D * 4;
constexpr size_t WS_CTL = 0, CTL_BYTES = 1 * MiB;
constexpr size_t WS_X    = WS_CTL + CTL_BYTES;
constexpr size_t WS_HB   = WS_X + SZ_MD_F;
constexpr size_t WS_ACT  = WS_HB + SZ_MD_BF;
constexpr size_t WS_P0   = WS_ACT + (size_t)M * DFF * 2;
constexpr size_t WS_P1   = WS_P0 + 192 * MiB;
constexpr size_t WS_YB   = WS_P1 + 3 * SZ_MD_F;
constexpr size_t WS_QB2  = WS_YB + SZ_MD_BF;
constexpr size_t WS_SC   = WS_QB2 + SZ_MD_BF;
constexpr size_t WS_PB   = WS_SC + (size_t)16 * SEQ * NMEM * 4;
constexpr size_t WS_OB   = WS_PB + (size_t)16 * SEQ * NMEM * 2;
constexpr size_t WS_KALL = WS_OB + SZ_MD_BF;
constexpr size_t WS_VT   = WS_KALL + (size_t)MMEM * 4 * D * 2;
constexpr size_t WS_MEMN = WS_VT + (size_t)MMEM * 4 * D * 2;
constexpr size_t WS_MISC = WS_MEMN + (size_t)MMEM * D * 2;
constexpr size_t MISC_LB = 0, MISC_C8 = 4 * 2048 * 4, MISC_SSQ = MISC_C8 + 2048 * 4, MISC_GATES = MISC_SSQ + (size_t)M * 8 * 4, MISC_MLWG = MISC_GATES + (size_t)M * 16 * 4, MISC_BYTES = 1 * MiB;
static_assert(MISC_MLWG + 16 * 2048 * 4 <= MISC_BYTES, "misc");
constexpr int ML_NPAD = 6400;
constexpr size_t SZ_WGU = (size_t)NGU * D * 2, SZ_WDN = (size_t)D * DFF * 2, SZ_WDD = (size_t)D * D * 2;
constexpr size_t WS_WGU  = WS_MISC + MISC_BYTES;
constexpr size_t WS_WDN  = WS_WGU + 8 * SZ_WGU;
constexpr size_t WS_WQ   = WS_WDN + 8 * SZ_WDN;
constexpr size_t WS_WO   = WS_WQ + 4 * SZ_WDD;
constexpr size_t WS_WK   = WS_WO + 4 * SZ_WDD;
constexpr size_t WS_WV   = WS_WK + 4 * SZ_WDD;
constexpr size_t WS_HGIN = WS_WV + 4 * SZ_WDD;
constexpr size_t WS_HGOUT = WS_HGIN + 2 * 4 * SZ_WDD;
constexpr size_t WS_LRUIN = WS_HGOUT + 2 * SZ_WDD;
constexpr size_t WS_LRUG = WS_LRUIN + 2 * SZ_WDD;
constexpr size_t WS_LRUOUT = WS_LRUG + (size_t)4096 * 256 * 2;
constexpr size_t WS_MLIN = WS_LRUOUT + SZ_WDD;
constexpr size_t WS_MLOUT = WS_MLIN + (size_t)ML_NPAD * D * 2;
constexpr size_t WS_GT   = WS_MLOUT + SZ_WDD;
constexpr size_t WS_UT   = WS_GT + (size_t)4 * 16 * NMEM * D * 2;
constexpr size_t WS_END  = WS_UT + (size_t)4 * 4 * D * 4 * NMEM * 2;

constexpr int NWAVES = 8, NT = NWAVES * 64;

struct Args {
    const float* in[27]; float* out; unsigned char* ws; int ph_lo, ph_hi;
};
enum { I_X = 0, I_MEM, I_MEMG, I_NORMG, I_FINALG, I_WGU, I_WDN, I_XAQ, I_XAKV, I_XAO, I_HGLB, I_HGIN, I_HGG, I_HGOUT,
       I_LRUIN, I_CONVW, I_CONVB, I_LRUWA, I_LRUBA, I_LRUWX, I_LRUBX, I_LRULAM, I_LRUOUT, I_MLIN, I_MLBIF, I_MLG, I_MLOUT };

struct Frame { LAS unsigned char* lds; int tid, lane, wave, G, bid, gw, NGW;
    template <class T> __device__ __forceinline__ T* ptr(int i) const { const u32x2 v = *(const LAS u32x2*)(lds + CTRL + 64 + 8 * i);
        const unsigned lo = __builtin_amdgcn_readfirstlane(v.x), hi = __builtin_amdgcn_readfirstlane(v.y); return (T*)(((unsigned long long)hi << 32) | lo); }
    __device__ __forceinline__ const float* in(int i) const { return ptr<const float>(i); }
    __device__ __forceinline__ float* out() const { return ptr<float>(27); }
    __device__ __forceinline__ unsigned char* ws() const { return ptr<unsigned char>(28); }
};
__device__ __forceinline__ unsigned hw_wave_key() { return (unsigned)__builtin_amdgcn_s_getreg((12 - 1) << 11 | 4) & 0xfffu; }

struct CvtJob { const float* W; bf16* WT; const float* gk; int K, ldw, nrows, off, gu, nvalid; };
__device__ __forceinline__ void convert_job_rt(const Frame& F, int& rot, const CvtJob& j, const int num0 = 0, const int num1 = 8) {
    const int nnb = j.nrows / 64, nkb = j.K / 64, nitems = nnb * nkb; const int cg = F.lane & 15, kg = F.lane >> 4;
    const int i0 = (nitems * num0) >> 3, i1 = (nitems * num1) >> 3, nrange = i1 - i0;
    int q = F.gw - rot; if (q < 0) q += F.NGW;
    for (; q < nrange; q += F.NGW) { const int it = i0 + q;
        const int kb = it / nnb, nb = it % nnb, k0 = kb * 64, n0 = nb * 64; int sc = j.off + n0;
        if (j.gu) { const int pn = n0 >> 8, r = n0 & 255; sc = (r >> 7) * DFF + 128 * pn + (r & 127); }
        const bool ok = (sc + 4 * cg + 3) < j.nvalid; const float* src = j.W + (size_t)(k0 + 16 * kg) * j.ldw + (ok ? sc + 4 * cg : 0);
        f32x4 v[16];
#pragma unroll
        for (int i = 0; i < 16; ++i) v[i] = __builtin_nontemporal_load((const f32x4*)(src + (size_t)i * j.ldw));
        if (j.gk) { const f32x4* gp = (const f32x4*)(j.gk + k0 + 16 * kg);
#pragma unroll
            for (int q = 0; q < 4; ++q) { const f32x4 g = gp[q]; v[4 * q] *= g[0]; v[4 * q + 1] *= g[1]; v[4 * q + 2] *= g[2]; v[4 * q + 3] *= g[3]; } }
        if (!ok) {
#pragma unroll
            for (int i = 0; i < 16; ++i) v[i] = (f32x4){0.f, 0.f, 0.f, 0.f}; }
#pragma unroll
        for (int c = 0; c < 4; ++c) { bf16* dst = j.WT + (size_t)(n0 + 4 * cg + c) * j.K + k0 + 16 * kg;
            u32x4 lo, hi; lo.x = pk2(v[0][c], v[1][c]); lo.y = pk2(v[2][c], v[3][c]); lo.z = pk2(v[4][c], v[5][c]); lo.w = pk2(v[6][c], v[7][c]);
            hi.x = pk2(v[8][c], v[9][c]); hi.y = pk2(v[10][c], v[11][c]); hi.z = pk2(v[12][c], v[13][c]); hi.w = pk2(v[14][c], v[15][c]);
            *(u32x4*)dst = lo; *(u32x4*)(dst + 8) = hi; }
    }
    rot = (rot + nrange) % F.NGW;
}
struct MapPlain { int off; __device__ int operator()(int nb) const { return off + 64 * nb; } };
struct MapGU { __device__ int operator()(int nb) const { const int n = 64 * nb, pn = n >> 8, r = n & 255; return (r >> 7) * DFF + 128 * pn + (r & 127); } };

__device__ __forceinline__ void x_to_stream(const Frame& F, const float* x, bf16* XB, float* SSQ) {
    for (int row = F.gw; row < M; row += F.NGW) {
        const f32x4* xr = (const f32x4*)(x + (size_t)row * D) + F.lane; u32x2* o8 = (u32x2*)(XB + (size_t)row * D) + F.lane; float ss = 0.f;
#pragma unroll
        for (int j = 0; j < 8; ++j) { const f32x4 v = xr[64 * j]; ss += (v[0] * v[0] + v[1] * v[1]) + (v[2] * v[2] + v[3] * v[3]); u32x2 w; w.x = pk2(v[0], v[1]); w.y = pk2(v[2], v[3]); o8[64 * j] = w; }
        ss = wave_sum(ss);
        if (F.lane < 8) SSQ[(size_t)row * 8 + F.lane] = F.lane == 0 ? ss : 0.f;
    }
}
__device__ __forceinline__ void ml_gates_rows(const Frame& F, const bf16* XB, const float* SSQ, const bf16* wg, float* gates) {
    if (F.wave >= 2) return;
    const int lr = F.lane & 15, lq = F.lane >> 4;
    for (int tile = F.wave * F.G + F.bid; tile < M / 16; tile += 2 * F.G) {
        const int row0 = tile * 16;
        const bf16* ap = XB + (size_t)(row0 + lr) * D + 8 * lq; const bf16* bp = wg + (size_t)lr * D + 8 * lq;
        f32x4 acc = {0.f, 0.f, 0.f, 0.f};
        for (int k0 = 0; k0 < D; k0 += 256) { bf16x8 a[8], b[8];
#pragma unroll
            for (int j = 0; j < 8; ++j) { a[j] = *(const bf16x8*)(ap + k0 + 32 * j); b[j] = *(const bf16x8*)(bp + k0 + 32 * j); }
#pragma unroll
            for (int j = 0; j < 8; ++j) acc = __builtin_amdgcn_mfma_f32_16x16x32_bf16(a[j], b[j], acc, 0, 0, 0); }
#pragma unroll
        for (int r = 0; r < 4; ++r) { const int row = row0 + 4 * lq + r; const f32x4 s0 = *(const f32x4*)(SSQ + (size_t)row * 8), s1 = *(const f32x4*)(SSQ + (size_t)row * 8 + 4);
            const float rstd = 1.0f / sqrtf((((s0[0] + s0[1]) + (s0[2] + s0[3])) + ((s1[0] + s1[1]) + (s1[2] + s1[3]))) * (1.0f / D) + EPS);
            gates[(size_t)row * 16 + lr] = acc[r] * rstd; }
    }
}
__device__ __forceinline__ void final_norm_bf(const Frame& F, const bf16* XB, const float* SSQ, const float* g, float* out) {
    for (int row = F.gw; row < M; row += F.NGW) {
        const f32x4 a = *(const f32x4*)(SSQ + (size_t)row * 8), b = *(const f32x4*)(SSQ + (size_t)row * 8 + 4);
        const float rstd = 1.0f / sqrtf((((a[0] + a[1]) + (a[2] + a[3])) + ((b[0] + b[1]) + (b[2] + b[3]))) * (1.0f / D) + EPS);
        const u32x2* xr = (const u32x2*)(XB + (size_t)row * D) + F.lane; f32x4* o = (f32x4*)(out + (size_t)row * D) + F.lane;
#pragma unroll
        for (int j = 0; j < 8; ++j) { const u32x2 w = xr[64 * j]; const f32x4 gg = ((const f32x4*)g)[F.lane + 64 * j]; o[64 * j] = (f32x4){bflo(w.x), bfhi(w.x), bflo(w.y), bfhi(w.y)} * rstd * gg; }
    }
}
template <bool GATES>
__device__ __forceinline__ void norm_rows(const Frame& F, const float* x, const float* g, bf16* out, int nrows, const float* wg, float* gates) {
    for (int row = F.gw; row < nrows; row += F.NGW) {
        const f32x4* xr = (const f32x4*)(x + (size_t)row * D) + F.lane;
        f32x4 v[8]; float ss = 0.f;
#pragma unroll
        for (int j = 0; j < 8; ++j) { v[j] = xr[64 * j]; ss += (v[j][0] * v[j][0] + v[j][1] * v[j][1]) + (v[j][2] * v[j][2] + v[j][3] * v[j][3]); }
        ss = wave_sum(ss);
        const float rstd = 1.0f / sqrtf(ss * (1.0f / D) + EPS);
        u32x2* o8 = (u32x2*)(out + (size_t)row * D) + F.lane;
#pragma unroll
        for (int j = 0; j < 8; ++j) { const f32x4 gg = ((const f32x4*)g)[F.lane + 64 * j]; v[j] = v[j] * rstd * gg; u32x2 w; w.x = pk2(v[j][0], v[j][1]); w.y = pk2(v[j][2], v[j][3]); o8[64 * j] = w; }
        if constexpr (GATES) {
            for (int c = 0; c < 16; ++c) { const f32x4* wr_ = (const f32x4*)(wg + (size_t)c * D) + F.lane; float s = 0.f;
#pragma unroll
                for (int j = 0; j < 8; ++j) { const f32x4 w4 = wr_[64 * j]; s += (v[j][0] * w4[0] + v[j][1] * w4[1]) + (v[j][2] * w4[2] + v[j][3] * w4[3]); }
                s = wave_sum(s); if (F.lane == 0) gates[(size_t)row * 16 + c] = s; }
        }
    }
}
__device__ __forceinline__ void final_norm(const Frame& F, const float* x, const float* g, float* out) {
    for (int row = F.gw; row < M; row += F.NGW) {
        const f32x4* xr = (const f32x4*)(x + (size_t)row * D) + F.lane;
        f32x4 v[8]; float ss = 0.f;
#pragma unroll
        for (int j = 0; j < 8; ++j) { v[j] = xr[64 * j]; ss += (v[j][0] * v[j][0] + v[j][1] * v[j][1]) + (v[j][2] * v[j][2] + v[j][3] * v[j][3]); }
        ss = wave_sum(ss);
        const float rstd = 1.0f / sqrtf(ss * (1.0f / D) + EPS);
        f32x4* o = (f32x4*)(out + (size_t)row * D) + F.lane;
#pragma unroll
        for (int j = 0; j < 8; ++j) { const f32x4 gg = ((const f32x4*)g)[F.lane + 64 * j]; o[64 * j] = v[j] * rstd * gg; }
    }
}

template <bool ML>
__device__ __forceinline__ void recur_phase(const Frame& F, const bf16* QB, const float* LF, const bf16* KB, const bf16* VB, const bf16* PB, const float* gates, const float* bif, float* OF) {
    constexpr int H = ML ? ML_H : HG_H, DV = ML ? ML_DV : HG_D, NVS = DV / 32, TB = 32;
    LAS float* AL = (LAS float*)F.lds; LAS float* KA = AL + TB * 128; LAS float* QQ = KA + TB * 128; LAS float* VV = QQ + TB * 128; LAS float* OO = VV + TB * 32;
    const int dg = F.lane & 15, vsub = F.lane >> 4, vloc = F.wave * 4 + vsub;
    for (int unit = F.bid; unit < BATCH * H * NVS; unit += F.G) {
        const int b = unit / (H * NVS), h = (unit / NVS) % H, vs = unit % NVS;
        float S[8], Nn[8];
#pragma unroll
        for (int i = 0; i < 8; ++i) { S[i] = 0.f; Nn[i] = 0.f; }
        float bi_ = 0.f, bf_ = 0.f; if constexpr (ML) { bi_ = bif[h]; bf_ = bif[8 + h]; }
        for (int t0 = 0; t0 < SEQ; t0 += TB) {
            __syncthreads();
            { const int t = F.tid >> 4, d8 = (F.tid & 15) * 8; const size_t row = (size_t)b * SEQ + t0 + t;
                float al[8], ka[8], qq[8];
                if constexpr (!ML) {
                    const f32x4 l0 = *(const f32x4*)(LF + row * D + h * 128 + d8), l1 = *(const f32x4*)(LF + row * D + h * 128 + d8 + 4);
                    const u32x4 kw = *(const u32x4*)(KB + row * D + h * 128 + d8), qw = *(const u32x4*)(QB + row * D + h * 128 + d8);
                    const float lf[8] = {l0[0], l0[1], l0[2], l0[3], l1[0], l1[1], l1[2], l1[3]};
#pragma unroll
                    for (int i = 0; i < 8; ++i) al[i] = __expf(lf[i]);
                    ka[0] = bflo(kw.x); ka[1] = bfhi(kw.x); ka[2] = bflo(kw.y); ka[3] = bfhi(kw.y); ka[4] = bflo(kw.z); ka[5] = bfhi(kw.z); ka[6] = bflo(kw.w); ka[7] = bfhi(kw.w);
                    qq[0] = bflo(qw.x); qq[1] = bfhi(qw.x); qq[2] = bflo(qw.y); qq[3] = bfhi(qw.y); qq[4] = bflo(qw.z); qq[5] = bfhi(qw.z); qq[6] = bflo(qw.w); qq[7] = bfhi(qw.w);
                } else {
                    const float fg = gates[row * 16 + 8 + h] + bf_, ig = gates[row * 16 + h] + bi_;
                    const float a_ = 1.0f / (1.0f + expf(-15.0f * tanhf(fg * (1.0f / 15.0f))));
                    const float ei = expf(15.0f * tanhf(ig * (1.0f / 15.0f))) * 0.08838834764831845f;
                    const u32x4 qw = *(const u32x4*)(PB + row * ML_PROJ + h * 128 + d8), kw = *(const u32x4*)(PB + row * ML_PROJ + 1024 + h * 128 + d8);
#pragma unroll
                    for (int i = 0; i < 8; ++i) al[i] = a_;
                    ka[0] = bflo(kw.x) * ei; ka[1] = bfhi(kw.x) * ei; ka[2] = bflo(kw.y) * ei; ka[3] = bfhi(kw.y) * ei; ka[4] = bflo(kw.z) * ei; ka[5] = bfhi(kw.z) * ei; ka[6] = bflo(kw.w) * ei; ka[7] = bfhi(kw.w) * ei;
                    qq[0] = bflo(qw.x); qq[1] = bfhi(qw.x); qq[2] = bflo(qw.y); qq[3] = bfhi(qw.y); qq[4] = bflo(qw.z); qq[5] = bfhi(qw.z); qq[6] = bflo(qw.w); qq[7] = bfhi(qw.w);
                }
                *(LAS f32x4*)(AL + t * 128 + d8) = (f32x4){al[0], al[1], al[2], al[3]}; *(LAS f32x4*)(AL + t * 128 + d8 + 4) = (f32x4){al[4], al[5], al[6], al[7]};
                *(LAS f32x4*)(KA + t * 128 + d8) = (f32x4){ka[0], ka[1], ka[2], ka[3]}; *(LAS f32x4*)(KA + t * 128 + d8 + 4) = (f32x4){ka[4], ka[5], ka[6], ka[7]};
                *(LAS f32x4*)(QQ + t * 128 + d8) = (f32x4){qq[0], qq[1], qq[2], qq[3]}; *(LAS f32x4*)(QQ + t * 128 + d8 + 4) = (f32x4){qq[4], qq[5], qq[6], qq[7]};
                if (F.tid < 256) { const int tv = F.tid >> 3, v4 = (F.tid & 7) * 4; const size_t rv = (size_t)b * SEQ + t0 + tv;
                    const u32x2 vw = ML ? *(const u32x2*)(PB + rv * ML_PROJ + 2048 + h * 256 + vs * 32 + v4) : *(const u32x2*)(VB + rv * D + h * 128 + vs * 32 + v4);
                    *(LAS f32x4*)(VV + tv * 32 + v4) = (f32x4){bflo(vw.x), bfhi(vw.x), bflo(vw.y), bfhi(vw.y)}; }
            }
            __syncthreads();
#pragma unroll 4
            for (int t = 0; t < TB; ++t) {
                const f32x4 a0 = *(const LAS f32x4*)(AL + t * 128 + dg * 8), a1 = *(const LAS f32x4*)(AL + t * 128 + dg * 8 + 4);
                const f32x4 k0 = *(const LAS f32x4*)(KA + t * 128 + dg * 8), k1 = *(const LAS f32x4*)(KA + t * 128 + dg * 8 + 4);
                const f32x4 q0 = *(const LAS f32x4*)(QQ + t * 128 + dg * 8), q1 = *(const LAS f32x4*)(QQ + t * 128 + dg * 8 + 4);
                const float vv = VV[t * 32 + vloc];
                const float al[8] = {a0[0], a0[1], a0[2], a0[3], a1[0], a1[1], a1[2], a1[3]}, ka[8] = {k0[0], k0[1], k0[2], k0[3], k1[0], k1[1], k1[2], k1[3]}, qq[8] = {q0[0], q0[1], q0[2], q0[3], q1[0], q1[1], q1[2], q1[3]};
                float po = 0.f, pd = 0.f;
#pragma unroll
                for (int i = 0; i < 8; ++i) { S[i] = al[i] * S[i] + ka[i] * vv; po += S[i] * qq[i]; if constexpr (ML) { Nn[i] = al[i] * Nn[i] + ka[i]; pd += Nn[i] * qq[i]; } }
#pragma unroll
                for (int o = 1; o < 16; o <<= 1) { po += __shfl_xor(po, o); if constexpr (ML) pd += __shfl_xor(pd, o); }
                if (dg == 0) { float r = po; if constexpr (ML) r = po / fmaxf(fabsf(pd), 1.0f); OO[t * 32 + vloc] = r; }
            }
            __syncthreads();
            if (F.tid < 256) { const int tv = F.tid >> 3, v4 = (F.tid & 7) * 4; const size_t rv = (size_t)b * SEQ + t0 + tv;
                *(f32x4*)(OF + rv * D + h * DV + vs * 32 + v4) = *(const LAS f32x4*)(OO + tv * 32 + v4); }
        }
    }
}
namespace ck {
constexpr int SK = 136, SS = 72;
constexpr int O_QH = 0, O_KH = O_QH + 64 * SK * 2, O_QE = O_KH + 160 * SK * 2, O_KET = O_QE + 64 * SK * 2, O_VT = O_KET + 128 * SS * 2, O_P = O_VT + 48 * SS * 2,
              O_SB = O_P + 64 * SS * 2, O_EBC = O_SB + 48 * SK * 2, O_TOT = O_EBC + 512, O_GT = O_TOT + 2048, O_END = O_GT + 2048 + 2 * 1280;
static_assert(O_END <= CTRL, "chunk LDS map");
__device__ __forceinline__ f32x4 mm(const LAS bf16* A, int sa, int ar, const LAS bf16* B, int sb, int br, int ksteps, f32x4 acc, int lane) {
    const int r = lane & 15, q8 = (lane >> 4) * 8;
    const LAS bf16* ap = A + (ar + r) * sa + q8; const LAS bf16* bp = B + (br + r) * sb + q8;
    for (int ks = 0; ks < ksteps; ++ks) { const bf16x8 a = *(const LAS bf16x8*)(ap + ks * 32), b = *(const LAS bf16x8*)(bp + ks * 32);
        acc = __builtin_amdgcn_mfma_f32_16x16x32_bf16(a, b, acc, 0, 0, 0); }
    return acc;
}
__device__ __forceinline__ bf16 f2bf(float x) { return (bf16)(pk2(x, x) & 0xffffu); }
__device__ __forceinline__ float bf2f(unsigned short x) { return __uint_as_float((unsigned)x << 16); }
__device__ __forceinline__ void tile_of(int tile, int& qi, int& kj) {
    qi = tile < 1 ? 0 : (tile < 3 ? 1 : (tile < 6 ? 2 : 3)); kj = tile - (qi * (qi + 1)) / 2; }

__device__ __forceinline__ void store_pairs(bf16* op, const f32x4& v, int lr) {
    const bool odd = lr & 1;
    const float r01 = __shfl_xor(odd ? v[0] : v[1], 1), r23 = __shfl_xor(odd ? v[2] : v[3], 1);
    const unsigned w01 = odd ? pk2(r01, v[1]) : pk2(v[0], r01), w23 = odd ? pk2(r23, v[3]) : pk2(v[2], r23);
    *(GAS unsigned*)(op + (size_t)(odd ? 1 : 0) * D) = w01; *(GAS unsigned*)(op + (size_t)(odd ? 3 : 2) * D) = w23;
}
template <int NSL, bool ML>
__device__ __forceinline__ void headnorm_tail(const Frame& F, const bf16* OF, float* SSQP, unsigned* cnt, const int b, const int col0, const int slot0, const int vs,
                                              const bf16* gate, const int ldg, const int gcol0, const float* gain, bf16* Y) {
    constexpr float INV_HD = 1.0f / (NSL * 32);
    const int q = F.tid & 3, r0 = F.tid >> 2;
    asm volatile("s_waitcnt vmcnt(0)" ::: "memory"); __syncthreads();
    const size_t rowb = (size_t)b * SEQ + r0;
#pragma unroll
    for (int i0 = 0; i0 < 16; i0 += 8) { u32x4 w[8];
#pragma unroll
        for (int i = 0; i < 8; ++i) w[i] = *(GAS const u32x4*)(OF + (rowb + 128 * (i0 + i)) * D + col0 + 8 * q);
#pragma unroll
        for (int i = 0; i < 8; ++i) {
            const float a0 = bflo(w[i].x), a1 = bfhi(w[i].x), a2 = bflo(w[i].y), a3 = bfhi(w[i].y), a4 = bflo(w[i].z), a5 = bfhi(w[i].z), a6 = bflo(w[i].w), a7 = bfhi(w[i].w);
            float ss = ((a0 * a0 + a1 * a1) + (a2 * a2 + a3 * a3)) + ((a4 * a4 + a5 * a5) + (a6 * a6 + a7 * a7));
            ss += __shfl_xor(ss, 1); ss += __shfl_xor(ss, 2);
            if (q == 0) *(GAS float*)(SSQP + (rowb + 128 * (i0 + i)) * 64 + slot0 + vs) = ss; } }
    asm volatile("s_waitcnt vmcnt(0)" ::: "memory"); __syncthreads();
    if (F.tid == 0) { __builtin_amdgcn_fence(__ATOMIC_RELEASE, "agent"); asm volatile("s_waitcnt vmcnt(0)" ::: "memory"); (void)xb_add(cnt, 1u);
        unsigned sp = 0u; while (xb_ld(cnt) < (unsigned)NSL) { __builtin_amdgcn_s_sleep(1); if (++sp > (1u << 24)) break; }
        __builtin_amdgcn_fence(__ATOMIC_ACQUIRE, "agent"); asm volatile("s_waitcnt vmcnt(0)" ::: "memory"); }
    __syncthreads();
    const f32x4 g0 = *(GAS const f32x4*)(gain + 8 * q), g1 = *(GAS const f32x4*)(gain + 8 * q + 4);
#pragma unroll
    for (int i0 = 0; i0 < 16; i0 += 4) {
        u32x4 w[4], gw[4]; f32x4 p0[4], p1[4];
#pragma unroll
        for (int j = 0; j < 4; ++j) { const size_t row = rowb + 128 * (i0 + j);
            w[j] = *(GAS const u32x4*)(OF + row * D + col0 + 8 * q); gw[j] = *(GAS const u32x4*)(gate + row * ldg + gcol0 + 8 * q);
            p0[j] = *(GAS const f32x4*)(SSQP + row * 64 + slot0); if constexpr (NSL == 8) p1[j] = *(GAS const f32x4*)(SSQP + row * 64 + slot0 + 4); else p1[j] = (f32x4){0.f, 0.f, 0.f, 0.f}; }
#pragma unroll
        for (int j = 0; j < 4; ++j) { const size_t row = rowb + 128 * (i0 + j);
            const float tot = ((p0[j][0] + p0[j][1]) + (p0[j][2] + p0[j][3])) + ((p1[j][0] + p1[j][1]) + (p1[j][2] + p1[j][3]));
            const float rstd = 1.0f / sqrtf(tot * INV_HD + EPS);
            float gg[8] = {bflo(gw[j].x), bfhi(gw[j].x), bflo(gw[j].y), bfhi(gw[j].y), bflo(gw[j].z), bfhi(gw[j].z), bflo(gw[j].w), bfhi(gw[j].w)};
            if constexpr (ML) {
#pragma unroll
                for (int e = 0; e < 8; ++e) gg[e] = sigmoidf_(gg[e]); }
            const f32x4 a = (f32x4){bflo(w[j].x), bfhi(w[j].x), bflo(w[j].y), bfhi(w[j].y)} * rstd * g0, c = (f32x4){bflo(w[j].z), bfhi(w[j].z), bflo(w[j].w), bfhi(w[j].w)} * rstd * g1;
            u32x4 o; o.x = pk2(a[0] * gg[0], a[1] * gg[1]); o.y = pk2(a[2] * gg[2], a[3] * gg[3]); o.z = pk2(c[0] * gg[4], c[1] * gg[5]); o.w = pk2(c[2] * gg[6], c[3] * gg[7]);
            *(GAS u32x4*)(Y + row * D + col0 + 8 * q) = o; } }
}
__device__ __forceinline__ void hg_chunk_phase(const Frame& F, const bf16* QB, const bf16* LF, const bf16* KB, const bf16* VB, bf16* OF, const bf16* GB, const float* gn, bf16* Y, float* SSQP, unsigned* hcnt) {
    LAS bf16* QH = (LAS bf16*)(F.lds + O_QH); LAS bf16* KH = (LAS bf16*)(F.lds + O_KH); LAS bf16* QE = (LAS bf16*)(F.lds + O_QE); LAS bf16* KET = (LAS bf16*)(F.lds + O_KET);
    LAS bf16* VT = (LAS bf16*)(F.lds + O_VT); LAS bf16* P = (LAS bf16*)(F.lds + O_P); LAS bf16* SB = (LAS bf16*)(F.lds + O_SB);
    LAS float* EBC = (LAS float*)(F.lds + O_EBC); LAS float* TOT = (LAS float*)(F.lds + O_TOT);
    const int tid = F.tid, lane = F.lane, w = F.wave, lq = lane >> 4, lr = lane & 15;
    const int g = w, i = g >> 1, d2 = 2 * lane, sv = tid >> 3, v4 = (tid & 7) * 4;
    for (int unit = F.bid; unit < 256; unit += F.G) {
        const int xk = unit >> 3, vs = xk & 3, gq = (xk >> 2) * 8 + (unit & 7); const int b = gq >> 4, h = gq & 15;
        __syncthreads();
        for (int e = tid; e < 64 * SS / 2; e += NT) ((LAS unsigned*)P)[e] = 0u;
        for (int e = tid; e < 48 * SK / 2; e += NT) ((LAS unsigned*)SB)[e] = 0u;
        f32x4 S0 = {0.f, 0.f, 0.f, 0.f}, S1 = {0.f, 0.f, 0.f, 0.f};
        unsigned lfA[8], lfB[8]; unsigned qvA[8], qvB[8]; u32x2 vvA, vvB;
        const size_t colb = (size_t)h * 128 + d2, colv = (size_t)h * 128 + vs * 32 + v4;
        auto load = [&](unsigned (&lfw)[8], unsigned (&qv)[8], u32x2& vv, const int cc) { const size_t r0 = (size_t)b * SEQ + (size_t)cc * 64 + 8 * g;
#pragma unroll
            for (int tt = 0; tt < 8; ++tt) { lfw[tt] = *(const unsigned*)(LF + (r0 + tt) * D + colb); qv[tt] = *(const unsigned*)(QB + (r0 + tt) * D + colb); }
            vv = *(const u32x2*)(VB + ((size_t)b * SEQ + (size_t)cc * 64 + sv) * D + colv); };
        load(lfA, qvA, vvA, 0); load(lfB, qvB, vvB, 1);
        auto step = [&](unsigned (&lfw)[8], unsigned (&qv)[8], u32x2& vv, const int c) {
            f32x2 lf[8], loc[8]; { f32x2 run = {0.f, 0.f};
#pragma unroll
                for (int tt = 0; tt < 8; ++tt) { lf[tt] = (f32x2){bflo(lfw[tt]), bfhi(lfw[tt])}; run += lf[tt]; loc[tt] = run; }
                *(LAS f32x2*)(TOT + g * 128 + d2) = run; }
            __syncthreads();
            { u32x2 s0, s1; s0.x = pk2(S0[0], S0[1]); s0.y = pk2(S0[2], S0[3]); s1.x = pk2(S1[0], S1[1]); s1.y = pk2(S1[2], S1[3]);
                *(LAS u32x2*)(SB + lr * SK + 16 * w + 4 * lq) = s0; *(LAS u32x2*)(SB + (16 + lr) * SK + 16 * w + 4 * lq) = s1; }
            f32x2 tg[8];
#pragma unroll
            for (int j = 0; j < 8; ++j) tg[j] = *(const LAS f32x2*)(TOT + j * 128 + d2);
            f32x2 Pf[4]; Pf[0] = (f32x2){0.f, 0.f}; Pf[1] = tg[0] + tg[1]; Pf[2] = Pf[1] + tg[2] + tg[3]; Pf[3] = Pf[2] + tg[4] + tg[5]; const f32x2 bC = Pf[3] + tg[6] + tg[7];
            const f32x2 Pi = i == 0 ? Pf[0] : (i == 1 ? Pf[1] : (i == 2 ? Pf[2] : Pf[3]));
            const f32x2 half = (g & 1) ? (g == 1 ? tg[0] : (g == 3 ? tg[2] : (g == 5 ? tg[4] : tg[6]))) : (f32x2){0.f, 0.f};
            const f32x2 eP = {__expf(Pi.x), __expf(Pi.y)}; const f32x2 eC = {__expf(bC.x - Pi.x), __expf(bC.y - Pi.y)};
            f32x2 fac[4];
#pragma unroll
            for (int ip = 0; ip < 4; ++ip) fac[ip] = (f32x2){__expf(Pf[ip].x - Pi.x), __expf(Pf[ip].y - Pi.y)};
            const int koff[4] = {0, 16, 48, 96};
            unsigned ke0[4], ke1[4];
#pragma unroll
            for (int tt = 0; tt < 8; ++tt) { const int t = 8 * g + tt; const f32x2 lo = loc[tt] + half;
                const float q0 = bflo(qv[tt]), q1 = bfhi(qv[tt]), k0 = 1.0f - __expf(lf[tt].x), k1 = 1.0f - __expf(lf[tt].y);
                const float e0 = __expf(fmaxf(lo.x, -80.f)), e1 = __expf(fmaxf(lo.y, -80.f));
                const float kr0 = k0 * __builtin_amdgcn_rcpf(e0), kr1 = k1 * __builtin_amdgcn_rcpf(e1);
                *(LAS unsigned*)(QH + t * SK + d2) = pk2(q0 * e0, q1 * e1); *(LAS unsigned*)(QE + t * SK + d2) = pk2(q0 * e0 * eP.x, q1 * e1 * eP.y);
#pragma unroll
                for (int ip = 0; ip < 4; ++ip) if (ip >= i) *(LAS unsigned*)(KH + (koff[ip] + t) * SK + d2) = pk2(kr0 * fac[ip].x, kr1 * fac[ip].y);
                const float c0 = kr0 * eC.x, c1 = kr1 * eC.y;
                if (tt & 1) { ke0[tt >> 1] = pk2(__uint_as_float(ke0[tt >> 1]), c0); ke1[tt >> 1] = pk2(__uint_as_float(ke1[tt >> 1]), c1); } else { ke0[tt >> 1] = __float_as_uint(c0); ke1[tt >> 1] = __float_as_uint(c1); } }
            *(LAS u32x4*)(KET + d2 * SS + 8 * g) = (u32x4){ke0[0], ke0[1], ke0[2], ke0[3]}; *(LAS u32x4*)(KET + (d2 + 1) * SS + 8 * g) = (u32x4){ke1[0], ke1[1], ke1[2], ke1[3]};
            if (g == 0) *(LAS f32x2*)(EBC + d2) = (f32x2){__expf(bC.x), __expf(bC.y)};
            VT[(v4 + 0) * SS + sv] = (bf16)(vv.x & 0xffffu); VT[(v4 + 1) * SS + sv] = (bf16)(vv.x >> 16); VT[(v4 + 2) * SS + sv] = (bf16)(vv.y & 0xffffu); VT[(v4 + 3) * SS + sv] = (bf16)(vv.y >> 16);
            if (c + 2 < SEQ / 64) load(lfw, qv, vv, c + 2);
            __syncthreads();
            for (int tile = w; tile < 10; tile += 8) { int qi, kj; tile_of(tile, qi, kj);
                f32x4 acc = {0.f, 0.f, 0.f, 0.f}; acc = mm(QH, SK, 16 * qi, KH, SK, koff[qi] + 16 * kj, 4, acc, lane);
#pragma unroll
                for (int r = 0; r < 4; ++r) { const int tl = 4 * lq + r; const float val = (qi != kj || lr <= tl) ? acc[r] : 0.f; P[(16 * qi + tl) * SS + 16 * kj + lr] = f2bf(val); } }
            __syncthreads();
            { const int tq = w & 3, nv = w >> 2; f32x4 acc = {0.f, 0.f, 0.f, 0.f};
                acc = mm(P, SS, 16 * tq, VT, SS, 16 * nv, tq < 2 ? 1 : 2, acc, lane);
                acc = mm(QE, SK, 16 * tq, SB, SK, 16 * nv, 4, acc, lane);
                bf16* op = OF + ((size_t)b * SEQ + c * 64 + 16 * tq + 4 * lq) * D + h * 128 + vs * 32 + 16 * nv + (lr & ~1);
                store_pairs(op, acc, lr); }
            { f32x4 U0 = {0.f, 0.f, 0.f, 0.f}, U1 = {0.f, 0.f, 0.f, 0.f}; U0 = mm(KET, SS, 16 * w, VT, SS, 0, 2, U0, lane); U1 = mm(KET, SS, 16 * w, VT, SS, 16, 2, U1, lane);
                const f32x4 dec = *(const LAS f32x4*)(EBC + 16 * w + 4 * lq); S0 = S0 * dec + U0; S1 = S1 * dec + U1; }
        };
        for (int c = 0; c < SEQ / 64; c += 2) { step(lfA, qvA, vvA, c); step(lfB, qvB, vvB, c + 1); }
        if (hcnt) headnorm_tail<4, false>(F, OF, SSQP, hcnt + b * 16 + h, b, h * 128 + vs * 32, h * 4, vs, GB, D, h * 128 + vs * 32, gn + vs * 32, Y);
    }
}

constexpr int A_QH = 0, A_KH = A_QH + 64 * SK * 2, A_IMG = A_KH + 160 * SK * 2;
constexpr int I_QE = 0, I_KET = I_QE + 64 * SK * 2, I_P = I_KET + 128 * SS * 2, I_EBC = I_P + 64 * SS * 2, I_VT = I_EBC + 512, IMG_BYTES = I_VT + 128 * SS * 2;
constexpr int A_TOT = A_IMG + IMG_BYTES, A_END = A_TOT + 4096;
constexpr int B_VT = I_VT, B_SB = B_VT + 32 * SS * 2, B_BUF = B_SB + 32 * SK * 2;
static_assert(IMG_BYTES == 64000 && A_END <= CTRL && 2 * B_BUF <= CTRL, "hg stage LDS maps");
__device__ __forceinline__ void hg_prep_phase(const Frame& F, const bf16* QB, const bf16* LF, const bf16* VB, unsigned char* IMG) {
    LAS bf16* QH = (LAS bf16*)(F.lds + A_QH); LAS bf16* KH = (LAS bf16*)(F.lds + A_KH); LAS bf16* QE = (LAS bf16*)(F.lds + A_IMG + I_QE); LAS bf16* KET = (LAS bf16*)(F.lds + A_IMG + I_KET);
    LAS bf16* VT = (LAS bf16*)(F.lds + A_IMG + I_VT); LAS bf16* P = (LAS bf16*)(F.lds + A_IMG + I_P); LAS float* EBC = (LAS float*)(F.lds + A_IMG + I_EBC); LAS float* TOT = (LAS float*)(F.lds + A_TOT);
    const int tid = F.tid, lane = F.lane, w = F.wave, lq = lane >> 4, lr = lane & 15;
    const int g = w, i = g >> 1, d2 = 2 * lane, sv = tid >> 3, vc = (tid & 7) * 16;
    constexpr int NITEM = BATCH * 16 * (SEQ / 64);
    __syncthreads();
    for (int e = tid; e < 64 * SS / 2; e += NT) ((LAS unsigned*)P)[e] = 0u;
    unsigned lfA[8], lfB[8], qvA[8], qvB[8];
    auto load = [&](unsigned (&lfw)[8], unsigned (&qv)[8], const int item) { const int c = item & 31, gq = item >> 5, b = gq >> 4, h = gq & 15;
        const size_t r0 = (size_t)b * SEQ + (size_t)c * 64 + 8 * g, colb = (size_t)h * 128 + d2;
#pragma unroll
        for (int tt = 0; tt < 8; ++tt) { lfw[tt] = *(GAS const unsigned*)(LF + (r0 + tt) * D + colb); qv[tt] = *(GAS const unsigned*)(QB + (r0 + tt) * D + colb); }
};
    const int first = F.bid, stride = F.G;
    if (first < NITEM) load(lfA, qvA, first);
    if (first + stride < NITEM) load(lfB, qvB, first + stride);
    auto step = [&](unsigned (&lfw)[8], unsigned (&qv)[8], const int item) {
        f32x2 lf[8], loc[8]; { f32x2 run = {0.f, 0.f};
#pragma unroll
            for (int tt = 0; tt < 8; ++tt) { lf[tt] = (f32x2){bflo(lfw[tt]), bfhi(lfw[tt])}; run += lf[tt]; loc[tt] = run; }
            *(LAS f32x2*)(TOT + g * 128 + d2) = run; }
        __syncthreads();
        f32x2 tg[8];
#pragma unroll
        for (int j = 0; j < 8; ++j) tg[j] = *(const LAS f32x2*)(TOT + j * 128 + d2);
        f32x2 Pf[4]; Pf[0] = (f32x2){0.f, 0.f}; Pf[1] = tg[0] + tg[1]; Pf[2] = Pf[1] + tg[2] + tg[3]; Pf[3] = Pf[2] + tg[4] + tg[5]; const f32x2 bC = Pf[3] + tg[6] + tg[7];
        const f32x2 Pi = i == 0 ? Pf[0] : (i == 1 ? Pf[1] : (i == 2 ? Pf[2] : Pf[3]));
        const f32x2 half = (g & 1) ? (g == 1 ? tg[0] : (g == 3 ? tg[2] : (g == 5 ? tg[4] : tg[6]))) : (f32x2){0.f, 0.f};
        const f32x2 eP = {__expf(Pi.x), __expf(Pi.y)}; const f32x2 eC = {__expf(bC.x - Pi.x), __expf(bC.y - Pi.y)};
        f32x2 fac[4];
#pragma unroll
        for (int ip = 0; ip < 4; ++ip) fac[ip] = (f32x2){__expf(Pf[ip].x - Pi.x), __expf(Pf[ip].y - Pi.y)};
        const int koff[4] = {0, 16, 48, 96};
        unsigned ke0[4], ke1[4];
#pragma unroll
        for (int tt = 0; tt < 8; ++tt) { const int t = 8 * g + tt; const f32x2 lo = loc[tt] + half;
            const float q0 = bflo(qv[tt]), q1 = bfhi(qv[tt]), k0 = 1.0f - __expf(lf[tt].x), k1 = 1.0f - __expf(lf[tt].y);
            const float e0 = __expf(fmaxf(lo.x, -80.f)), e1 = __expf(fmaxf(lo.y, -80.f));
            const float kr0 = k0 * __builtin_amdgcn_rcpf(e0), kr1 = k1 * __builtin_amdgcn_rcpf(e1);
            *(LAS unsigned*)(QH + t * SK + d2) = pk2(q0 * e0, q1 * e1); *(LAS unsigned*)(QE + t * SK + d2) = pk2(q0 * e0 * eP.x, q1 * e1 * eP.y);
#pragma unroll
            for (int ip = 0; ip < 4; ++ip) if (ip >= i) *(LAS unsigned*)(KH + (koff[ip] + t) * SK + d2) = pk2(kr0 * fac[ip].x, kr1 * fac[ip].y);
            const float c0 = kr0 * eC.x, c1 = kr1 * eC.y;
            if (tt & 1) { ke0[tt >> 1] = pk2(__uint_as_float(ke0[tt >> 1]), c0); ke1[tt >> 1] = pk2(__uint_as_float(ke1[tt >> 1]), c1); } else { ke0[tt >> 1] = __float_as_uint(c0); ke1[tt >> 1] = __float_as_uint(c1); } }
        *(LAS u32x4*)(KET + d2 * SS + 8 * g) = (u32x4){ke0[0], ke0[1], ke0[2], ke0[3]}; *(LAS u32x4*)(KET + (d2 + 1) * SS + 8 * g) = (u32x4){ke1[0], ke1[1], ke1[2], ke1[3]};
        if (g == 0) *(LAS f32x2*)(EBC + d2) = (f32x2){__expf(bC.x), __expf(bC.y)};
        load(lfw, qv, item + 2 * stride < NITEM ? item + 2 * stride : item);
        __syncthreads();
        for (int tile = w; tile < 10; tile += 8) { int qi, kj; tile_of(tile, qi, kj);
            f32x4 acc = {0.f, 0.f, 0.f, 0.f}; acc = mm(QH, SK, 16 * qi, KH, SK, koff[qi] + 16 * kj, 4, acc, lane);
#pragma unroll
            for (int r = 0; r < 4; ++r) { const int tl = 4 * lq + r; const float val = (qi != kj || lr <= tl) ? acc[r] : 0.f; P[(16 * qi + tl) * SS + 16 * kj + lr] = f2bf(val); } }
        __syncthreads();
        { unsigned char* img = IMG + (size_t)item * I_VT;
            for (int o = tid * 16; o < I_VT; o += NT * 16) *(GAS u32x4*)(img + o) = *(const LAS u32x4*)(F.lds + A_IMG + o); }
    };
    for (int item = first; item < NITEM; item += 2 * stride) { step(lfA, qvA, item); if (item + stride < NITEM) step(lfB, qvB, item + stride); }
}
__device__ __forceinline__ void hg_scan_phase(const Frame& F, const unsigned char* IMG, const bf16* VB, bf16* OF, const bf16* GB, const float* gn, bf16* Y, float* SSQP, unsigned* hcnt) {
    const int tid = F.tid, lane = F.lane, w = F.wave, lq = lane >> 4, lr = lane & 15;
    for (int unit = F.bid; unit < 256; unit += F.G) {
        const int xk = unit >> 3, vs = xk & 3, gq = (xk >> 2) * 8 + (unit & 7); const int b = gq >> 4, h = gq & 15;
        __syncthreads();
        f32x4 S0 = {0.f, 0.f, 0.f, 0.f}, S1 = {0.f, 0.f, 0.f, 0.f};
        constexpr int NC = I_VT / 16;
        const int p5 = tid + 5 * NT; const bool ok5 = p5 < NC; const int s5 = ok5 ? p5 * 16 : 0;
        const int sv = tid >> 3, v4 = (tid & 7) * 4; const size_t colv = (size_t)h * 128 + vs * 32 + v4;
        u32x4 rA[7], rB[7];
        auto load = [&](u32x4 (&r)[7], const int c) { const unsigned char* img = IMG + (size_t)(gq * 32 + c) * I_VT;
#pragma unroll
            for (int k = 0; k < 5; ++k) r[k] = *(GAS const u32x4*)(img + (tid + k * NT) * 16);
            r[5] = *(GAS const u32x4*)(img + s5); { const u32x2 vv = *(GAS const u32x2*)(VB + ((size_t)b * SEQ + (size_t)c * 64 + sv) * D + colv); r[6] = (u32x4){vv.x, vv.y, 0u, 0u}; } };
        load(rA, 0); load(rB, 1);
        auto step = [&](u32x4 (&r)[7], const int c) {
            LAS unsigned char* buf = F.lds + (c & 1) * B_BUF;
            LAS bf16* QE = (LAS bf16*)(buf + I_QE); LAS bf16* KET = (LAS bf16*)(buf + I_KET); LAS bf16* P = (LAS bf16*)(buf + I_P); LAS float* EBC = (LAS float*)(buf + I_EBC);
            LAS bf16* VT = (LAS bf16*)(buf + B_VT); LAS bf16* SB = (LAS bf16*)(buf + B_SB);
#pragma unroll
            for (int k = 0; k < 5; ++k) *(LAS u32x4*)(buf + (tid + k * NT) * 16) = r[k];
            if (ok5) *(LAS u32x4*)(buf + s5) = r[5];
            VT[(v4 + 0) * SS + sv] = (bf16)(r[6].x & 0xffffu); VT[(v4 + 1) * SS + sv] = (bf16)(r[6].x >> 16); VT[(v4 + 2) * SS + sv] = (bf16)(r[6].y & 0xffffu); VT[(v4 + 3) * SS + sv] = (bf16)(r[6].y >> 16);
            { u32x2 s0, s1; s0.x = pk2(S0[0], S0[1]); s0.y = pk2(S0[2], S0[3]); s1.x = pk2(S1[0], S1[1]); s1.y = pk2(S1[2], S1[3]);
                *(LAS u32x2*)(SB + lr * SK + 16 * w + 4 * lq) = s0; *(LAS u32x2*)(SB + (16 + lr) * SK + 16 * w + 4 * lq) = s1; }
            load(r, c + 2 < SEQ / 64 ? c + 2 : SEQ / 64 - 1);
            __syncthreads();
            { const int tq = w & 3, nv = w >> 2; f32x4 acc = {0.f, 0.f, 0.f, 0.f};
                acc = mm(P, SS, 16 * tq, VT, SS, 16 * nv, tq < 2 ? 1 : 2, acc, lane);
                acc = mm(QE, SK, 16 * tq, SB, SK, 16 * nv, 4, acc, lane);
                bf16* op = OF + ((size_t)b * SEQ + c * 64 + 16 * tq + 4 * lq) * D + h * 128 + vs * 32 + 16 * nv + (lr & ~1);
                store_pairs(op, acc, lr); }
            { f32x4 U0 = {0.f, 0.f, 0.f, 0.f}, U1 = {0.f, 0.f, 0.f, 0.f}; U0 = mm(KET, SS, 16 * w, VT, SS, 0, 2, U0, lane); U1 = mm(KET, SS, 16 * w, VT, SS, 16, 2, U1, lane);
                const f32x4 dec = *(const LAS f32x4*)(EBC + 16 * w + 4 * lq); S0 = S0 * dec + U0; S1 = S1 * dec + U1; }
        };
        for (int c = 0; c < SEQ / 64; c += 2) { step(rA, c); step(rB, c + 1); }
        if (hcnt) headnorm_tail<4, false>(F, OF, SSQP, hcnt + b * 16 + h, b, h * 128 + vs * 32, h * 4, vs, GB, D, h * 128 + vs * 32, gn + vs * 32, Y);
    }
}

__device__ __forceinline__ void ml_chunk_phase(const Frame& F, const bf16* PB, const float* gates, const float* bif, bf16* OF, const float* gn, bf16* Y, float* SSQP, unsigned* hcnt) {
    LAS bf16* QH = (LAS bf16*)(F.lds + O_QH); LAS bf16* KH = (LAS bf16*)(F.lds + O_KH); LAS bf16* KET = (LAS bf16*)(F.lds + O_KET);
    LAS bf16* VT = (LAS bf16*)(F.lds + O_VT); LAS bf16* P = (LAS bf16*)(F.lds + O_P); LAS bf16* SB = (LAS bf16*)(F.lds + O_SB);
    LAS float* GT0 = (LAS float*)(F.lds + O_GT + 2048);
    const int tid = F.tid, lane = F.lane, w = F.wave, lq = lane >> 4, lr = lane & 15;
    const int g = w, d2 = 2 * lane, sv = tid >> 3, v4 = (tid & 7) * 4;
    constexpr float S128 = 0.08838834764831845f;
    for (int unit = F.bid; unit < 256; unit += F.G) {
        const int xk = unit >> 3, vs = xk & 7, gq = (xk >> 3) * 8 + (unit & 7); const int b = gq >> 3, h = gq & 7;
        const float bi_ = *(GAS const float*)(bif + h), bf_ = *(GAS const float*)(bif + 8 + h);
        __syncthreads();
        for (int e = tid; e < 64 * SS / 2; e += NT) ((LAS unsigned*)P)[e] = 0u;
        for (int e = tid; e < 48 * SK / 2; e += NT) ((LAS unsigned*)SB)[e] = 0u;
        for (int e = tid; e < 16 * SS; e += NT) VT[32 * SS + e] = (e < 64) ? (bf16)0x3F80u : (bf16)0u;
        f32x4 S0 = {0.f, 0.f, 0.f, 0.f}, S1 = {0.f, 0.f, 0.f, 0.f}, S2 = {0.f, 0.f, 0.f, 0.f};
        unsigned qvA[8], kvA[8], qvB[8], kvB[8]; u32x2 vvA, vvB; float giA = 0.f, gfA = 0.f, giB = 0.f, gfB = 0.f;
        const size_t colq = (size_t)h * 128 + d2, colv = (size_t)2048 + h * 256 + vs * 32 + v4;
        auto load = [&](unsigned (&qv)[8], unsigned (&kv)[8], u32x2& vv, float& gi, float& gf, const int cc) { const size_t r0 = (size_t)b * SEQ + (size_t)cc * 64 + 8 * g;
#pragma unroll
            for (int tt = 0; tt < 8; ++tt) { qv[tt] = *(GAS const unsigned*)(PB + (r0 + tt) * ML_PROJ + colq); kv[tt] = *(GAS const unsigned*)(PB + (r0 + tt) * ML_PROJ + 1024 + colq); }
            vv = *(GAS const u32x2*)(PB + ((size_t)b * SEQ + (size_t)cc * 64 + sv) * ML_PROJ + colv);
            gi = *(GAS const float*)(gates + ((size_t)b * SEQ + (size_t)cc * 64 + lane) * 16 + h); gf = *(GAS const float*)(gates + ((size_t)b * SEQ + (size_t)cc * 64 + lane) * 16 + 8 + h); };
        load(qvA, kvA, vvA, giA, gfA, 0); load(qvB, kvB, vvB, giB, gfB, 1);
        auto step = [&](unsigned (&qv)[8], unsigned (&kv)[8], u32x2& vv, float& gi, float& gf, const int c) {
            LAS float* BT = GT0 + (c & 1) * 320; LAS float* WI = BT + 64; LAS float* WK = WI + 64; LAS float* EB = WK + 64; LAS float* EC = EB + 64;
            if (w == 0) {
                const float it = 15.0f * tanhf((gi + bi_) * (1.0f / 15.0f)); const float y = 15.0f * tanhf((gf + bf_) * (1.0f / 15.0f));
                const float lfv = -(fmaxf(-y, 0.f) + log1pf(expf(-fabsf(y))));
                float bt = lfv;
#pragma unroll
                for (int o = 1; o < 64; o <<= 1) { const float up = __shfl_up(bt, o); if (lane >= o) bt += up; }
                const float bC = __shfl(bt, 63);
                BT[lane] = bt; WI[lane] = it - bt; WK[lane] = __expf(bC - bt + it) * S128; EB[lane] = __expf(bt); if (lane == 0) EC[0] = __expf(bC);
            }
            __syncthreads();
            { u32x2 s0, s1, s2; s0.x = pk2(S0[0], S0[1]); s0.y = pk2(S0[2], S0[3]); s1.x = pk2(S1[0], S1[1]); s1.y = pk2(S1[2], S1[3]); s2.x = pk2(S2[0], S2[1]); s2.y = pk2(S2[2], S2[3]);
                *(LAS u32x2*)(SB + lr * SK + 16 * w + 4 * lq) = s0; *(LAS u32x2*)(SB + (16 + lr) * SK + 16 * w + 4 * lq) = s1; *(LAS u32x2*)(SB + (32 + lr) * SK + 16 * w + 4 * lq) = s2; }
            { unsigned ke0[4], ke1[4];
#pragma unroll
                for (int tt = 0; tt < 8; ++tt) { const int t = 8 * g + tt; *(LAS unsigned*)(QH + t * SK + d2) = qv[tt]; *(LAS unsigned*)(KH + t * SK + d2) = kv[tt];
                    const float wk = WK[t]; const float c0 = bflo(kv[tt]) * wk, c1 = bfhi(kv[tt]) * wk;
                    if (tt & 1) { ke0[tt >> 1] = pk2(__uint_as_float(ke0[tt >> 1]), c0); ke1[tt >> 1] = pk2(__uint_as_float(ke1[tt >> 1]), c1); } else { ke0[tt >> 1] = __float_as_uint(c0); ke1[tt >> 1] = __float_as_uint(c1); } }
                *(LAS u32x4*)(KET + d2 * SS + 8 * g) = (u32x4){ke0[0], ke0[1], ke0[2], ke0[3]}; *(LAS u32x4*)(KET + (d2 + 1) * SS + 8 * g) = (u32x4){ke1[0], ke1[1], ke1[2], ke1[3]}; }
            VT[(v4 + 0) * SS + sv] = (bf16)(vv.x & 0xffffu); VT[(v4 + 1) * SS + sv] = (bf16)(vv.x >> 16); VT[(v4 + 2) * SS + sv] = (bf16)(vv.y & 0xffffu); VT[(v4 + 3) * SS + sv] = (bf16)(vv.y >> 16);
            load(qv, kv, vv, gi, gf, c + 2 < SEQ / 64 ? c + 2 : SEQ / 64 - 1);
            __syncthreads();
            for (int tile = w; tile < 10; tile += 8) { int qi, kj; tile_of(tile, qi, kj);
                f32x4 acc = {0.f, 0.f, 0.f, 0.f}; acc = mm(QH, SK, 16 * qi, KH, SK, 16 * kj, 4, acc, lane);
                const float wis = WI[16 * kj + lr];
#pragma unroll
                for (int r = 0; r < 4; ++r) { const int tl = 4 * lq + r; const float wgt = __expf(BT[16 * qi + tl] + wis) * S128;
                    const float val = (qi != kj || lr <= tl) ? acc[r] * wgt : 0.f; P[(16 * qi + tl) * SS + 16 * kj + lr] = f2bf(val); } }
            __syncthreads();
            { const int tq = w & 3, nv = w >> 2, ksn = tq < 2 ? 1 : 2; f32x4 num = {0.f, 0.f, 0.f, 0.f}, den = num, qs = num, qn = num;
                num = mm(P, SS, 16 * tq, VT, SS, 16 * nv, ksn, num, lane); den = mm(P, SS, 16 * tq, VT, SS, 32, ksn, den, lane);
                qs = mm(QH, SK, 16 * tq, SB, SK, 16 * nv, 4, qs, lane); qn = mm(QH, SK, 16 * tq, SB, SK, 32, 4, qn, lane);
                const f32x4 eb = *(const LAS f32x4*)(EB + 16 * tq + 4 * lq);
                bf16* op = OF + ((size_t)b * SEQ + c * 64 + 16 * tq + 4 * lq) * D + h * 256 + vs * 32 + 16 * nv + (lr & ~1); f32x4 hv;
#pragma unroll
                for (int r = 0; r < 4; ++r) { const float nm = num[r] + eb[r] * qs[r]; float dn = den[r] + eb[r] * qn[r]; dn = __shfl(dn, lane & 48);
                    hv[r] = nm / fmaxf(fabsf(dn), 1.0f); }
                store_pairs(op, hv, lr); }
            { f32x4 U0 = {0.f, 0.f, 0.f, 0.f}, U1 = U0, U2 = U0; U0 = mm(KET, SS, 16 * w, VT, SS, 0, 2, U0, lane); U1 = mm(KET, SS, 16 * w, VT, SS, 16, 2, U1, lane); U2 = mm(KET, SS, 16 * w, VT, SS, 32, 2, U2, lane);
                const float dec = EC[0]; S0 = S0 * dec + U0; S1 = S1 * dec + U1; S2 = S2 * dec + U2; }
        };
        for (int c = 0; c < SEQ / 64; c += 2) { step(qvA, kvA, vvA, giA, gfA, c); step(qvB, kvB, vvB, giB, gfB, c + 1); }
        if (hcnt) headnorm_tail<8, true>(F, OF, SSQP, hcnt + b * 8 + h, b, h * 256 + vs * 32, h * 8, vs, PB, ML_PROJ, 4096 + h * 256 + vs * 32, gn + vs * 32, Y);
    }
}

constexpr int MA_KH = 0, MA_IMG = MA_KH + 64 * SK * 2, ML_IMG_BYTES = I_VT + 256 * SS * 2, MA_GS = MA_IMG + ML_IMG_BYTES, MA_END = MA_GS + 2 * 1280;
constexpr int MB_VT = I_VT, MB_SB = MB_VT + 48 * SS * 2, MB_BUF = MB_SB + 48 * SK * 2;
static_assert(MA_END <= CTRL && 2 * MB_BUF <= CTRL, "ml stage LDS maps");
__device__ __forceinline__ void ml_prep_phase(const Frame& F, const bf16* PB, const float* gates, const float* bif, unsigned char* IMG) {
    LAS bf16* KH = (LAS bf16*)(F.lds + MA_KH); LAS bf16* QH = (LAS bf16*)(F.lds + MA_IMG + I_QE); LAS bf16* KET = (LAS bf16*)(F.lds + MA_IMG + I_KET);
    LAS bf16* VT = (LAS bf16*)(F.lds + MA_IMG + I_VT); LAS bf16* P = (LAS bf16*)(F.lds + MA_IMG + I_P); LAS float* EBI = (LAS float*)(F.lds + MA_IMG + I_EBC);
    const int tid = F.tid, lane = F.lane, w = F.wave, lq = lane >> 4, lr = lane & 15;
    const int g = w, d2 = 2 * lane, tp = tid >> 4, vc = (tid & 15) * 16;
    constexpr float S128 = 0.08838834764831845f;
    constexpr int NITEM = BATCH * 8 * (SEQ / 64);
    __syncthreads();
    for (int e = tid; e < 64 * SS / 2; e += NT) ((LAS unsigned*)P)[e] = 0u;
    unsigned qvA[8], kvA[8], qvB[8], kvB[8]; float giA = 0.f, gfA = 0.f, giB = 0.f, gfB = 0.f;
    auto load = [&](unsigned (&qv)[8], unsigned (&kv)[8], float& gi, float& gf, const int item) { const int c = item & 31, gq = item >> 5, b = gq >> 3, h = gq & 7;
        const size_t r0 = (size_t)b * SEQ + (size_t)c * 64 + 8 * g, colq = (size_t)h * 128 + d2;
#pragma unroll
        for (int tt = 0; tt < 8; ++tt) { qv[tt] = *(GAS const unsigned*)(PB + (r0 + tt) * ML_PROJ + colq); kv[tt] = *(GAS const unsigned*)(PB + (r0 + tt) * ML_PROJ + 1024 + colq); }
        const size_t gr = ((size_t)b * SEQ + (size_t)c * 64 + lane) * 16 + h; gi = *(GAS const float*)(gates + gr) + *(GAS const float*)(bif + h); gf = *(GAS const float*)(gates + gr + 8) + *(GAS const float*)(bif + 8 + h); };
    const int first = F.bid, stride = F.G;
    if (first < NITEM) load(qvA, kvA, giA, gfA, first);
    if (first + stride < NITEM) load(qvB, kvB, giB, gfB, first + stride);
    int par = 0;
    auto step = [&](unsigned (&qv)[8], unsigned (&kv)[8], float& gi, float& gf, const int item) {
        LAS float* BT = (LAS float*)(F.lds + MA_GS) + par * 320; LAS float* WI = BT + 64; LAS float* WK = WI + 64; LAS float* EB = WK + 64; LAS float* EC = EB + 64;
        if (w == 0) {
            const float it = 15.0f * tanhf(gi * (1.0f / 15.0f)); const float y = 15.0f * tanhf(gf * (1.0f / 15.0f));
            const float lfv = -(fmaxf(-y, 0.f) + log1pf(expf(-fabsf(y))));
            float bt = lfv;
#pragma unroll
            for (int o = 1; o < 64; o <<= 1) { const float up = __shfl_up(bt, o); if (lane >= o) bt += up; }
            const float bC = __shfl(bt, 63);
            BT[lane] = bt; WI[lane] = it - bt; WK[lane] = __expf(bC - bt + it) * S128; EB[lane] = __expf(bt); if (lane == 0) EC[0] = __expf(bC);
        }
        __syncthreads();
        if (w == 0) { EBI[lane] = EB[lane]; if (lane == 0) EBI[64] = EC[0]; }
        { unsigned ke0[4], ke1[4];
#pragma unroll
            for (int tt = 0; tt < 8; ++tt) { const int t = 8 * g + tt; *(LAS unsigned*)(QH + t * SK + d2) = qv[tt]; *(LAS unsigned*)(KH + t * SK + d2) = kv[tt];
                const float wk = WK[t]; const float c0 = bflo(kv[tt]) * wk, c1 = bfhi(kv[tt]) * wk;
                if (tt & 1) { ke0[tt >> 1] = pk2(__uint_as_float(ke0[tt >> 1]), c0); ke1[tt >> 1] = pk2(__uint_as_float(ke1[tt >> 1]), c1); } else { ke0[tt >> 1] = __float_as_uint(c0); ke1[tt >> 1] = __float_as_uint(c1); } }
            *(LAS u32x4*)(KET + d2 * SS + 8 * g) = (u32x4){ke0[0], ke0[1], ke0[2], ke0[3]}; *(LAS u32x4*)(KET + (d2 + 1) * SS + 8 * g) = (u32x4){ke1[0], ke1[1], ke1[2], ke1[3]}; }
        load(qv, kv, gi, gf, item + 2 * stride < NITEM ? item + 2 * stride : item);
        __syncthreads();
        for (int tile = w; tile < 10; tile += 8) { int qi, kj; tile_of(tile, qi, kj);
            f32x4 acc = {0.f, 0.f, 0.f, 0.f}; acc = mm(QH, SK, 16 * qi, KH, SK, 16 * kj, 4, acc, lane);
            const float wis = WI[16 * kj + lr];
#pragma unroll
            for (int r = 0; r < 4; ++r) { const int tl = 4 * lq + r; const float wgt = __expf(BT[16 * qi + tl] + wis) * S128;
                const float val = (qi != kj || lr <= tl) ? acc[r] * wgt : 0.f; P[(16 * qi + tl) * SS + 16 * kj + lr] = f2bf(val); } }
        __syncthreads();
        { unsigned char* img = IMG + (size_t)item * I_VT;
            for (int o = tid * 16; o < I_VT; o += NT * 16) *(GAS u32x4*)(img + o) = *(const LAS u32x4*)(F.lds + MA_IMG + o); }
        par ^= 1;
    };
    for (int item = first; item < NITEM; item += 2 * stride) { step(qvA, kvA, giA, gfA, item); if (item + stride < NITEM) step(qvB, kvB, giB, gfB, item + stride); }
}
__device__ __forceinline__ void ml_scan_phase(const Frame& F, const unsigned char* IMG, bf16* OF, const bf16* PB, const float* gn, bf16* Y, float* SSQP, unsigned* hcnt) {
    const int tid = F.tid, lane = F.lane, w = F.wave, lq = lane >> 4, lr = lane & 15;
    for (int unit = F.bid; unit < 256; unit += F.G) {
        const int xk = unit >> 3, vs = xk & 7, gq = (xk >> 3) * 8 + (unit & 7); const int b = gq >> 3, h = gq & 7;
        __syncthreads();
#pragma unroll
        for (int bb = 0; bb < 2; ++bb) { LAS bf16* VTb = (LAS bf16*)(F.lds + bb * MB_BUF + MB_VT);
            for (int e = tid; e < 16 * SS; e += NT) VTb[32 * SS + e] = (e < 64) ? (bf16)0x3F80u : (bf16)0u; }
        f32x4 S0 = {0.f, 0.f, 0.f, 0.f}, S1 = {0.f, 0.f, 0.f, 0.f}, S2 = {0.f, 0.f, 0.f, 0.f};
        constexpr int NC = I_VT / 16;
        const int p5 = tid + 5 * NT; const bool ok5 = p5 < NC; const int s5 = ok5 ? p5 * 16 : 0;
        const int sv = tid >> 3, v4 = (tid & 7) * 4; const size_t colv = (size_t)2048 + h * 256 + vs * 32 + v4;
        u32x4 rA[7], rB[7];
        auto load = [&](u32x4 (&r)[7], const int c) { const unsigned char* img = IMG + (size_t)(gq * 32 + c) * I_VT;
#pragma unroll
            for (int k = 0; k < 5; ++k) r[k] = *(GAS const u32x4*)(img + (tid + k * NT) * 16);
            r[5] = *(GAS const u32x4*)(img + s5); { const u32x2 vv = *(GAS const u32x2*)(PB + ((size_t)b * SEQ + (size_t)c * 64 + sv) * ML_PROJ + colv); r[6] = (u32x4){vv.x, vv.y, 0u, 0u}; } };
        load(rA, 0); load(rB, 1);
        auto step = [&](u32x4 (&r)[7], const int c) {
            LAS unsigned char* buf = F.lds + (c & 1) * MB_BUF;
            LAS bf16* QH = (LAS bf16*)(buf + I_QE); LAS bf16* KET = (LAS bf16*)(buf + I_KET); LAS bf16* P = (LAS bf16*)(buf + I_P); LAS float* EB = (LAS float*)(buf + I_EBC);
            LAS bf16* VT = (LAS bf16*)(buf + MB_VT); LAS bf16* SB = (LAS bf16*)(buf + MB_SB);
#pragma unroll
            for (int k = 0; k < 5; ++k) *(LAS u32x4*)(buf + (tid + k * NT) * 16) = r[k];
            if (ok5) *(LAS u32x4*)(buf + s5) = r[5];
            VT[(v4 + 0) * SS + sv] = (bf16)(r[6].x & 0xffffu); VT[(v4 + 1) * SS + sv] = (bf16)(r[6].x >> 16); VT[(v4 + 2) * SS + sv] = (bf16)(r[6].y & 0xffffu); VT[(v4 + 3) * SS + sv] = (bf16)(r[6].y >> 16);
            { u32x2 s0, s1, s2; s0.x = pk2(S0[0], S0[1]); s0.y = pk2(S0[2], S0[3]); s1.x = pk2(S1[0], S1[1]); s1.y = pk2(S1[2], S1[3]); s2.x = pk2(S2[0], S2[1]); s2.y = pk2(S2[2], S2[3]);
                *(LAS u32x2*)(SB + lr * SK + 16 * w + 4 * lq) = s0; *(LAS u32x2*)(SB + (16 + lr) * SK + 16 * w + 4 * lq) = s1; *(LAS u32x2*)(SB + (32 + lr) * SK + 16 * w + 4 * lq) = s2; }
            load(r, c + 2 < SEQ / 64 ? c + 2 : SEQ / 64 - 1);
            __syncthreads();
            { const int tq = w & 3, nv = w >> 2, ksn = tq < 2 ? 1 : 2; f32x4 num = {0.f, 0.f, 0.f, 0.f}, den = num, qs = num, qn = num;
                num = mm(P, SS, 16 * tq, VT, SS, 16 * nv, ksn, num, lane); den = mm(P, SS, 16 * tq, VT, SS, 32, ksn, den, lane);
                qs = mm(QH, SK, 16 * tq, SB, SK, 16 * nv, 4, qs, lane); qn = mm(QH, SK, 16 * tq, SB, SK, 32, 4, qn, lane);
                const f32x4 eb = *(const LAS f32x4*)(EB + 16 * tq + 4 * lq);
                bf16* op = OF + ((size_t)b * SEQ + c * 64 + 16 * tq + 4 * lq) * D + h * 256 + vs * 32 + 16 * nv + (lr & ~1); f32x4 hv;
#pragma unroll
                for (int r4 = 0; r4 < 4; ++r4) { const float nm = num[r4] + eb[r4] * qs[r4]; float dn = den[r4] + eb[r4] * qn[r4]; dn = __shfl(dn, lane & 48);
                    hv[r4] = nm / fmaxf(fabsf(dn), 1.0f); }
                store_pairs(op, hv, lr); }
            { f32x4 U0 = {0.f, 0.f, 0.f, 0.f}, U1 = U0, U2 = U0; U0 = mm(KET, SS, 16 * w, VT, SS, 0, 2, U0, lane); U1 = mm(KET, SS, 16 * w, VT, SS, 16, 2, U1, lane); U2 = mm(KET, SS, 16 * w, VT, SS, 32, 2, U2, lane);
                const float dec = EB[64]; S0 = S0 * dec + U0; S1 = S1 * dec + U1; S2 = S2 * dec + U2; }
        };
        for (int c = 0; c < SEQ / 64; c += 2) { step(rA, c); step(rB, c + 1); }
        if (hcnt) headnorm_tail<8, true>(F, OF, SSQP, hcnt + b * 8 + h, b, h * 256 + vs * 32, h * 8, vs, PB, ML_PROJ, 4096 + h * 256 + vs * 32, gn + vs * 32, Y);
    }
}
}

template <bool ML>
__device__ __forceinline__ void headnorm_rows(const Frame& F, const bf16* OF, const float* gn, const bf16* gate, int ldg, bf16* Y) {
    constexpr int HD = ML ? 256 : 128, LPH = HD / 32;
    for (int row = F.gw; row < M; row += F.NGW) {
        const u32x4* p = (const u32x4*)(OF + (size_t)row * D + F.lane * 32);
        f32x4 v[8]; float ss = 0.f;
#pragma unroll
        for (int j = 0; j < 4; ++j) { const u32x4 w = p[j]; v[2 * j] = (f32x4){bflo(w.x), bfhi(w.x), bflo(w.y), bfhi(w.y)}; v[2 * j + 1] = (f32x4){bflo(w.z), bfhi(w.z), bflo(w.w), bfhi(w.w)}; }
#pragma unroll
        for (int j = 0; j < 8; ++j) ss += (v[j][0] * v[j][0] + v[j][1] * v[j][1]) + (v[j][2] * v[j][2] + v[j][3] * v[j][3]);
#pragma unroll
        for (int o = 1; o < LPH; o <<= 1) ss += __shfl_xor(ss, o);
        const float rstd = 1.0f / sqrtf(ss * (1.0f / HD) + EPS);
        const int cih = (F.lane * 32) % HD;
        const u32x4* gp = (const u32x4*)(gate + (size_t)row * ldg + F.lane * 32);
        u32x4* yp = (u32x4*)(Y + (size_t)row * D + F.lane * 32);
#pragma unroll
        for (int j = 0; j < 4; ++j) { const u32x4 gw = gp[j]; const f32x4 g0 = *(GAS const f32x4*)(gn + cih + 8 * j), g1 = *(GAS const f32x4*)(gn + cih + 8 * j + 4);
            float gg[8] = {bflo(gw.x), bfhi(gw.x), bflo(gw.y), bfhi(gw.y), bflo(gw.z), bfhi(gw.z), bflo(gw.w), bfhi(gw.w)};
            if constexpr (ML) {
#pragma unroll
                for (int i = 0; i < 8; ++i) gg[i] = sigmoidf_(gg[i]); }
            const f32x4 a = v[2 * j] * rstd * g0, c = v[2 * j + 1] * rstd * g1;
            u32x4 w; w.x = pk2(a[0] * gg[0], a[1] * gg[1]); w.y = pk2(a[2] * gg[2], a[3] * gg[3]); w.z = pk2(c[0] * gg[4], c[1] * gg[5]); w.w = pk2(c[2] * gg[6], c[3] * gg[7]);
            yp[j] = w; }
    }
}
__device__ __forceinline__ void lru_conv(const Frame& F, const bf16* UR, const float* cw, const float* cb, bf16* UCB) {
    constexpr int total = (M / 4) * (D / 8);
    const int first = F.bid * NT + F.tid, c8 = (first % (D / 8)) * 8;
    f32x4 w0[4], w1[4];
#pragma unroll
    for (int j = 0; j < 4; ++j) { w0[j] = *(GAS const f32x4*)(cw + j * D + c8); w1[j] = *(GAS const f32x4*)(cw + j * D + c8 + 4); }
    const f32x4 b0 = *(GAS const f32x4*)(cb + c8), b1 = *(GAS const f32x4*)(cb + c8 + 4);
    for (int idx = first; idx < total; idx += F.G * NT) {
        const int row0 = (idx / (D / 8)) * 4, t0 = row0 % SEQ;
        u32x4 u[7];
#pragma unroll
        for (int i = 0; i < 7; ++i) { u[i] = (u32x4){0u, 0u, 0u, 0u}; if (i >= 3 || t0 > 0) u[i] = *(GAS const u32x4*)(UR + (size_t)(row0 + i - 3) * D + c8); }
#pragma unroll
        for (int o = 0; o < 4; ++o) { f32x4 a0 = b0, a1 = b1;
#pragma unroll
            for (int j = 0; j < 4; ++j) { const u32x4 v = u[o + j];
                a0 += w0[j] * (f32x4){bflo(v.x), bfhi(v.x), bflo(v.y), bfhi(v.y)}; a1 += w1[j] * (f32x4){bflo(v.z), bfhi(v.z), bflo(v.w), bfhi(v.w)}; }
            u32x4 w; w.x = pk2(a0[0], a0[1]); w.y = pk2(a0[2], a0[3]); w.z = pk2(a1[0], a1[1]); w.w = pk2(a1[2], a1[3]);
            *(GAS u32x4*)(UCB + (size_t)(row0 + o) * D + c8) = w; }
    }
}
__device__ __forceinline__ void lru_scan(const Frame& F, const bf16* LA, const bf16* INP, const bf16* GBR, bf16* Y) {
    LAS float* CP = (LAS float*)F.lds; LAS float* CH = CP + 128 * 32; LAS float* QP = CH + 128 * 32; LAS float* QH = QP + 16 * 32; LAS float* HC = QH + 16 * 32;
    const int seg = F.tid >> 2, q = F.tid & 3, ch = F.tid & 31, part = F.tid >> 5;
    for (int unit = F.bid; unit < BATCH * 64; unit += F.G) {
        const int b = unit >> 6;
        __syncthreads();
        if (F.tid < 32) HC[F.tid] = 0.f;
        for (int half = 0; half < 2; ++half) {
            const size_t base = ((size_t)b * SEQ + half * (SEQ / 2) + seg * 8) * D + (unit & 63) * 32 + 8 * q;
            u32x4 la[8], xi[8];
#pragma unroll
            for (int j = 0; j < 8; ++j) { la[j] = *(GAS const u32x4*)(LA + base + (size_t)j * D); xi[j] = *(GAS const u32x4*)(INP + base + (size_t)j * D); }
            float sl[8], h[8];
#pragma unroll
            for (int e = 0; e < 8; ++e) { sl[e] = 0.f; h[e] = 0.f; }
#pragma unroll
            for (int j = 0; j < 8; ++j) {
                const float l8[8] = {bflo(la[j].x), bfhi(la[j].x), bflo(la[j].y), bfhi(la[j].y), bflo(la[j].z), bfhi(la[j].z), bflo(la[j].w), bfhi(la[j].w)};
                const float x8[8] = {bflo(xi[j].x), bfhi(xi[j].x), bflo(xi[j].y), bfhi(xi[j].y), bflo(xi[j].z), bfhi(xi[j].z), bflo(xi[j].w), bfhi(xi[j].w)};
#pragma unroll
                for (int e = 0; e < 8; ++e) { h[e] = __expf(l8[e]) * h[e] + x8[e]; sl[e] += l8[e]; } }
            __syncthreads();
            *(LAS f32x4*)(CP + seg * 32 + 8 * q) = (f32x4){__expf(sl[0]), __expf(sl[1]), __expf(sl[2]), __expf(sl[3])}; *(LAS f32x4*)(CP + seg * 32 + 8 * q + 4) = (f32x4){__expf(sl[4]), __expf(sl[5]), __expf(sl[6]), __expf(sl[7])};
            *(LAS f32x4*)(CH + seg * 32 + 8 * q) = (f32x4){h[0], h[1], h[2], h[3]}; *(LAS f32x4*)(CH + seg * 32 + 8 * q + 4) = (f32x4){h[4], h[5], h[6], h[7]};
            __syncthreads();
            { float p = 1.f, hh = 0.f;
#pragma unroll
                for (int s = 0; s < 8; ++s) { const float cp = CP[(part * 8 + s) * 32 + ch], cv = CH[(part * 8 + s) * 32 + ch]; hh = cp * hh + cv; p *= cp; }
                QP[part * 32 + ch] = p; QH[part * 32 + ch] = hh; }
            __syncthreads();
            { float carry = HC[ch];
                for (int s = 0; s < part; ++s) carry = QP[s * 32 + ch] * carry + QH[s * 32 + ch];
#pragma unroll
                for (int s = 0; s < 8; ++s) { const int o = (part * 8 + s) * 32 + ch; const float cp = CP[o], cv = CH[o]; CH[o] = carry; carry = cp * carry + cv; }
                __syncthreads();
                if (part == 15) HC[ch] = carry; }
            { const f32x4 c0 = *(const LAS f32x4*)(CH + seg * 32 + 8 * q), c1 = *(const LAS f32x4*)(CH + seg * 32 + 8 * q + 4);
                h[0] = c0[0]; h[1] = c0[1]; h[2] = c0[2]; h[3] = c0[3]; h[4] = c1[0]; h[5] = c1[1]; h[6] = c1[2]; h[7] = c1[3]; }
            u32x4 gg[8];
#pragma unroll
            for (int j = 0; j < 8; ++j) gg[j] = *(GAS const u32x4*)(GBR + base + (size_t)j * D);
#pragma unroll
            for (int j = 0; j < 8; ++j) { const u32x4 lw = la[j], xw = xi[j], gw = gg[j];
                const float l8[8] = {bflo(lw.x), bfhi(lw.x), bflo(lw.y), bfhi(lw.y), bflo(lw.z), bfhi(lw.z), bflo(lw.w), bfhi(lw.w)};
                const float x8[8] = {bflo(xw.x), bfhi(xw.x), bflo(xw.y), bfhi(xw.y), bflo(xw.z), bfhi(xw.z), bflo(xw.w), bfhi(xw.w)};
                const float g8[8] = {bflo(gw.x), bfhi(gw.x), bflo(gw.y), bfhi(gw.y), bflo(gw.z), bfhi(gw.z), bflo(gw.w), bfhi(gw.w)};
                float y[8];
#pragma unroll
                for (int e = 0; e < 8; ++e) { h[e] = __expf(l8[e]) * h[e] + x8[e]; y[e] = g8[e] * h[e]; }
                u32x4 w; w.x = pk2(y[0], y[1]); w.y = pk2(y[2], y[3]); w.z = pk2(y[4], y[5]); w.w = pk2(y[6], y[7]);
                *(GAS u32x4*)(Y + base + (size_t)j * D) = w; }
        }
    }
}
__device__ __forceinline__ void softmax_rows(const Frame& F, const float* S, bf16* P) {
    for (int row = F.gw; row < 16 * SEQ; row += F.NGW) {
        const f32x4 s = ((const f32x4*)(S + (size_t)row * NMEM))[F.lane];
        const float mx = wave_max(fmaxf(fmaxf(s[0], s[1]), fmaxf(s[2], s[3])));
        const f32x4 e = {__expf(s[0] - mx), __expf(s[1] - mx), __expf(s[2] - mx), __expf(s[3] - mx)};
        const float inv = 1.0f / wave_sum((e[0] + e[1]) + (e[2] + e[3]));
        u32x2 w; w.x = pk2(e[0] * inv, e[1] * inv); w.y = pk2(e[2] * inv, e[3] * inv); ((u32x2*)(P + (size_t)row * NMEM))[F.lane] = w;
    }
}


__device__ __forceinline__ int uni(int v) { return __builtin_amdgcn_readfirstlane(v); }
__device__ __forceinline__ Frame make_frame(unsigned ldsb) {
    Frame F; F.lds = (LAS unsigned char*)(size_t)__builtin_amdgcn_readfirstlane(ldsb);
    F.lane = (int)__builtin_amdgcn_mbcnt_hi(~0u, __builtin_amdgcn_mbcnt_lo(~0u, 0u));
    const unsigned key = hw_wave_key(); int w = 0;
#pragma unroll
    for (int i = 1; i < NWAVES; ++i) { const unsigned k = __builtin_amdgcn_readfirstlane(*(const LAS unsigned*)(F.lds + CTRL + 16 + 4 * i)); w = (k == key) ? i : w; }
    F.wave = w; F.tid = w * 64 + F.lane;
    F.bid = __builtin_amdgcn_readfirstlane(*(const LAS int*)(F.lds + CTRL + 48)); F.G = __builtin_amdgcn_readfirstlane(*(const LAS int*)(F.lds + CTRL + 52));
    F.gw = F.bid * NWAVES + F.wave; F.NGW = F.G * NWAVES; return F;
}
__device__ __forceinline__ void phase_end(const unsigned ldsb, int bar_) {
    if (uni(bar_)) { asm volatile("" ::: "memory"); const Frame F = make_frame(ldsb); XcdBarrier b; b.bar = (unsigned*)(F.ws() + WS_CTL); b.x = xb_xcc_id(); b.st = (volatile LAS unsigned*)(F.lds + CTRL); xcd_barrier(b, F.tid, (unsigned)F.G); }
}
#define PHASE_FN static __device__ __noinline__ __attribute__((not_tail_called)) void
#define PHASE_FN_G static __device__ __forceinline__ void

__device__ __forceinline__ int cvt_njobs(int l, int part) { return part == 0 ? ((l % 3) == 1 ? 2 + 1 + 32 : 2 + 1) : 3; }
__device__ __forceinline__ CvtJob cvt_job(const Frame& F, int l, int part, int j) {
    unsigned char* ws = F.ws(); const float* ng = F.in(I_NORMG); const int kind = l % 3, idx = l / 3;
    CvtJob J; J.gk = nullptr; J.off = 0; J.gu = 0; J.nvalid = 1 << 30;
    if (j == 0) { J.W = F.in(I_WGU) + (size_t)(l * 2 + part) * D * NGU; J.WT = (bf16*)(ws + WS_WGU + (size_t)(l * 2 + part) * SZ_WGU); J.K = D; J.ldw = NGU; J.nrows = NGU; J.gu = 1; J.gk = ng + ((size_t)l * 4 + (part ? 3 : 0)) * D; return J; }
    if (j == 1) { J.W = F.in(I_WDN) + (size_t)(l * 2 + part) * DFF * D; J.WT = (bf16*)(ws + WS_WDN + (size_t)(l * 2 + part) * SZ_WDN); J.K = DFF; J.ldw = D; J.nrows = D; return J; }
    if (part == 1) { J.K = D; J.ldw = D; J.nrows = D;
        if (kind == 0) { J.W = F.in(I_HGOUT) + (size_t)idx * D * D; J.WT = (bf16*)(ws + WS_HGOUT + (size_t)idx * SZ_WDD); }
        else if (kind == 1) { J.W = F.in(I_LRUOUT); J.WT = (bf16*)(ws + WS_LRUOUT); }
        else { J.W = F.in(I_MLOUT); J.WT = (bf16*)(ws + WS_MLOUT); }
        return J; }
    J.gk = ng + ((size_t)l * 4 + 1) * D; J.K = D;
    if (kind == 0) { J.W = F.in(I_HGIN) + (size_t)idx * D * 4 * D; J.WT = (bf16*)(ws + WS_HGIN + (size_t)idx * 4 * SZ_WDD); J.ldw = 4 * D; J.nrows = 4 * D; return J; }
    if (kind == 2) { J.W = F.in(I_MLIN); J.WT = (bf16*)(ws + WS_MLIN); J.ldw = ML_IN; J.nrows = ML_PROJ; return J; }
    if (j == 2) { J.W = F.in(I_LRUIN); J.WT = (bf16*)(ws + WS_LRUIN); J.ldw = 2 * D; J.nrows = 2 * D; return J; }
    { const int q = j - 3, g = q >> 4, blk = (q >> 1) & 7, jj = q & 1;
        J.gk = nullptr; J.W = F.in(g ? I_LRUWX : I_LRUWA) + (size_t)blk * 256 * 256; J.WT = (bf16*)(ws + WS_LRUG) + (size_t)(blk * 512 + jj * 256 + g * 128) * 256; J.K = 256; J.ldw = 256; J.nrows = 128; J.off = jj * 128; return J; }
}
__device__ __forceinline__ void convert_set(const Frame& F, int& rot, int l, int part, int num0 = 0, int num1 = 8) {
    const int nj = cvt_njobs(l, part);
    for (int j = 0; j < nj; ++j) { const CvtJob J = cvt_job(F, l, part, j); convert_job_rt(F, rot, J, num0, num1); }
}
constexpr int CVT_SC = 3;
PHASE_FN_G ph_prologue(unsigned ldsb, int bar_) {
    const Frame F = make_frame(ldsb);
    unsigned char* ws = F.ws(); int rot = 0;
    convert_set(F, rot, 0, 0);
    for (int l = 0; l < DEPTH; ++l) for (int kv = 0; kv < 2; ++kv) { CvtJob J; J.gk = nullptr; J.gu = 0; J.nvalid = 1 << 30; J.K = D; J.ldw = 2 * D; J.nrows = D; J.off = kv * D;
        J.W = F.in(I_XAKV) + (size_t)l * D * 2 * D; J.WT = (bf16*)(ws + (kv ? WS_WV : WS_WK) + (size_t)l * SZ_WDD); convert_job_rt(F, rot, J); }
    for (int l = 0; l < DEPTH; ++l) { CvtJob J; J.gk = nullptr; J.gu = 0; J.nvalid = 1 << 30; J.K = D; J.ldw = D; J.nrows = D; J.off = 0;
        J.W = F.in(I_XAO) + (size_t)l * D * D; J.WT = (bf16*)(ws + WS_WO + (size_t)l * SZ_WDD); convert_job_rt(F, rot, J); }
    { const float* wq = F.in(I_XAQ); const float* ngq = F.in(I_NORMG); bf16* wqn = (bf16*)(ws + WS_WQ);
      for (size_t i = (size_t)F.bid * NT + F.tid; i < (size_t)DEPTH * D * D / 8; i += (size_t)F.G * NT) { const size_t e = i * 8; const int l = (int)(e / ((size_t)D * D)), d = (int)((e / D) % D);
          const float g = ngq[((size_t)l * 4 + 2) * D + d]; const f32x4 a = __builtin_nontemporal_load((const f32x4*)(wq + e)), b = __builtin_nontemporal_load((const f32x4*)(wq + e + 4));
          u32x4 w; w.x = pk2(a[0] * g, a[1] * g); w.y = pk2(a[2] * g, a[3] * g); w.z = pk2(b[0] * g, b[1] * g); w.w = pk2(b[2] * g, b[3] * g); *(u32x4*)(wqn + e) = w; } }
    float* misc = (float*)(ws + WS_MISC);
    const int gt = F.bid * NT + F.tid, GT = F.G * NT;
    const float* hglb = F.in(I_HGLB); const float* lamp = F.in(I_LRULAM);
    for (int c = gt; c < 2048; c += GT) {
        const float p0 = hglb[c], p1 = hglb[2048 + c], p2 = hglb[4096 + c], p3 = hglb[6144 + c];
        const float mx = fmaxf(fmaxf(p0, p1), fmaxf(p2, p3)); const float e0 = expf(p0 - mx), e1 = expf(p1 - mx), e2 = expf(p2 - mx), e3 = expf(p3 - mx); const float inv = 1.0f / (e0 + e1 + e2 + e3);
        misc[MISC_LB / 4 + c] = 0.f; misc[MISC_LB / 4 + 2048 + c] = e1 * inv; misc[MISC_LB / 4 + 4096 + c] = (e1 + e2) * inv; misc[MISC_LB / 4 + 6144 + c] = (e1 + e2 + e3) * inv;
        const float lam = lamp[c]; const float sp = fmaxf(-lam, 0.f) + log1pf(expf(-fabsf(lam)));
        misc[MISC_C8 / 4 + c] = 8.0f * sp;
    }
    { const float* mlin = F.in(I_MLIN); const float* g21 = F.in(I_NORMG) + ((size_t)2 * 4 + 1) * D;
      bf16* wgb = (bf16*)(misc + MISC_MLWG / 4);
      for (int i = gt; i < 16 * 2048; i += GT) { const int c = i >> 11, k = i & 2047; const float w_ = g21[k] * mlin[(size_t)k * ML_IN + ML_PROJ + c]; wgb[i] = (bf16)(pk2(w_, w_) & 0xffffu); } }
    x_to_stream(F, F.in(I_X), (bf16*)(ws + WS_HB), misc + MISC_SSQ / 4);
    norm_rows<false>(F, F.in(I_MEM), F.in(I_MEMG), (bf16*)(ws + WS_MEMN), MMEM, nullptr, nullptr);
    phase_end(ldsb, bar_);
}

enum { NRM_FFN1 = 0, NRM_MIX = 1, NRM_ATT = 2, NRM_FFN2 = 3 };
PHASE_FN ph_final(unsigned ldsb) { const Frame F = make_frame(ldsb); unsigned char* ws = F.ws();
    if (X_F32) final_norm(F, (const float*)(ws + WS_X), F.in(I_FINALG), F.out()); else final_norm_bf(F, (const bf16*)(ws + WS_HB), (const float*)(ws + WS_MISC) + MISC_SSQ / 4, F.in(I_FINALG), F.out()); }
constexpr size_t CTL_HCNT = 32768;
constexpr size_t HG_IMG_OFF = 64 * MiB;
static_assert(HG_IMG_OFF + (size_t)BATCH * 16 * (SEQ / 64) * ck::IMG_BYTES <= 192 * MiB, "hg images");
PHASE_FN_G ph_hg_prep(unsigned ldsb, int bar_) { const Frame F = make_frame(ldsb); unsigned char* ws = F.ws();
    bf16* QB = (bf16*)(ws + WS_P0); bf16* VB = QB + (size_t)2 * M * D; const bf16* LF = (const bf16*)(ws + WS_P1);
    ck::hg_prep_phase(F, QB, LF, VB, ws + WS_P1 + HG_IMG_OFF); phase_end(ldsb, bar_); }
PHASE_FN_G ph_hg_recur(unsigned ldsb, int l_, int bar_) { const Frame F = make_frame(ldsb); unsigned char* ws = F.ws(); const int l = uni(l_);
    bf16* GB = (bf16*)(ws + WS_P0) + (size_t)3 * M * D; bf16* OF = (bf16*)(ws + WS_P1) + (size_t)M * D;
    const bool fuse = FUSE_TAIL && F.G >= 256;
    ck::hg_scan_phase(F, ws + WS_P1 + HG_IMG_OFF, (const bf16*)(ws + WS_P0) + (size_t)2 * M * D, OF, GB, F.in(I_HGG) + (l / 3) * HG_D, (bf16*)(ws + WS_YB), (float*)(ws + WS_SC), fuse ? (unsigned*)(ws + WS_CTL + CTL_HCNT) + l * 64 : nullptr); phase_end(ldsb, bar_); }
PHASE_FN ph_hg_norm(unsigned ldsb, int idx_, int bar_) { const Frame F = make_frame(ldsb); unsigned char* ws = F.ws(); const int idx = uni(idx_); if (FUSE_TAIL && F.G >= 256) return;
    bf16* GB = (bf16*)(ws + WS_P0) + (size_t)3 * M * D; const bf16* OF = (const bf16*)(ws + WS_P1) + (size_t)M * D;
    headnorm_rows<false>(F, OF, F.in(I_HGG) + idx * HG_D, GB, D, (bf16*)(ws + WS_YB)); phase_end(ldsb, bar_); }
static_assert(HG_IMG_OFF + (size_t)BATCH * 8 * (SEQ / 64) * ck::ML_IMG_BYTES <= 192 * MiB, "ml images");
PHASE_FN_G ph_ml_prep(unsigned ldsb, int bar_) { const Frame F = make_frame(ldsb); unsigned char* ws = F.ws();
    ck::ml_prep_phase(F, (const bf16*)(ws + WS_P0), (const float*)(ws + WS_MISC) + MISC_GATES / 4, F.in(I_MLBIF), ws + WS_P1 + HG_IMG_OFF); phase_end(ldsb, bar_); }
PHASE_FN_G ph_ml_recur(unsigned ldsb, int l_, int bar_) { const Frame F = make_frame(ldsb); unsigned char* ws = F.ws(); const int l = uni(l_); const bool fuse = FUSE_TAIL && F.G >= 256;
    ck::ml_scan_phase(F, ws + WS_P1 + HG_IMG_OFF, (bf16*)(ws + WS_P1), (const bf16*)(ws + WS_P0), F.in(I_MLG), (bf16*)(ws + WS_YB), (float*)(ws + WS_SC), fuse ? (unsigned*)(ws + WS_CTL + CTL_HCNT) + l * 64 : nullptr); phase_end(ldsb, bar_); }
PHASE_FN ph_ml_gates(unsigned ldsb, int bar_) { const Frame F = make_frame(ldsb); unsigned char* ws = F.ws(); const float* misc = (const float*)(ws + WS_MISC);
    ml_gates_rows(F, (const bf16*)(ws + WS_HB), misc + MISC_SSQ / 4, (const bf16*)(misc + MISC_MLWG / 4), (float*)(ws + WS_MISC) + MISC_GATES / 4); phase_end(ldsb, bar_); }
PHASE_FN ph_ml_norm(unsigned ldsb, int bar_) { const Frame F = make_frame(ldsb); unsigned char* ws = F.ws(); if (FUSE_TAIL && F.G >= 256) return;
    headnorm_rows<true>(F, (const bf16*)(ws + WS_P1), F.in(I_MLG), (const bf16*)(ws + WS_P0) + 4096, ML_PROJ, (bf16*)(ws + WS_YB)); phase_end(ldsb, bar_); }
PHASE_FN ph_lru_conv(unsigned ldsb, int bar_) { const Frame F = make_frame(ldsb); unsigned char* ws = F.ws();
    lru_conv(F, (const bf16*)(ws + WS_P1), F.in(I_CONVW), F.in(I_CONVB), (bf16*)(ws + WS_P0) + (size_t)M * D); phase_end(ldsb, bar_); }
PHASE_FN ph_lru_scan(unsigned ldsb, int bar_) { const Frame F = make_frame(ldsb); unsigned char* ws = F.ws();
    lru_scan(F, (const bf16*)(ws + WS_P1) + (size_t)4 * M * D, (const bf16*)(ws + WS_P1) + (size_t)2 * M * D, (const bf16*)(ws + WS_P0), (bf16*)(ws + WS_YB)); phase_end(ldsb, bar_); }
PHASE_FN ph_softmax(unsigned ldsb, int bar_) { const Frame F = make_frame(ldsb); unsigned char* ws = F.ws(); softmax_rows(F, (const float*)(ws + WS_SC), (bf16*)(ws + WS_PB)); phase_end(ldsb, bar_); }

PHASE_FN_G ph_gemm_kv(unsigned ldsb, int bar_) {
    const Frame F = make_frame(ldsb); unsigned char* ws = F.ws(); const int half = F.G >> 1;
    if (F.bid < half) { pg8::PlainSched<D, D, MMEM, 4 * D> S; S.gsub = half; S.coff = 0; S.init(F.lds, ws + WS_MEMN, ws + WS_WK);
        auto E = [=]() { const Frame F2 = make_frame(ldsb); unsigned char* ws = F2.ws(); return pg8::EpiBf16P{(bf16*)(ws + WS_KALL), 4 * D, 0, 0, 1.f, nullptr}; };
        pg8::gemm_phase(F.lds, F.tid, D, D, D, S, E); }
    else { pg8::PlainSched<D, D, MMEM, 4 * D> S; S.gsub = F.G - half; S.coff = half; S.init(F.lds, ws + WS_MEMN, ws + WS_WV);
        auto E = [=]() { const Frame F2 = make_frame(ldsb); unsigned char* ws = F2.ws(); return pg8::EpiBf16P{(bf16*)(ws + WS_VT), 4 * D, 0, 0, 1.f, nullptr}; };
        pg8::gemm_phase(F.lds, F.tid, D, D, D, S, E); }
    phase_end(ldsb, bar_);
}
PHASE_FN_G ph_gemm_mlin(unsigned ldsb, int bar_) {
    const Frame F = make_frame(ldsb); unsigned char* ws = F.ws();
    pg8::PlainSched<D, D, M, ML_PROJ> S; S.init(F.lds, ws + WS_HB, ws + WS_MLIN); auto E = [=]() { const Frame F2 = make_frame(ldsb); unsigned char* ws = F2.ws(); (void)ws; return pg8::EpiBf16P{(bf16*)(ws + WS_P0), ML_PROJ, 0, 0, 1.f, (const float*)(ws + WS_MISC) + MISC_SSQ / 4}; };
    pg8::gemm_phase(F.lds, F.tid, D, D, D, S, E); phase_end(ldsb, bar_);
}
PHASE_FN_G ph_gemm_qproj(unsigned ldsb, int l_, int bar_) {
    const Frame F = make_frame(ldsb); const int l = uni(l_); unsigned char* ws = F.ws();
    pg8::PlainSched<D, D, M, D> S; S.init(F.lds, ws + WS_HB, ws + WS_WQ + (size_t)l * SZ_WDD); auto E = [=]() { const Frame F2 = make_frame(ldsb); unsigned char* ws = F2.ws(); (void)ws; return pg8::EpiBf16P{(bf16*)(ws + WS_QB2), D, 0, 0, 1.f, (const float*)(ws + WS_MISC) + MISC_SSQ / 4}; };
    pg8::gemm_phase(F.lds, F.tid, D, D, D, S, E); phase_end(ldsb, bar_);
}
PHASE_FN_G ph_gemm_dn(unsigned ldsb, int l_, int f_, int bar_) {
    const Frame F = make_frame(ldsb); const int l = uni(l_), f = uni(f_) & 1; const float dsc = uni(f_) >= 2 ? 0.0f : 0.5f; unsigned char* ws = F.ws();
    pg8::PlainSched<DFF, DFF, M, D> S; S.init(F.lds, ws + WS_ACT, ws + WS_WDN + (size_t)(l * 2 + f) * SZ_WDN); auto E = [=]() { const Frame F2 = make_frame(ldsb); unsigned char* ws = F2.ws(); (void)ws; float* X = (float*)(ws + WS_X); const float* xin = (l == 0 && f == 0) ? F2.in(I_X) : X; return pg8::EpiResid{xin, X, (bf16*)(ws + WS_HB), (float*)(ws + WS_MISC) + MISC_SSQ / 4, dsc, F2.lds, F2.tid}; };
    pg8::gemm_phase(F.lds, F.tid, DFF, DFF, DFF, S, E); phase_end(ldsb, bar_);
}
enum { GR_MIXOUT = 0, GR_OPROJ, GR_PROBE0 };
PHASE_FN_G ph_gemm_resid(unsigned ldsb, int which_, int l_, int bar_) {
    const Frame F = make_frame(ldsb); const int which = uni(which_), l = uni(l_); unsigned char* ws = F.ws();
    const int kind = l % 3, idx = l / 3;
    const size_t wo = which == GR_OPROJ ? WS_WO + (size_t)l * SZ_WDD : (kind == 0 ? WS_HGOUT + (size_t)idx * SZ_WDD : (kind == 1 ? WS_LRUOUT : WS_MLOUT));
    const size_t ao = which == GR_OPROJ ? WS_OB : WS_YB; const float rs_ = which == GR_PROBE0 ? 0.0f : 1.0f;
    pg8::PlainSched<D, D, M, D> S; S.init(F.lds, ws + ao, ws + wo); auto E = [=]() { const Frame F2 = make_frame(ldsb); unsigned char* ws = F2.ws(); (void)ws; float* X = (float*)(ws + WS_X); return pg8::EpiResid{X, X, (bf16*)(ws + WS_HB), (float*)(ws + WS_MISC) + MISC_SSQ / 4, rs_, F2.lds, F2.tid}; };
    pg8::gemm_phase(F.lds, F.tid, D, D, D, S, E); phase_end(ldsb, bar_);
}
PHASE_FN_G ph_gemm_gu(unsigned ldsb, int l_, int f_, int bar_) {
    const Frame F = make_frame(ldsb); const int l = uni(l_), f = uni(f_); unsigned char* ws = F.ws();
    pg8::PlainSched<D, D, M, NGU> S; S.init(F.lds, ws + WS_HB, ws + WS_WGU + (size_t)(l * 2 + f) * SZ_WGU); auto E = [=]() { const Frame F2 = make_frame(ldsb); unsigned char* ws = F2.ws(); (void)ws; return pg8::EpiSwiGLU{(bf16*)(ws + WS_ACT), (const float*)(ws + WS_MISC) + MISC_SSQ / 4}; };
    pg8::gemm_phase(F.lds, F.tid, D, D, D, S, E);
    { constexpr int NU = (M / 256) * (NGU / 256); const int rounds = (NU + F.G - 1) / F.G, busy = NU - (rounds - 1) * F.G;
        const int nl = f ? l + 1 : l, np = f ? 0 : 1;
        if (nl < DEPTH && F.bid >= busy && busy < F.G) { Frame Fc = F; Fc.gw = (F.bid - busy) * NWAVES + F.wave; Fc.NGW = (F.G - busy) * NWAVES; int rot = 0; convert_set(Fc, rot, nl, np); } }
    phase_end(ldsb, bar_);
}
PHASE_FN_G ph_gemm_hgin(unsigned ldsb, int l_, int bar_) {
    const Frame F = make_frame(ldsb); const int l = uni(l_), idx = l / 3; unsigned char* ws = F.ws();
    pg8::PlainSched<D, D, M, 4 * D> S; S.init(F.lds, ws + WS_HB, ws + WS_HGIN + (size_t)idx * 4 * SZ_WDD);
    auto E = [=]() { const Frame F2 = make_frame(ldsb); unsigned char* ws = F2.ws(); (void)ws; return pg8::EpiHgIn{(bf16*)(ws + WS_P0), (bf16*)(ws + WS_P1), (const float*)(ws + WS_MISC) + MISC_LB / 4 + l * 2048, (const float*)(ws + WS_MISC) + MISC_SSQ / 4}; };
    pg8::gemm_phase(F.lds, F.tid, D, D, D, S, E); phase_end(ldsb, bar_);
}
PHASE_FN_G ph_gemm_lruin(unsigned ldsb, int bar_) {
    const Frame F = make_frame(ldsb); unsigned char* ws = F.ws();
    pg8::PlainSched<D, D, M, 2 * D> S; S.init(F.lds, ws + WS_HB, ws + WS_LRUIN); auto E = [=]() { const Frame F2 = make_frame(ldsb); unsigned char* ws = F2.ws(); (void)ws; return pg8::EpiLruIn{(bf16*)(ws + WS_P0), (bf16*)(ws + WS_P1), (const float*)(ws + WS_MISC) + MISC_SSQ / 4}; };
    pg8::gemm_phase(F.lds, F.tid, D, D, D, S, E); phase_end(ldsb, bar_);
}
PHASE_FN_G ph_gemm_lrugate(unsigned ldsb, int bar_) {
    const Frame F = make_frame(ldsb); unsigned char* ws = F.ws();
    bf16* UCB = (bf16*)(ws + WS_P0) + (size_t)M * D;
    pg8::PlainSched<D, 256, M, 4096, 1, 512> S; S.init(F.lds, UCB, ws + WS_LRUG);
    auto E = [=]() { const Frame F2 = make_frame(ldsb); unsigned char* ws = F2.ws(); (void)ws; bf16* P1b = (bf16*)(ws + WS_P1); return pg8::EpiLruGate{(const bf16*)(ws + WS_P0) + (size_t)M * D, F2.in(I_LRUBA), F2.in(I_LRUBX), (const float*)(ws + WS_MISC) + MISC_C8 / 4, P1b + (size_t)4 * M * D, P1b + (size_t)2 * M * D}; };
    pg8::gemm_phase(F.lds, F.tid, D, 256, 256, S, E); phase_end(ldsb, bar_);
}
PHASE_FN_G ph_gemm_scores(unsigned ldsb, int l_, int bar_) {
    const Frame F = make_frame(ldsb); const int l = uni(l_); unsigned char* ws = F.ws();
    pg8::BatchSched S; S.init(F.lds, ws + WS_QB2, ws + WS_KALL + (size_t)l * D * 2);
    S.a_b = SEQ * D * 2; S.a_h = XA_D * 2; S.a_pm = 256 * D * 2; S.b_b = NMEM * 4 * D * 2; S.b_h = XA_D * 2; S.b_pn = 0; S.nM = SEQ / 256; S.nN = 1; S.nwg = 16 * S.nM;
    auto E = [=]() { const Frame F2 = make_frame(ldsb); unsigned char* ws = F2.ws(); (void)ws; return pg8::EpiF32Z{(float*)(ws + WS_SC), 0.044194173824159216f}; };
    pg8::gemm_phase(F.lds, F.tid, D, 4 * D, XA_D, S, E);
    phase_end(ldsb, bar_);
}
PHASE_FN_G ph_gemm_pv(unsigned ldsb, int l_, int bar_) {
    const Frame F = make_frame(ldsb); const int l = uni(l_); unsigned char* ws = F.ws();
    pg8::BatchSched S; S.init(F.lds, ws + WS_PB, ws + WS_VT + (size_t)l * D * MMEM * 2);
    S.a_b = 4 * SEQ * NMEM * 2; S.a_h = SEQ * NMEM * 2; S.a_pm = 256 * NMEM * 2; S.b_b = NMEM * 2; S.b_h = XA_D * MMEM * 2; S.b_pn = 256 * MMEM * 2; S.nM = SEQ / 256; S.nN = 2; S.nwg = 16 * S.nM * 2;
    auto E = [=]() { const Frame F2 = make_frame(ldsb); unsigned char* ws = F2.ws(); (void)ws; return pg8::EpiBf16P{(bf16*)(ws + WS_OB), D, (size_t)SEQ * D, XA_D, 1.f, nullptr}; };
    pg8::gemm_phase(F.lds, F.tid, NMEM, MMEM, NMEM, S, E);
    phase_end(ldsb, bar_);
}

PHASE_FN_G ph_attn(unsigned ldsb, int l_, int bar_) {
    const Frame F = make_frame(ldsb); const int l = uni(l_); unsigned char* ws = F.ws();
    for (int u = F.bid; u < 256; u += F.G) {
        const int z = u >> 4, pm = (u >> 1) & 7, pn = u & 1, b = z >> 2, h = z & 3;
        bf16* Pc = (bf16*)(ws + (pn ? WS_SC : WS_PB)) + ((size_t)z * SEQ + pm * 256) * NMEM;
        { pg8::OneSched S; S.A = (const char*)((const bf16*)(ws + WS_QB2) + ((size_t)b * SEQ + pm * 256) * D + h * XA_D); S.B = (const char*)((const bf16*)(ws + WS_KALL) + (size_t)b * NMEM * 4 * D + (size_t)l * D + h * XA_D); S.u0 = pg8::Unit{pm, 0, z};
          auto E = [=]() { const Frame F2 = make_frame(ldsb); return pg8::EpiSoftmax{Pc, 0.044194173824159216f, F2.lds}; };
          pg8::gemm_phase(F.lds, F.tid, D, 4 * D, XA_D, S, E); }
        if (F.tid == 0) __builtin_amdgcn_fence(__ATOMIC_ACQUIRE, "agent");
        asm volatile("s_waitcnt vmcnt(0)" ::: "memory"); __syncthreads();
        { pg8::OneSched S; S.A = (const char*)Pc; S.B = (const char*)((const bf16*)(ws + WS_VT) + ((size_t)l * D + h * XA_D + pn * 256) * MMEM + b * NMEM); S.u0 = pg8::Unit{pm, pn, z};
          auto E = [=]() { const Frame F2 = make_frame(ldsb); unsigned char* ws2 = F2.ws(); return pg8::EpiBf16P{(bf16*)(ws2 + WS_OB), D, (size_t)SEQ * D, XA_D, 1.f, nullptr}; };
          pg8::gemm_phase(F.lds, F.tid, NMEM, MMEM, NMEM, S, E); }
    }
    phase_end(ldsb, bar_);
}

__device__ __forceinline__ void gtut_units(const Frame& F, const unsigned ldsb, int la, int lb, int gsub, int coff, int coff_ut) {
    unsigned char* ws = F.ws(); const int c = (F.bid >= coff && F.bid < coff + gsub) ? F.bid - coff : -1, cu = (F.bid >= coff_ut && F.bid < coff_ut + gsub) ? F.bid - coff_ut : -1;
    { pg8::GtSched S{(const char*)(ws + WS_KALL), (const char*)(ws + WS_WQ), gsub, c, la * 128, lb * 128};
      auto E = [=]() { const Frame F2 = make_frame(ldsb); unsigned char* ws2 = F2.ws(); return pg8::EpiBf16P{(bf16*)(ws2 + WS_GT), D, (size_t)4 * NMEM * D, (size_t)NMEM * D, 1.f, nullptr}; };
      pg8::gemm_phase(F.lds, F.tid, 4 * D, D, XA_D, S, E); }
    { pg8::UtSched S{(const char*)(ws + WS_WO), (const char*)(ws + WS_VT), gsub, cu, la * 128, lb * 128};
      auto E = [=]() { const Frame F2 = make_frame(ldsb); unsigned char* ws2 = F2.ws(); return pg8::EpiBf16P{(bf16*)(ws2 + WS_UT), 4 * NMEM, (size_t)D * 4 * NMEM, (size_t)NMEM, 1.f, nullptr}; };
      pg8::gemm_phase(F.lds, F.tid, D, 4 * D, XA_D, S, E); }
}
PHASE_FN_G ph_gemm_gtut(unsigned ldsb, int bar_) {
    const Frame F = make_frame(ldsb); if (F.G >= 256) gtut_units(F, ldsb, 0, 1, 128, 0, 128); else gtut_units(F, ldsb, 0, 1, F.G, 0, 0);
    phase_end(ldsb, bar_);
}
PHASE_FN_G ph_attn_scores(unsigned ldsb, int l_, int bar_) {
    const Frame F = make_frame(ldsb); const int l = uni(l_); unsigned char* ws = F.ws();
    pg8::ScSched S{(const char*)(ws + WS_HB), (const char*)(ws + WS_GT) + (size_t)l * 16 * NMEM * D * 2, F.G, F.bid};
    auto E = [=]() { const Frame F2 = make_frame(ldsb); unsigned char* ws2 = F2.ws(); return pg8::EpiSoftmax{(bf16*)(ws2 + WS_PB), 0.044194173824159216f, F2.lds, (const float*)(ws2 + WS_MISC) + MISC_SSQ / 4}; };
    pg8::gemm_phase(F.lds, F.tid, D, D, D, S, E);
    if (l + 1 < DEPTH) gtut_units(F, ldsb, l + 1, l + 2, F.G > 128 ? F.G - 128 : F.G, F.G > 128 ? 128 : 0, F.G > 128 ? 128 : 0);
    phase_end(ldsb, bar_);
}
PHASE_FN_G ph_gemm_attnout(unsigned ldsb, int l_, int bar_) {
    const Frame F = make_frame(ldsb); const int l = uni(l_); unsigned char* ws = F.ws();
    pg8::PlainSched<4 * NMEM, 4 * NMEM, M, D, 30, 0, 3, (unsigned)(D * 4 * NMEM * 2)> S; S.init(F.lds, ws + WS_PB, ws + WS_UT + (size_t)l * 4 * D * 4 * NMEM * 2);
    auto E = [=]() { const Frame F2 = make_frame(ldsb); unsigned char* ws2 = F2.ws(); float* X = (float*)(ws2 + WS_X); return pg8::EpiResid{X, X, (bf16*)(ws2 + WS_HB), (float*)(ws2 + WS_MISC) + MISC_SSQ / 4, 1.0f, F2.lds, F2.tid}; };
    pg8::gemm_phase(F.lds, F.tid, 4 * NMEM, 4 * NMEM, 4 * NMEM, S, E);
    phase_end(ldsb, bar_);
}

constexpr int SLOTS = 20, PH_LAYER0 = 3, PH_FINAL = PH_LAYER0 + DEPTH * SLOTS, N_PHASES = PH_FINAL + 1;
enum { SL_NORM0 = 0, SL_GU1, SL_DN1, SL_NORM1, SL_MIXIN, SL_MIXA, SL_MIXB, SL_MIXC, SL_MIXD, SL_MIXOUT, SL_NORM2, SL_QPROJ, SL_SCORES, SL_SOFTMAX, SL_PV, SL_OPROJ, SL_NORM3, SL_GU2, SL_DN2, SL_SPARE };
__host__ __device__ constexpr bool phase_used(int ph) {
    if (ph < PH_LAYER0 || ph == PH_FINAL) return true;
    const int l = (ph - PH_LAYER0) / SLOTS, s = (ph - PH_LAYER0) % SLOTS, kind = l % 3;
    if (s == SL_SPARE || s == SL_QPROJ || s == SL_SOFTMAX || s == SL_PV || s == SL_NORM0 || s == SL_NORM1 || s == SL_NORM2 || s == SL_NORM3) return false;
    if (s == SL_MIXC) return true;
    if (s == SL_MIXD) return kind == 2;
    return true;
}
__device__ __forceinline__ int ctl_lo(unsigned ldsb) { return __builtin_amdgcn_readfirstlane(*(volatile LAS int*)((LAS unsigned char*)(size_t)ldsb + CTRL + 56)); }
__device__ __forceinline__ int ctl_hi(unsigned ldsb) { return __builtin_amdgcn_readfirstlane(*(volatile LAS int*)((LAS unsigned char*)(size_t)ldsb + CTRL + 60)); }
#ifndef PROBE_SEL
#define PROBE_SEL -1
#endif
#if PROBE_SEL >= 0
#ifndef PROBE_AMP
#define PROBE_AMP 4
#endif
__host__ __device__ constexpr int probe_cls(int k) { if (k < PH_LAYER0) return PROBE_SEL >= 20 ? 20 + k : 0; if (k >= PH_FINAL) return 8; const int s = (k - PH_LAYER0) % SLOTS;
    { const int l = (k - PH_LAYER0) / SLOTS, kind = l % 3;
      if (PROBE_SEL >= 10) { if (kind == 0 && s == SL_MIXA) return 10; if (kind == 0 && s == SL_MIXB) return 16; if (kind == 1 && s == SL_MIXA) return 11; if (kind == 1 && s == SL_MIXB) return 12; if (kind == 1 && s == SL_MIXC) return 13;
          if (kind == 2 && s == SL_MIXA) return 14; if (kind == 2 && s == SL_MIXB) return 15; if (kind == 2 && s == SL_MIXC) return 17; if (kind == 2 && s == SL_MIXD) return 18; if (kind == 0 && s == SL_MIXC) return 19; return 99; } }
    return (s == SL_GU1 || s == SL_GU2) ? 1 : (s == SL_DN1 || s == SL_DN2) ? 2 : s == SL_MIXIN ? 3 : (s == SL_MIXA || s == SL_MIXB || s == SL_MIXC || s == SL_MIXD) ? 4 : s == SL_MIXOUT ? 5 : s == SL_SCORES ? 6 : 7; }
__device__ __forceinline__ void probe_t0(unsigned ldsb) { const Frame F = make_frame(ldsb); if (F.tid == 0) *(volatile LAS unsigned long long*)(F.lds + CTRL + 320) = __builtin_amdgcn_s_memrealtime(); }
__device__ __forceinline__ void probe_t1(unsigned ldsb, int cls) { const Frame F = make_frame(ldsb); if (F.tid == 0 && cls == PROBE_SEL) { const unsigned long long t1 = __builtin_amdgcn_s_memrealtime(), t0 = *(volatile LAS unsigned long long*)(F.lds + CTRL + 320);
        *(volatile LAS unsigned*)(F.lds + CTRL + 328) = *(volatile LAS unsigned*)(F.lds + CTRL + 328) + (unsigned)(t1 - t0); } }
#define RUN(k, fn, ...) do { const int hi_ = ctl_hi(ldsb); if (ctl_lo(ldsb) <= (k) && (k) < hi_) { probe_t0(ldsb); fn(ldsb, ##__VA_ARGS__, ((k) + 1 < hi_) ? 1 : 0); probe_t1(ldsb, probe_cls(k)); } } while (0)
#else
#define RUN(k, fn, ...) do { const int hi_ = ctl_hi(ldsb); if (ctl_lo(ldsb) <= (k) && (k) < hi_) fn(ldsb, ##__VA_ARGS__, ((k) + 1 < hi_) ? 1 : 0); } while (0)
#endif

template <int L> __device__ __forceinline__ void run_layer(const unsigned ldsb) {
    constexpr int pb = PH_LAYER0 + L * SLOTS, kind = L % 3;
    RUN(pb + SL_GU1, ph_gemm_gu, L, 0);
    RUN(pb + SL_DN1, ph_gemm_dn, L, 0);
    if constexpr (kind == 0) {
        RUN(pb + SL_MIXIN, ph_gemm_hgin, L);
        RUN(pb + SL_MIXA, ph_hg_prep);
        RUN(pb + SL_MIXB, ph_hg_recur, L);
        RUN(pb + SL_MIXC, ph_hg_norm, L / 3);
    } else if constexpr (kind == 1) {
        RUN(pb + SL_MIXIN, ph_gemm_lruin);
        RUN(pb + SL_MIXA, ph_lru_conv);
        RUN(pb + SL_MIXB, ph_gemm_lrugate);
        RUN(pb + SL_MIXC, ph_lru_scan);
    } else {
        RUN(pb + SL_MIXIN, ph_gemm_mlin);
        RUN(pb + SL_MIXA, ph_ml_gates);
        RUN(pb + SL_MIXB, ph_ml_prep);
        RUN(pb + SL_MIXC, ph_ml_recur, L);
        RUN(pb + SL_MIXD, ph_ml_norm);
    }
    RUN(pb + SL_MIXOUT, ph_gemm_resid, GR_MIXOUT, L);
    RUN(pb + SL_SCORES, ph_attn_scores, L);
    RUN(pb + SL_OPROJ, ph_gemm_attnout, L);
    RUN(pb + SL_GU2, ph_gemm_gu, L, 1);
    RUN(pb + SL_DN2, ph_gemm_dn, L, 1);
}

__global__ void __launch_bounds__(NT, 2) fwd_kernel(Args args) {
    extern __shared__ __attribute__((aligned(16))) unsigned char lds_raw[];
    LAS unsigned char* lds = (LAS unsigned char*)lds_raw;
    const unsigned ldsb = (unsigned)(size_t)lds;
    {
        const int tid = threadIdx.x, lane = tid & 63, wave = tid >> 6;
        LAS unsigned* cw = (LAS unsigned*)(lds + CTRL);
        if (tid < 4) cw[tid] = 0u;
        if (tid == 0) cw[82] = 0u;
        if (lane == 0) cw[4 + wave] = hw_wave_key();
        if (tid == 0) { cw[12] = blockIdx.x; cw[13] = gridDim.x; cw[14] = (unsigned)args.ph_lo; cw[15] = (unsigned)args.ph_hi;
            LAS unsigned long long* ap = (LAS unsigned long long*)(lds + CTRL + 64);
#pragma unroll
            for (int i = 0; i < 27; ++i) ap[i] = (unsigned long long)args.in[i];
            ap[27] = (unsigned long long)args.out; ap[28] = (unsigned long long)args.ws; }
        __syncthreads();
        if (args.ph_hi - args.ph_lo > 1 && tid == 0) (void)xb_add(&((unsigned*)(args.ws + WS_CTL))[XB_XCNT(xb_xcc_id())], 1u);
    }
    RUN(0, ph_prologue);
    RUN(1, ph_gemm_kv);
    RUN(2, ph_gemm_gtut);
    run_layer<0>(ldsb); run_layer<1>(ldsb); run_layer<2>(ldsb); run_layer<3>(ldsb);
    { if (ctl_lo(ldsb) <= PH_FINAL && PH_FINAL < ctl_hi(ldsb)) ph_final(ldsb); }
#if PROBE_SEL >= 0
    { const Frame F = make_frame(ldsb); if (F.bid == 0) { __syncthreads(); const unsigned acc = *(volatile LAS unsigned*)(F.lds + CTRL + 328);
        const unsigned long long tend = __builtin_amdgcn_s_memrealtime() + (unsigned long long)acc * PROBE_AMP; while (__builtin_amdgcn_s_memrealtime() < tend) __builtin_amdgcn_s_sleep(8); } }
#endif
}

extern "C" void kernel_launch(void* const* d_in, const int* in_sizes, int n_in, void* d_out, int out_size, void* d_ws, size_t ws_size, hipStream_t stream) {
    static int grid = 0;
    if (grid == 0) {
        if (n_in != 27 || in_sizes[0] != M * D || out_size != M * D || ws_size < WS_END) { fprintf(stderr, "kernel_launch: unexpected shapes (n_in %d, in0 %d, out %d, ws %zu < %zu)\n", n_in, n_in > 0 ? in_sizes[0] : -1, out_size, ws_size, (size_t)WS_END); grid = -1; return; }
        int dev = 0, cus = 0, per_cu = 0;
        if (hipGetDevice(&dev) != hipSuccess || hipDeviceGetAttribute(&cus, hipDeviceAttributeMultiprocessorCount, dev) != hipSuccess) { grid = -1; return; }
        if (hipFuncSetAttribute((const void*)fwd_kernel, hipFuncAttributeMaxDynamicSharedMemorySize, LDS_BYTES) != hipSuccess) { fprintf(stderr, "kernel_launch: hipFuncSetAttribute failed\n"); grid = -1; return; }
        if (hipOccupancyMaxActiveBlocksPerMultiprocessor(&per_cu, (const void*)fwd_kernel, NT, LDS_BYTES) != hipSuccess || per_cu < 1) fprintf(stderr, "kernel_launch: occupancy query reports %d\n", per_cu);
        (void)hipGetLastError();
        grid = cus;
    }
    if (grid < 0) return;
    if (hipMemsetAsync((char*)d_ws + WS_CTL, 0, CTL_BYTES, stream) != hipSuccess) { fprintf(stderr, "kernel_launch: memset failed\n"); return; }
    Args a{};
    for (int i = 0; i < 27; ++i) a.in[i] = (const float*)d_in[i];
    a.out = (float*)d_out; a.ws = (unsigned char*)d_ws;
#if MK_ONE_LAUNCH
    a.ph_lo = 0; a.ph_hi = N_PHASES;
    hipLaunchKernelGGL(fwd_kernel, dim3(grid), dim3(NT), LDS_BYTES, stream, a);
#else
    for (int ph = 0; ph < N_PHASES; ++ph) { if (!phase_used(ph)) continue; a.ph_lo = ph; a.ph_hi = ph + 1;
        hipLaunchKernelGGL(fwd_kernel, dim3(grid), dim3(NT), LDS_BYTES, stream, a);
        const hipError_t le = hipPeekAtLastError(); if (le != hipSuccess) { fprintf(stderr, "kernel_launch: launch of phase %d failed: %s\n", ph, hipGetErrorName(le)); break; } }
#endif
}
```

```cpp
#include <hip/hip_runtime.h>
#include <cstdio>
#include <cstdint>

#ifndef X_F32
#define X_F32 0
#endif
#ifndef MK_ONE_LAUNCH
#define MK_ONE_LAUNCH 1
#define FUSE_TAIL 0
#ifndef FUSE_TAIL
#define FUSE_TAIL 1
#endif
#endif

#define LAS __attribute__((address_space(3)))
typedef unsigned short bf16;
typedef short bf16x8 __attribute__((ext_vector_type(8)));
typedef float f32x4 __attribute__((ext_vector_type(4)));
typedef float f32x2 __attribute__((ext_vector_type(2)));
typedef unsigned u32x4 __attribute__((ext_vector_type(4)));
typedef unsigned u32x2 __attribute__((ext_vector_type(2)));
#define GAS __attribute__((address_space(1)))

constexpr int BATCH = 4, SEQ = 2048, D = 2048, DEPTH = 4, M = BATCH * SEQ;
constexpr int NMEM = 256, MMEM = BATCH * NMEM;
constexpr int DFF = 5504, NGU = 2 * DFF;
constexpr int HG_H = 16, HG_D = 128;
constexpr int ML_H = 8, ML_DQK = 128, ML_DV = 256, ML_IN = 6160, ML_PROJ = 6144;
constexpr int XA_H = 4, XA_D = 512;
constexpr float EPS = 1e-6f;
constexpr int LDS_BYTES = 147456;
constexpr int CTRL = LDS_BYTES - 512;

__device__ __forceinline__ unsigned pk2(float lo, float hi) { unsigned r; asm volatile("v_cvt_pk_bf16_f32 %0, %1, %2" : "=v"(r) : "v"(lo), "v"(hi)); return r; }
__device__ __forceinline__ float bflo(unsigned w) { return __uint_as_float(w << 16); }
__device__ __forceinline__ float bfhi(unsigned w) { return __uint_as_float(w & 0xffff0000u); }
__device__ __forceinline__ float sigmoidf_(float x) { return __builtin_amdgcn_rcpf(1.0f + __expf(-x)); }
__device__ __forceinline__ float siluf_(float x) { return x * sigmoidf_(x); }
__device__ __forceinline__ float gelu_tanh_(float x) { const float u = 0.7978845608028654f * (x + 0.044715f * x * x * x); const float t = 1.0f - 2.0f * __builtin_amdgcn_rcpf(__expf(2.0f * u) + 1.0f); return 0.5f * x * (1.0f + t); }
__device__ __forceinline__ float wave_sum(float v) {
#pragma unroll
    for (int o = 1; o < 64; o <<= 1) v += __shfl_xor(v, o);
    return v;
}
__device__ __forceinline__ float wave_max(float v) {
#pragma unroll
    for (int o = 1; o < 64; o <<= 1) v = fmaxf(v, __shfl_xor(v, o));
    return v;
}

__device__ __forceinline__ int lds_ld_i32(LAS unsigned char* p) { return __builtin_amdgcn_readfirstlane(*(volatile LAS int*)p); }
__device__ __forceinline__ const char* lds_ld_ptr(LAS unsigned char* p) { const unsigned lo = __builtin_amdgcn_readfirstlane(*(volatile LAS unsigned*)p), hi = __builtin_amdgcn_readfirstlane(*(volatile LAS unsigned*)(p + 4)); return (const char*)(((unsigned long long)hi << 32) | lo); }

namespace pg8 {
constexpr int BM = 256, BK = 64, HALF = 128, HTB = HALF * BK * 2, STAGE_BYTES = 8 * HTB, NXCD = 8, WGM = 8;
__host__ __device__ __forceinline__ int lds_byte(int r, int c) { const int st = (r >> 4) * 2 + (c >> 5), rr = r & 15, cc = c & 31, ob = rr * 64 + cc * 2; return st * 1024 + (ob ^ (((ob >> 9) & 1) << 5)); }
__host__ __device__ __forceinline__ void stage_rc(int b, int& R, int& C) { const int st = b / 1024, sb = b % 1024, swz = sb ^ (((sb >> 9) & 1) << 5); R = (st >> 1) * 16 + swz / 64; C = (st & 1) * 32 + (swz % 64) / 2; }
__host__ __device__ __forceinline__ int perm32(int rho) { const int n = rho >> 4, i = rho & 15; return 8 * (i >> 2) + 4 * n + (i & 3); }

struct Unit { int pm, pn, z; };

template <int LDA, int LDB, int MROWS, int NCOLS, int ZSHIFT = 30, int AZ = 0, int BPMSHIFT = 30, unsigned BPMSTRIDE = 0>
struct PlainSched {
    static constexpr int nM = MROWS / BM, nN = NCOLS / BM, nwg = nM * nN; static constexpr unsigned a_tile = BM * LDA * 2, b_tile = BM * LDB * 2;
    LAS unsigned char* lds; int gsub = 0, coff = 0;
    __device__ void init(LAS unsigned char* lds_, const void* A_, const void* B_) { lds = lds_;
        *(volatile LAS unsigned long long*)(lds + CTRL + 304) = (unsigned long long)A_; *(volatile LAS unsigned long long*)(lds + CTRL + 312) = (unsigned long long)B_; __syncthreads(); }
    __device__ bool next(int i, Unit& u) const {
        const int G = gsub > 0 ? gsub : lds_ld_i32(lds + CTRL + 52), c = lds_ld_i32(lds + CTRL + 48) - coff;
        const int L = i * G + c; if (L >= nwg) return false;
        int wgid = L; { constexpr int q = nwg / NXCD, r = nwg % NXCD; const int xcd = wgid % NXCD, off = wgid / NXCD; wgid = (xcd < r ? xcd * (q + 1) : r * (q + 1) + (xcd - r) * q) + off; }
        constexpr int nig = WGM * nN; const int gid = wgid / nig, fm = gid * WGM, gsz = (nM - fm) < WGM ? (nM - fm) : WGM;
        u.pm = fm + ((wgid % nig) % gsz); u.pn = (wgid % nig) / gsz; u.z = u.pn >> ZSHIFT; return true;
    }
    __device__ __forceinline__ const char* a_ptr(const Unit& u) const { return lds_ld_ptr(lds + CTRL + 304) + (size_t)((unsigned)u.pm * a_tile) + (size_t)((unsigned)u.z * (unsigned)AZ); }
    __device__ __forceinline__ const char* b_ptr(const Unit& u) const { return lds_ld_ptr(lds + CTRL + 312) + (size_t)((unsigned)u.pn * b_tile) + (size_t)((unsigned)(u.pm >> BPMSHIFT) * BPMSTRIDE); }
};
struct BatchSched {
    LAS unsigned char* lds; unsigned a_b, a_h, a_pm, b_b, b_h, b_pn; int nM, nN, nwg;
    __device__ void init(LAS unsigned char* lds_, const void* A_, const void* B_) { lds = lds_;
        *(volatile LAS unsigned long long*)(lds + CTRL + 304) = (unsigned long long)A_; *(volatile LAS unsigned long long*)(lds + CTRL + 312) = (unsigned long long)B_; __syncthreads(); }
    __device__ bool next(int i, Unit& u) const {
        const int G = lds_ld_i32(lds + CTRL + 52), c = lds_ld_i32(lds + CTRL + 48);
        const int L = i * G + c; if (L >= nwg) return false;
        const int per = nM * nN, z = L / per, r = L % per; u.pm = r % nM; u.pn = r / nM; u.z = z;
        return true;
    }
    __device__ __forceinline__ const char* a_ptr(const Unit& u) const { return lds_ld_ptr(lds + CTRL + 304) + (size_t)((unsigned)(u.z >> 2) * a_b) + (size_t)((unsigned)(u.z & 3) * a_h) + (size_t)((unsigned)u.pm * a_pm); }
    __device__ __forceinline__ const char* b_ptr(const Unit& u) const { return lds_ld_ptr(lds + CTRL + 312) + (size_t)((unsigned)(u.z >> 2) * b_b) + (size_t)((unsigned)(u.z & 3) * b_h) + (size_t)((unsigned)u.pn * b_pn); }
};

typedef f32x4 Acc[2][2][4][2];

__device__ __forceinline__ void load_rstd(const float* SSQ, int row0, float (&rs)[2][4]) {
#pragma unroll
    for (int ai = 0; ai < 2; ++ai)
#pragma unroll
        for (int m = 0; m < 4; ++m) { const float* p = SSQ + (size_t)(row0 + ai * HALF + m * 16) * 8; const f32x4 a = *(const f32x4*)p, b = *(const f32x4*)(p + 4);
            rs[ai][m] = __builtin_amdgcn_rsqf((((a[0] + a[1]) + (a[2] + a[3])) + ((b[0] + b[1]) + (b[2] + b[3]))) * (1.0f / D) + EPS); }
}
struct EpiBf16P {
    static constexpr bool PERM = true;
    bf16* O; int ldc; size_t zb, zh; float scale; const float* SSQ; int cgrp = 0; size_t cgs = 0;
    __device__ __forceinline__ void operator()(const Acc& acc, const Unit& u, int wr, int wc, int fr, int fq) const {
        bf16* base = O + (size_t)(u.z >> 2) * zb + (size_t)(u.z & 3) * zh; int pnl = u.pn;
        if (cgrp > 0) { base += (size_t)(u.pn / cgrp) * cgs; pnl = u.pn % cgrp; }
        const int row0 = u.pm * BM + wr * 64 + fr, col0 = pnl * BM + wc * 32 + 8 * fq;
        float rs[2][4];
        if (SSQ) load_rstd(SSQ, row0, rs); else {
#pragma unroll
            for (int ai = 0; ai < 2; ++ai)
#pragma unroll
                for (int m = 0; m < 4; ++m) rs[ai][m] = 1.0f; }
#pragma unroll
        for (int ai = 0; ai < 2; ++ai)
#pragma unroll
            for (int m = 0; m < 4; ++m) { bf16* rowp = base + (size_t)(row0 + ai * HALF + m * 16) * ldc + col0; const float sc = scale * rs[ai][m];
#pragma unroll
                for (int bj = 0; bj < 2; ++bj) { const f32x4 v0 = acc[ai][bj][m][0] * sc, v1 = acc[ai][bj][m][1] * sc;
                    u32x4 w; w.x = pk2(v0[0], v0[1]); w.y = pk2(v0[2], v0[3]); w.z = pk2(v1[0], v1[1]); w.w = pk2(v1[2], v1[3]);
                    *(u32x4*)(rowp + bj * HALF) = w; } }
    }
};
struct EpiMlIn {
    static constexpr bool PERM = true;
    bf16* PB; float* GATES; const float* SSQ;
    __device__ __forceinline__ void operator()(const Acc& acc, const Unit& u, int wr, int wc, int fr, int fq) const {
        const int row0 = u.pm * BM + wr * 64 + fr, col0 = u.pn * BM + wc * 32 + 8 * fq;
        float rs[2][4]; load_rstd(SSQ, row0, rs);
        if (u.pn < 24) {
#pragma unroll
            for (int ai = 0; ai < 2; ++ai)
#pragma unroll
                for (int m = 0; m < 4; ++m) { bf16* rowp = PB + (size_t)(row0 + ai * HALF + m * 16) * ML_PROJ + col0; const float sc = rs[ai][m];
#pragma unroll
                    for (int bj = 0; bj < 2; ++bj) { const f32x4 v0 = acc[ai][bj][m][0] * sc, v1 = acc[ai][bj][m][1] * sc;
                        u32x4 w; w.x = pk2(v0[0], v0[1]); w.y = pk2(v0[2], v0[3]); w.z = pk2(v1[0], v1[1]); w.w = pk2(v1[2], v1[3]);
                        *(u32x4*)(rowp + bj * HALF) = w; } }
        } else if (wc == 0 && fq < 2) {
#pragma unroll
            for (int ai = 0; ai < 2; ++ai)
#pragma unroll
                for (int m = 0; m < 4; ++m) { float* gp = GATES + (size_t)(row0 + ai * HALF + m * 16) * 16 + 8 * fq; const float sc = rs[ai][m];
                    *(f32x4*)gp = acc[ai][0][m][0] * sc; *(f32x4*)(gp + 4) = acc[ai][0][m][1] * sc; }
        }
    }
};
struct EpiSwiGLU {
    static constexpr bool PERM = true;
    bf16* O; const float* SSQ;
    __device__ __forceinline__ void operator()(const Acc& acc, const Unit& u, int wr, int wc, int fr, int fq) const {
        const int row0 = u.pm * BM + wr * 64 + fr, col0 = u.pn * HALF + wc * 32 + 8 * fq;
        float rs[2][4]; load_rstd(SSQ, row0, rs);
#pragma unroll
        for (int ai = 0; ai < 2; ++ai)
#pragma unroll
            for (int m = 0; m < 4; ++m) { bf16* p = O + (size_t)(row0 + ai * HALF + m * 16) * DFF + col0; const float sc = rs[ai][m];
                const f32x4 g0 = acc[ai][0][m][0] * sc, g1 = acc[ai][0][m][1] * sc, u0 = acc[ai][1][m][0] * sc, u1 = acc[ai][1][m][1] * sc;
                u32x4 w; w.x = pk2(siluf_(g0[0]) * u0[0], siluf_(g0[1]) * u0[1]); w.y = pk2(siluf_(g0[2]) * u0[2], siluf_(g0[3]) * u0[3]);
                w.z = pk2(siluf_(g1[0]) * u1[0], siluf_(g1[1]) * u1[1]); w.w = pk2(siluf_(g1[2]) * u1[2], siluf_(g1[3]) * u1[3]);
                *(u32x4*)p = w; }
    }
};
template <bool XF32> struct EpiResidT {
    static constexpr bool PERM = true;
    const float* Xin; float* Xout; bf16* XB; float* SSQ; float scale; LAS unsigned char* lds; int tid;
    __device__ __forceinline__ void operator()(const Acc& acc, const Unit& u, int wr, int wc, int fr, int fq) const {
        typedef __attribute__((address_space(1))) const f32x4 gcf4; typedef __attribute__((address_space(1))) f32x4 gf4; typedef __attribute__((address_space(1))) u32x4 gu4;
        typedef __attribute__((address_space(1))) const float gcf; typedef __attribute__((address_space(1))) float gf; typedef __attribute__((address_space(1))) bf16 gb;
        gcf* xin = (gcf*)Xin; gf* xout = (gf*)Xout; gb* xb = (gb*)XB;
        const int row0 = u.pm * BM + wr * 64 + fr, col0 = u.pn * BM + wc * 32 + 8 * fq;
        LAS float* red = (LAS float*)(lds + STAGE_BYTES);
#pragma unroll
        for (int ai = 0; ai < 2; ++ai)
#pragma unroll
            for (int m = 0; m < 4; ++m) { const unsigned off = (unsigned)(row0 + ai * HALF + m * 16) * (unsigned)D + (unsigned)col0; float ss = 0.f;
#pragma unroll
                for (int bj = 0; bj < 2; ++bj) { const unsigned o = off + bj * HALF; f32x4 x0, x1;
                    if constexpr (XF32) { x0 = *(gcf4*)(xin + o); x1 = *(gcf4*)(xin + o + 4); }
                    else { const u32x4 w = *(const gu4*)(xb + o); x0 = (f32x4){bflo(w.x), bfhi(w.x), bflo(w.y), bfhi(w.y)}; x1 = (f32x4){bflo(w.z), bfhi(w.z), bflo(w.w), bfhi(w.w)}; }
                    x0 += acc[ai][bj][m][0] * scale; x1 += acc[ai][bj][m][1] * scale;
                    if constexpr (XF32) { *(gf4*)(xout + o) = x0; *(gf4*)(xout + o + 4) = x1; }
                    u32x4 w; w.x = pk2(x0[0], x0[1]); w.y = pk2(x0[2], x0[3]); w.z = pk2(x1[0], x1[1]); w.w = pk2(x1[2], x1[3]); *(gu4*)(xb + o) = w;
                    ss += ((x0[0] * x0[0] + x0[1] * x0[1]) + (x0[2] * x0[2] + x0[3] * x0[3])) + ((x1[0] * x1[0] + x1[1] * x1[1]) + (x1[2] * x1[2] + x1[3] * x1[3]));
                    asm volatile("" ::: "memory"); }
                ss += __shfl_xor(ss, 16); ss += __shfl_xor(ss, 32);
                if (fq == 0) red[(ai * HALF + wr * 64 + m * 16 + fr) * 4 + wc] = ss; }
        asm volatile("s_waitcnt lgkmcnt(0)" ::: "memory"); __builtin_amdgcn_s_barrier(); asm volatile("" ::: "memory");
        if (tid < 256) { const f32x4 r = *(const LAS f32x4*)(red + tid * 4); SSQ[(size_t)(u.pm * BM + tid) * 8 + u.pn] = (r[0] + r[1]) + (r[2] + r[3]); }
        asm volatile("s_waitcnt lgkmcnt(0)" ::: "memory"); __builtin_amdgcn_s_barrier(); asm volatile("" ::: "memory");
    }
};
typedef EpiResidT<(X_F32 != 0)> EpiResid;
struct EpiHgIn {
    static constexpr bool PERM = true;
    bf16* P0; bf16* LF; const float* lb; const float* SSQ;
    __device__ __forceinline__ void operator()(const Acc& acc, const Unit& u, int wr, int wc, int fr, int fq) const {
        const int grp = u.pn >> 3; const int row0 = u.pm * BM + wr * 64 + fr, col0 = (u.pn & 7) * BM + wc * 32 + 8 * fq;
        float rs[2][4]; load_rstd(SSQ, row0, rs);
        if (grp == 1) {
#pragma unroll
            for (int bj = 0; bj < 2; ++bj) {
                const f32x4 l0 = *(const f32x4*)(lb + col0 + bj * HALF), l1 = *(const f32x4*)(lb + col0 + bj * HALF + 4);
                const float lbv[8] = {l0[0], l0[1], l0[2], l0[3], l1[0], l1[1], l1[2], l1[3]};
#pragma unroll
                for (int ai = 0; ai < 2; ++ai)
#pragma unroll
                    for (int m = 0; m < 4; ++m) { const size_t o = (size_t)(row0 + ai * HALF + m * 16) * D + col0 + bj * HALF;
                        const f32x4 v0 = acc[ai][bj][m][0] * rs[ai][m], v1 = acc[ai][bj][m][1] * rs[ai][m];
                        const float a[8] = {v0[0], v0[1], v0[2], v0[3], v1[0], v1[1], v1[2], v1[3]};
                        float lf[8];
#pragma unroll
                        for (int j = 0; j < 8; ++j) { const float e = __expf(-a[j]); const float sg = __builtin_amdgcn_rcpf(1.0f + e); const float om = 1.0f - lbv[j];
                            const float f = lbv[j] + om * sg; lf[j] = __logf(fmaxf(f, 1e-12f)); }
                        { u32x4 w; w.x = pk2(lf[0], lf[1]); w.y = pk2(lf[2], lf[3]); w.z = pk2(lf[4], lf[5]); w.w = pk2(lf[6], lf[7]); *(u32x4*)(LF + o) = w; }
                        asm volatile("" ::: "memory"); }
            }
        } else {
            bf16* dst = P0 + (size_t)grp * M * D;
#pragma unroll
            for (int ai = 0; ai < 2; ++ai)
#pragma unroll
                for (int m = 0; m < 4; ++m) { const size_t ro = (size_t)(row0 + ai * HALF + m * 16) * D + col0;
#pragma unroll
                    for (int bj = 0; bj < 2; ++bj) { const f32x4 v0 = acc[ai][bj][m][0] * rs[ai][m], v1 = acc[ai][bj][m][1] * rs[ai][m];
                        float a[8] = {v0[0], v0[1], v0[2], v0[3], v1[0], v1[1], v1[2], v1[3]};
                        if (grp != 2) {
#pragma unroll
                            for (int j = 0; j < 8; ++j) a[j] = siluf_(a[j]); }
                        u32x4 w; w.x = pk2(a[0], a[1]); w.y = pk2(a[2], a[3]); w.z = pk2(a[4], a[5]); w.w = pk2(a[6], a[7]);
                        *(u32x4*)(dst + ro + bj * HALF) = w; }
                    asm volatile("" ::: "memory"); }
        }
    }
};
struct EpiLruIn {
    static constexpr bool PERM = true;
    bf16* GBR; bf16* UR; const float* SSQ;
    __device__ __forceinline__ void operator()(const Acc& acc, const Unit& u, int wr, int wc, int fr, int fq) const {
        const int grp = u.pn >> 3; const int row0 = u.pm * BM + wr * 64 + fr, col0 = (u.pn & 7) * BM + wc * 32 + 8 * fq;
        float rs[2][4]; load_rstd(SSQ, row0, rs);
#pragma unroll
        for (int ai = 0; ai < 2; ++ai)
#pragma unroll
            for (int m = 0; m < 4; ++m) { const size_t ro = (size_t)(row0 + ai * HALF + m * 16) * D + col0;
#pragma unroll
                for (int bj = 0; bj < 2; ++bj) { const f32x4 v0 = acc[ai][bj][m][0] * rs[ai][m], v1 = acc[ai][bj][m][1] * rs[ai][m]; const size_t o = ro + bj * HALF;
                    if (grp == 0) { u32x4 w; w.x = pk2(gelu_tanh_(v0[0]), gelu_tanh_(v0[1])); w.y = pk2(gelu_tanh_(v0[2]), gelu_tanh_(v0[3])); w.z = pk2(gelu_tanh_(v1[0]), gelu_tanh_(v1[1])); w.w = pk2(gelu_tanh_(v1[2]), gelu_tanh_(v1[3]));
                        *(u32x4*)(GBR + o) = w; }
                    else { u32x4 w; w.x = pk2(v0[0], v0[1]); w.y = pk2(v0[2], v0[3]); w.z = pk2(v1[0], v1[1]); w.w = pk2(v1[2], v1[3]); *(u32x4*)(UR + o) = w; } } }
    }
};
struct EpiLruGate {
    static constexpr bool PERM = true;
    const bf16* UC; const float* ba; const float* bx; const float* c8; bf16* LA; bf16* INP;
    __device__ __forceinline__ void operator()(const Acc& acc, const Unit& u, int wr, int wc, int fr, int fq) const {
        const int row0 = u.pm * BM + wr * 64 + fr, ch = u.z * 256 + (u.pn & 1) * HALF + wc * 32 + 8 * fq;
        const f32x4 vba[2] = {*(const f32x4*)(ba + ch), *(const f32x4*)(ba + ch + 4)}, vbx[2] = {*(const f32x4*)(bx + ch), *(const f32x4*)(bx + ch + 4)}, vc8[2] = {*(const f32x4*)(c8 + ch), *(const f32x4*)(c8 + ch + 4)};
#pragma unroll
        for (int ai = 0; ai < 2; ++ai)
#pragma unroll
            for (int m = 0; m < 4; ++m) { const size_t o = (size_t)(row0 + ai * HALF + m * 16) * D + ch;
                const u32x4 uw = *(const u32x4*)(UC + o); const float uu[8] = {bflo(uw.x), bfhi(uw.x), bflo(uw.y), bfhi(uw.y), bflo(uw.z), bfhi(uw.z), bflo(uw.w), bfhi(uw.w)};
                float av[8], iv[8];
#pragma unroll
                for (int n = 0; n < 2; ++n) { const f32x4 pa = acc[ai][0][m][n] + vba[n], px = acc[ai][1][m][n] + vbx[n];
#pragma unroll
                    for (int j = 0; j < 4; ++j) { const float r = sigmoidf_(pa[j]), ig = sigmoidf_(px[j]); const float la = -vc8[n][j] * r;
                        const float x2 = -2.0f * la;
                        const float om = x2 < 0.02f ? x2 * (1.0f - 0.5f * x2 + x2 * x2 * 0.16666667f) : 1.0f - __expf(-x2);
                        const float mult = __builtin_amdgcn_sqrtf(fmaxf(om, 0.0f)); av[4 * n + j] = la; iv[4 * n + j] = mult * (ig * uu[4 * n + j]); } }
                { u32x4 wa, wi; wa.x = pk2(av[0], av[1]); wa.y = pk2(av[2], av[3]); wa.z = pk2(av[4], av[5]); wa.w = pk2(av[6], av[7]);
                    wi.x = pk2(iv[0], iv[1]); wi.y = pk2(iv[2], iv[3]); wi.z = pk2(iv[4], iv[5]); wi.w = pk2(iv[6], iv[7]); *(u32x4*)(LA + o) = wa; *(u32x4*)(INP + o) = wi; } asm volatile("" ::: "memory"); }
    }
};
struct EpiF32Z {
    static constexpr bool PERM = false;
    float* S; float scale;
    __device__ __forceinline__ void operator()(const Acc& acc, const Unit& u, int wr, int wc, int fr, int fq) const {
        float* base = S + (size_t)u.z * SEQ * NMEM; const int row0 = u.pm * BM + wr * 64 + fr, col0 = wc * 32 + 4 * fq;
#pragma unroll
        for (int ai = 0; ai < 2; ++ai)
#pragma unroll
            for (int m = 0; m < 4; ++m) { float* rowp = base + (size_t)(row0 + ai * HALF + m * 16) * NMEM + col0;
#pragma unroll
                for (int bj = 0; bj < 2; ++bj)
#pragma unroll
                    for (int n = 0; n < 2; ++n) *(f32x4*)(rowp + bj * HALF + n * 16) = acc[ai][bj][m][n] * scale; }
    }
};

struct GtSched { const char* Kall; const char* Wq; int G, c, L0, L1;
    __device__ bool next(int i, Unit& u) const { const int L = L0 + i * G + c; if (c < 0 || L >= L1) return false; u.pm = 0; u.pn = L & 7; u.z = L >> 3; return true; }
    __device__ __forceinline__ const char* a_ptr(const Unit& u) const { const int l = u.z >> 4, b = (u.z >> 2) & 3, h = u.z & 3; return Kall + ((size_t)b * NMEM * 4 * D + (size_t)l * D + h * XA_D) * 2; }
    __device__ __forceinline__ const char* b_ptr(const Unit& u) const { const int l = u.z >> 4, h = u.z & 3; return Wq + ((size_t)l * D * D + (size_t)u.pn * 256 * D + h * XA_D) * 2; }
};
struct UtSched { const char* Wo; const char* Vall; int G, c, L0, L1;
    __device__ bool next(int i, Unit& u) const { const int L = L0 + i * G + c; if (c < 0 || L >= L1) return false; u.pm = L & 7; u.pn = 0; u.z = L >> 3; return true; }
    __device__ __forceinline__ const char* a_ptr(const Unit& u) const { const int l = u.z >> 4, h = u.z & 3; return Wo + ((size_t)l * D * D + (size_t)u.pm * 256 * D + h * XA_D) * 2; }
    __device__ __forceinline__ const char* b_ptr(const Unit& u) const { const int l = u.z >> 4, b = (u.z >> 2) & 3, h = u.z & 3; return Vall + ((size_t)b * NMEM * 4 * D + (size_t)l * D + h * XA_D) * 2; }
};
struct ScSched { const char* XBp; const char* GTl; int G, c;
    __device__ bool next(int i, Unit& u) const { const int L = i * G + c; if (L >= 16 * 8) return false; u.pm = L & 7; u.pn = 0; u.z = L >> 3; return true; }
    __device__ __forceinline__ const char* a_ptr(const Unit& u) const { return XBp + ((size_t)(u.z >> 2) * SEQ + (size_t)u.pm * 256) * D * 2; }
    __device__ __forceinline__ const char* b_ptr(const Unit& u) const { return GTl + (size_t)u.z * NMEM * D * 2; }
};
struct OneSched {
    const char* A; const char* B; Unit u0;
    __device__ bool next(int i, Unit& u) const { if (i > 0) return false; u = u0; return true; }
    __device__ __forceinline__ const char* a_ptr(const Unit&) const { return A; }
    __device__ __forceinline__ const char* b_ptr(const Unit&) const { return B; }
};
struct EpiSoftmax {
    static constexpr bool PERM = true;
    bf16* Pall; float scale0; LAS unsigned char* lds; const float* SSQ;
    __device__ __forceinline__ void operator()(const Acc& acc, const Unit& u, int wr, int wc, int fr, int fq) const {
        LAS float* rmax = (LAS float*)(lds + STAGE_BYTES); LAS float* rsum = rmax + 1024;
        const int growb = (u.z >> 2) * SEQ + u.pm * BM; bf16* P = Pall + (size_t)growb * (4 * NMEM) + (u.z & 3) * NMEM;
        float rs[2][4]; load_rstd(SSQ, growb + wr * 64 + fr, rs);
        float mx[2][4];
#pragma unroll
        for (int ai = 0; ai < 2; ++ai)
#pragma unroll
            for (int m = 0; m < 4; ++m) { float v = -3.0e38f;
#pragma unroll
                for (int bj = 0; bj < 2; ++bj)
#pragma unroll
                    for (int n = 0; n < 2; ++n) { const f32x4 a = acc[ai][bj][m][n]; v = fmaxf(v, fmaxf(fmaxf(a[0], a[1]), fmaxf(a[2], a[3]))); }
                v = fmaxf(v, __shfl_xor(v, 16)); v = fmaxf(v, __shfl_xor(v, 32));
                if (fq == 0) rmax[(ai * HALF + wr * 64 + m * 16 + fr) * 4 + wc] = v; }
        asm volatile("s_waitcnt lgkmcnt(0)" ::: "memory"); __builtin_amdgcn_s_barrier(); asm volatile("" ::: "memory");
#pragma unroll
        for (int ai = 0; ai < 2; ++ai)
#pragma unroll
            for (int m = 0; m < 4; ++m) { const int rl = ai * HALF + wr * 64 + m * 16 + fr; const f32x4 r = *(const LAS f32x4*)(rmax + rl * 4); const float mxa = fmaxf(fmaxf(r[0], r[1]), fmaxf(r[2], r[3])); mx[ai][m] = mxa; const float scale = scale0 * rs[ai][m];
                float s = 0.f;
#pragma unroll
                for (int bj = 0; bj < 2; ++bj)
#pragma unroll
                    for (int n = 0; n < 2; ++n) { const f32x4 a = acc[ai][bj][m][n]; s += (__expf((a[0] - mxa) * scale) + __expf((a[1] - mxa) * scale)) + (__expf((a[2] - mxa) * scale) + __expf((a[3] - mxa) * scale)); }
                s += __shfl_xor(s, 16); s += __shfl_xor(s, 32);
                if (fq == 0) rsum[rl * 4 + wc] = s; }
        asm volatile("s_waitcnt lgkmcnt(0)" ::: "memory"); __builtin_amdgcn_s_barrier(); asm volatile("" ::: "memory");
#pragma unroll
        for (int ai = 0; ai < 2; ++ai)
#pragma unroll
            for (int m = 0; m < 4; ++m) { const int rl = ai * HALF + wr * 64 + m * 16 + fr; const f32x4 r = *(const LAS f32x4*)(rsum + rl * 4); const float inv = 1.0f / ((r[0] + r[1]) + (r[2] + r[3])); const float mxa = mx[ai][m]; const float scale = scale0 * rs[ai][m];
                bf16* rowp = P + (size_t)rl * (4 * NMEM) + wc * 32 + 8 * fq;
#pragma unroll
                for (int bj = 0; bj < 2; ++bj) { const f32x4 a0 = acc[ai][bj][m][0], a1 = acc[ai][bj][m][1];
                    u32x4 w; w.x = pk2(__expf((a0[0] - mxa) * scale) * inv, __expf((a0[1] - mxa) * scale) * inv); w.y = pk2(__expf((a0[2] - mxa) * scale) * inv, __expf((a0[3] - mxa) * scale) * inv);
                    w.z = pk2(__expf((a1[0] - mxa) * scale) * inv, __expf((a1[1] - mxa) * scale) * inv); w.w = pk2(__expf((a1[2] - mxa) * scale) * inv, __expf((a1[3] - mxa) * scale) * inv);
                    *(u32x4*)(rowp + bj * HALF) = w; } }
        asm volatile("s_waitcnt lgkmcnt(0)" ::: "memory"); __builtin_amdgcn_s_barrier(); asm volatile("" ::: "memory");
    }
};

template <class Epi, class Sched, class MkEpi, bool ALIGN_EPI = true, bool SP2 = true>
__device__ __forceinline__ void gemm_phase_(LAS unsigned char* lds, const int tid, const int lda, const int ldb, const int K, const Sched& S, const MkEpi& mk) {
    const int wid = __builtin_amdgcn_readfirstlane(tid >> 6), lane = tid & 63, wr = wid >> 2, wc = wid & 3, fr = lane & 15, fq = lane >> 4;
    int nt = K / BK; asm volatile("" : "+s"(nt));
    unsigned voffA[2], voffB[2];
#pragma unroll
    for (int i = 0; i < 2; ++i) { int R, C; stage_rc(tid * 16 + i * 8192, R, C); const int Rb = Epi::PERM ? ((R & ~31) + perm32(R & 31)) : R;
        voffA[i] = (unsigned)(R * lda + C) * 2u; voffB[i] = (unsigned)(Rb * ldb + C) * 2u; }
    constexpr unsigned kstep = BK * 2;
    const unsigned hstepA = (unsigned)(HALF * lda * 2), hstepB = (unsigned)(HALF * ldb * 2);
    const unsigned ldsw = (unsigned)wid * 1024u;
    const int aoff = lds_byte(wr * 64 + fr, fq * 8), boff = lds_byte(wc * 32 + fr, fq * 8);
#define PG8_SA(b, h) (((b) * 2 + (h)) * HTB)
#define PG8_SB(b, h) ((4 + (b) * 2 + (h)) * HTB)
#define PG8_STAGE(bufoff, gbase, voff) do { _Pragma("unroll") for (int _i = 0; _i < 2; ++_i) \
        __builtin_amdgcn_global_load_lds((const unsigned*)((const char*)(gbase) + (voff)[_i]), (LAS unsigned*)(lds + (bufoff) + ldsw + _i * 8192), 16, 0, 0); } while (0)
#define PG8_LDA(dst, b, h) do { _Pragma("unroll") for (int m = 0; m < 4; ++m) _Pragma("unroll") for (int k = 0; k < 2; ++k) dst[m][k] = *(const LAS bf16x8*)(lds + PG8_SA(b, h) + aoff + m * 2048 + k * 1024); } while (0)
#define PG8_LDB(dst, b, h) do { _Pragma("unroll") for (int n = 0; n < 2; ++n) _Pragma("unroll") for (int k = 0; k < 2; ++k) dst[n][k] = *(const LAS bf16x8*)(lds + PG8_SB(b, h) + boff + n * 2048 + k * 1024); } while (0)
#define PG8_MMA(ai, bj, At, Bt) do { __builtin_amdgcn_s_setprio(1); _Pragma("unroll") for (int m = 0; m < 4; ++m) _Pragma("unroll") for (int n = 0; n < 2; ++n) _Pragma("unroll") for (int k = 0; k < 2; ++k) \
        acc[ai][bj][m][n] = __builtin_amdgcn_mfma_f32_16x16x32_bf16(Bt[n][k], At[m][k], acc[ai][bj][m][n], 0, 0, 0); __builtin_amdgcn_s_setprio(0); } while (0)
#define PG8_WAIT_V(n) asm volatile("s_waitcnt vmcnt(" #n ")" ::: "memory")
#define PG8_WAIT_L(n) asm volatile("s_waitcnt lgkmcnt(" #n ")" ::: "memory")
#define PG8_BAR __builtin_amdgcn_s_barrier()
#define PG8_SCHED __builtin_amdgcn_sched_barrier(0)
    Unit cur, nxt; int ui = 0;
    if (!S.next(0, cur)) return;
    f32x4 acc[2][2][4][2];
#pragma unroll
    for (int a = 0; a < 2; ++a)
#pragma unroll
        for (int b = 0; b < 2; ++b)
#pragma unroll
            for (int m = 0; m < 4; ++m)
#pragma unroll
                for (int n = 0; n < 2; ++n) acc[a][b][m][n] = (f32x4){0.f, 0.f, 0.f, 0.f};
    bf16x8 At[4][2], B0[2][2], B1[2][2];
    const char* cA = S.a_ptr(cur); const char* cB = S.b_ptr(cur);
    if constexpr (SP2) {
        PG8_STAGE(PG8_SB(0, 0), cB, voffB); PG8_STAGE(PG8_SB(0, 1), cB + hstepB, voffB); PG8_STAGE(PG8_SA(0, 0), cA, voffA); PG8_STAGE(PG8_SA(0, 1), cA + hstepA, voffA);
        if (wr == 1) PG8_BAR;
        PG8_WAIT_V(2); PG8_BAR;
        PG8_STAGE(PG8_SB(1, 0), cB + kstep, voffB); PG8_STAGE(PG8_SA(1, 0), cA + kstep, voffA); PG8_STAGE(PG8_SB(1, 1), cB + hstepB + kstep, voffB);
        PG8_WAIT_V(6); PG8_BAR;
    } else {
        PG8_STAGE(PG8_SB(0, 0), cB, voffB); PG8_STAGE(PG8_SA(0, 0), cA, voffA); PG8_STAGE(PG8_SB(0, 1), cB + hstepB, voffB); PG8_STAGE(PG8_SA(0, 1), cA + hstepA, voffA);
        if (wr == 1) PG8_BAR;
        PG8_WAIT_V(4); PG8_BAR;
        PG8_STAGE(PG8_SB(1, 0), cB + kstep, voffB); PG8_STAGE(PG8_SA(1, 0), cA + kstep, voffA); PG8_STAGE(PG8_SB(1, 1), cB + hstepB + kstep, voffB);
        PG8_WAIT_V(6); PG8_BAR;
    }
    for (;;) {
        const bool has_next = S.next(ui + 1, nxt);
        if (!has_next) nxt = cur;
        const char* nA = S.a_ptr(nxt); const char* nB = S.b_ptr(nxt);
        for (int t = 0; t < nt; t += 2) {
            const bool last = (t == nt - 2);
            const char* a1 = cA + (size_t)(t + 1) * kstep;
            const char* a2 = last ? nA : cA + (size_t)(t + 2) * kstep; const char* b2 = last ? nB : cB + (size_t)(t + 2) * kstep;
            const char* a3 = a2 + kstep; const char* b3 = b2 + kstep;
            if constexpr (SP2) {
            PG8_LDB(B0, 0, 0); PG8_LDB(B1, 0, 1); PG8_SCHED; PG8_LDA(At, 0, 0); PG8_STAGE(PG8_SA(1, 1), a1 + hstepA, voffA);
            PG8_WAIT_V(8); PG8_WAIT_L(0); PG8_BAR; PG8_MMA(0, 0, At, B0); PG8_MMA(0, 1, At, B1); PG8_BAR; PG8_SCHED;
            PG8_LDA(At, 0, 1); PG8_STAGE(PG8_SB(0, 0), b2, voffB); PG8_STAGE(PG8_SB(0, 1), b2 + hstepB, voffB); PG8_STAGE(PG8_SA(0, 0), a2, voffA);
            PG8_WAIT_V(8); PG8_WAIT_L(0); PG8_BAR; PG8_MMA(1, 0, At, B0); PG8_MMA(1, 1, At, B1); PG8_BAR; PG8_SCHED;
            PG8_LDB(B0, 1, 0); PG8_LDB(B1, 1, 1); PG8_SCHED; PG8_LDA(At, 1, 0); PG8_STAGE(PG8_SA(0, 1), a2 + hstepA, voffA);
            PG8_WAIT_V(8); PG8_WAIT_L(0); PG8_BAR; PG8_MMA(0, 0, At, B0); PG8_MMA(0, 1, At, B1); PG8_BAR; PG8_SCHED;
            PG8_LDA(At, 1, 1); PG8_STAGE(PG8_SB(1, 0), b3, voffB); PG8_STAGE(PG8_SB(1, 1), b3 + hstepB, voffB); PG8_STAGE(PG8_SA(1, 0), a3, voffA);
            PG8_WAIT_V(8); PG8_WAIT_L(0); PG8_BAR; PG8_MMA(1, 0, At, B0); PG8_MMA(1, 1, At, B1); PG8_BAR; PG8_SCHED;
            } else {
            PG8_LDB(B0, 0, 0); PG8_SCHED; PG8_LDA(At, 0, 0); PG8_STAGE(PG8_SA(1, 1), a1 + hstepA, voffA);
            PG8_WAIT_L(8); PG8_BAR; PG8_WAIT_L(0); PG8_MMA(0, 0, At, B0); PG8_BAR; PG8_SCHED;
            PG8_LDB(B1, 0, 1); PG8_STAGE(PG8_SB(0, 0), b2, voffB);
            PG8_BAR; PG8_WAIT_L(0); PG8_MMA(0, 1, At, B1); PG8_BAR;
            PG8_LDA(At, 0, 1); PG8_STAGE(PG8_SA(0, 0), a2, voffA);
            PG8_BAR; PG8_WAIT_L(0); PG8_MMA(1, 0, At, B0); PG8_BAR; PG8_SCHED;
            PG8_STAGE(PG8_SB(0, 1), b2 + hstepB, voffB);
            PG8_WAIT_V(6); PG8_BAR; PG8_MMA(1, 1, At, B1); PG8_BAR;
            PG8_LDB(B0, 1, 0); PG8_SCHED; PG8_LDA(At, 1, 0); PG8_STAGE(PG8_SA(0, 1), a2 + hstepA, voffA);
            PG8_WAIT_L(8); PG8_BAR; PG8_WAIT_L(0); PG8_MMA(0, 0, At, B0); PG8_BAR; PG8_SCHED;
            PG8_LDB(B1, 1, 1); PG8_STAGE(PG8_SB(1, 0), b3, voffB);
            PG8_BAR; PG8_WAIT_L(0); PG8_MMA(0, 1, At, B1); PG8_BAR;
            PG8_LDA(At, 1, 1); PG8_STAGE(PG8_SA(1, 0), a3, voffA);
            PG8_BAR; PG8_WAIT_L(0); PG8_MMA(1, 0, At, B0); PG8_BAR; PG8_SCHED;
            PG8_STAGE(PG8_SB(1, 1), b3 + hstepB, voffB);
            PG8_WAIT_V(6); PG8_BAR; PG8_MMA(1, 1, At, B1); PG8_BAR;
            }
        }
        if constexpr (ALIGN_EPI) { if (wr == 0) PG8_BAR; }
        { asm volatile("" ::: "memory"); const Epi E = mk(); E(acc, cur, wr, wc, fr, fq); }
        if (!has_next) break;
#pragma unroll
        for (int a = 0; a < 2; ++a)
#pragma unroll
            for (int b = 0; b < 2; ++b)
#pragma unroll
                for (int m = 0; m < 4; ++m)
#pragma unroll
                    for (int n = 0; n < 2; ++n) acc[a][b][m][n] = (f32x4){0.f, 0.f, 0.f, 0.f};
        cur = nxt; cA = nA; cB = nB; ++ui;
        if constexpr (ALIGN_EPI) { if (wr == 1) PG8_BAR; }
    }
    PG8_WAIT_V(0);
    if constexpr (!ALIGN_EPI) { if (wr == 0) PG8_BAR; }
    PG8_BAR;
#undef PG8_SA
#undef PG8_SB
#undef PG8_STAGE
#undef PG8_LDA
#undef PG8_LDB
#undef PG8_MMA
#undef PG8_WAIT_V
#undef PG8_WAIT_L
#undef PG8_BAR
#undef PG8_SCHED
}
template <class MkEpi, class Sched> __device__ __forceinline__ void gemm_phase(LAS unsigned char* lds, const int tid, const int lda, const int ldb, const int K, const Sched& S, const MkEpi& mk) {
    gemm_phase_<decltype(mk()), Sched, MkEpi>(lds, tid, lda, ldb, K, S, mk); }
}

#define XB_TMO      128
#define XB_XCNT(j)  (256  + 64 * (j))
#define XB_XSUB(j)  (1280 + 64 * (j))
#define XB_XGEN(j)  (2304 + 64 * (j))
#define XB_TOP      3328
#define XB_TOPGEN   3392
#define XCD_BAR_WORDS 3456
#define XB_SPIN_CAP (1u << 18)

__device__ __forceinline__ unsigned xb_ld(unsigned* p)              { return __hip_atomic_load(p, __ATOMIC_RELAXED, __HIP_MEMORY_SCOPE_AGENT); }
__device__ __forceinline__ unsigned xb_add(unsigned* p, unsigned v) { return __hip_atomic_fetch_add(p, v, __ATOMIC_RELAXED, __HIP_MEMORY_SCOPE_AGENT); }
__device__ __forceinline__ unsigned xb_xcc_id() { return (unsigned)__builtin_amdgcn_s_getreg((3 << 11) | 20) & 0xFu; }
#define XB_SPIN(cond, bar) do { unsigned _sp = 0; while (cond) { __builtin_amdgcn_s_sleep(1); \
    if ((++_sp & 255u) == 0u) { if (xb_ld(&(bar)[XB_TMO])) break; if (_sp > XB_SPIN_CAP) { atomicAdd(&(bar)[XB_TMO], 1u); break; } } } } while (0)

struct XcdBarrier { unsigned* bar; unsigned x; volatile LAS unsigned* st; };

__device__ __forceinline__ XcdBarrier xcd_barrier_post(unsigned* bar, volatile LAS unsigned* st) {
    XcdBarrier b; b.bar = bar; b.x = xb_xcc_id(); b.st = st;
    if (threadIdx.x == 0) (void)xb_add(&bar[XB_XCNT(b.x)], 1u);
    return b;
}
__device__ __forceinline__ void xcd_barrier_complete(unsigned* bar, unsigned x, unsigned& nloc, unsigned& nx, const unsigned G) {
    unsigned sum, cnt, mine, sp = 0u;
    for (;;) {
        sum = 0u; cnt = 0u; mine = 0u;
#pragma unroll
        for (unsigned j = 0; j < 16; ++j) { const unsigned c = xb_ld(&bar[XB_XCNT(j)]); sum += c; cnt += (c > 0u) ? 1u : 0u; mine = (j == x) ? c : mine; }
        if (sum == G) break;
        __builtin_amdgcn_s_sleep(1);
        if ((++sp & 255u) == 0u) { if (xb_ld(&bar[XB_TMO])) break; if (sp > XB_SPIN_CAP) { atomicAdd(&bar[XB_TMO], 1u); break; } }
    }
    nloc = mine > 0u ? mine : 1u; nx = cnt > 0u ? cnt : 1u;
}
__device__ __forceinline__ void xcd_barrier(const XcdBarrier& b, const int tid, const unsigned G) {
    asm volatile("s_waitcnt vmcnt(0)" ::: "memory");
    __syncthreads();
    if (tid == 0) {
        unsigned* bar = b.bar;
        __builtin_amdgcn_s_waitcnt(0);
        unsigned nloc = b.st[0], nx = b.st[1];
        if (nloc == 0u) { xcd_barrier_complete(bar, b.x, nloc, nx, G); b.st[0] = nloc; b.st[1] = nx; }
        const unsigned old = xb_add(&bar[XB_XSUB(b.x)], 1u);
        const unsigned gen = old / nloc;
        if (old + 1u == (gen + 1u) * nloc) {
            __builtin_amdgcn_fence(__ATOMIC_RELEASE, "agent");
            asm volatile("s_waitcnt vmcnt(0)" ::: "memory");
            const unsigned og = xb_add(&bar[XB_TOP], 1u);
            const unsigned tg = og / nx;
            if (og + 1u == (tg + 1u) * nx) xb_add(&bar[XB_TOPGEN], 1u);
            else XB_SPIN(xb_ld(&bar[XB_TOPGEN]) == tg, bar);
            __builtin_amdgcn_fence(__ATOMIC_ACQUIRE, "agent");
            xb_add(&bar[XB_XGEN(b.x)], 1u);
            asm volatile("s_waitcnt vmcnt(0)" ::: "memory");
        } else {
            XB_SPIN(xb_ld(&bar[XB_XGEN(b.x)]) == gen, bar);
            __builtin_amdgcn_fence(__ATOMIC_ACQUIRE, "agent");
            asm volatile("s_waitcnt vmcnt(0)" ::: "memory");
        }
    }
    __syncthreads();
}

constexpr size_t MiB = 1u << 20;
constexpr size_t SZ_MD_BF = (size_t)M * D * 2, SZ_MD_F = (size_t)M * D * 4;
constexpr size_t WS_CTL = 0, CTL_BYTES = 1 * MiB;
constexpr size_t WS_X    = WS_CTL + CTL_BYTES;
constexpr size_t WS_HB   = WS_X + SZ_MD_F;
constexpr size_t WS_ACT  = WS_HB + SZ_MD_BF;
constexpr size_t WS_P0   = WS_ACT + (size_t)M * DFF * 2;
constexpr size_t WS_P1   = WS_P0 + 192 * MiB;
constexpr size_t WS_YB   = WS_P1 + 3 * SZ_MD_F;
constexpr size_t WS_QB2  = WS_YB + SZ_MD_BF;
constexpr size_t WS_SC   = WS_QB2 + SZ_MD_BF;
constexpr size_t WS_PB   = WS_SC + (size_t)16 * SEQ * NMEM * 4;
constexpr size_t WS_OB   = WS_PB + (size_t)16 * SEQ * NMEM * 2;
constexpr size_t WS_KALL = WS_OB + SZ_MD_BF;
constexpr size_t WS_VT   = WS_KALL + (size_t)MMEM * 4 * D * 2;
constexpr size_t WS_MEMN = WS_VT + (size_t)MMEM * 4 * D * 2;
constexpr size_t WS_MISC = WS_MEMN + (size_t)MMEM * D * 2;
constexpr size_t MISC_LB = 0, MISC_C8 = 4 * 2048 * 4, MISC_SSQ = MISC_C8 + 2048 * 4, MISC_GATES = MISC_SSQ + (size_t)M * 8 * 4, MISC_MLWG = MISC_GATES + (size_t)M * 16 * 4, MISC_BYTES = 1 * MiB;
static_assert(MISC_MLWG + 16 * 2048 * 4 <= MISC_BYTES, "misc");
constexpr int ML_NPAD = 6400;
constexpr size_t SZ_WGU = (size_t)NGU * D * 2, SZ_WDN = (size_t)D * DFF * 2, SZ_WDD = (size_t)D * D * 2;
constexpr size_t WS_WGU  = WS_MISC + MISC_BYTES;
constexpr size_t WS_WDN  = WS_WGU + 8 * SZ_WGU;
constexpr size_t WS_WQ   = WS_WDN + 8 * SZ_WDN;
constexpr size_t WS_WO   = WS_WQ + 4 * SZ_WDD;
constexpr size_t WS_WK   = WS_WO + 4 * SZ_WDD;
constexpr size_t WS_WV   = WS_WK + 4 * SZ_WDD;
constexpr size_t WS_HGIN = WS_WV + 4 * SZ_WDD;
constexpr size_t WS_HGOUT = WS_HGIN + 2 * 4 * SZ_WDD;
constexpr size_t WS_LRUIN = WS_HGOUT + 2 * SZ_WDD;
constexpr size_t WS_LRUG = WS_LRUIN + 2 * SZ_WDD;
constexpr size_t WS_LRUOUT = WS_LRUG + (size_t)4096 * 256 * 2;
constexpr size_t WS_MLIN = WS_LRUOUT + SZ_WDD;
constexpr size_t WS_MLOUT = WS_MLIN + (size_t)ML_NPAD * D * 2;
constexpr size_t WS_GT   = WS_MLOUT + SZ_WDD;
constexpr size_t WS_UT   = WS_GT + (size_t)4 * 16 * NMEM * D * 2;
constexpr size_t WS_END  = WS_UT + (size_t)4 * 4 * D * 4 * NMEM * 2;

constexpr int NWAVES = 8, NT = NWAVES * 64;

struct Args {
    const float* in[27]; float* out; unsigned char* ws; int ph_lo, ph_hi;
};
enum { I_X = 0, I_MEM, I_MEMG, I_NORMG, I_FINALG, I_WGU, I_WDN, I_XAQ, I_XAKV, I_XAO, I_HGLB, I_HGIN, I_HGG, I_HGOUT,
       I_LRUIN, I_CONVW, I_CONVB, I_LRUWA, I_LRUBA, I_LRUWX, I_LRUBX, I_LRULAM, I_LRUOUT, I_MLIN, I_MLBIF, I_MLG, I_MLOUT };

struct Frame { LAS unsigned char* lds; int tid, lane, wave, G, bid, gw, NGW;
    template <class T> __device__ __forceinline__ T* ptr(int i) const { const u32x2 v = *(const LAS u32x2*)(lds + CTRL + 64 + 8 * i);
        const unsigned lo = __builtin_amdgcn_readfirstlane(v.x), hi = __builtin_amdgcn_readfirstlane(v.y); return (T*)(((unsigned long long)hi << 32) | lo); }
    __device__ __forceinline__ const float* in(int i) const { return ptr<const float>(i); }
    __device__ __forceinline__ float* out() const { return ptr<float>(27); }
    __device__ __forceinline__ unsigned char* ws() const { return ptr<unsigned char>(28); }
};
__device__ __forceinline__ unsigned hw_wave_key() { return (unsigned)__builtin_amdgcn_s_getreg((12 - 1) << 11 | 4) & 0xfffu; }

struct CvtJob { const float* W; bf16* WT; const float* gk; int K, ldw, nrows, off, gu, nvalid; };
__device__ __forceinline__ void convert_job_rt(const Frame& F, int& rot, const CvtJob& j, const int num0 = 0, const int num1 = 8) {
    const int nnb = j.nrows / 64, nkb = j.K / 64, nitems = nnb * nkb; const int cg = F.lane & 15, kg = F.lane >> 4;
    const int i0 = (nitems * num0) >> 3, i1 = (nitems * num1) >> 3, nrange = i1 - i0;
    int q = F.gw - rot; if (q < 0) q += F.NGW;
    for (; q < nrange; q += F.NGW) { const int it = i0 + q;
        const int kb = it / nnb, nb = it % nnb, k0 = kb * 64, n0 = nb * 64; int sc = j.off + n0;
        if (j.gu) { const int pn = n0 >> 8, r = n0 & 255; sc = (r >> 7) * DFF + 128 * pn + (r & 127); }
        const bool ok = (sc + 4 * cg + 3) < j.nvalid; const float* src = j.W + (size_t)(k0 + 16 * kg) * j.ldw + (ok ? sc + 4 * cg : 0);
        f32x4 v[16];
#pragma unroll
        for (int i = 0; i < 16; ++i) v[i] = __builtin_nontemporal_load((const f32x4*)(src + (size_t)i * j.ldw));
        if (j.gk) { const f32x4* gp = (const f32x4*)(j.gk + k0 + 16 * kg);
#pragma unroll
            for (int q = 0; q < 4; ++q) { const f32x4 g = gp[q]; v[4 * q] *= g[0]; v[4 * q + 1] *= g[1]; v[4 * q + 2] *= g[2]; v[4 * q + 3] *= g[3]; } }
        if (!ok) {
#pragma unroll
            for (int i = 0; i < 16; ++i) v[i] = (f32x4){0.f, 0.f, 0.f, 0.f}; }
#pragma unroll
        for (int c = 0; c < 4; ++c) { bf16* dst = j.WT + (size_t)(n0 + 4 * cg + c) * j.K + k0 + 16 * kg;
            u32x4 lo, hi; lo.x = pk2(v[0][c], v[1][c]); lo.y = pk2(v[2][c], v[3][c]); lo.z = pk2(v[4][c], v[5][c]); lo.w = pk2(v[6][c], v[7][c]);
            hi.x = pk2(v[8][c], v[9][c]); hi.y = pk2(v[10][c], v[11][c]); hi.z = pk2(v[12][c], v[13][c]); hi.w = pk2(v[14][c], v[15][c]);
            *(u32x4*)dst = lo; *(u32x4*)(dst + 8) = hi; }
    }
    rot = (rot + nrange) % F.NGW;
}
struct MapPlain { int off; __device__ int operator()(int nb) const { return off + 64 * nb; } };
struct MapGU { __device__ int operator()(int nb) const { const int n = 64 * nb, pn = n >> 8, r = n & 255; return (r >> 7) * DFF + 128 * pn + (r & 127); } };

__device__ __forceinline__ void x_to_stream(const Frame& F, const float* x, bf16* XB, float* SSQ) {
    for (int row = F.gw; row < M; row += F.NGW) {
        const f32x4* xr = (const f32x4*)(x + (size_t)row * D) + F.lane; u32x2* o8 = (u32x2*)(XB + (size_t)row * D) + F.lane; float ss = 0.f;
#pragma unroll
        for (int j = 0; j < 8; ++j) { const f32x4 v = xr[64 * j]; ss += (v[0] * v[0] + v[1] * v[1]) + (v[2] * v[2] + v[3] * v[3]); u32x2 w; w.x = pk2(v[0], v[1]); w.y = pk2(v[2], v[3]); o8[64 * j] = w; }
        ss = wave_sum(ss);
        if (F.lane < 8) SSQ[(size_t)row * 8 + F.lane] = F.lane == 0 ? ss : 0.f;
    }
}
__device__ __forceinline__ void ml_gates_rows(const Frame& F, const bf16* XB, const float* SSQ, const bf16* wg, float* gates) {
    if (F.wave >= 2) return;
    const int lr = F.lane & 15, lq = F.lane >> 4;
    for (int tile = F.wave * F.G + F.bid; tile < M / 16; tile += 2 * F.G) {
        const int row0 = tile * 16;
        const bf16* ap = XB + (size_t)(row0 + lr) * D + 8 * lq; const bf16* bp = wg + (size_t)lr * D + 8 * lq;
        f32x4 acc = {0.f, 0.f, 0.f, 0.f};
        for (int k0 = 0; k0 < D; k0 += 256) { bf16x8 a[8], b[8];
#pragma unroll
            for (int j = 0; j < 8; ++j) { a[j] = *(const bf16x8*)(ap + k0 + 32 * j); b[j] = *(const bf16x8*)(bp + k0 + 32 * j); }
#pragma unroll
            for (int j = 0; j < 8; ++j) acc = __builtin_amdgcn_mfma_f32_16x16x32_bf16(a[j], b[j], acc, 0, 0, 0); }
#pragma unroll
        for (int r = 0; r < 4; ++r) { const int row = row0 + 4 * lq + r; const f32x4 s0 = *(const f32x4*)(SSQ + (size_t)row * 8), s1 = *(const f32x4*)(SSQ + (size_t)row * 8 + 4);
            const float rstd = 1.0f / sqrtf((((s0[0] + s0[1]) + (s0[2] + s0[3])) + ((s1[0] + s1[1]) + (s1[2] + s1[3]))) * (1.0f / D) + EPS);
            gates[(size_t)row * 16 + lr] = acc[r] * rstd; }
    }
}
__device__ __forceinline__ void final_norm_bf(const Frame& F, const bf16* XB, const float* SSQ, const float* g, float* out) {
    for (int row = F.gw; row < M; row += F.NGW) {
        const f32x4 a = *(const f32x4*)(SSQ + (size_t)row * 8), b = *(const f32x4*)(SSQ + (size_t)row * 8 + 4);
        const float rstd = 1.0f / sqrtf((((a[0] + a[1]) + (a[2] + a[3])) + ((b[0] + b[1]) + (b[2] + b[3]))) * (1.0f / D) + EPS);
        const u32x2* xr = (const u32x2*)(XB + (size_t)row * D) + F.lane; f32x4* o = (f32x4*)(out + (size_t)row * D) + F.lane;
#pragma unroll
        for (int j = 0; j < 8; ++j) { const u32x2 w = xr[64 * j]; const f32x4 gg = ((const f32x4*)g)[F.lane + 64 * j]; o[64 * j] = (f32x4){bflo(w.x), bfhi(w.x), bflo(w.y), bfhi(w.y)} * rstd * gg; }
    }
}
template <bool GATES>
__device__ __forceinline__ void norm_rows(const Frame& F, const float* x, const float* g, bf16* out, int nrows, const float* wg, float* gates) {
    for (int row = F.gw; row < nrows; row += F.NGW) {
        const f32x4* xr = (const f32x4*)(x + (size_t)row * D) + F.lane;
        f32x4 v[8]; float ss = 0.f;
#pragma unroll
        for (int j = 0; j < 8; ++j) { v[j] = xr[64 * j]; ss += (v[j][0] * v[j][0] + v[j][1] * v[j][1]) + (v[j][2] * v[j][2] + v[j][3] * v[j][3]); }
        ss = wave_sum(ss);
        const float rstd = 1.0f / sqrtf(ss * (1.0f / D) + EPS);
        u32x2* o8 = (u32x2*)(out + (size_t)row * D) + F.lane;
#pragma unroll
        for (int j = 0; j < 8; ++j) { const f32x4 gg = ((const f32x4*)g)[F.lane + 64 * j]; v[j] = v[j] * rstd * gg; u32x2 w; w.x = pk2(v[j][0], v[j][1]); w.y = pk2(v[j][2], v[j][3]); o8[64 * j] = w; }
        if constexpr (GATES) {
            for (int c = 0; c < 16; ++c) { const f32x4* wr_ = (const f32x4*)(wg + (size_t)c * D) + F.lane; float s = 0.f;
#pragma unroll
                for (int j = 0; j < 8; ++j) { const f32x4 w4 = wr_[64 * j]; s += (v[j][0] * w4[0] + v[j][1] * w4[1]) + (v[j][2] * w4[2] + v[j][3] * w4[3]); }
                s = wave_sum(s); if (F.lane == 0) gates[(size_t)row * 16 + c] = s; }
        }
    }
}
__device__ __forceinline__ void final_norm(const Frame& F, const float* x, const float* g, float* out) {
    for (int row = F.gw; row < M; row += F.NGW) {
        const f32x4* xr = (const f32x4*)(x + (size_t)row * D) + F.lane;
        f32x4 v[8]; float ss = 0.f;
#pragma unroll
        for (int j = 0; j < 8; ++j) { v[j] = xr[64 * j]; ss += (v[j][0] * v[j][0] + v[j][1] * v[j][1]) + (v[j][2] * v[j][2] + v[j][3] * v[j][3]); }
        ss = wave_sum(ss);
        const float rstd = 1.0f / sqrtf(ss * (1.0f / D) + EPS);
        f32x4* o = (f32x4*)(out + (size_t)row * D) + F.lane;
#pragma unroll
        for (int j = 0; j < 8; ++j) { const f32x4 gg = ((const f32x4*)g)[F.lane + 64 * j]; o[64 * j] = v[j] * rstd * gg; }
    }
}

template <bool ML>
__device__ __forceinline__ void recur_phase(const Frame& F, const bf16* QB, const float* LF, const bf16* KB, const bf16* VB, const bf16* PB, const float* gates, const float* bif, float* OF) {
    constexpr int H = ML ? ML_H : HG_H, DV = ML ? ML_DV : HG_D, NVS = DV / 32, TB = 32;
    LAS float* AL = (LAS float*)F.lds; LAS float* KA = AL + TB * 128; LAS float* QQ = KA + TB * 128; LAS float* VV = QQ + TB * 128; LAS float* OO = VV + TB * 32;
    const int dg = F.lane & 15, vsub = F.lane >> 4, vloc = F.wave * 4 + vsub;
    for (int unit = F.bid; unit < BATCH * H * NVS; unit += F.G) {
        const int b = unit / (H * NVS), h = (unit / NVS) % H, vs = unit % NVS;
        float S[8], Nn[8];
#pragma unroll
        for (int i = 0; i < 8; ++i) { S[i] = 0.f; Nn[i] = 0.f; }
        float bi_ = 0.f, bf_ = 0.f; if constexpr (ML) { bi_ = bif[h]; bf_ = bif[8 + h]; }
        for (int t0 = 0; t0 < SEQ; t0 += TB) {
            __syncthreads();
            { const int t = F.tid >> 4, d8 = (F.tid & 15) * 8; const size_t row = (size_t)b * SEQ + t0 + t;
                float al[8], ka[8], qq[8];
                if constexpr (!ML) {
                    const f32x4 l0 = *(const f32x4*)(LF + row * D + h * 128 + d8), l1 = *(const f32x4*)(LF + row * D + h * 128 + d8 + 4);
                    const u32x4 kw = *(const u32x4*)(KB + row * D + h * 128 + d8), qw = *(const u32x4*)(QB + row * D + h * 128 + d8);
                    const float lf[8] = {l0[0], l0[1], l0[2], l0[3], l1[0], l1[1], l1[2], l1[3]};
#pragma unroll
                    for (int i = 0; i < 8; ++i) al[i] = __expf(lf[i]);
                    ka[0] = bflo(kw.x); ka[1] = bfhi(kw.x); ka[2] = bflo(kw.y); ka[3] = bfhi(kw.y); ka[4] = bflo(kw.z); ka[5] = bfhi(kw.z); ka[6] = bflo(kw.w); ka[7] = bfhi(kw.w);
                    qq[0] = bflo(qw.x); qq[1] = bfhi(qw.x); qq[2] = bflo(qw.y); qq[3] = bfhi(qw.y); qq[4] = bflo(qw.z); qq[5] = bfhi(qw.z); qq[6] = bflo(qw.w); qq[7] = bfhi(qw.w);
                } else {
                    const float fg = gates[row * 16 + 8 + h] + bf_, ig = gates[row * 16 + h] + bi_;
                    const float a_ = 1.0f / (1.0f + expf(-15.0f * tanhf(fg * (1.0f / 15.0f))));
                    const float ei = expf(15.0f * tanhf(ig * (1.0f / 15.0f))) * 0.08838834764831845f;
                    const u32x4 qw = *(const u32x4*)(PB + row * ML_PROJ + h * 128 + d8), kw = *(const u32x4*)(PB + row * ML_PROJ + 1024 + h * 128 + d8);
#pragma unroll
                    for (int i = 0; i < 8; ++i) al[i] = a_;
                    ka[0] = bflo(kw.x) * ei; ka[1] = bfhi(kw.x) * ei; ka[2] = bflo(kw.y) * ei; ka[3] = bfhi(kw.y) * ei; ka[4] = bflo(kw.z) * ei; ka[5] = bfhi(kw.z) * ei; ka[6] = bflo(kw.w) * ei; ka[7] = bfhi(kw.w) * ei;
                    qq[0] = bflo(qw.x); qq[1] = bfhi(qw.x); qq[2] = bflo(qw.y); qq[3] = bfhi(qw.y); qq[4] = bflo(qw.z); qq[5] = bfhi(qw.z); qq[6] = bflo(qw.w); qq[7] = bfhi(qw.w);
                }
                *(LAS f32x4*)(AL + t * 128 + d8) = (f32x4){al[0], al[1], al[2], al[3]}; *(LAS f32x4*)(AL + t * 128 + d8 + 4) = (f32x4){al[4], al[5], al[6], al[7]};
                *(LAS f32x4*)(KA + t * 128 + d8) = (f32x4){ka[0], ka[1], ka[2], ka[3]}; *(LAS f32x4*)(KA + t * 128 + d8 + 4) = (f32x4){ka[4], ka[5], ka[6], ka[7]};
                *(LAS f32x4*)(QQ + t * 128 + d8) = (f32x4){qq[0], qq[1], qq[2], qq[3]}; *(LAS f32x4*)(QQ + t * 128 + d8 + 4) = (f32x4){qq[4], qq[5], qq[6], qq[7]};
                if (F.tid < 256) { const int tv = F.tid >> 3, v4 = (F.tid & 7) * 4; const size_t rv = (size_t)b * SEQ + t0 + tv;
                    const u32x2 vw = ML ? *(const u32x2*)(PB + rv * ML_PROJ + 2048 + h * 256 + vs * 32 + v4) : *(const u32x2*)(VB + rv * D + h * 128 + vs * 32 + v4);
                    *(LAS f32x4*)(VV + tv * 32 + v4) = (f32x4){bflo(vw.x), bfhi(vw.x), bflo(vw.y), bfhi(vw.y)}; }
            }
            __syncthreads();
#pragma unroll 4
            for (int t = 0; t < TB; ++t) {
                const f32x4 a0 = *(const LAS f32x4*)(AL + t * 128 + dg * 8), a1 = *(const LAS f32x4*)(AL + t * 128 + dg * 8 + 4);
                const f32x4 k0 = *(const LAS f32x4*)(KA + t * 128 + dg * 8), k1 = *(const LAS f32x4*)(KA + t * 128 + dg * 8 + 4);
                const f32x4 q0 = *(const LAS f32x4*)(QQ + t * 128 + dg * 8), q1 = *(const LAS f32x4*)(QQ + t * 128 + dg * 8 + 4);
                const float vv = VV[t * 32 + vloc];
                const float al[8] = {a0[0], a0[1], a0[2], a0[3], a1[0], a1[1], a1[2], a1[3]}, ka[8] = {k0[0], k0[1], k0[2], k0[3], k1[0], k1[1], k1[2], k1[3]}, qq[8] = {q0[0], q0[1], q0[2], q0[3], q1[0], q1[1], q1[2], q1[3]};
                float po = 0.f, pd = 0.f;
#pragma unroll
                for (int i = 0; i < 8; ++i) { S[i] = al[i] * S[i] + ka[i] * vv; po += S[i] * qq[i]; if constexpr (ML) { Nn[i] = al[i] * Nn[i] + ka[i]; pd += Nn[i] * qq[i]; } }
#pragma unroll
                for (int o = 1; o < 16; o <<= 1) { po += __shfl_xor(po, o); if constexpr (ML) pd += __shfl_xor(pd, o); }
                if (dg == 0) { float r = po; if constexpr (ML) r = po / fmaxf(fabsf(pd), 1.0f); OO[t * 32 + vloc] = r; }
            }
            __syncthreads();
            if (F.tid < 256) { const int tv = F.tid >> 3, v4 = (F.tid & 7) * 4; const size_t rv = (size_t)b * SEQ + t0 + tv;
                *(f32x4*)(OF + rv * D + h * DV + vs * 32 + v4) = *(const LAS f32x4*)(OO + tv * 32 + v4); }
        }
    }
}
namespace ck {
constexpr int SK = 136, SS = 72;
constexpr int O_QH = 0, O_KH = O_QH + 64 * SK * 2, O_QE = O_KH + 160 * SK * 2, O_KET = O_QE + 64 * SK * 2, O_VT = O_KET + 128 * SS * 2, O_P = O_VT + 48 * SS * 2,
              O_SB = O_P + 64 * SS * 2, O_EBC = O_SB + 48 * SK * 2, O_TOT = O_EBC + 512, O_GT = O_TOT + 2048, O_END = O_GT + 2048 + 2 * 1280;
static_assert(O_END <= CTRL, "chunk LDS map");
__device__ __forceinline__ f32x4 mm(const LAS bf16* A, int sa, int ar, const LAS bf16* B, int sb, int br, int ksteps, f32x4 acc, int lane) {
    const int r = lane & 15, q8 = (lane >> 4) * 8;
    const LAS bf16* ap = A + (ar + r) * sa + q8; const LAS bf16* bp = B + (br + r) * sb + q8;
    for (int ks = 0; ks < ksteps; ++ks) { const bf16x8 a = *(const LAS bf16x8*)(ap + ks * 32), b = *(const LAS bf16x8*)(bp + ks * 32);
        acc = __builtin_amdgcn_mfma_f32_16x16x32_bf16(a, b, acc, 0, 0, 0); }
    return acc;
}
__device__ __forceinline__ bf16 f2bf(float x) { return (bf16)(pk2(x, x) & 0xffffu); }
__device__ __forceinline__ float bf2f(unsigned short x) { return __uint_as_float((unsigned)x << 16); }
__device__ __forceinline__ void tile_of(int tile, int& qi, int& kj) {
    qi = tile < 1 ? 0 : (tile < 3 ? 1 : (tile < 6 ? 2 : 3)); kj = tile - (qi * (qi + 1)) / 2; }

__device__ __forceinline__ void store_pairs(bf16* op, const f32x4& v, int lr) {
    const bool odd = lr & 1;
    const float r01 = __shfl_xor(odd ? v[0] : v[1], 1), r23 = __shfl_xor(odd ? v[2] : v[3], 1);
    const unsigned w01 = odd ? pk2(r01, v[1]) : pk2(v[0], r01), w23 = odd ? pk2(r23, v[3]) : pk2(v[2], r23);
    *(GAS unsigned*)(op + (size_t)(odd ? 1 : 0) * D) = w01; *(GAS unsigned*)(op + (size_t)(odd ? 3 : 2) * D) = w23;
}
template <int NSL, bool ML>
__device__ __forceinline__ void headnorm_tail(const Frame& F, const bf16* OF, float* SSQP, unsigned* cnt, const int b, const int col0, const int slot0, const int vs,
                                              const bf16* gate, const int ldg, const int gcol0, const float* gain, bf16* Y) {
    constexpr float INV_HD = 1.0f / (NSL * 32);
    const int q = F.tid & 3, r0 = F.tid >> 2;
    asm volatile("s_waitcnt vmcnt(0)" ::: "memory"); __syncthreads();
    const size_t rowb = (size_t)b * SEQ + r0;
#pragma unroll
    for (int i0 = 0; i0 < 16; i0 += 8) { u32x4 w[8];
#pragma unroll
        for (int i = 0; i < 8; ++i) w[i] = *(GAS const u32x4*)(OF + (rowb + 128 * (i0 + i)) * D + col0 + 8 * q);
#pragma unroll
        for (int i = 0; i < 8; ++i) {
            const float a0 = bflo(w[i].x), a1 = bfhi(w[i].x), a2 = bflo(w[i].y), a3 = bfhi(w[i].y), a4 = bflo(w[i].z), a5 = bfhi(w[i].z), a6 = bflo(w[i].w), a7 = bfhi(w[i].w);
            float ss = ((a0 * a0 + a1 * a1) + (a2 * a2 + a3 * a3)) + ((a4 * a4 + a5 * a5) + (a6 * a6 + a7 * a7));
            ss += __shfl_xor(ss, 1); ss += __shfl_xor(ss, 2);
            if (q == 0) *(GAS float*)(SSQP + (rowb + 128 * (i0 + i)) * 64 + slot0 + vs) = ss; } }
    asm volatile("s_waitcnt vmcnt(0)" ::: "memory"); __syncthreads();
    if (F.tid == 0) { __builtin_amdgcn_fence(__ATOMIC_RELEASE, "agent"); asm volatile("s_waitcnt vmcnt(0)" ::: "memory"); (void)xb_add(cnt, 1u);
        unsigned sp = 0u; while (xb_ld(cnt) < (unsigned)NSL) { __builtin_amdgcn_s_sleep(1); if (++sp > (1u << 24)) break; }
        __builtin_amdgcn_fence(__ATOMIC_ACQUIRE, "agent"); asm volatile("s_waitcnt vmcnt(0)" ::: "memory"); }
    __syncthreads();
    const f32x4 g0 = *(GAS const f32x4*)(gain + 8 * q), g1 = *(GAS const f32x4*)(gain + 8 * q + 4);
#pragma unroll
    for (int i0 = 0; i0 < 16; i0 += 4) {
        u32x4 w[4], gw[4]; f32x4 p0[4], p1[4];
#pragma unroll
        for (int j = 0; j < 4; ++j) { const size_t row = rowb + 128 * (i0 + j);
            w[j] = *(GAS const u32x4*)(OF + row * D + col0 + 8 * q); gw[j] = *(GAS const u32x4*)(gate + row * ldg + gcol0 + 8 * q);
            p0[j] = *(GAS const f32x4*)(SSQP + row * 64 + slot0); if constexpr (NSL == 8) p1[j] = *(GAS const f32x4*)(SSQP + row * 64 + slot0 + 4); else p1[j] = (f32x4){0.f, 0.f, 0.f, 0.f}; }
#pragma unroll
        for (int j = 0; j < 4; ++j) { const size_t row = rowb + 128 * (i0 + j);
            const float tot = ((p0[j][0] + p0[j][1]) + (p0[j][2] + p0[j][3])) + ((p1[j][0] + p1[j][1]) + (p1[j][2] + p1[j][3]));
            const float rstd = 1.0f / sqrtf(tot * INV_HD + EPS);
            float gg[8] = {bflo(gw[j].x), bfhi(gw[j].x), bflo(gw[j].y), bfhi(gw[j].y), bflo(gw[j].z), bfhi(gw[j].z), bflo(gw[j].w), bfhi(gw[j].w)};
            if constexpr (ML) {
#pragma unroll
                for (int e = 0; e < 8; ++e) gg[e] = sigmoidf_(gg[e]); }
            const f32x4 a = (f32x4){bflo(w[j].x), bfhi(w[j].x), bflo(w[j].y), bfhi(w[j].y)} * rstd * g0, c = (f32x4){bflo(w[j].z), bfhi(w[j].z), bflo(w[j].w), bfhi(w[j].w)} * rstd * g1;
            u32x4 o; o.x = pk2(a[0] * gg[0], a[1] * gg[1]); o.y = pk2(a[2] * gg[2], a[3] * gg[3]); o.z = pk2(c[0] * gg[4], c[1] * gg[5]); o.w = pk2(c[2] * gg[6], c[3] * gg[7]);
            *(GAS u32x4*)(Y + row * D + col0 + 8 * q) = o; } }
}
__device__ __forceinline__ void hg_chunk_phase(const Frame& F, const bf16* QB, const bf16* LF, const bf16* KB, const bf16* VB, bf16* OF, const bf16* GB, const float* gn, bf16* Y, float* SSQP, unsigned* hcnt) {
    LAS bf16* QH = (LAS bf16*)(F.lds + O_QH); LAS bf16* KH = (LAS bf16*)(F.lds + O_KH); LAS bf16* QE = (LAS bf16*)(F.lds + O_QE); LAS bf16* KET = (LAS bf16*)(F.lds + O_KET);
    LAS bf16* VT = (LAS bf16*)(F.lds + O_VT); LAS bf16* P = (LAS bf16*)(F.lds + O_P); LAS bf16* SB = (LAS bf16*)(F.lds + O_SB);
    LAS float* EBC = (LAS float*)(F.lds + O_EBC); LAS float* TOT = (LAS float*)(F.lds + O_TOT);
    const int tid = F.tid, lane = F.lane, w = F.wave, lq = lane >> 4, lr = lane & 15;
    const int g = w, i = g >> 1, d2 = 2 * lane, sv = tid >> 3, v4 = (tid & 7) * 4;
    for (int unit = F.bid; unit < 256; unit += F.G) {
        const int xk = unit >> 3, vs = xk & 3, gq = (xk >> 2) * 8 + (unit & 7); const int b = gq >> 4, h = gq & 15;
        __syncthreads();
        for (int e = tid; e < 64 * SS / 2; e += NT) ((LAS unsigned*)P)[e] = 0u;
        for (int e = tid; e < 48 * SK / 2; e += NT) ((LAS unsigned*)SB)[e] = 0u;
        f32x4 S0 = {0.f, 0.f, 0.f, 0.f}, S1 = {0.f, 0.f, 0.f, 0.f};
        unsigned lfA[8], lfB[8]; unsigned qvA[8], qvB[8]; u32x2 vvA, vvB;
        const size_t colb = (size_t)h * 128 + d2, colv = (size_t)h * 128 + vs * 32 + v4;
        auto load = [&](unsigned (&lfw)[8], unsigned (&qv)[8], u32x2& vv, const int cc) { const size_t r0 = (size_t)b * SEQ + (size_t)cc * 64 + 8 * g;
#pragma unroll
            for (int tt = 0; tt < 8; ++tt) { lfw[tt] = *(const unsigned*)(LF + (r0 + tt) * D + colb); qv[tt] = *(const unsigned*)(QB + (r0 + tt) * D + colb); }
            vv = *(const u32x2*)(VB + ((size_t)b * SEQ + (size_t)cc * 64 + sv) * D + colv); };
        load(lfA, qvA, vvA, 0); load(lfB, qvB, vvB, 1);
        auto step = [&](unsigned (&lfw)[8], unsigned (&qv)[8], u32x2& vv, const int c) {
            f32x2 lf[8], loc[8]; { f32x2 run = {0.f, 0.f};
#pragma unroll
                for (int tt = 0; tt < 8; ++tt) { lf[tt] = (f32x2){bflo(lfw[tt]), bfhi(lfw[tt])}; run += lf[tt]; loc[tt] = run; }
                *(LAS f32x2*)(TOT + g * 128 + d2) = run; }
            __syncthreads();
            { u32x2 s0, s1; s0.x = pk2(S0[0], S0[1]); s0.y = pk2(S0[2], S0[3]); s1.x = pk2(S1[0], S1[1]); s1.y = pk2(S1[2], S1[3]);
                *(LAS u32x2*)(SB + lr * SK + 16 * w + 4 * lq) = s0; *(LAS u32x2*)(SB + (16 + lr) * SK + 16 * w + 4 * lq) = s1; }
            f32x2 tg[8];
#pragma unroll
            for (int j = 0; j < 8; ++j) tg[j] = *(const LAS f32x2*)(TOT + j * 128 + d2);
            f32x2 Pf[4]; Pf[0] = (f32x2){0.f, 0.f}; Pf[1] = tg[0] + tg[1]; Pf[2] = Pf[1] + tg[2] + tg[3]; Pf[3] = Pf[2] + tg[4] + tg[5]; const f32x2 bC = Pf[3] + tg[6] + tg[7];
            const f32x2 Pi = i == 0 ? Pf[0] : (i == 1 ? Pf[1] : (i == 2 ? Pf[2] : Pf[3]));
            const f32x2 half = (g & 1) ? (g == 1 ? tg[0] : (g == 3 ? tg[2] : (g == 5 ? tg[4] : tg[6]))) : (f32x2){0.f, 0.f};
            const f32x2 eP = {__expf(Pi.x), __expf(Pi.y)}; const f32x2 eC = {__expf(bC.x - Pi.x), __expf(bC.y - Pi.y)};
            f32x2 fac[4];
#pragma unroll
            for (int ip = 0; ip < 4; ++ip) fac[ip] = (f32x2){__expf(Pf[ip].x - Pi.x), __expf(Pf[ip].y - Pi.y)};
            const int koff[4] = {0, 16, 48, 96};
            unsigned ke0[4], ke1[4];
#pragma unroll
            for (int tt = 0; tt < 8; ++tt) { const int t = 8 * g + tt; const f32x2 lo = loc[tt] + half;
                const float q0 = bflo(qv[tt]), q1 = bfhi(qv[tt]), k0 = 1.0f - __expf(lf[tt].x), k1 = 1.0f - __expf(lf[tt].y);
                const float e0 = __expf(fmaxf(lo.x, -80.f)), e1 = __expf(fmaxf(lo.y, -80.f));
                const float kr0 = k0 * __builtin_amdgcn_rcpf(e0), kr1 = k1 * __builtin_amdgcn_rcpf(e1);
                *(LAS unsigned*)(QH + t * SK + d2) = pk2(q0 * e0, q1 * e1); *(LAS unsigned*)(QE + t * SK + d2) = pk2(q0 * e0 * eP.x, q1 * e1 * eP.y);
#pragma unroll
                for (int ip = 0; ip < 4; ++ip) if (ip >= i) *(LAS unsigned*)(KH + (koff[ip] + t) * SK + d2) = pk2(kr0 * fac[ip].x, kr1 * fac[ip].y);
                const float c0 = kr0 * eC.x, c1 = kr1 * eC.y;
                if (tt & 1) { ke0[tt >> 1] = pk2(__uint_as_float(ke0[tt >> 1]), c0); ke1[tt >> 1] = pk2(__uint_as_float(ke1[tt >> 1]), c1); } else { ke0[tt >> 1] = __float_as_uint(c0); ke1[tt >> 1] = __float_as_uint(c1); } }
            *(LAS u32x4*)(KET + d2 * SS + 8 * g) = (u32x4){ke0[0], ke0[1], ke0[2], ke0[3]}; *(LAS u32x4*)(KET + (d2 + 1) * SS + 8 * g) = (u32x4){ke1[0], ke1[1], ke1[2], ke1[3]};
            if (g == 0) *(LAS f32x2*)(EBC + d2) = (f32x2){__expf(bC.x), __expf(bC.y)};
            VT[(v4 + 0) * SS + sv] = (bf16)(vv.x & 0xffffu); VT[(v4 + 1) * SS + sv] = (bf16)(vv.x >> 16); VT[(v4 + 2) * SS + sv] = (bf16)(vv.y & 0xffffu); VT[(v4 + 3) * SS + sv] = (bf16)(vv.y >> 16);
            if (c + 2 < SEQ / 64) load(lfw, qv, vv, c + 2);
            __syncthreads();
            for (int tile = w; tile < 10; tile += 8) { int qi, kj; tile_of(tile, qi, kj);
                f32x4 acc = {0.f, 0.f, 0.f, 0.f}; acc = mm(QH, SK, 16 * qi, KH, SK, koff[qi] + 16 * kj, 4, acc, lane);
#pragma unroll
                for (int r = 0; r < 4; ++r) { const int tl = 4 * lq + r; const float val = (qi != kj || lr <= tl) ? acc[r] : 0.f; P[(16 * qi + tl) * SS + 16 * kj + lr] = f2bf(val); } }
            __syncthreads();
            { const int tq = w & 3, nv = w >> 2; f32x4 acc = {0.f, 0.f, 0.f, 0.f};
                acc = mm(P, SS, 16 * tq, VT, SS, 16 * nv, tq < 2 ? 1 : 2, acc, lane);
                acc = mm(QE, SK, 16 * tq, SB, SK, 16 * nv, 4, acc, lane);
                bf16* op = OF + ((size_t)b * SEQ + c * 64 + 16 * tq + 4 * lq) * D + h * 128 + vs * 32 + 16 * nv + (lr & ~1);
                store_pairs(op, acc, lr); }
            { f32x4 U0 = {0.f, 0.f, 0.f, 0.f}, U1 = {0.f, 0.f, 0.f, 0.f}; U0 = mm(KET, SS, 16 * w, VT, SS, 0, 2, U0, lane); U1 = mm(KET, SS, 16 * w, VT, SS, 16, 2, U1, lane);
                const f32x4 dec = *(const LAS f32x4*)(EBC + 16 * w + 4 * lq); S0 = S0 * dec + U0; S1 = S1 * dec + U1; }
        };
        for (int c = 0; c < SEQ / 64; c += 2) { step(lfA, qvA, vvA, c); step(lfB, qvB, vvB, c + 1); }
        if (hcnt) headnorm_tail<4, false>(F, OF, SSQP, hcnt + b * 16 + h, b, h * 128 + vs * 32, h * 4, vs, GB, D, h * 128 + vs * 32, gn + vs * 32, Y);
    }
}

constexpr int A_QH = 0, A_KH = A_QH + 64 * SK * 2, A_IMG = A_KH + 160 * SK * 2;
constexpr int I_QE = 0, I_KET = I_QE + 64 * SK * 2, I_P = I_KET + 128 * SS * 2, I_EBC = I_P + 64 * SS * 2, I_VT = I_EBC + 512, IMG_BYTES = I_VT + 128 * SS * 2;
constexpr int A_TOT = A_IMG + IMG_BYTES, A_END = A_TOT + 4096;
constexpr int B_VT = I_VT, B_SB = B_VT + 32 * SS * 2, B_BUF = B_SB + 32 * SK * 2;
static_assert(IMG_BYTES == 64000 && A_END <= CTRL && 2 * B_BUF <= CTRL, "hg stage LDS maps");
__device__ __forceinline__ void hg_prep_phase(const Frame& F, const bf16* QB, const bf16* LF, const bf16* VB, unsigned char* IMG) {
    LAS bf16* QH = (LAS bf16*)(F.lds + A_QH); LAS bf16* KH = (LAS bf16*)(F.lds + A_KH); LAS bf16* QE = (LAS bf16*)(F.lds + A_IMG + I_QE); LAS bf16* KET = (LAS bf16*)(F.lds + A_IMG + I_KET);
    LAS bf16* VT = (LAS bf16*)(F.lds + A_IMG + I_VT); LAS bf16* P = (LAS bf16*)(F.lds + A_IMG + I_P); LAS float* EBC = (LAS float*)(F.lds + A_IMG + I_EBC); LAS float* TOT = (LAS float*)(F.lds + A_TOT);
    const int tid = F.tid, lane = F.lane, w = F.wave, lq = lane >> 4, lr = lane & 15;
    const int g = w, i = g >> 1, d2 = 2 * lane, sv = tid >> 3, vc = (tid & 7) * 16;
    constexpr int NITEM = BATCH * 16 * (SEQ / 64);
    __syncthreads();
    for (int e = tid; e < 64 * SS / 2; e += NT) ((LAS unsigned*)P)[e] = 0u;
    unsigned lfA[8], lfB[8], qvA[8], qvB[8];
    auto load = [&](unsigned (&lfw)[8], unsigned (&qv)[8], const int item) { const int c = item & 31, gq = item >> 5, b = gq >> 4, h = gq & 15;
        const size_t r0 = (size_t)b * SEQ + (size_t)c * 64 + 8 * g, colb = (size_t)h * 128 + d2;
#pragma unroll
        for (int tt = 0; tt < 8; ++tt) { lfw[tt] = *(GAS const unsigned*)(LF + (r0 + tt) * D + colb); qv[tt] = *(GAS const unsigned*)(QB + (r0 + tt) * D + colb); }
};
    const int first = F.bid, stride = F.G;
    if (first < NITEM) load(lfA, qvA, first);
    if (first + stride < NITEM) load(lfB, qvB, first + stride);
    auto step = [&](unsigned (&lfw)[8], unsigned (&qv)[8], const int item) {
        f32x2 lf[8], loc[8]; { f32x2 run = {0.f, 0.f};
#pragma unroll
            for (int tt = 0; tt < 8; ++tt) { lf[tt] = (f32x2){bflo(lfw[tt]), bfhi(lfw[tt])}; run += lf[tt]; loc[tt] = run; }
            *(LAS f32x2*)(TOT + g * 128 + d2) = run; }
        __syncthreads();
        f32x2 tg[8];
#pragma unroll
        for (int j = 0; j < 8; ++j) tg[j] = *(const LAS f32x2*)(TOT + j * 128 + d2);
        f32x2 Pf[4]; Pf[0] = (f32x2){0.f, 0.f}; Pf[1] = tg[0] + tg[1]; Pf[2] = Pf[1] + tg[2] + tg[3]; Pf[3] = Pf[2] + tg[4] + tg[5]; const f32x2 bC = Pf[3] + tg[6] + tg[7];
        const f32x2 Pi = i == 0 ? Pf[0] : (i == 1 ? Pf[1] : (i == 2 ? Pf[2] : Pf[3]));
        const f32x2 half = (g & 1) ? (g == 1 ? tg[0] : (g == 3 ? tg[2] : (g == 5 ? tg[4] : tg[6]))) : (f32x2){0.f, 0.f};
        const f32x2 eP = {__expf(Pi.x), __expf(Pi.y)}; const f32x2 eC = {__expf(bC.x - Pi.x), __expf(bC.y - Pi.y)};
        f32x2 fac[4];
#pragma unroll
        for (int ip = 0; ip < 4; ++ip) fac[ip] = (f32x2){__expf(Pf[ip].x - Pi.x), __expf(Pf[ip].y - Pi.y)};
        const int koff[4] = {0, 16, 48, 96};
        unsigned ke0[4], ke1[4];
#pragma unroll
        for (int tt = 0; tt < 8; ++tt) { const int t = 8 * g + tt; const f32x2 lo = loc[tt] + half;
            const float q0 = bflo(qv[tt]), q1 = bfhi(qv[tt]), k0 = 1.0f - __expf(lf[tt].x), k1 = 1.0f - __expf(lf[tt].y);
            const float e0 = __expf(fmaxf(lo.x, -80.f)), e1 = __expf(fmaxf(lo.y, -80.f));
            const float kr0 = k0 * __builtin_amdgcn_rcpf(e0), kr1 = k1 * __builtin_amdgcn_rcpf(e1);
            *(LAS unsigned*)(QH + t * SK + d2) = pk2(q0 * e0, q1 * e1); *(LAS unsigned*)(QE + t * SK + d2) = pk2(q0 * e0 * eP.x, q1 * e1 * eP.y);
#pragma unroll
            for (int ip = 0; ip < 4; ++ip) if (ip >= i) *(LAS unsigned*)(KH + (koff[ip] + t) * SK + d2) = pk2(kr0 * fac[ip].x, kr1 * fac[ip].y);
            const float c0 = kr0 * eC.x, c1 = kr1 * eC.y;
            if (tt & 1) { ke0[tt >> 1] = pk2(__uint_as_float(ke0[tt >> 1]), c0); ke1[tt >> 1] = pk2(__uint_as_float(ke1[tt >> 1]), c1); } else { ke0[tt >> 1] = __float_as_uint(c0); ke1[tt >> 1] = __float_as_uint(c1); } }
        *(LAS u32x4*)(KET + d2 * SS + 8 * g) = (u32x4){ke0[0], ke0[1], ke0[2], ke0[3]}; *(LAS u32x4*)(KET + (d2 + 1) * SS + 8 * g) = (u32x4){ke1[0], ke1[1], ke1[2], ke1[3]};
        if (g == 0) *(LAS f32x2*)(EBC + d2) = (f32x2){__expf(bC.x), __expf(bC.y)};
        load(lfw, qv, item + 2 * stride < NITEM ? item + 2 * stride : item);
        __syncthreads();
        for (int tile = w; tile < 10; tile += 8) { int qi, kj; tile_of(tile, qi, kj);
            f32x4 acc = {0.f, 0.f, 0.f, 0.f}; acc = mm(QH, SK, 16 * qi, KH, SK, koff[qi] + 16 * kj, 4, acc, lane);
#pragma unroll
            for (int r = 0; r < 4; ++r) { const int tl = 4 * lq + r; const float val = (qi != kj || lr <= tl) ? acc[r] : 0.f; P[(16 * qi + tl) * SS + 16 * kj + lr] = f2bf(val); } }
        __syncthreads();
        { unsigned char* img = IMG + (size_t)item * I_VT;
            for (int o = tid * 16; o < I_VT; o += NT * 16) *(GAS u32x4*)(img + o) = *(const LAS u32x4*)(F.lds + A_IMG + o); }
    };
    for (int item = first; item < NITEM; item += 2 * stride) { step(lfA, qvA, item); if (item + stride < NITEM) step(lfB, qvB, item + stride); }
}
__device__ __forceinline__ void hg_scan_phase(const Frame& F, const unsigned char* IMG, const bf16* VB, bf16* OF, const bf16* GB, const float* gn, bf16* Y, float* SSQP, unsigned* hcnt) {
    const int tid = F.tid, lane = F.lane, w = F.wave, lq = lane >> 4, lr = lane & 15;
    for (int unit = F.bid; unit < 256; unit += F.G) {
        const int xk = unit >> 3, vs = xk & 3, gq = (xk >> 2) * 8 + (unit & 7); const int b = gq >> 4, h = gq & 15;
        __syncthreads();
        f32x4 S0 = {0.f, 0.f, 0.f, 0.f}, S1 = {0.f, 0.f, 0.f, 0.f};
        constexpr int NC = I_VT / 16;
        const int p5 = tid + 5 * NT; const bool ok5 = p5 < NC; const int s5 = ok5 ? p5 * 16 : 0;
        const int sv = tid >> 3, v4 = (tid & 7) * 4; const size_t colv = (size_t)h * 128 + vs * 32 + v4;
        u32x4 rA[7], rB[7];
        auto load = [&](u32x4 (&r)[7], const int c) { const unsigned char* img = IMG + (size_t)(gq * 32 + c) * I_VT;
#pragma unroll
            for (int k = 0; k < 5; ++k) r[k] = *(GAS const u32x4*)(img + (tid + k * NT) * 16);
            r[5] = *(GAS const u32x4*)(img + s5); { const u32x2 vv = *(GAS const u32x2*)(VB + ((size_t)b * SEQ + (size_t)c * 64 + sv) * D + colv); r[6] = (u32x4){vv.x, vv.y, 0u, 0u}; } };
        load(rA, 0); load(rB, 1);
        auto step = [&](u32x4 (&r)[7], const int c) {
            LAS unsigned char* buf = F.lds + (c & 1) * B_BUF;
            LAS bf16* QE = (LAS bf16*)(buf + I_QE); LAS bf16* KET = (LAS bf16*)(buf + I_KET); LAS bf16* P = (LAS bf16*)(buf + I_P); LAS float* EBC = (LAS float*)(buf + I_EBC);
            LAS bf16* VT = (LAS bf16*)(buf + B_VT); LAS bf16* SB = (LAS bf16*)(buf + B_SB);
#pragma unroll
            for (int k = 0; k < 5; ++k) *(LAS u32x4*)(buf + (tid + k * NT) * 16) = r[k];
            if (ok5) *(LAS u32x4*)(buf + s5) = r[5];
            VT[(v4 + 0) * SS + sv] = (bf16)(r[6].x & 0xffffu); VT[(v4 + 1) * SS + sv] = (bf16)(r[6].x >> 16); VT[(v4 + 2) * SS + sv] = (bf16)(r[6].y & 0xffffu); VT[(v4 + 3) * SS + sv] = (bf16)(r[6].y >> 16);
            { u32x2 s0, s1; s0.x = pk2(S0[0], S0[1]); s0.y = pk2(S0[2], S0[3]); s1.x = pk2(S1[0], S1[1]); s1.y = pk2(S1[2], S1[3]);
                *(LAS u32x2*)(SB + lr * SK + 16 * w + 4 * lq) = s0; *(LAS u32x2*)(SB + (16 + lr) * SK + 16 * w + 4 * lq) = s1; }
            load(r, c + 2 < SEQ / 64 ? c + 2 : SEQ / 64 - 1);
            __syncthreads();
            { const int tq = w & 3, nv = w >> 2; f32x4 acc = {0.f, 0.f, 0.f, 0.f};
                acc = mm(P, SS, 16 * tq, VT, SS, 16 * nv, tq < 2 ? 1 : 2, acc, lane);
                acc = mm(QE, SK, 16 * tq, SB, SK, 16 * nv, 4, acc, lane);
                bf16* op = OF + ((size_t)b * SEQ + c * 64 + 16 * tq + 4 * lq) * D + h * 128 + vs * 32 + 16 * nv + (lr & ~1);
                store_pairs(op, acc, lr); }
            { f32x4 U0 = {0.f, 0.f, 0.f, 0.f}, U1 = {0.f, 0.f, 0.f, 0.f}; U0 = mm(KET, SS, 16 * w, VT, SS, 0, 2, U0, lane); U1 = mm(KET, SS, 16 * w, VT, SS, 16, 2, U1, lane);
                const f32x4 dec = *(const LAS f32x4*)(EBC + 16 * w + 4 * lq); S0 = S0 * dec + U0; S1 = S1 * dec + U1; }
        };
        for (int c = 0; c < SEQ / 64; c += 2) { step(rA, c); step(rB, c + 1); }
        if (hcnt) headnorm_tail<4, false>(F, OF, SSQP, hcnt + b * 16 + h, b, h * 128 + vs * 32, h * 4, vs, GB, D, h * 128 + vs * 32, gn + vs * 32, Y);
    }
}

__device__ __forceinline__ void ml_chunk_phase(const Frame& F, const bf16* PB, const float* gates, const float* bif, bf16* OF, const float* gn, bf16* Y, float* SSQP, unsigned* hcnt) {
    LAS bf16* QH = (LAS bf16*)(F.lds + O_QH); LAS bf16* KH = (LAS bf16*)(F.lds + O_KH); LAS bf16* KET = (LAS bf16*)(F.lds + O_KET);
    LAS bf16* VT = (LAS bf16*)(F.lds + O_VT); LAS bf16* P = (LAS bf16*)(F.lds + O_P); LAS bf16* SB = (LAS bf16*)(F.lds + O_SB);
    LAS float* GT0 = (LAS float*)(F.lds + O_GT + 2048);
    const int tid = F.tid, lane = F.lane, w = F.wave, lq = lane >> 4, lr = lane & 15;
    const int g = w, d2 = 2 * lane, sv = tid >> 3, v4 = (tid & 7) * 4;
    constexpr float S128 = 0.08838834764831845f;
    for (int unit = F.bid; unit < 256; unit += F.G) {
        const int xk = unit >> 3, vs = xk & 7, gq = (xk >> 3) * 8 + (unit & 7); const int b = gq >> 3, h = gq & 7;
        const float bi_ = *(GAS const float*)(bif + h), bf_ = *(GAS const float*)(bif + 8 + h);
        __syncthreads();
        for (int e = tid; e < 64 * SS / 2; e += NT) ((LAS unsigned*)P)[e] = 0u;
        for (int e = tid; e < 48 * SK / 2; e += NT) ((LAS unsigned*)SB)[e] = 0u;
        for (int e = tid; e < 16 * SS; e += NT) VT[32 * SS + e] = (e < 64) ? (bf16)0x3F80u : (bf16)0u;
        f32x4 S0 = {0.f, 0.f, 0.f, 0.f}, S1 = {0.f, 0.f, 0.f, 0.f}, S2 = {0.f, 0.f, 0.f, 0.f};
        unsigned qvA[8], kvA[8], qvB[8], kvB[8]; u32x2 vvA, vvB; float giA = 0.f, gfA = 0.f, giB = 0.f, gfB = 0.f;
        const size_t colq = (size_t)h * 128 + d2, colv = (size_t)2048 + h * 256 + vs * 32 + v4;
        auto load = [&](unsigned (&qv)[8], unsigned (&kv)[8], u32x2& vv, float& gi, float& gf, const int cc) { const size_t r0 = (size_t)b * SEQ + (size_t)cc * 64 + 8 * g;
#pragma unroll
            for (int tt = 0; tt < 8; ++tt) { qv[tt] = *(GAS const unsigned*)(PB + (r0 + tt) * ML_PROJ + colq); kv[tt] = *(GAS const unsigned*)(PB + (r0 + tt) * ML_PROJ + 1024 + colq); }
            vv = *(GAS const u32x2*)(PB + ((size_t)b * SEQ + (size_t)cc * 64 + sv) * ML_PROJ + colv);
            gi = *(GAS const float*)(gates + ((size_t)b * SEQ + (size_t)cc * 64 + lane) * 16 + h); gf = *(GAS const float*)(gates + ((size_t)b * SEQ + (size_t)cc * 64 + lane) * 16 + 8 + h); };
        load(qvA, kvA, vvA, giA, gfA, 0); load(qvB, kvB, vvB, giB, gfB, 1);
        auto step = [&](unsigned (&qv)[8], unsigned (&kv)[8], u32x2& vv, float& gi, float& gf, const int c) {
            LAS float* BT = GT0 + (c & 1) * 320; LAS float* WI = BT + 64; LAS float* WK = WI + 64; LAS float* EB = WK + 64; LAS float* EC = EB + 64;
            if (w == 0) {
                const float it = 15.0f * tanhf((gi + bi_) * (1.0f / 15.0f)); const float y = 15.0f * tanhf((gf + bf_) * (1.0f / 15.0f));
                const float lfv = -(fmaxf(-y, 0.f) + log1pf(expf(-fabsf(y))));
                float bt = lfv;
#pragma unroll
                for (int o = 1; o < 64; o <<= 1) { const float up = __shfl_up(bt, o); if (lane >= o) bt += up; }
                const float bC = __shfl(bt, 63);
                BT[lane] = bt; WI[lane] = it - bt; WK[lane] = __expf(bC - bt + it) * S128; EB[lane] = __expf(bt); if (lane == 0) EC[0] = __expf(bC);
            }
            __syncthreads();
            { u32x2 s0, s1, s2; s0.x = pk2(S0[0], S0[1]); s0.y = pk2(S0[2], S0[3]); s1.x = pk2(S1[0], S1[1]); s1.y = pk2(S1[2], S1[3]); s2.x = pk2(S2[0], S2[1]); s2.y = pk2(S2[2], S2[3]);
                *(LAS u32x2*)(SB + lr * SK + 16 * w + 4 * lq) = s0; *(LAS u32x2*)(SB + (16 + lr) * SK + 16 * w + 4 * lq) = s1; *(LAS u32x2*)(SB + (32 + lr) * SK + 16 * w + 4 * lq) = s2; }
            { unsigned ke0[4], ke1[4];
#pragma unroll
                for (int tt = 0; tt < 8; ++tt) { const int t = 8 * g + tt; *(LAS unsigned*)(QH + t * SK + d2) = qv[tt]; *(LAS unsigned*)(KH + t * SK + d2) = kv[tt];
                    const float wk = WK[t]; const float c0 = bflo(kv[tt]) * wk, c1 = bfhi(kv[tt]) * wk;
                    if (tt & 1) { ke0[tt >> 1] = pk2(__uint_as_float(ke0[tt >> 1]), c0); ke1[tt >> 1] = pk2(__uint_as_float(ke1[tt >> 1]), c1); } else { ke0[tt >> 1] = __float_as_uint(c0); ke1[tt >> 1] = __float_as_uint(c1); } }
                *(LAS u32x4*)(KET + d2 * SS + 8 * g) = (u32x4){ke0[0], ke0[1], ke0[2], ke0[3]}; *(LAS u32x4*)(KET + (d2 + 1) * SS + 8 * g) = (u32x4){ke1[0], ke1[1], ke1[2], ke1[3]}; }
            VT[(v4 + 0) * SS + sv] = (bf16)(vv.x & 0xffffu); VT[(v4 + 1) * SS + sv] = (bf16)(vv.x >> 16); VT[(v4 + 2) * SS + sv] = (bf16)(vv.y & 0xffffu); VT[(v4 + 3) * SS + sv] = (bf16)(vv.y >> 16);
            load(qv, kv, vv, gi, gf, c + 2 < SEQ / 64 ? c + 2 : SEQ / 64 - 1);
            __syncthreads();
            for (int tile = w; tile < 10; tile += 8) { int qi, kj; tile_of(tile, qi, kj);
                f32x4 acc = {0.f, 0.f, 0.f, 0.f}; acc = mm(QH, SK, 16 * qi, KH, SK, 16 * kj, 4, acc, lane);
                const float wis = WI[16 * kj + lr];
#pragma unroll
                for (int r = 0; r < 4; ++r) { const int tl = 4 * lq + r; const float wgt = __expf(BT[16 * qi + tl] + wis) * S128;
                    const float val = (qi != kj || lr <= tl) ? acc[r] * wgt : 0.f; P[(16 * qi + tl) * SS + 16 * kj + lr] = f2bf(val); } }
            __syncthreads();
            { const int tq = w & 3, nv = w >> 2, ksn = tq < 2 ? 1 : 2; f32x4 num = {0.f, 0.f, 0.f, 0.f}, den = num, qs = num, qn = num;
                num = mm(P, SS, 16 * tq, VT, SS, 16 * nv, ksn, num, lane); den = mm(P, SS, 16 * tq, VT, SS, 32, ksn, den, lane);
                qs = mm(QH, SK, 16 * tq, SB, SK, 16 * nv, 4, qs, lane); qn = mm(QH, SK, 16 * tq, SB, SK, 32, 4, qn, lane);
                const f32x4 eb = *(const LAS f32x4*)(EB + 16 * tq + 4 * lq);
                bf16* op = OF + ((size_t)b * SEQ + c * 64 + 16 * tq + 4 * lq) * D + h * 256 + vs * 32 + 16 * nv + (lr & ~1); f32x4 hv;
#pragma unroll
                for (int r = 0; r < 4; ++r) { const float nm = num[r] + eb[r] * qs[r]; float dn = den[r] + eb[r] * qn[r]; dn = __shfl(dn, lane & 48);
                    hv[r] = nm / fmaxf(fabsf(dn), 1.0f); }
                store_pairs(op, hv, lr); }
            { f32x4 U0 = {0.f, 0.f, 0.f, 0.f}, U1 = U0, U2 = U0; U0 = mm(KET, SS, 16 * w, VT, SS, 0, 2, U0, lane); U1 = mm(KET, SS, 16 * w, VT, SS, 16, 2, U1, lane); U2 = mm(KET, SS, 16 * w, VT, SS, 32, 2, U2, lane);
                const float dec = EC[0]; S0 = S0 * dec + U0; S1 = S1 * dec + U1; S2 = S2 * dec + U2; }
        };
        for (int c = 0; c < SEQ / 64; c += 2) { step(qvA, kvA, vvA, giA, gfA, c); step(qvB, kvB, vvB, giB, gfB, c + 1); }
        if (hcnt) headnorm_tail<8, true>(F, OF, SSQP, hcnt + b * 8 + h, b, h * 256 + vs * 32, h * 8, vs, PB, ML_PROJ, 4096 + h * 256 + vs * 32, gn + vs * 32, Y);
    }
}

constexpr int MA_KH = 0, MA_IMG = MA_KH + 64 * SK * 2, ML_IMG_BYTES = I_VT + 256 * SS * 2, MA_GS = MA_IMG + ML_IMG_BYTES, MA_END = MA_GS + 2 * 1280;
constexpr int MB_VT = I_VT, MB_SB = MB_VT + 48 * SS * 2, MB_BUF = MB_SB + 48 * SK * 2;
static_assert(MA_END <= CTRL && 2 * MB_BUF <= CTRL, "ml stage LDS maps");
__device__ __forceinline__ void ml_prep_phase(const Frame& F, const bf16* PB, const float* gates, const float* bif, unsigned char* IMG) {
    LAS bf16* KH = (LAS bf16*)(F.lds + MA_KH); LAS bf16* QH = (LAS bf16*)(F.lds + MA_IMG + I_QE); LAS bf16* KET = (LAS bf16*)(F.lds + MA_IMG + I_KET);
    LAS bf16* VT = (LAS bf16*)(F.lds + MA_IMG + I_VT); LAS bf16* P = (LAS bf16*)(F.lds + MA_IMG + I_P); LAS float* EBI = (LAS float*)(F.lds + MA_IMG + I_EBC);
    const int tid = F.tid, lane = F.lane, w = F.wave, lq = lane >> 4, lr = lane & 15;
    const int g = w, d2 = 2 * lane, tp = tid >> 4, vc = (tid & 15) * 16;
    constexpr float S128 = 0.08838834764831845f;
    constexpr int NITEM = BATCH * 8 * (SEQ / 64);
    __syncthreads();
    for (int e = tid; e < 64 * SS / 2; e += NT) ((LAS unsigned*)P)[e] = 0u;
    unsigned qvA[8], kvA[8], qvB[8], kvB[8]; float giA = 0.f, gfA = 0.f, giB = 0.f, gfB = 0.f;
    auto load = [&](unsigned (&qv)[8], unsigned (&kv)[8], float& gi, float& gf, const int item) { const int c = item & 31, gq = item >> 5, b = gq >> 3, h = gq & 7;
        const size_t r0 = (size_t)b * SEQ + (size_t)c * 64 + 8 * g, colq = (size_t)h * 128 + d2;
#pragma unroll
        for (int tt = 0; tt < 8; ++tt) { qv[tt] = *(GAS const unsigned*)(PB + (r0 + tt) * ML_PROJ + colq); kv[tt] = *(GAS const unsigned*)(PB + (r0 + tt) * ML_PROJ + 1024 + colq); }
        const size_t gr = ((size_t)b * SEQ + (size_t)c * 64 + lane) * 16 + h; gi = *(GAS const float*)(gates + gr) + *(GAS const float*)(bif + h); gf = *(GAS const float*)(gates + gr + 8) + *(GAS const float*)(bif + 8 + h); };
    const int first = F.bid, stride = F.G;
    if (first < NITEM) load(qvA, kvA, giA, gfA, first);
    if (first + stride < NITEM) load(qvB, kvB, giB, gfB, first + stride);
    int par = 0;
    auto step = [&](unsigned (&qv)[8], unsigned (&kv)[8], float& gi, float& gf, const int item) {
        LAS float* BT = (LAS float*)(F.lds + MA_GS) + par * 320; LAS float* WI = BT + 64; LAS float* WK = WI + 64; LAS float* EB = WK + 64; LAS float* EC = EB + 64;
        if (w == 0) {
            const float it = 15.0f * tanhf(gi * (1.0f / 15.0f)); const float y = 15.0f * tanhf(gf * (1.0f / 15.0f));
            const float lfv = -(fmaxf(-y, 0.f) + log1pf(expf(-fabsf(y))));
            float bt = lfv;
#pragma unroll
            for (int o = 1; o < 64; o <<= 1) { const float up = __shfl_up(bt, o); if (lane >= o) bt += up; }
            const float bC = __shfl(bt, 63);
            BT[lane] = bt; WI[lane] = it - bt; WK[lane] = __expf(bC - bt + it) * S128; EB[lane] = __expf(bt); if (lane == 0) EC[0] = __expf(bC);
        }
        __syncthreads();
        if (w == 0) { EBI[lane] = EB[lane]; if (lane == 0) EBI[64] = EC[0]; }
        { unsigned ke0[4], ke1[4];
#pragma unroll
            for (int tt = 0; tt < 8; ++tt) { const int t = 8 * g + tt; *(LAS unsigned*)(QH + t * SK + d2) = qv[tt]; *(LAS unsigned*)(KH + t * SK + d2) = kv[tt];
                const float wk = WK[t]; const float c0 = bflo(kv[tt]) * wk, c1 = bfhi(kv[tt]) * wk;
                if (tt & 1) { ke0[tt >> 1] = pk2(__uint_as_float(ke0[tt >> 1]), c0); ke1[tt >> 1] = pk2(__uint_as_float(ke1[tt >> 1]), c1); } else { ke0[tt >> 1] = __float_as_uint(c0); ke1[tt >> 1] = __float_as_uint(c1); } }
            *(LAS u32x4*)(KET + d2 * SS + 8 * g) = (u32x4){ke0[0], ke0[1], ke0[2], ke0[3]}; *(LAS u32x4*)(KET + (d2 + 1) * SS + 8 * g) = (u32x4){ke1[0], ke1[1], ke1[2], ke1[3]}; }
        load(qv, kv, gi, gf, item + 2 * stride < NITEM ? item + 2 * stride : item);
        __syncthreads();
        for (int tile = w; tile < 10; tile += 8) { int qi, kj; tile_of(tile, qi, kj);
            f32x4 acc = {0.f, 0.f, 0.f, 0.f}; acc = mm(QH, SK, 16 * qi, KH, SK, 16 * kj, 4, acc, lane);
            const float wis = WI[16 * kj + lr];
#pragma unroll
            for (int r = 0; r < 4; ++r) { const int tl = 4 * lq + r; const float wgt = __expf(BT[16 * qi + tl] + wis) * S128;
                const float val = (qi != kj || lr <= tl) ? acc[r] * wgt : 0.f; P[(16 * qi + tl) * SS + 16 * kj + lr] = f2bf(val); } }
        __syncthreads();
        { unsigned char* img = IMG + (size_t)item * I_VT;
            for (int o = tid * 16; o < I_VT; o += NT * 16) *(GAS u32x4*)(img + o) = *(const LAS u32x4*)(F.lds + MA_IMG + o); }
        par ^= 1;
    };
    for (int item = first; item < NITEM; item += 2 * stride) { step(qvA, kvA, giA, gfA, item); if (item + stride < NITEM) step(qvB, kvB, giB, gfB, item + stride); }
}
__device__ __forceinline__ void ml_scan_phase(const Frame& F, const unsigned char* IMG, bf16* OF, const bf16* PB, const float* gn, bf16* Y, float* SSQP, unsigned* hcnt) {
    const int tid = F.tid, lane = F.lane, w = F.wave, lq = lane >> 4, lr = lane & 15;
    for (int unit = F.bid; unit < 256; unit += F.G) {
        const int xk = unit >> 3, vs = xk & 7, gq = (xk >> 3) * 8 + (unit & 7); const int b = gq >> 3, h = gq & 7;
        __syncthreads();
#pragma unroll
        for (int bb = 0; bb < 2; ++bb) { LAS bf16* VTb = (LAS bf16*)(F.lds + bb * MB_BUF + MB_VT);
            for (int e = tid; e < 16 * SS; e += NT) VTb[32 * SS + e] = (e < 64) ? (bf16)0x3F80u : (bf16)0u; }
        f32x4 S0 = {0.f, 0.f, 0.f, 0.f}, S1 = {0.f, 0.f, 0.f, 0.f}, S2 = {0.f, 0.f, 0.f, 0.f};
        constexpr int NC = I_VT / 16;
        const int p5 = tid + 5 * NT; const bool ok5 = p5 < NC; const int s5 = ok5 ? p5 * 16 : 0;
        const int sv = tid >> 3, v4 = (tid & 7) * 4; const size_t colv = (size_t)2048 + h * 256 + vs * 32 + v4;
        u32x4 rA[7], rB[7];
        auto load = [&](u32x4 (&r)[7], const int c) { const unsigned char* img = IMG + (size_t)(gq * 32 + c) * I_VT;
#pragma unroll
            for (int k = 0; k < 5; ++k) r[k] = *(GAS const u32x4*)(img + (tid + k * NT) * 16);
            r[5] = *(GAS const u32x4*)(img + s5); { const u32x2 vv = *(GAS const u32x2*)(PB + ((size_t)b * SEQ + (size_t)c * 64 + sv) * ML_PROJ + colv); r[6] = (u32x4){vv.x, vv.y, 0u, 0u}; } };
        load(rA, 0); load(rB, 1);
        auto step = [&](u32x4 (&r)[7], const int c) {
            LAS unsigned char* buf = F.lds + (c & 1) * MB_BUF;
            LAS bf16* QH = (LAS bf16*)(buf + I_QE); LAS bf16* KET = (LAS bf16*)(buf + I_KET); LAS bf16* P = (LAS bf16*)(buf + I_P); LAS float* EB = (LAS float*)(buf + I_EBC);
            LAS bf16* VT = (LAS bf16*)(buf + MB_VT); LAS bf16* SB = (LAS bf16*)(buf + MB_SB);
#pragma unroll
            for (int k = 0; k < 5; ++k) *(LAS u32x4*)(buf + (tid + k * NT) * 16) = r[k];
            if (ok5) *(LAS u32x4*)(buf + s5) = r[5];
            VT[(v4 + 0) * SS + sv] = (bf16)(r[6].x & 0xffffu); VT[(v4 + 1) * SS + sv] = (bf16)(r[6].x >> 16); VT[(v4 + 2) * SS + sv] = (bf16)(r[6].y & 0xffffu); VT[(v4 + 3) * SS + sv] = (bf16)(r[6].y >> 16);
            { u32x2 s0, s1, s2; s0.x = pk2(S0[0], S0[1]); s0.y = pk2(S0[2], S0[3]); s1.x = pk2(S1[0], S1[1]); s1.y = pk2(S1[2], S1[3]); s2.x = pk2(S2[0], S2[1]); s2.y = pk2(S2[2], S2[3]);
                *(LAS u32x2*)(SB + lr * SK + 16 * w + 4 * lq) = s0; *(LAS u32x2*)(SB + (16 + lr) * SK + 16 * w + 4 * lq) = s1; *(LAS u32x2*)(SB + (32 + lr) * SK + 16 * w + 4 * lq) = s2; }
            load(r, c + 2 < SEQ / 64 ? c + 2 : SEQ / 64 - 1);
            __syncthreads();
            { const int tq = w & 3, nv = w >> 2, ksn = tq < 2 ? 1 : 2; f32x4 num = {0.f, 0.f, 0.f, 0.f}, den = num, qs = num, qn = num;
                num = mm(P, SS, 16 * tq, VT, SS, 16 * nv, ksn, num, lane); den = mm(P, SS, 16 * tq, VT, SS, 32, ksn, den, lane);
                qs = mm(QH, SK, 16 * tq, SB, SK, 16 * nv, 4, qs, lane); qn = mm(QH, SK, 16 * tq, SB, SK, 32, 4, qn, lane);
                const f32x4 eb = *(const LAS f32x4*)(EB + 16 * tq + 4 * lq);
                bf16* op = OF + ((size_t)b * SEQ + c * 64 + 16 * tq + 4 * lq) * D + h * 256 + vs * 32 + 16 * nv + (lr & ~1); f32x4 hv;
#pragma unroll
                for (int r4 = 0; r4 < 4; ++r4) { const float nm = num[r4] + eb[r4] * qs[r4]; float dn = den[r4] + eb[r4] * qn[r4]; dn = __shfl(dn, lane & 48);
                    hv[r4] = nm / fmaxf(fabsf(dn), 1.0f); }
                store_pairs(op, hv, lr); }
            { f32x4 U0 = {0.f, 0.f, 0.f, 0.f}, U1 = U0, U2 = U0; U0 = mm(KET, SS, 16 * w, VT, SS, 0, 2, U0, lane); U1 = mm(KET, SS, 16 * w, VT, SS, 16, 2, U1, lane); U2 = mm(KET, SS, 16 * w, VT, SS, 32, 2, U2, lane);
                const float dec = EB[64]; S0 = S0 * dec + U0; S1 = S1 * dec + U1; S2 = S2 * dec + U2; }
        };
        for (int c = 0; c < SEQ / 64; c += 2) { step(rA, c); step(rB, c + 1); }
        if (hcnt) headnorm_tail<8, true>(F, OF, SSQP, hcnt + b * 8 + h, b, h * 256 + vs * 32, h * 8, vs, PB, ML_PROJ, 4096 + h * 256 + vs * 32, gn + vs * 32, Y);
    }
}
}

template <bool ML>
__device__ __forceinline__ void headnorm_rows(const Frame& F, const bf16* OF, const float* gn, const bf16* gate, int ldg, bf16* Y) {
    constexpr int HD = ML ? 256 : 128, LPH = HD / 32;
    for (int row = F.gw; row < M; row += F.NGW) {
        const u32x4* p = (const u32x4*)(OF + (size_t)row * D + F.lane * 32);
        f32x4 v[8]; float ss = 0.f;
#pragma unroll
        for (int j = 0; j < 4; ++j) { const u32x4 w = p[j]; v[2 * j] = (f32x4){bflo(w.x), bfhi(w.x), bflo(w.y), bfhi(w.y)}; v[2 * j + 1] = (f32x4){bflo(w.z), bfhi(w.z), bflo(w.w), bfhi(w.w)}; }
#pragma unroll
        for (int j = 0; j < 8; ++j) ss += (v[j][0] * v[j][0] + v[j][1] * v[j][1]) + (v[j][2] * v[j][2] + v[j][3] * v[j][3]);
#pragma unroll
        for (int o = 1; o < LPH; o <<= 1) ss += __shfl_xor(ss, o);
        const float rstd = 1.0f / sqrtf(ss * (1.0f / HD) + EPS);
        const int cih = (F.lane * 32) % HD;
        const u32x4* gp = (const u32x4*)(gate + (size_t)row * ldg + F.lane * 32);
        u32x4* yp = (u32x4*)(Y + (size_t)row * D + F.lane * 32);
#pragma unroll
        for (int j = 0; j < 4; ++j) { const u32x4 gw = gp[j]; const f32x4 g0 = *(GAS const f32x4*)(gn + cih + 8 * j), g1 = *(GAS const f32x4*)(gn + cih + 8 * j + 4);
            float gg[8] = {bflo(gw.x), bfhi(gw.x), bflo(gw.y), bfhi(gw.y), bflo(gw.z), bfhi(gw.z), bflo(gw.w), bfhi(gw.w)};
            if constexpr (ML) {
#pragma unroll
                for (int i = 0; i < 8; ++i) gg[i] = sigmoidf_(gg[i]); }
            const f32x4 a = v[2 * j] * rstd * g0, c = v[2 * j + 1] * rstd * g1;
            u32x4 w; w.x = pk2(a[0] * gg[0], a[1] * gg[1]); w.y = pk2(a[2] * gg[2], a[3] * gg[3]); w.z = pk2(c[0] * gg[4], c[1] * gg[5]); w.w = pk2(c[2] * gg[6], c[3] * gg[7]);
            yp[j] = w; }
    }
}
__device__ __forceinline__ void lru_conv(const Frame& F, const bf16* UR, const float* cw, const float* cb, bf16* UCB) {
    constexpr int total = (M / 4) * (D / 8);
    const int first = F.bid * NT + F.tid, c8 = (first % (D / 8)) * 8;
    f32x4 w0[4], w1[4];
#pragma unroll
    for (int j = 0; j < 4; ++j) { w0[j] = *(GAS const f32x4*)(cw + j * D + c8); w1[j] = *(GAS const f32x4*)(cw + j * D + c8 + 4); }
    const f32x4 b0 = *(GAS const f32x4*)(cb + c8), b1 = *(GAS const f32x4*)(cb + c8 + 4);
    for (int idx = first; idx < total; idx += F.G * NT) {
        const int row0 = (idx / (D / 8)) * 4, t0 = row0 % SEQ;
        u32x4 u[7];
#pragma unroll
        for (int i = 0; i < 7; ++i) { u[i] = (u32x4){0u, 0u, 0u, 0u}; if (i >= 3 || t0 > 0) u[i] = *(GAS const u32x4*)(UR + (size_t)(row0 + i - 3) * D + c8); }
#pragma unroll
        for (int o = 0; o < 4; ++o) { f32x4 a0 = b0, a1 = b1;
#pragma unroll
            for (int j = 0; j < 4; ++j) { const u32x4 v = u[o + j];
                a0 += w0[j] * (f32x4){bflo(v.x), bfhi(v.x), bflo(v.y), bfhi(v.y)}; a1 += w1[j] * (f32x4){bflo(v.z), bfhi(v.z), bflo(v.w), bfhi(v.w)}; }
            u32x4 w; w.x = pk2(a0[0], a0[1]); w.y = pk2(a0[2], a0[3]); w.z = pk2(a1[0], a1[1]); w.w = pk2(a1[2], a1[3]);
            *(GAS u32x4*)(UCB + (size_t)(row0 + o) * D + c8) = w; }
    }
}
__device__ __forceinline__ void lru_scan(const Frame& F, const bf16* LA, const bf16* INP, const bf16* GBR, bf16* Y) {
    LAS float* CP = (LAS float*)F.lds; LAS float* CH = CP + 128 * 32; LAS float* QP = CH + 128 * 32; LAS float* QH = QP + 16 * 32; LAS float* HC = QH + 16 * 32;
    const int seg = F.tid >> 2, q = F.tid & 3, ch = F.tid & 31, part = F.tid >> 5;
    for (int unit = F.bid; unit < BATCH * 64; unit += F.G) {
        const int b = unit >> 6;
        __syncthreads();
        if (F.tid < 32) HC[F.tid] = 0.f;
        for (int half = 0; half < 2; ++half) {
            const size_t base = ((size_t)b * SEQ + half * (SEQ / 2) + seg * 8) * D + (unit & 63) * 32 + 8 * q;
            u32x4 la[8], xi[8];
#pragma unroll
            for (int j = 0; j < 8; ++j) { la[j] = *(GAS const u32x4*)(LA + base + (size_t)j * D); xi[j] = *(GAS const u32x4*)(INP + base + (size_t)j * D); }
            float sl[8], h[8];
#pragma unroll
            for (int e = 0; e < 8; ++e) { sl[e] = 0.f; h[e] = 0.f; }
#pragma unroll
            for (int j = 0; j < 8; ++j) {
                const float l8[8] = {bflo(la[j].x), bfhi(la[j].x), bflo(la[j].y), bfhi(la[j].y), bflo(la[j].z), bfhi(la[j].z), bflo(la[j].w), bfhi(la[j].w)};
                const float x8[8] = {bflo(xi[j].x), bfhi(xi[j].x), bflo(xi[j].y), bfhi(xi[j].y), bflo(xi[j].z), bfhi(xi[j].z), bflo(xi[j].w), bfhi(xi[j].w)};
#pragma unroll
                for (int e = 0; e < 8; ++e) { h[e] = __expf(l8[e]) * h[e] + x8[e]; sl[e] += l8[e]; } }
            __syncthreads();
            *(LAS f32x4*)(CP + seg * 32 + 8 * q) = (f32x4){__expf(sl[0]), __expf(sl[1]), __expf(sl[2]), __expf(sl[3])}; *(LAS f32x4*)(CP + seg * 32 + 8 * q + 4) = (f32x4){__expf(sl[4]), __expf(sl[5]), __expf(sl[6]), __expf(sl[7])};
            *(LAS f32x4*)(CH + seg * 32 + 8 * q) = (f32x4){h[0], h[1], h[2], h[3]}; *(LAS f32x4*)(CH + seg * 32 + 8 * q + 4) = (f32x4){h[4], h[5], h[6], h[7]};
            __syncthreads();
            { float p = 1.f, hh = 0.f;
#pragma unroll
                for (int s = 0; s < 8; ++s) { const float cp = CP[(part * 8 + s) * 32 + ch], cv = CH[(part * 8 + s) * 32 + ch]; hh = cp * hh + cv; p *= cp; }
                QP[part * 32 + ch] = p; QH[part * 32 + ch] = hh; }
            __syncthreads();
            { float carry = HC[ch];
                for (int s = 0; s < part; ++s) carry = QP[s * 32 + ch] * carry + QH[s * 32 + ch];
#pragma unroll
                for (int s = 0; s < 8; ++s) { const int o = (part * 8 + s) * 32 + ch; const float cp = CP[o], cv = CH[o]; CH[o] = carry; carry = cp * carry + cv; }
                __syncthreads();
                if (part == 15) HC[ch] = carry; }
            { const f32x4 c0 = *(const LAS f32x4*)(CH + seg * 32 + 8 * q), c1 = *(const LAS f32x4*)(CH + seg * 32 + 8 * q + 4);
                h[0] = c0[0]; h[1] = c0[1]; h[2] = c0[2]; h[3] = c0[3]; h[4] = c1[0]; h[5] = c1[1]; h[6] = c1[2]; h[7] = c1[3]; }
            u32x4 gg[8];
#pragma unroll
            for (int j = 0; j < 8; ++j) gg[j] = *(GAS const u32x4*)(GBR + base + (size_t)j * D);
#pragma unroll
            for (int j = 0; j < 8; ++j) { const u32x4 lw = la[j], xw = xi[j], gw = gg[j];
                const float l8[8] = {bflo(lw.x), bfhi(lw.x), bflo(lw.y), bfhi(lw.y), bflo(lw.z), bfhi(lw.z), bflo(lw.w), bfhi(lw.w)};
                const float x8[8] = {bflo(xw.x), bfhi(xw.x), bflo(xw.y), bfhi(xw.y), bflo(xw.z), bfhi(xw.z), bflo(xw.w), bfhi(xw.w)};
                const float g8[8] = {bflo(gw.x), bfhi(gw.x), bflo(gw.y), bfhi(gw.y), bflo(gw.z), bfhi(gw.z), bflo(gw.w), bfhi(gw.w)};
                float y[8];
#pragma unroll
                for (int e = 0; e < 8; ++e) { h[e] = __expf(l8[e]) * h[e] + x8[e]; y[e] = g8[e] * h[e]; }
                u32x4 w; w.x = pk2(y[0], y[1]); w.y = pk2(y[2], y[3]); w.z = pk2(y[4], y[5]); w.w = pk2(y[6], y[7]);
                *(GAS u32x4*)(Y + base + (size_t)j * D) = w; }
        }
    }
}
__device__ __forceinline__ void softmax_rows(const Frame& F, const float* S, bf16* P) {
    for (int row = F.gw; row < 16 * SEQ; row += F.NGW) {
        const f32x4 s = ((const f32x4*)(S + (size_t)row * NMEM))[F.lane];
        const float mx = wave_max(fmaxf(fmaxf(s[0], s[1]), fmaxf(s[2], s[3])));
        const f32x4 e = {__expf(s[0] - mx), __expf(s[1] - mx), __expf(s[2] - mx), __expf(s[3] - mx)};
        const float inv = 1.0f / wave_sum((e[0] + e[1]) + (e[2] + e[3]));
        u32x2 w; w.x = pk2(e[0] * inv, e[1] * inv); w.y = pk2(e[2] * inv, e[3] * inv); ((u32x2*)(P + (size_t)row * NMEM))[F.lane] = w;
    }
}


__device__ __forceinline__ int uni(int v) { return __builtin_amdgcn_readfirstlane(v); }
__device__ __forceinline__ Frame make_frame(unsigned ldsb) {
    Frame F; F.lds = (LAS unsigned char*)(size_t)__builtin_amdgcn_readfirstlane(ldsb);
    F.lane = (int)__builtin_amdgcn_mbcnt_hi(~0u, __builtin_amdgcn_mbcnt_lo(~0u, 0u));
    const unsigned key = hw_wave_key(); int w = 0;
#pragma unroll
    for (int i = 1; i < NWAVES; ++i) { const unsigned k = __builtin_amdgcn_readfirstlane(*(const LAS unsigned*)(F.lds + CTRL + 16 + 4 * i)); w = (k == key) ? i : w; }
    F.wave = w; F.tid = w * 64 + F.lane;
    F.bid = __builtin_amdgcn_readfirstlane(*(const LAS int*)(F.lds + CTRL + 48)); F.G = __builtin_amdgcn_readfirstlane(*(const LAS int*)(F.lds + CTRL + 52));
    F.gw = F.bid * NWAVES + F.wave; F.NGW = F.G * NWAVES; return F;
}
__device__ __forceinline__ void phase_end(const unsigned ldsb, int bar_) {
    if (uni(bar_)) { asm volatile("" ::: "memory"); const Frame F = make_frame(ldsb); XcdBarrier b; b.bar = (unsigned*)(F.ws() + WS_CTL); b.x = xb_xcc_id(); b.st = (volatile LAS unsigned*)(F.lds + CTRL); xcd_barrier(b, F.tid, (unsigned)F.G); }
}
#define PHASE_FN static __device__ __noinline__ __attribute__((not_tail_called)) void
#define PHASE_FN_G static __device__ __forceinline__ void

__device__ __forceinline__ int cvt_njobs(int l, int part) { return part == 0 ? ((l % 3) == 1 ? 2 + 1 + 32 : 2 + 1) : 3; }
__device__ __forceinline__ CvtJob cvt_job(const Frame& F, int l, int part, int j) {
    unsigned char* ws = F.ws(); const float* ng = F.in(I_NORMG); const int kind = l % 3, idx = l / 3;
    CvtJob J; J.gk = nullptr; J.off = 0; J.gu = 0; J.nvalid = 1 << 30;
    if (j == 0) { J.W = F.in(I_WGU) + (size_t)(l * 2 + part) * D * NGU; J.WT = (bf16*)(ws + WS_WGU + (size_t)(l * 2 + part) * SZ_WGU); J.K = D; J.ldw = NGU; J.nrows = NGU; J.gu = 1; J.gk = ng + ((size_t)l * 4 + (part ? 3 : 0)) * D; return J; }
    if (j == 1) { J.W = F.in(I_WDN) + (size_t)(l * 2 + part) * DFF * D; J.WT = (bf16*)(ws + WS_WDN + (size_t)(l * 2 + part) * SZ_WDN); J.K = DFF; J.ldw = D; J.nrows = D; return J; }
    if (part == 1) { J.K = D; J.ldw = D; J.nrows = D;
        if (kind == 0) { J.W = F.in(I_HGOUT) + (size_t)idx * D * D; J.WT = (bf16*)(ws + WS_HGOUT + (size_t)idx * SZ_WDD); }
        else if (kind == 1) { J.W = F.in(I_LRUOUT); J.WT = (bf16*)(ws + WS_LRUOUT); }
        else { J.W = F.in(I_MLOUT); J.WT = (bf16*)(ws + WS_MLOUT); }
        return J; }
    J.gk = ng + ((size_t)l * 4 + 1) * D; J.K = D;
    if (kind == 0) { J.W = F.in(I_HGIN) + (size_t)idx * D * 4 * D; J.WT = (bf16*)(ws + WS_HGIN + (size_t)idx * 4 * SZ_WDD); J.ldw = 4 * D; J.nrows = 4 * D; return J; }
    if (kind == 2) { J.W = F.in(I_MLIN); J.WT = (bf16*)(ws + WS_MLIN); J.ldw = ML_IN; J.nrows = ML_PROJ; return J; }
    if (j == 2) { J.W = F.in(I_LRUIN); J.WT = (bf16*)(ws + WS_LRUIN); J.ldw = 2 * D; J.nrows = 2 * D; return J; }
    { const int q = j - 3, g = q >> 4, blk = (q >> 1) & 7, jj = q & 1;
        J.gk = nullptr; J.W = F.in(g ? I_LRUWX : I_LRUWA) + (size_t)blk * 256 * 256; J.WT = (bf16*)(ws + WS_LRUG) + (size_t)(blk * 512 + jj * 256 + g * 128) * 256; J.K = 256; J.ldw = 256; J.nrows = 128; J.off = jj * 128; return J; }
}
__device__ __forceinline__ void convert_set(const Frame& F, int& rot, int l, int part, int num0 = 0, int num1 = 8) {
    const int nj = cvt_njobs(l, part);
    for (int j = 0; j < nj; ++j) { const CvtJob J = cvt_job(F, l, part, j); convert_job_rt(F, rot, J, num0, num1); }
}
constexpr int CVT_SC = 3;
PHASE_FN_G ph_prologue(unsigned ldsb, int bar_) {
    const Frame F = make_frame(ldsb);
    unsigned char* ws = F.ws(); int rot = 0;
    convert_set(F, rot, 0, 0);
    for (int l = 0; l < DEPTH; ++l) for (int kv = 0; kv < 2; ++kv) { CvtJob J; J.gk = nullptr; J.gu = 0; J.nvalid = 1 << 30; J.K = D; J.ldw = 2 * D; J.nrows = D; J.off = kv * D;
        J.W = F.in(I_XAKV) + (size_t)l * D * 2 * D; J.WT = (bf16*)(ws + (kv ? WS_WV : WS_WK) + (size_t)l * SZ_WDD); convert_job_rt(F, rot, J); }
    for (int l = 0; l < DEPTH; ++l) { CvtJob J; J.gk = nullptr; J.gu = 0; J.nvalid = 1 << 30; J.K = D; J.ldw = D; J.nrows = D; J.off = 0;
        J.W = F.in(I_XAO) + (size_t)l * D * D; J.WT = (bf16*)(ws + WS_WO + (size_t)l * SZ_WDD); convert_job_rt(F, rot, J); }
    { const float* wq = F.in(I_XAQ); const float* ngq = F.in(I_NORMG); bf16* wqn = (bf16*)(ws + WS_WQ);
      for (size_t i = (size_t)F.bid * NT + F.tid; i < (size_t)DEPTH * D * D / 8; i += (size_t)F.G * NT) { const size_t e = i * 8; const int l = (int)(e / ((size_t)D * D)), d = (int)((e / D) % D);
          const float g = ngq[((size_t)l * 4 + 2) * D + d]; const f32x4 a = __builtin_nontemporal_load((const f32x4*)(wq + e)), b = __builtin_nontemporal_load((const f32x4*)(wq + e + 4));
          u32x4 w; w.x = pk2(a[0] * g, a[1] * g); w.y = pk2(a[2] * g, a[3] * g); w.z = pk2(b[0] * g, b[1] * g); w.w = pk2(b[2] * g, b[3] * g); *(u32x4*)(wqn + e) = w; } }
    float* misc = (float*)(ws + WS_MISC);
    const int gt = F.bid * NT + F.tid, GT = F.G * NT;
    const float* hglb = F.in(I_HGLB); const float* lamp = F.in(I_LRULAM);
    for (int c = gt; c < 2048; c += GT) {
        const float p0 = hglb[c], p1 = hglb[2048 + c], p2 = hglb[4096 + c], p3 = hglb[6144 + c];
        const float mx = fmaxf(fmaxf(p0, p1), fmaxf(p2, p3)); const float e0 = expf(p0 - mx), e1 = expf(p1 - mx), e2 = expf(p2 - mx), e3 = expf(p3 - mx); const float inv = 1.0f / (e0 + e1 + e2 + e3);
        misc[MISC_LB / 4 + c] = 0.f; misc[MISC_LB / 4 + 2048 + c] = e1 * inv; misc[MISC_LB / 4 + 4096 + c] = (e1 + e2) * inv; misc[MISC_LB / 4 + 6144 + c] = (e1 + e2 + e3) * inv;
        const float lam = lamp[c]; const float sp = fmaxf(-lam, 0.f) + log1pf(expf(-fabsf(lam)));
        misc[MISC_C8 / 4 + c] = 8.0f * sp;
    }
    { const float* mlin = F.in(I_MLIN); const float* g21 = F.in(I_NORMG) + ((size_t)2 * 4 + 1) * D;
      bf16* wgb = (bf16*)(misc + MISC_MLWG / 4);
      for (int i = gt; i < 16 * 2048; i += GT) { const int c = i >> 11, k = i & 2047; const float w_ = g21[k] * mlin[(size_t)k * ML_IN + ML_PROJ + c]; wgb[i] = (bf16)(pk2(w_, w_) & 0xffffu); } }
    x_to_stream(F, F.in(I_X), (bf16*)(ws + WS_HB), misc + MISC_SSQ / 4);
    norm_rows<false>(F, F.in(I_MEM), F.in(I_MEMG), (bf16*)(ws + WS_MEMN), MMEM, nullptr, nullptr);
    phase_end(ldsb, bar_);
}

enum { NRM_FFN1 = 0, NRM_MIX = 1, NRM_ATT = 2, NRM_FFN2 = 3 };
PHASE_FN ph_final(unsigned ldsb) { const Frame F = make_frame(ldsb); unsigned char* ws = F.ws();
    if (X_F32) final_norm(F, (const float*)(ws + WS_X), F.in(I_FINALG), F.out()); else final_norm_bf(F, (const bf16*)(ws + WS_HB), (const float*)(ws + WS_MISC) + MISC_SSQ / 4, F.in(I_FINALG), F.out()); }
constexpr size_t CTL_HCNT = 32768;
constexpr size_t HG_IMG_OFF = 64 * MiB;
static_assert(HG_IMG_OFF + (size_t)BATCH * 16 * (SEQ / 64) * ck::IMG_BYTES <= 192 * MiB, "hg images");
PHASE_FN_G ph_hg_prep(unsigned ldsb, int bar_) { const Frame F = make_frame(ldsb); unsigned char* ws = F.ws();
    bf16* QB = (bf16*)(ws + WS_P0); bf16* VB = QB + (size_t)2 * M * D; const bf16* LF = (const bf16*)(ws + WS_P1);
    ck::hg_prep_phase(F, QB, LF, VB, ws + WS_P1 + HG_IMG_OFF); phase_end(ldsb, bar_); }
PHASE_FN_G ph_hg_recur(unsigned ldsb, int l_, int bar_) { const Frame F = make_frame(ldsb); unsigned char* ws = F.ws(); const int l = uni(l_);
    bf16* GB = (bf16*)(ws + WS_P0) + (size_t)3 * M * D; bf16* OF = (bf16*)(ws + WS_P1) + (size_t)M * D;
    const bool fuse = FUSE_TAIL && F.G >= 256;
    ck::hg_scan_phase(F, ws + WS_P1 + HG_IMG_OFF, (const bf16*)(ws + WS_P0) + (size_t)2 * M * D, OF, GB, F.in(I_HGG) + (l / 3) * HG_D, (bf16*)(ws + WS_YB), (float*)(ws + WS_SC), fuse ? (unsigned*)(ws + WS_CTL + CTL_HCNT) + l * 64 : nullptr); phase_end(ldsb, bar_); }
PHASE_FN ph_hg_norm(unsigned ldsb, int idx_, int bar_) { const Frame F = make_frame(ldsb); unsigned char* ws = F.ws(); const int idx = uni(idx_); if (FUSE_TAIL && F.G >= 256) return;
    bf16* GB = (bf16*)(ws + WS_P0) + (size_t)3 * M * D; const bf16* OF = (const bf16*)(ws + WS_P1) + (size_t)M * D;
    headnorm_rows<false>(F, OF, F.in(I_HGG) + idx * HG_D, GB, D, (bf16*)(ws + WS_YB)); phase_end(ldsb, bar_); }
static_assert(HG_IMG_OFF + (size_t)BATCH * 8 * (SEQ / 64) * ck::ML_IMG_BYTES <= 192 * MiB, "ml images");
PHASE_FN_G ph_ml_prep(unsigned ldsb, int bar_) { const Frame F = make_frame(ldsb); unsigned char* ws = F.ws();
    ck::ml_prep_phase(F, (const bf16*)(ws + WS_P0), (const float*)(ws + WS_MISC) + MISC_GATES / 4, F.in(I_MLBIF), ws + WS_P1 + HG_IMG_OFF); phase_end(ldsb, bar_); }
PHASE_FN_G ph_ml_recur(unsigned ldsb, int l_, int bar_) { const Frame F = make_frame(ldsb); unsigned char* ws = F.ws(); const int l = uni(l_); const bool fuse = FUSE_TAIL && F.G >= 256;
    ck::ml_scan_phase(F, ws + WS_P1 + HG_IMG_OFF, (bf16*)(ws + WS_P1), (const bf16*)(ws + WS_P0), F.in(I_MLG), (bf16*)(ws + WS_YB), (float*)(ws + WS_SC), fuse ? (unsigned*)(ws + WS_CTL + CTL_HCNT) + l * 64 : nullptr); phase_end(ldsb, bar_); }
PHASE_FN ph_ml_gates(unsigned ldsb, int bar_) { const Frame F = make_frame(ldsb); unsigned char* ws = F.ws(); const float* misc = (const float*)(ws + WS_MISC);
    ml_gates_rows(F, (const bf16*)(ws + WS_HB), misc + MISC_SSQ / 4, (const bf16*)(misc + MISC_MLWG / 4), (float*)(ws + WS_MISC) + MISC_GATES / 4); phase_end(ldsb, bar_); }
PHASE_FN ph_ml_norm(unsigned ldsb, int bar_) { const Frame F = make_frame(ldsb); unsigned char* ws = F.ws(); if (FUSE_TAIL && F.G >= 256) return;
    headnorm_rows<true>(F, (const bf16*)(ws + WS_P1), F.in(I_MLG), (const bf16*)(ws + WS_P0) + 4096, ML_PROJ, (bf16*)(ws + WS_YB)); phase_end(ldsb, bar_); }
PHASE_FN ph_lru_conv(unsigned ldsb, int bar_) { const Frame F = make_frame(ldsb); unsigned char* ws = F.ws();
    lru_conv(F, (const bf16*)(ws + WS_P1), F.in(I_CONVW), F.in(I_CONVB), (bf16*)(ws + WS_P0) + (size_t)M * D); phase_end(ldsb, bar_); }
PHASE_FN ph_lru_scan(unsigned ldsb, int bar_) { const Frame F = make_frame(ldsb); unsigned char* ws = F.ws();
    lru_scan(F, (const bf16*)(ws + WS_P1) + (size_t)4 * M * D, (const bf16*)(ws + WS_P1) + (size_t)2 * M * D, (const bf16*)(ws + WS_P0), (bf16*)(ws + WS_YB)); phase_end(ldsb, bar_); }
PHASE_FN ph_softmax(unsigned ldsb, int bar_) { const Frame F = make_frame(ldsb); unsigned char* ws = F.ws(); softmax_rows(F, (const float*)(ws + WS_SC), (bf16*)(ws + WS_PB)); phase_end(ldsb, bar_); }

PHASE_FN_G ph_gemm_kv(unsigned ldsb, int bar_) {
    const Frame F = make_frame(ldsb); unsigned char* ws = F.ws(); const int half = F.G >> 1;
    if (F.bid < half) { pg8::PlainSched<D, D, MMEM, 4 * D> S; S.gsub = half; S.coff = 0; S.init(F.lds, ws + WS_MEMN, ws + WS_WK);
        auto E = [=]() { const Frame F2 = make_frame(ldsb); unsigned char* ws = F2.ws(); return pg8::EpiBf16P{(bf16*)(ws + WS_KALL), 4 * D, 0, 0, 1.f, nullptr}; };
        pg8::gemm_phase(F.lds, F.tid, D, D, D, S, E); }
    else { pg8::PlainSched<D, D, MMEM, 4 * D> S; S.gsub = F.G - half; S.coff = half; S.init(F.lds, ws + WS_MEMN, ws + WS_WV);
        auto E = [=]() { const Frame F2 = make_frame(ldsb); unsigned char* ws = F2.ws(); return pg8::EpiBf16P{(bf16*)(ws + WS_VT), 4 * D, 0, 0, 1.f, nullptr}; };
        pg8::gemm_phase(F.lds, F.tid, D, D, D, S, E); }
    phase_end(ldsb, bar_);
}
PHASE_FN_G ph_gemm_mlin(unsigned ldsb, int bar_) {
    const Frame F = make_frame(ldsb); unsigned char* ws = F.ws();
    pg8::PlainSched<D, D, M, ML_PROJ> S; S.init(F.lds, ws + WS_HB, ws + WS_MLIN); auto E = [=]() { const Frame F2 = make_frame(ldsb); unsigned char* ws = F2.ws(); (void)ws; return pg8::EpiBf16P{(bf16*)(ws + WS_P0), ML_PROJ, 0, 0, 1.f, (const float*)(ws + WS_MISC) + MISC_SSQ / 4}; };
    pg8::gemm_phase(F.lds, F.tid, D, D, D, S, E); phase_end(ldsb, bar_);
}
PHASE_FN_G ph_gemm_qproj(unsigned ldsb, int l_, int bar_) {
    const Frame F = make_frame(ldsb); const int l = uni(l_); unsigned char* ws = F.ws();
    pg8::PlainSched<D, D, M, D> S; S.init(F.lds, ws + WS_HB, ws + WS_WQ + (size_t)l * SZ_WDD); auto E = [=]() { const Frame F2 = make_frame(ldsb); unsigned char* ws = F2.ws(); (void)ws; return pg8::EpiBf16P{(bf16*)(ws + WS_QB2), D, 0, 0, 1.f, (const float*)(ws + WS_MISC) + MISC_SSQ / 4}; };
    pg8::gemm_phase(F.lds, F.tid, D, D, D, S, E); phase_end(ldsb, bar_);
}
PHASE_FN_G ph_gemm_dn(unsigned ldsb, int l_, int f_, int bar_) {
    const Frame F = make_frame(ldsb); const int l = uni(l_), f = uni(f_) & 1; const float dsc = uni(f_) >= 2 ? 0.0f : 0.5f; unsigned char* ws = F.ws();
    pg8::PlainSched<DFF, DFF, M, D> S; S.init(F.lds, ws + WS_ACT, ws + WS_WDN + (size_t)(l * 2 + f) * SZ_WDN); auto E = [=]() { const Frame F2 = make_frame(ldsb); unsigned char* ws = F2.ws(); (void)ws; float* X = (float*)(ws + WS_X); const float* xin = (l == 0 && f == 0) ? F2.in(I_X) : X; return pg8::EpiResid{xin, X, (bf16*)(ws + WS_HB), (float*)(ws + WS_MISC) + MISC_SSQ / 4, dsc, F2.lds, F2.tid}; };
    pg8::gemm_phase(F.lds, F.tid, DFF, DFF, DFF, S, E); phase_end(ldsb, bar_);
}
enum { GR_MIXOUT = 0, GR_OPROJ, GR_PROBE0 };
PHASE_FN_G ph_gemm_resid(unsigned ldsb, int which_, int l_, int bar_) {
    const Frame F = make_frame(ldsb); const int which = uni(which_), l = uni(l_); unsigned char* ws = F.ws();
    const int kind = l % 3, idx = l / 3;
    const size_t wo = which == GR_OPROJ ? WS_WO + (size_t)l * SZ_WDD : (kind == 0 ? WS_HGOUT + (size_t)idx * SZ_WDD : (kind == 1 ? WS_LRUOUT : WS_MLOUT));
    const size_t ao = which == GR_OPROJ ? WS_OB : WS_YB; const float rs_ = which == GR_PROBE0 ? 0.0f : 1.0f;
    pg8::PlainSched<D, D, M, D> S; S.init(F.lds, ws + ao, ws + wo); auto E = [=]() { const Frame F2 = make_frame(ldsb); unsigned char* ws = F2.ws(); (void)ws; float* X = (float*)(ws + WS_X); return pg8::EpiResid{X, X, (bf16*)(ws + WS_HB), (float*)(ws + WS_MISC) + MISC_SSQ / 4, rs_, F2.lds, F2.tid}; };
    pg8::gemm_phase(F.lds, F.tid, D, D, D, S, E); phase_end(ldsb, bar_);
}
PHASE_FN_G ph_gemm_gu(unsigned ldsb, int l_, int f_, int bar_) {
    const Frame F = make_frame(ldsb); const int l = uni(l_), f = uni(f_); unsigned char* ws = F.ws();
    pg8::PlainSched<D, D, M, NGU> S; S.init(F.lds, ws + WS_HB, ws + WS_WGU + (size_t)(l * 2 + f) * SZ_WGU); auto E = [=]() { const Frame F2 = make_frame(ldsb); unsigned char* ws = F2.ws(); (void)ws; return pg8::EpiSwiGLU{(bf16*)(ws + WS_ACT), (const float*)(ws + WS_MISC) + MISC_SSQ / 4}; };
    pg8::gemm_phase(F.lds, F.tid, D, D, D, S, E);
    { constexpr int NU = (M / 256) * (NGU / 256); const int rounds = (NU + F.G - 1) / F.G, busy = NU - (rounds - 1) * F.G;
        const int nl = f ? l + 1 : l, np = f ? 0 : 1;
        if (nl < DEPTH && F.bid >= busy && busy < F.G) { Frame Fc = F; Fc.gw = (F.bid - busy) * NWAVES + F.wave; Fc.NGW = (F.G - busy) * NWAVES; int rot = 0; convert_set(Fc, rot, nl, np); } }
    phase_end(ldsb, bar_);
}
PHASE_FN_G ph_gemm_hgin(unsigned ldsb, int l_, int bar_) {
    const Frame F = make_frame(ldsb); const int l = uni(l_), idx = l / 3; unsigned char* ws = F.ws();
    pg8::PlainSched<D, D, M, 4 * D> S; S.init(F.lds, ws + WS_HB, ws + WS_HGIN + (size_t)idx * 4 * SZ_WDD);
    auto E = [=]() { const Frame F2 = make_frame(ldsb); unsigned char* ws = F2.ws(); (void)ws; return pg8::EpiHgIn{(bf16*)(ws + WS_P0), (bf16*)(ws + WS_P1), (const float*)(ws + WS_MISC) + MISC_LB / 4 + l * 2048, (const float*)(ws + WS_MISC) + MISC_SSQ / 4}; };
    pg8::gemm_phase(F.lds, F.tid, D, D, D, S, E); phase_end(ldsb, bar_);
}
PHASE_FN_G ph_gemm_lruin(unsigned ldsb, int bar_) {
    const Frame F = make_frame(ldsb); unsigned char* ws = F.ws();
    pg8::PlainSched<D, D, M, 2 * D> S; S.init(F.lds, ws + WS_HB, ws + WS_LRUIN); auto E = [=]() { const Frame F2 = make_frame(ldsb); unsigned char* ws = F2.ws(); (void)ws; return pg8::EpiLruIn{(bf16*)(ws + WS_P0), (bf16*)(ws + WS_P1), (const float*)(ws + WS_MISC) + MISC_SSQ / 4}; };
    pg8::gemm_phase(F.lds, F.tid, D, D, D, S, E); phase_end(ldsb, bar_);
}
PHASE_FN_G ph_gemm_lrugate(unsigned ldsb, int bar_) {
    const Frame F = make_frame(ldsb); unsigned char* ws = F.ws();
    bf16* UCB = (bf16*)(ws + WS_P0) + (size_t)M * D;
    pg8::PlainSched<D, 256, M, 4096, 1, 512> S; S.init(F.lds, UCB, ws + WS_LRUG);
    auto E = [=]() { const Frame F2 = make_frame(ldsb); unsigned char* ws = F2.ws(); (void)ws; bf16* P1b = (bf16*)(ws + WS_P1); return pg8::EpiLruGate{(const bf16*)(ws + WS_P0) + (size_t)M * D, F2.in(I_LRUBA), F2.in(I_LRUBX), (const float*)(ws + WS_MISC) + MISC_C8 / 4, P1b + (size_t)4 * M * D, P1b + (size_t)2 * M * D}; };
    pg8::gemm_phase(F.lds, F.tid, D, 256, 256, S, E); phase_end(ldsb, bar_);
}
PHASE_FN_G ph_gemm_scores(unsigned ldsb, int l_, int bar_) {
    const Frame F = make_frame(ldsb); const int l = uni(l_); unsigned char* ws = F.ws();
    pg8::BatchSched S; S.init(F.lds, ws + WS_QB2, ws + WS_KALL + (size_t)l * D * 2);
    S.a_b = SEQ * D * 2; S.a_h = XA_D * 2; S.a_pm = 256 * D * 2; S.b_b = NMEM * 4 * D * 2; S.b_h = XA_D * 2; S.b_pn = 0; S.nM = SEQ / 256; S.nN = 1; S.nwg = 16 * S.nM;
    auto E = [=]() { const Frame F2 = make_frame(ldsb); unsigned char* ws = F2.ws(); (void)ws; return pg8::EpiF32Z{(float*)(ws + WS_SC), 0.044194173824159216f}; };
    pg8::gemm_phase(F.lds, F.tid, D, 4 * D, XA_D, S, E);
    phase_end(ldsb, bar_);
}
PHASE_FN_G ph_gemm_pv(unsigned ldsb, int l_, int bar_) {
    const Frame F = make_frame(ldsb); const int l = uni(l_); unsigned char* ws = F.ws();
    pg8::BatchSched S; S.init(F.lds, ws + WS_PB, ws + WS_VT + (size_t)l * D * MMEM * 2);
    S.a_b = 4 * SEQ * NMEM * 2; S.a_h = SEQ * NMEM * 2; S.a_pm = 256 * NMEM * 2; S.b_b = NMEM * 2; S.b_h = XA_D * MMEM * 2; S.b_pn = 256 * MMEM * 2; S.nM = SEQ / 256; S.nN = 2; S.nwg = 16 * S.nM * 2;
    auto E = [=]() { const Frame F2 = make_frame(ldsb); unsigned char* ws = F2.ws(); (void)ws; return pg8::EpiBf16P{(bf16*)(ws + WS_OB), D, (size_t)SEQ * D, XA_D, 1.f, nullptr}; };
    pg8::gemm_phase(F.lds, F.tid, NMEM, MMEM, NMEM, S, E);
    phase_end(ldsb, bar_);
}

PHASE_FN_G ph_attn(unsigned ldsb, int l_, int bar_) {
    const Frame F = make_frame(ldsb); const int l = uni(l_); unsigned char* ws = F.ws();
    for (int u = F.bid; u < 256; u += F.G) {
        const int z = u >> 4, pm = (u >> 1) & 7, pn = u & 1, b = z >> 2, h = z & 3;
        bf16* Pc = (bf16*)(ws + (pn ? WS_SC : WS_PB)) + ((size_t)z * SEQ + pm * 256) * NMEM;
        { pg8::OneSched S; S.A = (const char*)((const bf16*)(ws + WS_QB2) + ((size_t)b * SEQ + pm * 256) * D + h * XA_D); S.B = (const char*)((const bf16*)(ws + WS_KALL) + (size_t)b * NMEM * 4 * D + (size_t)l * D + h * XA_D); S.u0 = pg8::Unit{pm, 0, z};
          auto E = [=]() { const Frame F2 = make_frame(ldsb); return pg8::EpiSoftmax{Pc, 0.044194173824159216f, F2.lds}; };
          pg8::gemm_phase(F.lds, F.tid, D, 4 * D, XA_D, S, E); }
        if (F.tid == 0) __builtin_amdgcn_fence(__ATOMIC_ACQUIRE, "agent");
        asm volatile("s_waitcnt vmcnt(0)" ::: "memory"); __syncthreads();
        { pg8::OneSched S; S.A = (const char*)Pc; S.B = (const char*)((const bf16*)(ws + WS_VT) + ((size_t)l * D + h * XA_D + pn * 256) * MMEM + b * NMEM); S.u0 = pg8::Unit{pm, pn, z};
          auto E = [=]() { const Frame F2 = make_frame(ldsb); unsigned char* ws2 = F2.ws(); return pg8::EpiBf16P{(bf16*)(ws2 + WS_OB), D, (size_t)SEQ * D, XA_D, 1.f, nullptr}; };
          pg8::gemm_phase(F.lds, F.tid, NMEM, MMEM, NMEM, S, E); }
    }
    phase_end(ldsb, bar_);
}

__device__ __forceinline__ void gtut_units(const Frame& F, const unsigned ldsb, int la, int lb, int gsub, int coff, int coff_ut) {
    unsigned char* ws = F.ws(); const int c = (F.bid >= coff && F.bid < coff + gsub) ? F.bid - coff : -1, cu = (F.bid >= coff_ut && F.bid < coff_ut + gsub) ? F.bid - coff_ut : -1;
    { pg8::GtSched S{(const char*)(ws + WS_KALL), (const char*)(ws + WS_WQ), gsub, c, la * 128, lb * 128};
      auto E = [=]() { const Frame F2 = make_frame(ldsb); unsigned char* ws2 = F2.ws(); return pg8::EpiBf16P{(bf16*)(ws2 + WS_GT), D, (size_t)4 * NMEM * D, (size_t)NMEM * D, 1.f, nullptr}; };
      pg8::gemm_phase(F.lds, F.tid, 4 * D, D, XA_D, S, E); }
    { pg8::UtSched S{(const char*)(ws + WS_WO), (const char*)(ws + WS_VT), gsub, cu, la * 128, lb * 128};
      auto E = [=]() { const Frame F2 = make_frame(ldsb); unsigned char* ws2 = F2.ws(); return pg8::EpiBf16P{(bf16*)(ws2 + WS_UT), 4 * NMEM, (size_t)D * 4 * NMEM, (size_t)NMEM, 1.f, nullptr}; };
      pg8::gemm_phase(F.lds, F.tid, D, 4 * D, XA_D, S, E); }
}
PHASE_FN_G ph_gemm_gtut(unsigned ldsb, int bar_) {
    const Frame F = make_frame(ldsb); if (F.G >= 256) gtut_units(F, ldsb, 0, 1, 128, 0, 128); else gtut_units(F, ldsb, 0, 1, F.G, 0, 0);
    phase_end(ldsb, bar_);
}
PHASE_FN_G ph_attn_scores(unsigned ldsb, int l_, int bar_) {
    const Frame F = make_frame(ldsb); const int l = uni(l_); unsigned char* ws = F.ws();
    pg8::ScSched S{(const char*)(ws + WS_HB), (const char*)(ws + WS_GT) + (size_t)l * 16 * NMEM * D * 2, F.G, F.bid};
    auto E = [=]() { const Frame F2 = make_frame(ldsb); unsigned char* ws2 = F2.ws(); return pg8::EpiSoftmax{(bf16*)(ws2 + WS_PB), 0.044194173824159216f, F2.lds, (const float*)(ws2 + WS_MISC) + MISC_SSQ / 4}; };
    pg8::gemm_phase(F.lds, F.tid, D, D, D, S, E);
    if (l + 1 < DEPTH) gtut_units(F, ldsb, l + 1, l + 2, F.G > 128 ? F.G - 128 : F.G, F.G > 128 ? 128 : 0, F.G > 128 ? 128 : 0);
    phase_end(ldsb, bar_);
}
PHASE_FN_G ph_gemm_attnout(unsigned ldsb, int l_, int bar_) {
    const Frame F = make_frame(ldsb); const int l = uni(l_); unsigned char* ws = F.ws();
    pg8::PlainSched<4 * NMEM, 4 * NMEM, M, D, 30, 0, 3, (unsigned)(D * 4 * NMEM * 2)> S; S.init(F.lds, ws + WS_PB, ws + WS_UT + (size_t)l * 4 * D * 4 * NMEM * 2);
    auto E = [=]() { const Frame F2 = make_frame(ldsb); unsigned char* ws2 = F2.ws(); float* X = (float*)(ws2 + WS_X); return pg8::EpiResid{X, X, (bf16*)(ws2 + WS_HB), (float*)(ws2 + WS_MISC) + MISC_SSQ / 4, 1.0f, F2.lds, F2.tid}; };
    pg8::gemm_phase(F.lds, F.tid, 4 * NMEM, 4 * NMEM, 4 * NMEM, S, E);
    phase_end(ldsb, bar_);
}

constexpr int SLOTS = 20, PH_LAYER0 = 3, PH_FINAL = PH_LAYER0 + DEPTH * SLOTS, N_PHASES = PH_FINAL + 1;
enum { SL_NORM0 = 0, SL_GU1, SL_DN1, SL_NORM1, SL_MIXIN, SL_MIXA, SL_MIXB, SL_MIXC, SL_MIXD, SL_MIXOUT, SL_NORM2, SL_QPROJ, SL_SCORES, SL_SOFTMAX, SL_PV, SL_OPROJ, SL_NORM3, SL_GU2, SL_DN2, SL_SPARE };
__host__ __device__ constexpr bool phase_used(int ph) {
    if (ph < PH_LAYER0 || ph == PH_FINAL) return true;
    const int l = (ph - PH_LAYER0) / SLOTS, s = (ph - PH_LAYER0) % SLOTS, kind = l % 3;
    if (s == SL_SPARE || s == SL_QPROJ || s == SL_SOFTMAX || s == SL_PV || s == SL_NORM0 || s == SL_NORM1 || s == SL_NORM2 || s == SL_NORM3) return false;
    if (s == SL_MIXC) return true;
    if (s == SL_MIXD) return kind == 2;
    return true;
}
__device__ __forceinline__ int ctl_lo(unsigned ldsb) { return __builtin_amdgcn_readfirstlane(*(volatile LAS int*)((LAS unsigned char*)(size_t)ldsb + CTRL + 56)); }
__device__ __forceinline__ int ctl_hi(unsigned ldsb) { return __builtin_amdgcn_readfirstlane(*(volatile LAS int*)((LAS unsigned char*)(size_t)ldsb + CTRL + 60)); }
#ifndef PROBE_SEL
#define PROBE_SEL -1
#endif
#if PROBE_SEL >= 0
#ifndef PROBE_AMP
#define PROBE_AMP 4
#endif
__host__ __device__ constexpr int probe_cls(int k) { if (k < PH_LAYER0) return PROBE_SEL >= 20 ? 20 + k : 0; if (k >= PH_FINAL) return 8; const int s = (k - PH_LAYER0) % SLOTS;
    { const int l = (k - PH_LAYER0) / SLOTS, kind = l % 3;
      if (PROBE_SEL >= 10) { if (kind == 0 && s == SL_MIXA) return 10; if (kind == 0 && s == SL_MIXB) return 16; if (kind == 1 && s == SL_MIXA) return 11; if (kind == 1 && s == SL_MIXB) return 12; if (kind == 1 && s == SL_MIXC) return 13;
          if (kind == 2 && s == SL_MIXA) return 14; if (kind == 2 && s == SL_MIXB) return 15; if (kind == 2 && s == SL_MIXC) return 17; if (kind == 2 && s == SL_MIXD) return 18; if (kind == 0 && s == SL_MIXC) return 19; return 99; } }
    return (s == SL_GU1 || s == SL_GU2) ? 1 : (s == SL_DN1 || s == SL_DN2) ? 2 : s == SL_MIXIN ? 3 : (s == SL_MIXA || s == SL_MIXB || s == SL_MIXC || s == SL_MIXD) ? 4 : s == SL_MIXOUT ? 5 : s == SL_SCORES ? 6 : 7; }
__device__ __forceinline__ void probe_t0(unsigned ldsb) { const Frame F = make_frame(ldsb); if (F.tid == 0) *(volatile LAS unsigned long long*)(F.lds + CTRL + 320) = __builtin_amdgcn_s_memrealtime(); }
__device__ __forceinline__ void probe_t1(unsigned ldsb, int cls) { const Frame F = make_frame(ldsb); if (F.tid == 0 && cls == PROBE_SEL) { const unsigned long long t1 = __builtin_amdgcn_s_memrealtime(), t0 = *(volatile LAS unsigned long long*)(F.lds + CTRL + 320);
        *(volatile LAS unsigned*)(F.lds + CTRL + 328) = *(volatile LAS unsigned*)(F.lds + CTRL + 328) + (unsigned)(t1 - t0); } }
#define RUN(k, fn, ...) do { const int hi_ = ctl_hi(ldsb); if (ctl_lo(ldsb) <= (k) && (k) < hi_) { probe_t0(ldsb); fn(ldsb, ##__VA_ARGS__, ((k) + 1 < hi_) ? 1 : 0); probe_t1(ldsb, probe_cls(k)); } } while (0)
#else
#define RUN(k, fn, ...) do { const int hi_ = ctl_hi(ldsb); if (ctl_lo(ldsb) <= (k) && (k) < hi_) fn(ldsb, ##__VA_ARGS__, ((k) + 1 < hi_) ? 1 : 0); } while (0)
#endif

template <int L> __device__ __forceinline__ void run_layer(const unsigned ldsb) {
    constexpr int pb = PH_LAYER0 + L * SLOTS, kind = L % 3;
    RUN(pb + SL_GU1, ph_gemm_gu, L, 0);
    RUN(pb + SL_DN1, ph_gemm_dn, L, 0);
    if constexpr (kind == 0) {
        RUN(pb + SL_MIXIN, ph_gemm_hgin, L);
        RUN(pb + SL_MIXA, ph_hg_prep);
        RUN(pb + SL_MIXB, ph_hg_recur, L);
        RUN(pb + SL_MIXC, ph_hg_norm, L / 3);
    } else if constexpr (kind == 1) {
        RUN(pb + SL_MIXIN, ph_gemm_lruin);
        RUN(pb + SL_MIXA, ph_lru_conv);
        RUN(pb + SL_MIXB, ph_gemm_lrugate);
        RUN(pb + SL_MIXC, ph_lru_scan);
    } else {
        RUN(pb + SL_MIXIN, ph_gemm_mlin);
        RUN(pb + SL_MIXA, ph_ml_gates);
        RUN(pb + SL_MIXB, ph_ml_prep);
        RUN(pb + SL_MIXC, ph_ml_recur, L);
        RUN(pb + SL_MIXD, ph_ml_norm);
    }
    RUN(pb + SL_MIXOUT, ph_gemm_resid, GR_MIXOUT, L);
    RUN(pb + SL_SCORES, ph_attn_scores, L);
    RUN(pb + SL_OPROJ, ph_gemm_attnout, L);
    RUN(pb + SL_GU2, ph_gemm_gu, L, 1);
    RUN(pb + SL_DN2, ph_gemm_dn, L, 1);
}

__global__ void __launch_bounds__(NT, 2) fwd_kernel(Args args) {
    extern __shared__ __attribute__((aligned(16))) unsigned char lds_raw[];
    LAS unsigned char* lds = (LAS unsigned char*)lds_raw;
    const unsigned ldsb = (unsigned)(size_t)lds;
    {
        const int tid = threadIdx.x, lane = tid & 63, wave = tid >> 6;
        LAS unsigned* cw = (LAS unsigned*)(lds + CTRL);
        if (tid < 4) cw[tid] = 0u;
        if (tid == 0) cw[82] = 0u;
        if (lane == 0) cw[4 + wave] = hw_wave_key();
        if (tid == 0) { cw[12] = blockIdx.x; cw[13] = gridDim.x; cw[14] = (unsigned)args.ph_lo; cw[15] = (unsigned)args.ph_hi;
            LAS unsigned long long* ap = (LAS unsigned long long*)(lds + CTRL + 64);
#pragma unroll
            for (int i = 0; i < 27; ++i) ap[i] = (unsigned long long)args.in[i];
            ap[27] = (unsigned long long)args.out; ap[28] = (unsigned long long)args.ws; }
        __syncthreads();
        if (args.ph_hi - args.ph_lo > 1 && tid == 0) (void)xb_add(&((unsigned*)(args.ws + WS_CTL))[XB_XCNT(xb_xcc_id())], 1u);
    }
    RUN(0, ph_prologue);
    RUN(1, ph_gemm_kv);
    RUN(2, ph_gemm_gtut);
    run_layer<0>(ldsb); run_layer<1>(ldsb); run_layer<2>(ldsb); run_layer<3>(ldsb);
    { if (ctl_lo(ldsb) <= PH_FINAL && PH_FINAL < ctl_hi(ldsb)) ph_final(ldsb); }
#if PROBE_SEL >= 0
    { const Frame F = make_frame(ldsb); if (F.bid == 0) { __syncthreads(); const unsigned acc = *(volatile LAS unsigned*)(F.lds + CTRL + 328);
        const unsigned long long tend = __builtin_amdgcn_s_memrealtime() + (unsigned long long)acc * PROBE_AMP; while (__builtin_amdgcn_s_memrealtime() < tend) __builtin_amdgcn_s_sleep(8); } }
#endif
}

extern "C" void kernel_launch(void* const* d_in, const int* in_sizes, int n_in, void* d_out, int out_size, void* d_ws, size_t ws_size, hipStream_t stream) {
    static int grid = 0;
    if (grid == 0) {
        if (n_in != 27 || in_sizes[0] != M * D || out_size != M * D || ws_size < WS_END) { fprintf(stderr, "kernel_launch: unexpected shapes (n_in %d, in0 %d, out %d, ws %zu < %zu)\n", n_in, n_in > 0 ? in_sizes[0] : -1, out_size, ws_size, (size_t)WS_END); grid = -1; return; }
        int dev = 0, cus = 0, per_cu = 0;
        if (hipGetDevice(&dev) != hipSuccess || hipDeviceGetAttribute(&cus, hipDeviceAttributeMultiprocessorCount, dev) != hipSuccess) { grid = -1; return; }
        if (hipFuncSetAttribute((const void*)fwd_kernel, hipFuncAttributeMaxDynamicSharedMemorySize, LDS_BYTES) != hipSuccess) { fprintf(stderr, "kernel_launch: hipFuncSetAttribute failed\n"); grid = -1; return; }
        if (hipOccupancyMaxActiveBlocksPerMultiprocessor(&per_cu, (const void*)fwd_kernel, NT, LDS_BYTES) != hipSuccess || per_cu < 1) fprintf(stderr, "kernel_launch: occupancy query reports %d\n", per_cu);
        (void)hipGetLastError();
        grid = cus;
    }
    if (grid < 0) return;
    if (hipMemsetAsync((char*)d_ws + WS_CTL, 0, CTL_BYTES, stream) != hipSuccess) { fprintf(stderr, "kernel_launch: memset failed\n"); return; }
    Args a{};
    for (int i = 0; i < 27; ++i) a.in[i] = (const float*)d_in[i];
    a.out = (float*)d_out; a.ws = (unsigned char*)d_ws;
#if MK_ONE_LAUNCH
    a.ph_lo = 0; a.ph_hi = N_PHASES;
    hipLaunchKernelGGL(fwd_kernel, dim3(grid), dim3(NT), LDS_BYTES, stream, a);
#else
    for (int ph = 0; ph < N_PHASES; ++ph) { if (!phase_used(ph)) continue; a.ph_lo = ph; a.ph_hi = ph + 1;
        hipLaunchKernelGGL(fwd_kernel, dim3(grid), dim3(NT), LDS_BYTES, stream, a);
        const hipError_t le = hipPeekAtLastError(); if (le != hipSuccess) { fprintf(stderr, "kernel_launch: launch of phase %d failed: %s\n", ph, hipGetErrorName(le)); break; } }
#endif
}
```

```cpp
#include <hip/hip_runtime.h>
#include <cstdio>
#include <cstdint>

#ifndef X_F32
#define X_F32 0
#endif
#ifndef MK_ONE_LAUNCH
#define MK_ONE_LAUNCH 1
#define FUSE_TAIL 0
#ifndef FUSE_TAIL
#define FUSE_TAIL 1
#endif
#endif

#define LAS __attribute__((address_space(3)))
typedef unsigned short bf16;
typedef short bf16x8 __attribute__((ext_vector_type(8)));
typedef float f32x4 __attribute__((ext_vector_type(4)));
typedef float f32x2 __attribute__((ext_vector_type(2)));
typedef unsigned u32x4 __attribute__((ext_vector_type(4)));
typedef unsigned u32x2 __attribute__((ext_vector_type(2)));
#define GAS __attribute__((address_space(1)))

constexpr int BATCH = 4, SEQ = 2048, D = 2048, DEPTH = 4, M = BATCH * SEQ;
constexpr int NMEM = 256, MMEM = BATCH * NMEM;
constexpr int DFF = 5504, NGU = 2 * DFF;
constexpr int HG_H = 16, HG_D = 128;
constexpr int ML_H = 8, ML_DQK = 128, ML_DV = 256, ML_IN = 6160, ML_PROJ = 6144;
constexpr int XA_H = 4, XA_D = 512;
constexpr float EPS = 1e-6f;
constexpr int LDS_BYTES = 147456;
constexpr int CTRL = LDS_BYTES - 512;

__device__ __forceinline__ unsigned pk2(float lo, float hi) { unsigned r; asm volatile("v_cvt_pk_bf16_f32 %0, %1, %2" : "=v"(r) : "v"(lo), "v"(hi)); return r; }
__device__ __forceinline__ float bflo(unsigned w) { return __uint_as_float(w << 16); }
__device__ __forceinline__ float bfhi(unsigned w) { return __uint_as_float(w & 0xffff0000u); }
__device__ __forceinline__ float sigmoidf_(float x) { return __builtin_amdgcn_rcpf(1.0f + __expf(-x)); }
__device__ __forceinline__ float siluf_(float x) { return x * sigmoidf_(x); }
__device__ __forceinline__ float gelu_tanh_(float x) { const float u = 0.7978845608028654f * (x + 0.044715f * x * x * x); const float t = 1.0f - 2.0f * __builtin_amdgcn_rcpf(__expf(2.0f * u) + 1.0f); return 0.5f * x * (1.0f + t); }
__device__ __forceinline__ float wave_sum(float v) {
#pragma unroll
    for (int o = 1; o < 64; o <<= 1) v += __shfl_xor(v, o);
    return v;
}
__device__ __forceinline__ float wave_max(float v) {
#pragma unroll
    for (int o = 1; o < 64; o <<= 1) v = fmaxf(v, __shfl_xor(v, o));
    return v;
}

__device__ __forceinline__ int lds_ld_i32(LAS unsigned char* p) { return __builtin_amdgcn_readfirstlane(*(volatile LAS int*)p); }
__device__ __forceinline__ const char* lds_ld_ptr(LAS unsigned char* p) { const unsigned lo = __builtin_amdgcn_readfirstlane(*(volatile LAS unsigned*)p), hi = __builtin_amdgcn_readfirstlane(*(volatile LAS unsigned*)(p + 4)); return (const char*)(((unsigned long long)hi << 32) | lo); }

namespace pg8 {
constexpr int BM = 256, BK = 64, HALF = 128, HTB = HALF * BK * 2, STAGE_BYTES = 8 * HTB, NXCD = 8, WGM = 8;
__host__ __device__ __forceinline__ int lds_byte(int r, int c) { const int st = (r >> 4) * 2 + (c >> 5), rr = r & 15, cc = c & 31, ob = rr * 64 + cc * 2; return st * 1024 + (ob ^ (((ob >> 9) & 1) << 5)); }
__host__ __device__ __forceinline__ void stage_rc(int b, int& R, int& C) { const int st = b / 1024, sb = b % 1024, swz = sb ^ (((sb >> 9) & 1) << 5); R = (st >> 1) * 16 + swz / 64; C = (st & 1) * 32 + (swz % 64) / 2; }
__host__ __device__ __forceinline__ int perm32(int rho) { const int n = rho >> 4, i = rho & 15; return 8 * (i >> 2) + 4 * n + (i & 3); }

struct Unit { int pm, pn, z; };

template <int LDA, int LDB, int MROWS, int NCOLS, int ZSHIFT = 30, int AZ = 0, int BPMSHIFT = 30, unsigned BPMSTRIDE = 0>
struct PlainSched {
    static constexpr int nM = MROWS / BM, nN = NCOLS / BM, nwg = nM * nN; static constexpr unsigned a_tile = BM * LDA * 2, b_tile = BM * LDB * 2;
    LAS unsigned char* lds; int gsub = 0, coff = 0;
    __device__ void init(LAS unsigned char* lds_, const void* A_, const void* B_) { lds = lds_;
        *(volatile LAS unsigned long long*)(lds + CTRL + 304) = (unsigned long long)A_; *(volatile LAS unsigned long long*)(lds + CTRL + 312) = (unsigned long long)B_; __syncthreads(); }
    __device__ bool next(int i, Unit& u) const {
        const int G = gsub > 0 ? gsub : lds_ld_i32(lds + CTRL + 52), c = lds_ld_i32(lds + CTRL + 48) - coff;
        const int L = i * G + c; if (L >= nwg) return false;
        int wgid = L; { constexpr int q = nwg / NXCD, r = nwg % NXCD; const int xcd = wgid % NXCD, off = wgid / NXCD; wgid = (xcd < r ? xcd * (q + 1) : r * (q + 1) + (xcd - r) * q) + off; }
        constexpr int nig = WGM * nN; const int gid = wgid / nig, fm = gid * WGM, gsz = (nM - fm) < WGM ? (nM - fm) : WGM;
        u.pm = fm + ((wgid % nig) % gsz); u.pn = (wgid % nig) / gsz; u.z = u.pn >> ZSHIFT; return true;
    }
    __device__ __forceinline__ const char* a_ptr(const Unit& u) const { return lds_ld_ptr(lds + CTRL + 304) + (size_t)((unsigned)u.pm * a_tile) + (size_t)((unsigned)u.z * (unsigned)AZ); }
    __device__ __forceinline__ const char* b_ptr(const Unit& u) const { return lds_ld_ptr(lds + CTRL + 312) + (size_t)((unsigned)u.pn * b_tile) + (size_t)((unsigned)(u.pm >> BPMSHIFT) * BPMSTRIDE); }
};
struct BatchSched {
    LAS unsigned char* lds; unsigned a_b, a_h, a_pm, b_b, b_h, b_pn; int nM, nN, nwg;
    __device__ void init(LAS unsigned char* lds_, const void* A_, const void* B_) { lds = lds_;
        *(volatile LAS unsigned long long*)(lds + CTRL + 304) = (unsigned long long)A_; *(volatile LAS unsigned long long*)(lds + CTRL + 312) = (unsigned long long)B_; __syncthreads(); }
    __device__ bool next(int i, Unit& u) const {
        const int G = lds_ld_i32(lds + CTRL + 52), c = lds_ld_i32(lds + CTRL + 48);
        const int L = i * G + c; if (L >= nwg) return false;
        const int per = nM * nN, z = L / per, r = L % per; u.pm = r % nM; u.pn = r / nM; u.z = z;
        return true;
    }
    __device__ __forceinline__ const char* a_ptr(const Unit& u) const { return lds_ld_ptr(lds + CTRL + 304) + (size_t)((unsigned)(u.z >> 2) * a_b) + (size_t)((unsigned)(u.z & 3) * a_h) + (size_t)((unsigned)u.pm * a_pm); }
    __device__ __forceinline__ const char* b_ptr(const Unit& u) const { return lds_ld_ptr(lds + CTRL + 312) + (size_t)((unsigned)(u.z >> 2) * b_b) + (size_t)((unsigned)(u.z & 3) * b_h) + (size_t)((unsigned)u.pn * b_pn); }
};

typedef f32x4 Acc[2][2][4][2];

__device__ __forceinline__ void load_rstd(const float* SSQ, int row0, float (&rs)[2][4]) {
#pragma unroll
    for (int ai = 0; ai < 2; ++ai)
#pragma unroll
        for (int m = 0; m < 4; ++m) { const float* p = SSQ + (size_t)(row0 + ai * HALF + m * 16) * 8; const f32x4 a = *(const f32x4*)p, b = *(const f32x4*)(p + 4);
            rs[ai][m] = __builtin_amdgcn_rsqf((((a[0] + a[1]) + (a[2] + a[3])) + ((b[0] + b[1]) + (b[2] + b[3]))) * (1.0f / D) + EPS); }
}
struct EpiBf16P {
    static constexpr bool PERM = true;
    bf16* O; int ldc; size_t zb, zh; float scale; const float* SSQ; int cgrp = 0; size_t cgs = 0;
    __device__ __forceinline__ void operator()(const Acc& acc, const Unit& u, int wr, int wc, int fr, int fq) const {
        bf16* base = O + (size_t)(u.z >> 2) * zb + (size_t)(u.z & 3) * zh; int pnl = u.pn;
        if (cgrp > 0) { base += (size_t)(u.pn / cgrp) * cgs; pnl = u.pn % cgrp; }
        const int row0 = u.pm * BM + wr * 64 + fr, col0 = pnl * BM + wc * 32 + 8 * fq;
        float rs[2][4];
        if (SSQ) load_rstd(SSQ, row0, rs); else {
#pragma unroll
            for (int ai = 0; ai < 2; ++ai)
#pragma unroll
                for (int m = 0; m < 4; ++m) rs[ai][m] = 1.0f; }
#pragma unroll
        for (int ai = 0; ai < 2; ++ai)
#pragma unroll
            for (int m = 0; m < 4; ++m) { bf16* rowp = base + (size_t)(row0 + ai * HALF + m * 16) * ldc + col0; const float sc = scale * rs[ai][m];
#pragma unroll
                for (int bj = 0; bj < 2; ++bj) { const f32x4 v0 = acc[ai][bj][m][0] * sc, v1 = acc[ai][bj][m][1] * sc;
                    u32x4 w; w.x = pk2(v0[0], v0[1]); w.y = pk2(v0[2], v0[3]); w.z = pk2(v1[0], v1[1]); w.w = pk2(v1[2], v1[3]);
                    *(u32x4*)(rowp + bj * HALF) = w; } }
    }
};
struct EpiMlIn {
    static constexpr bool PERM = true;
    bf16* PB; float* GATES; const float* SSQ;
    __device__ __forceinline__ void operator()(const Acc& acc, const Unit& u, int wr, int wc, int fr, int fq) const {
        const int row0 = u.pm * BM + wr * 64 + fr, col0 = u.pn * BM + wc * 32 + 8 * fq;
        float rs[2][4]; load_rstd(SSQ, row0, rs);
        if (u.pn < 24) {
#pragma unroll
            for (int ai = 0; ai < 2; ++ai)
#pragma unroll
                for (int m = 0; m < 4; ++m) { bf16* rowp = PB + (size_t)(row0 + ai * HALF + m * 16) * ML_PROJ + col0; const float sc = rs[ai][m];
#pragma unroll
                    for (int bj = 0; bj < 2; ++bj) { const f32x4 v0 = acc[ai][bj][m][0] * sc, v1 = acc[ai][bj][m][1] * sc;
                        u32x4 w; w.x = pk2(v0[0], v0[1]); w.y = pk2(v0[2], v0[3]); w.z = pk2(v1[0], v1[1]); w.w = pk2(v1[2], v1[3]);
                        *(u32x4*)(rowp + bj * HALF) = w; } }
        } else if (wc == 0 && fq < 2) {
#pragma unroll
            for (int ai = 0; ai < 2; ++ai)
#pragma unroll
                for (int m = 0; m < 4; ++m) { float* gp = GATES + (size_t)(row0 + ai * HALF + m * 16) * 16 + 8 * fq; const float sc = rs[ai][m];
                    *(f32x4*)gp = acc[ai][0][m][0] * sc; *(f32x4*)(gp + 4) = acc[ai][0][m][1] * sc; }
        }
    }
};
struct EpiSwiGLU {
    static constexpr bool PERM = true;
    bf16* O; const float* SSQ;
    __device__ __forceinline__ void operator()(const Acc& acc, const Unit& u, int wr, int wc, int fr, int fq) const {
        const int row0 = u.pm * BM + wr * 64 + fr, col0 = u.pn * HALF + wc * 32 + 8 * fq;
        float rs[2][4]; load_rstd(SSQ, row0, rs);
#pragma unroll
        for (int ai = 0; ai < 2; ++ai)
#pragma unroll
            for (int m = 0; m < 4; ++m) { bf16* p = O + (size_t)(row0 + ai * HALF + m * 16) * DFF + col0; const float sc = rs[ai][m];
                const f32x4 g0 = acc[ai][0][m][0] * sc, g1 = acc[ai][0][m][1] * sc, u0 = acc[ai][1][m][0] * sc, u1 = acc[ai][1][m][1] * sc;
                u32x4 w; w.x = pk2(siluf_(g0[0]) * u0[0], siluf_(g0[1]) * u0[1]); w.y = pk2(siluf_(g0[2]) * u0[2], siluf_(g0[3]) * u0[3]);
                w.z = pk2(siluf_(g1[0]) * u1[0], siluf_(g1[1]) * u1[1]); w.w = pk2(siluf_(g1[2]) * u1[2], siluf_(g1[3]) * u1[3]);
                *(u32x4*)p = w; }
    }
};
template <bool XF32> struct EpiResidT {
    static constexpr bool PERM = true;
    const float* Xin; float* Xout; bf16* XB; float* SSQ; float scale; LAS unsigned char* lds; int tid;
    __device__ __forceinline__ void operator()(const Acc& acc, const Unit& u, int wr, int wc, int fr, int fq) const {
        typedef __attribute__((address_space(1))) const f32x4 gcf4; typedef __attribute__((address_space(1))) f32x4 gf4; typedef __attribute__((address_space(1))) u32x4 gu4;
        typedef __attribute__((address_space(1))) const float gcf; typedef __attribute__((address_space(1))) float gf; typedef __attribute__((address_space(1))) bf16 gb;
        gcf* xin = (gcf*)Xin; gf* xout = (gf*)Xout; gb* xb = (gb*)XB;
        const int row0 = u.pm * BM + wr * 64 + fr, col0 = u.pn * BM + wc * 32 + 8 * fq;
        LAS float* red = (LAS float*)(lds + STAGE_BYTES);
#pragma unroll
        for (int ai = 0; ai < 2; ++ai)
#pragma unroll
            for (int m = 0; m < 4; ++m) { const unsigned off = (unsigned)(row0 + ai * HALF + m * 16) * (unsigned)D + (unsigned)col0; float ss = 0.f;
#pragma unroll
                for (int bj = 0; bj < 2; ++bj) { const unsigned o = off + bj * HALF; f32x4 x0, x1;
                    if constexpr (XF32) { x0 = *(gcf4*)(xin + o); x1 = *(gcf4*)(xin + o + 4); }
                    else { const u32x4 w = *(const gu4*)(xb + o); x0 = (f32x4){bflo(w.x), bfhi(w.x), bflo(w.y), bfhi(w.y)}; x1 = (f32x4){bflo(w.z), bfhi(w.z), bflo(w.w), bfhi(w.w)}; }
                    x0 += acc[ai][bj][m][0] * scale; x1 += acc[ai][bj][m][1] * scale;
                    if constexpr (XF32) { *(gf4*)(xout + o) = x0; *(gf4*)(xout + o + 4) = x1; }
                    u32x4 w; w.x = pk2(x0[0], x0[1]); w.y = pk2(x0[2], x0[3]); w.z = pk2(x1[0], x1[1]); w.w = pk2(x1[2], x1[3]); *(gu4*)(xb + o) = w;
                    ss += ((x0[0] * x0[0] + x0[1] * x0[1]) + (x0[2] * x0[2] + x0[3] * x0[3])) + ((x1[0] * x1[0] + x1[1] * x1[1]) + (x1[2] * x1[2] + x1[3] * x1[3]));
                    asm volatile("" ::: "memory"); }
                ss += __shfl_xor(ss, 16); ss += __shfl_xor(ss, 32);
                if (fq == 0) red[(ai * HALF + wr * 64 + m * 16 + fr) * 4 + wc] = ss; }
        asm volatile("s_waitcnt lgkmcnt(0)" ::: "memory"); __builtin_amdgcn_s_barrier(); asm volatile("" ::: "memory");
        if (tid < 256) { const f32x4 r = *(const LAS f32x4*)(red + tid * 4); SSQ[(size_t)(u.pm * BM + tid) * 8 + u.pn] = (r[0] + r[1]) + (r[2] + r[3]); }
        asm volatile("s_waitcnt lgkmcnt(0)" ::: "memory"); __builtin_amdgcn_s_barrier(); asm volatile("" ::: "memory");
    }
};
typedef EpiResidT<(X_F32 != 0)> EpiResid;
struct EpiHgIn {
    static constexpr bool PERM = true;
    bf16* P0; bf16* LF; const float* lb; const float* SSQ;
    __device__ __forceinline__ void operator()(const Acc& acc, const Unit& u, int wr, int wc, int fr, int fq) const {
        const int grp = u.pn >> 3; const int row0 = u.pm * BM + wr * 64 + fr, col0 = (u.pn & 7) * BM + wc * 32 + 8 * fq;
        float rs[2][4]; load_rstd(SSQ, row0, rs);
        if (grp == 1) {
#pragma unroll
            for (int bj = 0; bj < 2; ++bj) {
                const f32x4 l0 = *(const f32x4*)(lb + col0 + bj * HALF), l1 = *(const f32x4*)(lb + col0 + bj * HALF + 4);
                const float lbv[8] = {l0[0], l0[1], l0[2], l0[3], l1[0], l1[1], l1[2], l1[3]};
#pragma unroll
                for (int ai = 0; ai < 2; ++ai)
#pragma unroll
                    for (int m = 0; m < 4; ++m) { const size_t o = (size_t)(row0 + ai * HALF + m * 16) * D + col0 + bj * HALF;
                        const f32x4 v0 = acc[ai][bj][m][0] * rs[ai][m], v1 = acc[ai][bj][m][1] * rs[ai][m];
                        const float a[8] = {v0[0], v0[1], v0[2], v0[3], v1[0], v1[1], v1[2], v1[3]};
                        float lf[8];
#pragma unroll
                        for (int j = 0; j < 8; ++j) { const float e = __expf(-a[j]); const float sg = __builtin_amdgcn_rcpf(1.0f + e); const float om = 1.0f - lbv[j];
                            const float f = lbv[j] + om * sg; lf[j] = __logf(fmaxf(f, 1e-12f)); }
                        { u32x4 w; w.x = pk2(lf[0], lf[1]); w.y = pk2(lf[2], lf[3]); w.z = pk2(lf[4], lf[5]); w.w = pk2(lf[6], lf[7]); *(u32x4*)(LF + o) = w; }
                        asm volatile("" ::: "memory"); }
            }
        } else {
            bf16* dst = P0 + (size_t)grp * M * D;
#pragma unroll
            for (int ai = 0; ai < 2; ++ai)
#pragma unroll
                for (int m = 0; m < 4; ++m) { const size_t ro = (size_t)(row0 + ai * HALF + m * 16) * D + col0;
#pragma unroll
                    for (int bj = 0; bj < 2; ++bj) { const f32x4 v0 = acc[ai][bj][m][0] * rs[ai][m], v1 = acc[ai][bj][m][1] * rs[ai][m];
                        float a[8] = {v0[0], v0[1], v0[2], v0[3], v1[0], v1[1], v1[2], v1[3]};
                        if (grp != 2) {
#pragma unroll
                            for (int j = 0; j < 8; ++j) a[j] = siluf_(a[j]); }
                        u32x4 w; w.x = pk2(a[0], a[1]); w.y = pk2(a[2], a[3]); w.z = pk2(a[4], a[5]); w.w = pk2(a[6], a[7]);
                        *(u32x4*)(dst + ro + bj * HALF) = w; }
                    asm volatile("" ::: "memory"); }
        }
    }
};
struct EpiLruIn {
    static constexpr bool PERM = true;
    bf16* GBR; bf16* UR; const float* SSQ;
    __device__ __forceinline__ void operator()(const Acc& acc, const Unit& u, int wr, int wc, int fr, int fq) const {
        const int grp = u.pn >> 3; const int row0 = u.pm * BM + wr * 64 + fr, col0 = (u.pn & 7) * BM + wc * 32 + 8 * fq;
        float rs[2][4]; load_rstd(SSQ, row0, rs);
#pragma unroll
        for (int ai = 0; ai < 2; ++ai)
#pragma unroll
            for (int m = 0; m < 4; ++m) { const size_t ro = (size_t)(row0 + ai * HALF + m * 16) * D + col0;
#pragma unroll
                for (int bj = 0; bj < 2; ++bj) { const f32x4 v0 = acc[ai][bj][m][0] * rs[ai][m], v1 = acc[ai][bj][m][1] * rs[ai][m]; const size_t o = ro + bj * HALF;
                    if (grp == 0) { u32x4 w; w.x = pk2(gelu_tanh_(v0[0]), gelu_tanh_(v0[1])); w.y = pk2(gelu_tanh_(v0[2]), gelu_tanh_(v0[3])); w.z = pk2(gelu_tanh_(v1[0]), gelu_tanh_(v1[1])); w.w = pk2(gelu_tanh_(v1[2]), gelu_tanh_(v1[3]));
                        *(u32x4*)(GBR + o) = w; }
                    else { u32x4 w; w.x = pk2(v0[0], v0[1]); w.y = pk2(v0[2], v0[3]); w.z = pk2(v1[0], v1[1]); w.w = pk2(v1[2], v1[3]); *(u32x4*)(UR + o) = w; } } }
    }
};
struct EpiLruGate {
    static constexpr bool PERM = true;
    const bf16* UC; const float* ba; const float* bx; const float* c8; bf16* LA; bf16* INP;
    __device__ __forceinline__ void operator()(const Acc& acc, const Unit& u, int wr, int wc, int fr, int fq) const {
        const int row0 = u.pm * BM + wr * 64 + fr, ch = u.z * 256 + (u.pn & 1) * HALF + wc * 32 + 8 * fq;
        const f32x4 vba[2] = {*(const f32x4*)(ba + ch), *(const f32x4*)(ba + ch + 4)}, vbx[2] = {*(const f32x4*)(bx + ch), *(const f32x4*)(bx + ch + 4)}, vc8[2] = {*(const f32x4*)(c8 + ch), *(const f32x4*)(c8 + ch + 4)};
#pragma unroll
        for (int ai = 0; ai < 2; ++ai)
#pragma unroll
            for (int m = 0; m < 4; ++m) { const size_t o = (size_t)(row0 + ai * HALF + m * 16) * D + ch;
                const u32x4 uw = *(const u32x4*)(UC + o); const float uu[8] = {bflo(uw.x), bfhi(uw.x), bflo(uw.y), bfhi(uw.y), bflo(uw.z), bfhi(uw.z), bflo(uw.w), bfhi(uw.w)};
                float av[8], iv[8];
#pragma unroll
                for (int n = 0; n < 2; ++n) { const f32x4 pa = acc[ai][0][m][n] + vba[n], px = acc[ai][1][m][n] + vbx[n];
#pragma unroll
                    for (int j = 0; j < 4; ++j) { const float r = sigmoidf_(pa[j]), ig = sigmoidf_(px[j]); const float la = -vc8[n][j] * r;
                        const float x2 = -2.0f * la;
                        const float om = x2 < 0.02f ? x2 * (1.0f - 0.5f * x2 + x2 * x2 * 0.16666667f) : 1.0f - __expf(-x2);
                        const float mult = __builtin_amdgcn_sqrtf(fmaxf(om, 0.0f)); av[4 * n + j] = la; iv[4 * n + j] = mult * (ig * uu[4 * n + j]); } }
                { u32x4 wa, wi; wa.x = pk2(av[0], av[1]); wa.y = pk2(av[2], av[3]); wa.z = pk2(av[4], av[5]); wa.w = pk2(av[6], av[7]);
                    wi.x = pk2(iv[0], iv[1]); wi.y = pk2(iv[2], iv[3]); wi.z = pk2(iv[4], iv[5]); wi.w = pk2(iv[6], iv[7]); *(u32x4*)(LA + o) = wa; *(u32x4*)(INP + o) = wi; } asm volatile("" ::: "memory"); }
    }
};
struct EpiF32Z {
    static constexpr bool PERM = false;
    float* S; float scale;
    __device__ __forceinline__ void operator()(const Acc& acc, const Unit& u, int wr, int wc, int fr, int fq) const {
        float* base = S + (size_t)u.z * SEQ * NMEM; const int row0 = u.pm * BM + wr * 64 + fr, col0 = wc * 32 + 4 * fq;
#pragma unroll
        for (int ai = 0; ai < 2; ++ai)
#pragma unroll
            for (int m = 0; m < 4; ++m) { float* rowp = base + (size_t)(row0 + ai * HALF + m * 16) * NMEM + col0;
#pragma unroll
                for (int bj = 0; bj < 2; ++bj)
#pragma unroll
                    for (int n = 0; n < 2; ++n) *(f32x4*)(rowp + bj * HALF + n * 16) = acc[ai][bj][m][n] * scale; }
    }
};

struct GtSched { const char* Kall; const char* Wq; int G, c, L0, L1;
    __device__ bool next(int i, Unit& u) const { const int L = L0 + i * G + c; if (c < 0 || L >= L1) return false; u.pm = 0; u.pn = L & 7; u.z = L >> 3; return true; }
    __device__ __forceinline__ const char* a_ptr(const Unit& u) const { const int l = u.z >> 4, b = (u.z >> 2) & 3, h = u.z & 3; return Kall + ((size_t)b * NMEM * 4 * D + (size_t)l * D + h * XA_D) * 2; }
    __device__ __forceinline__ const char* b_ptr(const Unit& u) const { const int l = u.z >> 4, h = u.z & 3; return Wq + ((size_t)l * D * D + (size_t)u.pn * 256 * D + h * XA_D) * 2; }
};
struct UtSched { const char* Wo; const char* Vall; int G, c, L0, L1;
    __device__ bool next(int i, Unit& u) const { const int L = L0 + i * G + c; if (c < 0 || L >= L1) return false; u.pm = L & 7; u.pn = 0; u.z = L >> 3; return true; }
    __device__ __forceinline__ const char* a_ptr(const Unit& u) const { const int l = u.z >> 4, h = u.z & 3; return Wo + ((size_t)l * D * D + (size_t)u.pm * 256 * D + h * XA_D) * 2; }
    __device__ __forceinline__ const char* b_ptr(const Unit& u) const { const int l = u.z >> 4, b = (u.z >> 2) & 3, h = u.z & 3; return Vall + ((size_t)b * NMEM * 4 * D + (size_t)l * D + h * XA_D) * 2; }
};
struct ScSched { const char* XBp; const char* GTl; int G, c;
    __device__ bool next(int i, Unit& u) const { const int L = i * G + c; if (L >= 16 * 8) return false; u.pm = L & 7; u.pn = 0; u.z = L >> 3; return true; }
    __device__ __forceinline__ const char* a_ptr(const Unit& u) const { return XBp + ((size_t)(u.z >> 2) * SEQ + (size_t)u.pm * 256) * D * 2; }
    __device__ __forceinline__ const char* b_ptr(const Unit& u) const { return GTl + (size_t)u.z * NMEM * D * 2; }
};
struct OneSched {
    const char* A; const char* B; Unit u0;
    __device__ bool next(int i, Unit& u) const { if (i > 0) return false; u = u0; return true; }
    __device__ __forceinline__ const char* a_ptr(const Unit&) const { return A; }
    __device__ __forceinline__ const char* b_ptr(const Unit&) const { return B; }
};
struct EpiSoftmax {
    static constexpr bool PERM = true;
    bf16* Pall; float scale0; LAS unsigned char* lds; const float* SSQ;
    __device__ __forceinline__ void operator()(const Acc& acc, const Unit& u, int wr, int wc, int fr, int fq) const {
        LAS float* rmax = (LAS float*)(lds + STAGE_BYTES); LAS float* rsum = rmax + 1024;
        const int growb = (u.z >> 2) * SEQ + u.pm * BM; bf16* P = Pall + (size_t)growb * (4 * NMEM) + (u.z & 3) * NMEM;
        float rs[2][4]; load_rstd(SSQ, growb + wr * 64 + fr, rs);
        float mx[2][4];
#pragma unroll
        for (int ai = 0; ai < 2; ++ai)
#pragma unroll
            for (int m = 0; m < 4; ++m) { float v = -3.0e38f;
#pragma unroll
                for (int bj = 0; bj < 2; ++bj)
#pragma unroll
                    for (int n = 0; n < 2; ++n) { const f32x4 a = acc[ai][bj][m][n]; v = fmaxf(v, fmaxf(fmaxf(a[0], a[1]), fmaxf(a[2], a[3]))); }
                v = fmaxf(v, __shfl_xor(v, 16)); v = fmaxf(v, __shfl_xor(v, 32));
                if (fq == 0) rmax[(ai * HALF + wr * 64 + m * 16 + fr) * 4 + wc] = v; }
        asm volatile("s_waitcnt lgkmcnt(0)" ::: "memory"); __builtin_amdgcn_s_barrier(); asm volatile("" ::: "memory");
#pragma unroll
        for (int ai = 0; ai < 2; ++ai)
#pragma unroll
            for (int m = 0; m < 4; ++m) { const int rl = ai * HALF + wr * 64 + m * 16 + fr; const f32x4 r = *(const LAS f32x4*)(rmax + rl * 4); const float mxa = fmaxf(fmaxf(r[0], r[1]), fmaxf(r[2], r[3])); mx[ai][m] = mxa; const float scale = scale0 * rs[ai][m];
                float s = 0.f;
#pragma unroll
                for (int bj = 0; bj < 2; ++bj)
#pragma unroll
                    for (int n = 0; n < 2; ++n) { const f32x4 a = acc[ai][bj][m][n]; s += (__expf((a[0] - mxa) * scale) + __expf((a[1] - mxa) * scale)) + (__expf((a[2] - mxa) * scale) + __expf((a[3] - mxa) * scale)); }
                s += __shfl_xor(s, 16); s += __shfl_xor(s, 32);
                if (fq == 0) rsum[rl * 4 + wc] = s; }
        asm volatile("s_waitcnt lgkmcnt(0)" ::: "memory"); __builtin_amdgcn_s_barrier(); asm volatile("" ::: "memory");
#pragma unroll
        for (int ai = 0; ai < 2; ++ai)
#pragma unroll
            for (int m = 0; m < 4; ++m) { const int rl = ai * HALF + wr * 64 + m * 16 + fr; const f32x4 r = *(const LAS f32x4*)(rsum + rl * 4); const float inv = __builtin_amdgcn_rcpf((r[0] + r[1]) + (r[2] + r[3])); const float mxa = mx[ai][m]; const float scale = scale0 * rs[ai][m];
                bf16* rowp = P + (size_t)rl * (4 * NMEM) + wc * 32 + 8 * fq;
#pragma unroll
                for (int bj = 0; bj < 2; ++bj) { const f32x4 a0 = acc[ai][bj][m][0], a1 = acc[ai][bj][m][1];
                    u32x4 w; w.x = pk2(__expf((a0[0] - mxa) * scale) * inv, __expf((a0[1] - mxa) * scale) * inv); w.y = pk2(__expf((a0[2] - mxa) * scale) * inv, __expf((a0[3] - mxa) * scale) * inv);
                    w.z = pk2(__expf((a1[0] - mxa) * scale) * inv, __expf((a1[1] - mxa) * scale) * inv); w.w = pk2(__expf((a1[2] - mxa) * scale) * inv, __expf((a1[3] - mxa) * scale) * inv);
                    *(u32x4*)(rowp + bj * HALF) = w; } }
        asm volatile("s_waitcnt lgkmcnt(0)" ::: "memory"); __builtin_amdgcn_s_barrier(); asm volatile("" ::: "memory");
    }
};

template <class Epi, class Sched, class MkEpi, bool ALIGN_EPI = true, bool SP2 = true>
__device__ __forceinline__ void gemm_phase_(LAS unsigned char* lds, const int tid, const int lda, const int ldb, const int K, const Sched& S, const MkEpi& mk) {
    const int wid = __builtin_amdgcn_readfirstlane(tid >> 6), lane = tid & 63, wr = wid >> 2, wc = wid & 3, fr = lane & 15, fq = lane >> 4;
    int nt = K / BK; asm volatile("" : "+s"(nt));
    unsigned voffA[2], voffB[2];
#pragma unroll
    for (int i = 0; i < 2; ++i) { int R, C; stage_rc(tid * 16 + i * 8192, R, C); const int Rb = Epi::PERM ? ((R & ~31) + perm32(R & 31)) : R;
        voffA[i] = (unsigned)(R * lda + C) * 2u; voffB[i] = (unsigned)(Rb * ldb + C) * 2u; }
    constexpr unsigned kstep = BK * 2;
    const unsigned hstepA = (unsigned)(HALF * lda * 2), hstepB = (unsigned)(HALF * ldb * 2);
    const unsigned ldsw = (unsigned)wid * 1024u;
    const int aoff = lds_byte(wr * 64 + fr, fq * 8), boff = lds_byte(wc * 32 + fr, fq * 8);
#define PG8_SA(b, h) (((b) * 2 + (h)) * HTB)
#define PG8_SB(b, h) ((4 + (b) * 2 + (h)) * HTB)
#define PG8_STAGE(bufoff, gbase, voff) do { _Pragma("unroll") for (int _i = 0; _i < 2; ++_i) \
        __builtin_amdgcn_global_load_lds((const unsigned*)((const char*)(gbase) + (voff)[_i]), (LAS unsigned*)(lds + (bufoff) + ldsw + _i * 8192), 16, 0, 0); } while (0)
#define PG8_LDA(dst, b, h) do { _Pragma("unroll") for (int m = 0; m < 4; ++m) _Pragma("unroll") for (int k = 0; k < 2; ++k) dst[m][k] = *(const LAS bf16x8*)(lds + PG8_SA(b, h) + aoff + m * 2048 + k * 1024); } while (0)
#define PG8_LDB(dst, b, h) do { _Pragma("unroll") for (int n = 0; n < 2; ++n) _Pragma("unroll") for (int k = 0; k < 2; ++k) dst[n][k] = *(const LAS bf16x8*)(lds + PG8_SB(b, h) + boff + n * 2048 + k * 1024); } while (0)
#define PG8_MMA(ai, bj, At, Bt) do { __builtin_amdgcn_s_setprio(1); _Pragma("unroll") for (int m = 0; m < 4; ++m) _Pragma("unroll") for (int n = 0; n < 2; ++n) _Pragma("unroll") for (int k = 0; k < 2; ++k) \
        acc[ai][bj][m][n] = __builtin_amdgcn_mfma_f32_16x16x32_bf16(Bt[n][k], At[m][k], acc[ai][bj][m][n], 0, 0, 0); __builtin_amdgcn_s_setprio(0); } while (0)
#define PG8_WAIT_V(n) asm volatile("s_waitcnt vmcnt(" #n ")" ::: "memory")
#define PG8_WAIT_L(n) asm volatile("s_waitcnt lgkmcnt(" #n ")" ::: "memory")
#define PG8_BAR __builtin_amdgcn_s_barrier()
#define PG8_SCHED __builtin_amdgcn_sched_barrier(0)
    Unit cur, nxt; int ui = 0;
    if (!S.next(0, cur)) return;
    f32x4 acc[2][2][4][2];
#pragma unroll
    for (int a = 0; a < 2; ++a)
#pragma unroll
        for (int b = 0; b < 2; ++b)
#pragma unroll
            for (int m = 0; m < 4; ++m)
#pragma unroll
                for (int n = 0; n < 2; ++n) acc[a][b][m][n] = (f32x4){0.f, 0.f, 0.f, 0.f};
    bf16x8 At[4][2], B0[2][2], B1[2][2];
    const char* cA = S.a_ptr(cur); const char* cB = S.b_ptr(cur);
    if constexpr (SP2) {
        PG8_STAGE(PG8_SB(0, 0), cB, voffB); PG8_STAGE(PG8_SB(0, 1), cB + hstepB, voffB); PG8_STAGE(PG8_SA(0, 0), cA, voffA); PG8_STAGE(PG8_SA(0, 1), cA + hstepA, voffA);
        if (wr == 1) PG8_BAR;
        PG8_WAIT_V(2); PG8_BAR;
        PG8_STAGE(PG8_SB(1, 0), cB + kstep, voffB); PG8_STAGE(PG8_SA(1, 0), cA + kstep, voffA); PG8_STAGE(PG8_SB(1, 1), cB + hstepB + kstep, voffB);
        PG8_WAIT_V(6); PG8_BAR;
    } else {
        PG8_STAGE(PG8_SB(0, 0), cB, voffB); PG8_STAGE(PG8_SA(0, 0), cA, voffA); PG8_STAGE(PG8_SB(0, 1), cB + hstepB, voffB); PG8_STAGE(PG8_SA(0, 1), cA + hstepA, voffA);
        if (wr == 1) PG8_BAR;
        PG8_WAIT_V(4); PG8_BAR;
        PG8_STAGE(PG8_SB(1, 0), cB + kstep, voffB); PG8_STAGE(PG8_SA(1, 0), cA + kstep, voffA); PG8_STAGE(PG8_SB(1, 1), cB + hstepB + kstep, voffB);
        PG8_WAIT_V(6); PG8_BAR;
    }
    for (;;) {
        const bool has_next = S.next(ui + 1, nxt);
        if (!has_next) nxt = cur;
        const char* nA = S.a_ptr(nxt); const char* nB = S.b_ptr(nxt);
        for (int t = 0; t < nt; t += 2) {
            const bool last = (t == nt - 2);
            const char* a1 = cA + (size_t)(t + 1) * kstep;
            const char* a2 = last ? nA : cA + (size_t)(t + 2) * kstep; const char* b2 = last ? nB : cB + (size_t)(t + 2) * kstep;
            const char* a3 = a2 + kstep; const char* b3 = b2 + kstep;
            if constexpr (SP2) {
            PG8_LDB(B0, 0, 0); PG8_LDB(B1, 0, 1); PG8_SCHED; PG8_LDA(At, 0, 0); PG8_STAGE(PG8_SA(1, 1), a1 + hstepA, voffA);
            PG8_WAIT_V(8); PG8_WAIT_L(0); PG8_BAR; PG8_MMA(0, 0, At, B0); PG8_MMA(0, 1, At, B1); PG8_BAR; PG8_SCHED;
            PG8_LDA(At, 0, 1); PG8_STAGE(PG8_SB(0, 0), b2, voffB); PG8_STAGE(PG8_SB(0, 1), b2 + hstepB, voffB); PG8_STAGE(PG8_SA(0, 0), a2, voffA);
            PG8_WAIT_V(8); PG8_WAIT_L(0); PG8_BAR; PG8_MMA(1, 0, At, B0); PG8_MMA(1, 1, At, B1); PG8_BAR; PG8_SCHED;
            PG8_LDB(B0, 1, 0); PG8_LDB(B1, 1, 1); PG8_SCHED; PG8_LDA(At, 1, 0); PG8_STAGE(PG8_SA(0, 1), a2 + hstepA, voffA);
            PG8_WAIT_V(8); PG8_WAIT_L(0); PG8_BAR; PG8_MMA(0, 0, At, B0); PG8_MMA(0, 1, At, B1); PG8_BAR; PG8_SCHED;
            PG8_LDA(At, 1, 1); PG8_STAGE(PG8_SB(1, 0), b3, voffB); PG8_STAGE(PG8_SB(1, 1), b3 + hstepB, voffB); PG8_STAGE(PG8_SA(1, 0), a3, voffA);
            PG8_WAIT_V(8); PG8_WAIT_L(0); PG8_BAR; PG8_MMA(1, 0, At, B0); PG8_MMA(1, 1, At, B1); PG8_BAR; PG8_SCHED;
            } else {
            PG8_LDB(B0, 0, 0); PG8_SCHED; PG8_LDA(At, 0, 0); PG8_STAGE(PG8_SA(1, 1), a1 + hstepA, voffA);
            PG8_WAIT_L(8); PG8_BAR; PG8_WAIT_L(0); PG8_MMA(0, 0, At, B0); PG8_BAR; PG8_SCHED;
            PG8_LDB(B1, 0, 1); PG8_STAGE(PG8_SB(0, 0), b2, voffB);
            PG8_BAR; PG8_WAIT_L(0); PG8_MMA(0, 1, At, B1); PG8_BAR;
            PG8_LDA(At, 0, 1); PG8_STAGE(PG8_SA(0, 0), a2, voffA);
            PG8_BAR; PG8_WAIT_L(0); PG8_MMA(1, 0, At, B0); PG8_BAR; PG8_SCHED;
            PG8_STAGE(PG8_SB(0, 1), b2 + hstepB, voffB);
            PG8_WAIT_V(6); PG8_BAR; PG8_MMA(1, 1, At, B1); PG8_BAR;
            PG8_LDB(B0, 1, 0); PG8_SCHED; PG8_LDA(At, 1, 0); PG8_STAGE(PG8_SA(0, 1), a2 + hstepA, voffA);
            PG8_WAIT_L(8); PG8_BAR; PG8_WAIT_L(0); PG8_MMA(0, 0, At, B0); PG8_BAR; PG8_SCHED;
            PG8_LDB(B1, 1, 1); PG8_STAGE(PG8_SB(1, 0), b3, voffB);
            PG8_BAR; PG8_WAIT_L(0); PG8_MMA(0, 1, At, B1); PG8_BAR;
            PG8_LDA(At, 1, 1); PG8_STAGE(PG8_SA(1, 0), a3, voffA);
            PG8_BAR; PG8_WAIT_L(0); PG8_MMA(1, 0, At, B0); PG8_BAR; PG8_SCHED;
            PG8_STAGE(PG8_SB(1, 1), b3 + hstepB, voffB);
            PG8_WAIT_V(6); PG8_BAR; PG8_MMA(1, 1, At, B1); PG8_BAR;
            }
        }
        if constexpr (ALIGN_EPI) { if (wr == 0) PG8_BAR; }
        { asm volatile("" ::: "memory"); const Epi E = mk(); E(acc, cur, wr, wc, fr, fq); }
        if (!has_next) break;
#pragma unroll
        for (int a = 0; a < 2; ++a)
#pragma unroll
            for (int b = 0; b < 2; ++b)
#pragma unroll
                for (int m = 0; m < 4; ++m)
#pragma unroll
                    for (int n = 0; n < 2; ++n) acc[a][b][m][n] = (f32x4){0.f, 0.f, 0.f, 0.f};
        cur = nxt; cA = nA; cB = nB; ++ui;
        if constexpr (ALIGN_EPI) { if (wr == 1) PG8_BAR; }
    }
    PG8_WAIT_V(0);
    if constexpr (!ALIGN_EPI) { if (wr == 0) PG8_BAR; }
    PG8_BAR;
#undef PG8_SA
#undef PG8_SB
#undef PG8_STAGE
#undef PG8_LDA
#undef PG8_LDB
#undef PG8_MMA
#undef PG8_WAIT_V
#undef PG8_WAIT_L
#undef PG8_BAR
#undef PG8_SCHED
}
template <class MkEpi, class Sched> __device__ __forceinline__ void gemm_phase(LAS unsigned char* lds, const int tid, const int lda, const int ldb, const int K, const Sched& S, const MkEpi& mk) {
    gemm_phase_<decltype(mk()), Sched, MkEpi>(lds, tid, lda, ldb, K, S, mk); }
}

#define XB_TMO      128
#define XB_XCNT(j)  (256  + 64 * (j))
#define XB_XSUB(j)  (1280 + 64 * (j))
#define XB_XGEN(j)  (2304 + 64 * (j))
#define XB_TOP      3328
#define XB_TOPGEN   3392
#define XCD_BAR_WORDS 3456
#define XB_SPIN_CAP (1u << 18)

__device__ __forceinline__ unsigned xb_ld(unsigned* p)              { return __hip_atomic_load(p, __ATOMIC_RELAXED, __HIP_MEMORY_SCOPE_AGENT); }
__device__ __forceinline__ unsigned xb_add(unsigned* p, unsigned v) { return __hip_atomic_fetch_add(p, v, __ATOMIC_RELAXED, __HIP_MEMORY_SCOPE_AGENT); }
__device__ __forceinline__ unsigned xb_xcc_id() { return (unsigned)__builtin_amdgcn_s_getreg((3 << 11) | 20) & 0xFu; }
#define XB_SPIN(cond, bar) do { unsigned _sp = 0; while (cond) { __builtin_amdgcn_s_sleep(1); \
    if ((++_sp & 255u) == 0u) { if (xb_ld(&(bar)[XB_TMO])) break; if (_sp > XB_SPIN_CAP) { atomicAdd(&(bar)[XB_TMO], 1u); break; } } } } while (0)

struct XcdBarrier { unsigned* bar; unsigned x; volatile LAS unsigned* st; };

__device__ __forceinline__ XcdBarrier xcd_barrier_post(unsigned* bar, volatile LAS unsigned* st) {
    XcdBarrier b; b.bar = bar; b.x = xb_xcc_id(); b.st = st;
    if (threadIdx.x == 0) (void)xb_add(&bar[XB_XCNT(b.x)], 1u);
    return b;
}
__device__ __forceinline__ void xcd_barrier_complete(unsigned* bar, unsigned x, unsigned& nloc, unsigned& nx, const unsigned G) {
    unsigned sum, cnt, mine, sp = 0u;
    for (;;) {
        sum = 0u; cnt = 0u; mine = 0u;
#pragma unroll
        for (unsigned j = 0; j < 16; ++j) { const unsigned c = xb_ld(&bar[XB_XCNT(j)]); sum += c; cnt += (c > 0u) ? 1u : 0u; mine = (j == x) ? c : mine; }
        if (sum == G) break;
        __builtin_amdgcn_s_sleep(1);
        if ((++sp & 255u) == 0u) { if (xb_ld(&bar[XB_TMO])) break; if (sp > XB_SPIN_CAP) { atomicAdd(&bar[XB_TMO], 1u); break; } }
    }
    nloc = mine > 0u ? mine : 1u; nx = cnt > 0u ? cnt : 1u;
}
__device__ __forceinline__ void xcd_barrier(const XcdBarrier& b, const int tid, const unsigned G) {
    asm volatile("s_waitcnt vmcnt(0)" ::: "memory");
    __syncthreads();
    if (tid == 0) {
        unsigned* bar = b.bar;
        __builtin_amdgcn_s_waitcnt(0);
        unsigned nloc = b.st[0], nx = b.st[1];
        if (nloc == 0u) { xcd_barrier_complete(bar, b.x, nloc, nx, G); b.st[0] = nloc; b.st[1] = nx; }
        const unsigned old = xb_add(&bar[XB_XSUB(b.x)], 1u);
        const unsigned gen = old / nloc;
        if (old + 1u == (gen + 1u) * nloc) {
            __builtin_amdgcn_fence(__ATOMIC_RELEASE, "agent");
            asm volatile("s_waitcnt vmcnt(0)" ::: "memory");
            const unsigned og = xb_add(&bar[XB_TOP], 1u);
            const unsigned tg = og / nx;
            if (og + 1u == (tg + 1u) * nx) xb_add(&bar[XB_TOPGEN], 1u);
            else XB_SPIN(xb_ld(&bar[XB_TOPGEN]) == tg, bar);
            __builtin_amdgcn_fence(__ATOMIC_ACQUIRE, "agent");
            xb_add(&bar[XB_XGEN(b.x)], 1u);
            asm volatile("s_waitcnt vmcnt(0)" ::: "memory");
        } else {
            XB_SPIN(xb_ld(&bar[XB_XGEN(b.x)]) == gen, bar);
            __builtin_amdgcn_fence(__ATOMIC_ACQUIRE, "agent");
            asm volatile("s_waitcnt vmcnt(0)" ::: "memory");
        }
    }
    __syncthreads();
}

constexpr size_t MiB = 1u << 20;
constexpr size_t SZ_MD_BF = (size_t)M * D * 2, SZ_MD_F = (size_t)M * D * 4;
constexpr size_t WS_CTL = 0, CTL_BYTES = 1 * MiB;
constexpr size_t WS_X    = WS_CTL + CTL_BYTES;
constexpr size_t WS_HB   = WS_X + SZ_MD_F;
constexpr size_t WS_ACT  = WS_HB + SZ_MD_BF;
constexpr size_t WS_P0   = WS_ACT + (size_t)M * DFF * 2;
constexpr size_t WS_P1   = WS_P0 + 192 * MiB;
constexpr size_t WS_YB   = WS_P1 + 3 * SZ_MD_F;
constexpr size_t WS_QB2  = WS_YB + SZ_MD_BF;
constexpr size_t WS_SC   = WS_QB2 + SZ_MD_BF;
constexpr size_t WS_PB   = WS_SC + (size_t)16 * SEQ * NMEM * 4;
constexpr size_t WS_OB   = WS_PB + (size_t)16 * SEQ * NMEM * 2;
constexpr size_t WS_KALL = WS_OB + SZ_MD_BF;
constexpr size_t WS_VT   = WS_KALL + (size_t)MMEM * 4 * D * 2;
constexpr size_t WS_MEMN = WS_VT + (size_t)MMEM * 4 * D * 2;
constexpr size_t WS_MISC = WS_MEMN + (size_t)MMEM * D * 2;
constexpr size_t MISC_LB = 0, MISC_C8 = 4 * 2048 * 4, MISC_SSQ = MISC_C8 + 2048 * 4, MISC_GATES = MISC_SSQ + (size_t)M * 8 * 4, MISC_MLWG = MISC_GATES + (size_t)M * 16 * 4, MISC_BYTES = 1 * MiB;
static_assert(MISC_MLWG + 16 * 2048 * 4 <= MISC_BYTES, "misc");
constexpr int ML_NPAD = 6400;
constexpr size_t SZ_WGU = (size_t)NGU * D * 2, SZ_WDN = (size_t)D * DFF * 2, SZ_WDD = (size_t)D * D * 2;
constexpr size_t WS_WGU  = WS_MISC + MISC_BYTES;
constexpr size_t WS_WDN  = WS_WGU + 8 * SZ_WGU;
constexpr size_t WS_WQ   = WS_WDN + 8 * SZ_WDN;
constexpr size_t WS_WO   = WS_WQ + 4 * SZ_WDD;
constexpr size_t WS_WK   = WS_WO + 4 * SZ_WDD;
constexpr size_t WS_WV   = WS_WK + 4 * SZ_WDD;
constexpr size_t WS_HGIN = WS_WV + 4 * SZ_WDD;
constexpr size_t WS_HGOUT = WS_HGIN + 2 * 4 * SZ_WDD;
constexpr size_t WS_LRUIN = WS_HGOUT + 2 * SZ_WDD;
constexpr size_t WS_LRUG = WS_LRUIN + 2 * SZ_WDD;
constexpr size_t WS_LRUOUT = WS_LRUG + (size_t)4096 * 256 * 2;
constexpr size_t WS_MLIN = WS_LRUOUT + SZ_WDD;
constexpr size_t WS_MLOUT = WS_MLIN + (size_t)ML_NPAD * D * 2;
constexpr size_t WS_GT   = WS_MLOUT + SZ_WDD;
constexpr size_t WS_UT   = WS_GT + (size_t)4 * 16 * NMEM * D * 2;
constexpr size_t WS_END  = WS_UT + (size_t)4 * 4 * D * 4 * NMEM * 2;

constexpr int NWAVES = 8, NT = NWAVES * 64;

struct Args {
    const float* in[27]; float* out; unsigned char* ws; int ph_lo, ph_hi;
};
enum { I_X = 0, I_MEM, I_MEMG, I_NORMG, I_FINALG, I_WGU, I_WDN, I_XAQ, I_XAKV, I_XAO, I_HGLB, I_HGIN, I_HGG, I_HGOUT,
       I_LRUIN, I_CONVW, I_CONVB, I_LRUWA, I_LRUBA, I_LRUWX, I_LRUBX, I_LRULAM, I_LRUOUT, I_MLIN, I_MLBIF, I_MLG, I_MLOUT };

struct Frame { LAS unsigned char* lds; int tid, lane, wave, G, bid, gw, NGW;
    template <class T> __device__ __forceinline__ T* ptr(int i) const { const u32x2 v = *(const LAS u32x2*)(lds + CTRL + 64 + 8 * i);
        const unsigned lo = __builtin_amdgcn_readfirstlane(v.x), hi = __builtin_amdgcn_readfirstlane(v.y); return (T*)(((unsigned long long)hi << 32) | lo); }
    __device__ __forceinline__ const float* in(int i) const { return ptr<const float>(i); }
    __device__ __forceinline__ float* out() const { return ptr<float>(27); }
    __device__ __forceinline__ unsigned char* ws() const { return ptr<unsigned char>(28); }
};
__device__ __forceinline__ unsigned hw_wave_key() { return (unsigned)__builtin_amdgcn_s_getreg((12 - 1) << 11 | 4) & 0xfffu; }

struct CvtJob { const float* W; bf16* WT; const float* gk; int K, ldw, nrows, off, gu, nvalid; };
__device__ __forceinline__ void convert_job_rt(const Frame& F, int& rot, const CvtJob& j, const int num0 = 0, const int num1 = 8) {
    const int nnb = j.nrows / 64, nkb = j.K / 64, nitems = nnb * nkb; const int cg = F.lane & 15, kg = F.lane >> 4;
    const int i0 = (nitems * num0) >> 3, i1 = (nitems * num1) >> 3, nrange = i1 - i0;
    int q = F.gw - rot; if (q < 0) q += F.NGW;
    for (; q < nrange; q += F.NGW) { const int it = i0 + q;
        const int kb = it / nnb, nb = it % nnb, k0 = kb * 64, n0 = nb * 64; int sc = j.off + n0;
        if (j.gu) { const int pn = n0 >> 8, r = n0 & 255; sc = (r >> 7) * DFF + 128 * pn + (r & 127); }
        const bool ok = (sc + 4 * cg + 3) < j.nvalid; const float* src = j.W + (size_t)(k0 + 16 * kg) * j.ldw + (ok ? sc + 4 * cg : 0);
        f32x4 v[16];
#pragma unroll
        for (int i = 0; i < 16; ++i) v[i] = __builtin_nontemporal_load((const f32x4*)(src + (size_t)i * j.ldw));
        if (j.gk) { const f32x4* gp = (const f32x4*)(j.gk + k0 + 16 * kg);
#pragma unroll
            for (int q = 0; q < 4; ++q) { const f32x4 g = gp[q]; v[4 * q] *= g[0]; v[4 * q + 1] *= g[1]; v[4 * q + 2] *= g[2]; v[4 * q + 3] *= g[3]; } }
        if (!ok) {
#pragma unroll
            for (int i = 0; i < 16; ++i) v[i] = (f32x4){0.f, 0.f, 0.f, 0.f}; }
#pragma unroll
        for (int c = 0; c < 4; ++c) { bf16* dst = j.WT + (size_t)(n0 + 4 * cg + c) * j.K + k0 + 16 * kg;
            u32x4 lo, hi; lo.x = pk2(v[0][c], v[1][c]); lo.y = pk2(v[2][c], v[3][c]); lo.z = pk2(v[4][c], v[5][c]); lo.w = pk2(v[6][c], v[7][c]);
            hi.x = pk2(v[8][c], v[9][c]); hi.y = pk2(v[10][c], v[11][c]); hi.z = pk2(v[12][c], v[13][c]); hi.w = pk2(v[14][c], v[15][c]);
            *(u32x4*)dst = lo; *(u32x4*)(dst + 8) = hi; }
    }
    rot = (rot + nrange) % F.NGW;
}
struct MapPlain { int off; __device__ int operator()(int nb) const { return off + 64 * nb; } };
struct MapGU { __device__ int operator()(int nb) const { const int n = 64 * nb, pn = n >> 8, r = n & 255; return (r >> 7) * DFF + 128 * pn + (r & 127); } };

__device__ __forceinline__ void x_to_stream(const Frame& F, const float* x, bf16* XB, float* SSQ) {
    for (int row = F.gw; row < M; row += F.NGW) {
        const f32x4* xr = (const f32x4*)(x + (size_t)row * D) + F.lane; u32x2* o8 = (u32x2*)(XB + (size_t)row * D) + F.lane; float ss = 0.f;
#pragma unroll
        for (int j = 0; j < 8; ++j) { const f32x4 v = xr[64 * j]; ss += (v[0] * v[0] + v[1] * v[1]) + (v[2] * v[2] + v[3] * v[3]); u32x2 w; w.x = pk2(v[0], v[1]); w.y = pk2(v[2], v[3]); o8[64 * j] = w; }
        ss = wave_sum(ss);
        if (F.lane < 8) SSQ[(size_t)row * 8 + F.lane] = F.lane == 0 ? ss : 0.f;
    }
}
__device__ __forceinline__ void ml_gates_rows(const Frame& F, const bf16* XB, const float* SSQ, const bf16* wg, float* gates) {
    if (F.wave >= 2) return;
    const int lr = F.lane & 15, lq = F.lane >> 4;
    for (int tile = F.wave * F.G + F.bid; tile < M / 16; tile += 2 * F.G) {
        const int row0 = tile * 16;
        const bf16* ap = XB + (size_t)(row0 + lr) * D + 8 * lq; const bf16* bp = wg + (size_t)lr * D + 8 * lq;
        f32x4 acc = {0.f, 0.f, 0.f, 0.f};
        for (int k0 = 0; k0 < D; k0 += 256) { bf16x8 a[8], b[8];
#pragma unroll
            for (int j = 0; j < 8; ++j) { a[j] = *(const bf16x8*)(ap + k0 + 32 * j); b[j] = *(const bf16x8*)(bp + k0 + 32 * j); }
#pragma unroll
            for (int j = 0; j < 8; ++j) acc = __builtin_amdgcn_mfma_f32_16x16x32_bf16(a[j], b[j], acc, 0, 0, 0); }
#pragma unroll
        for (int r = 0; r < 4; ++r) { const int row = row0 + 4 * lq + r; const f32x4 s0 = *(const f32x4*)(SSQ + (size_t)row * 8), s1 = *(const f32x4*)(SSQ + (size_t)row * 8 + 4);
            const float rstd = 1.0f / sqrtf((((s0[0] + s0[1]) + (s0[2] + s0[3])) + ((s1[0] + s1[1]) + (s1[2] + s1[3]))) * (1.0f / D) + EPS);
            gates[(size_t)row * 16 + lr] = acc[r] * rstd; }
    }
}
__device__ __forceinline__ void final_norm_bf(const Frame& F, const bf16* XB, const float* SSQ, const float* g, float* out) {
    for (int row = F.gw; row < M; row += F.NGW) {
        const f32x4 a = *(const f32x4*)(SSQ + (size_t)row * 8), b = *(const f32x4*)(SSQ + (size_t)row * 8 + 4);
        const float rstd = 1.0f / sqrtf((((a[0] + a[1]) + (a[2] + a[3])) + ((b[0] + b[1]) + (b[2] + b[3]))) * (1.0f / D) + EPS);
        const u32x2* xr = (const u32x2*)(XB + (size_t)row * D) + F.lane; f32x4* o = (f32x4*)(out + (size_t)row * D) + F.lane;
#pragma unroll
        for (int j = 0; j < 8; ++j) { const u32x2 w = xr[64 * j]; const f32x4 gg = ((const f32x4*)g)[F.lane + 64 * j]; o[64 * j] = (f32x4){bflo(w.x), bfhi(w.x), bflo(w.y), bfhi(w.y)} * rstd * gg; }
    }
}
template <bool GATES>
__device__ __forceinline__ void norm_rows(const Frame& F, const float* x, const float* g, bf16* out, int nrows, const float* wg, float* gates) {
    for (int row = F.gw; row < nrows; row += F.NGW) {
        const f32x4* xr = (const f32x4*)(x + (size_t)row * D) + F.lane;
        f32x4 v[8]; float ss = 0.f;
#pragma unroll
        for (int j = 0; j < 8; ++j) { v[j] = xr[64 * j]; ss += (v[j][0] * v[j][0] + v[j][1] * v[j][1]) + (v[j][2] * v[j][2] + v[j][3] * v[j][3]); }
        ss = wave_sum(ss);
        const float rstd = 1.0f / sqrtf(ss * (1.0f / D) + EPS);
        u32x2* o8 = (u32x2*)(out + (size_t)row * D) + F.lane;
#pragma unroll
        for (int j = 0; j < 8; ++j) { const f32x4 gg = ((const f32x4*)g)[F.lane + 64 * j]; v[j] = v[j] * rstd * gg; u32x2 w; w.x = pk2(v[j][0], v[j][1]); w.y = pk2(v[j][2], v[j][3]); o8[64 * j] = w; }
        if constexpr (GATES) {
            for (int c = 0; c < 16; ++c) { const f32x4* wr_ = (const f32x4*)(wg + (size_t)c * D) + F.lane; float s = 0.f;
#pragma unroll
                for (int j = 0; j < 8; ++j) { const f32x4 w4 = wr_[64 * j]; s += (v[j][0] * w4[0] + v[j][1] * w4[1]) + (v[j][2] * w4[2] + v[j][3] * w4[3]); }
                s = wave_sum(s); if (F.lane == 0) gates[(size_t)row * 16 + c] = s; }
        }
    }
}
__device__ __forceinline__ void final_norm(const Frame& F, const float* x, const float* g, float* out) {
    for (int row = F.gw; row < M; row += F.NGW) {
        const f32x4* xr = (const f32x4*)(x + (size_t)row * D) + F.lane;
        f32x4 v[8]; float ss = 0.f;
#pragma unroll
        for (int j = 0; j < 8; ++j) { v[j] = xr[64 * j]; ss += (v[j][0] * v[j][0] + v[j][1] * v[j][1]) + (v[j][2] * v[j][2] + v[j][3] * v[j][3]); }
        ss = wave_sum(ss);
        const float rstd = 1.0f / sqrtf(ss * (1.0f / D) + EPS);
        f32x4* o = (f32x4*)(out + (size_t)row * D) + F.lane;
#pragma unroll
        for (int j = 0; j < 8; ++j) { const f32x4 gg = ((const f32x4*)g)[F.lane + 64 * j]; o[64 * j] = v[j] * rstd * gg; }
    }
}

template <bool ML>
__device__ __forceinline__ void recur_phase(const Frame& F, const bf16* QB, const float* LF, const bf16* KB, const bf16* VB, const bf16* PB, const float* gates, const float* bif, float* OF) {
    constexpr int H = ML ? ML_H : HG_H, DV = ML ? ML_DV : HG_D, NVS = DV / 32, TB = 32;
    LAS float* AL = (LAS float*)F.lds; LAS float* KA = AL + TB * 128; LAS float* QQ = KA + TB * 128; LAS float* VV = QQ + TB * 128; LAS float* OO = VV + TB * 32;
    const int dg = F.lane & 15, vsub = F.lane >> 4, vloc = F.wave * 4 + vsub;
    for (int unit = F.bid; unit < BATCH * H * NVS; unit += F.G) {
        const int b = unit / (H * NVS), h = (unit / NVS) % H, vs = unit % NVS;
        float S[8], Nn[8];
#pragma unroll
        for (int i = 0; i < 8; ++i) { S[i] = 0.f; Nn[i] = 0.f; }
        float bi_ = 0.f, bf_ = 0.f; if constexpr (ML) { bi_ = bif[h]; bf_ = bif[8 + h]; }
        for (int t0 = 0; t0 < SEQ; t0 += TB) {
            __syncthreads();
            { const int t = F.tid >> 4, d8 = (F.tid & 15) * 8; const size_t row = (size_t)b * SEQ + t0 + t;
                float al[8], ka[8], qq[8];
                if constexpr (!ML) {
                    const f32x4 l0 = *(const f32x4*)(LF + row * D + h * 128 + d8), l1 = *(const f32x4*)(LF + row * D + h * 128 + d8 + 4);
                    const u32x4 kw = *(const u32x4*)(KB + row * D + h * 128 + d8), qw = *(const u32x4*)(QB + row * D + h * 128 + d8);
                    const float lf[8] = {l0[0], l0[1], l0[2], l0[3], l1[0], l1[1], l1[2], l1[3]};
#pragma unroll
                    for (int i = 0; i < 8; ++i) al[i] = __expf(lf[i]);
                    ka[0] = bflo(kw.x); ka[1] = bfhi(kw.x); ka[2] = bflo(kw.y); ka[3] = bfhi(kw.y); ka[4] = bflo(kw.z); ka[5] = bfhi(kw.z); ka[6] = bflo(kw.w); ka[7] = bfhi(kw.w);
                    qq[0] = bflo(qw.x); qq[1] = bfhi(qw.x); qq[2] = bflo(qw.y); qq[3] = bfhi(qw.y); qq[4] = bflo(qw.z); qq[5] = bfhi(qw.z); qq[6] = bflo(qw.w); qq[7] = bfhi(qw.w);
                } else {
                    const float fg = gates[row * 16 + 8 + h] + bf_, ig = gates[row * 16 + h] + bi_;
                    const float a_ = 1.0f / (1.0f + expf(-15.0f * tanhf(fg * (1.0f / 15.0f))));
                    const float ei = expf(15.0f * tanhf(ig * (1.0f / 15.0f))) * 0.08838834764831845f;
                    const u32x4 qw = *(const u32x4*)(PB + row * ML_PROJ + h * 128 + d8), kw = *(const u32x4*)(PB + row * ML_PROJ + 1024 + h * 128 + d8);
#pragma unroll
                    for (int i = 0; i < 8; ++i) al[i] = a_;
                    ka[0] = bflo(kw.x) * ei; ka[1] = bfhi(kw.x) * ei; ka[2] = bflo(kw.y) * ei; ka[3] = bfhi(kw.y) * ei; ka[4] = bflo(kw.z) * ei; ka[5] = bfhi(kw.z) * ei; ka[6] = bflo(kw.w) * ei; ka[7] = bfhi(kw.w) * ei;
                    qq[0] = bflo(qw.x); qq[1] = bfhi(qw.x); qq[2] = bflo(qw.y); qq[3] = bfhi(qw.y); qq[4] = bflo(qw.z); qq[5] = bfhi(qw.z); qq[6] = bflo(qw.w); qq[7] = bfhi(qw.w);
                }
                *(LAS f32x4*)(AL + t * 128 + d8) = (f32x4){al[0], al[1], al[2], al[3]}; *(LAS f32x4*)(AL + t * 128 + d8 + 4) = (f32x4){al[4], al[5], al[6], al[7]};
                *(LAS f32x4*)(KA + t * 128 + d8) = (f32x4){ka[0], ka[1], ka[2], ka[3]}; *(LAS f32x4*)(KA + t * 128 + d8 + 4) = (f32x4){ka[4], ka[5], ka[6], ka[7]};
                *(LAS f32x4*)(QQ + t * 128 + d8) = (f32x4){qq[0], qq[1], qq[2], qq[3]}; *(LAS f32x4*)(QQ + t * 128 + d8 + 4) = (f32x4){qq[4], qq[5], qq[6], qq[7]};
                if (F.tid < 256) { const int tv = F.tid >> 3, v4 = (F.tid & 7) * 4; const size_t rv = (size_t)b * SEQ + t0 + tv;
                    const u32x2 vw = ML ? *(const u32x2*)(PB + rv * ML_PROJ + 2048 + h * 256 + vs * 32 + v4) : *(const u32x2*)(VB + rv * D + h * 128 + vs * 32 + v4);
                    *(LAS f32x4*)(VV + tv * 32 + v4) = (f32x4){bflo(vw.x), bfhi(vw.x), bflo(vw.y), bfhi(vw.y)}; }
            }
            __syncthreads();
#pragma unroll 4
            for (int t = 0; t < TB; ++t) {
                const f32x4 a0 = *(const LAS f32x4*)(AL + t * 128 + dg * 8), a1 = *(const LAS f32x4*)(AL + t * 128 + dg * 8 + 4);
                const f32x4 k0 = *(const LAS f32x4*)(KA + t * 128 + dg * 8), k1 = *(const LAS f32x4*)(KA + t * 128 + dg * 8 + 4);
                const f32x4 q0 = *(const LAS f32x4*)(QQ + t * 128 + dg * 8), q1 = *(const LAS f32x4*)(QQ + t * 128 + dg * 8 + 4);
                const float vv = VV[t * 32 + vloc];
                const float al[8] = {a0[0], a0[1], a0[2], a0[3], a1[0], a1[1], a1[2], a1[3]}, ka[8] = {k0[0], k0[1], k0[2], k0[3], k1[0], k1[1], k1[2], k1[3]}, qq[8] = {q0[0], q0[1], q0[2], q0[3], q1[0], q1[1], q1[2], q1[3]};
                float po = 0.f, pd = 0.f;
#pragma unroll
                for (int i = 0; i < 8; ++i) { S[i] = al[i] * S[i] + ka[i] * vv; po += S[i] * qq[i]; if constexpr (ML) { Nn[i] = al[i] * Nn[i] + ka[i]; pd += Nn[i] * qq[i]; } }
#pragma unroll
                for (int o = 1; o < 16; o <<= 1) { po += __shfl_xor(po, o); if constexpr (ML) pd += __shfl_xor(pd, o); }
                if (dg == 0) { float r = po; if constexpr (ML) r = po / fmaxf(fabsf(pd), 1.0f); OO[t * 32 + vloc] = r; }
            }
            __syncthreads();
            if (F.tid < 256) { const int tv = F.tid >> 3, v4 = (F.tid & 7) * 4; const size_t rv = (size_t)b * SEQ + t0 + tv;
                *(f32x4*)(OF + rv * D + h * DV + vs * 32 + v4) = *(const LAS f32x4*)(OO + tv * 32 + v4); }
        }
    }
}
namespace ck {
constexpr int SK = 136, SS = 72;
constexpr int O_QH = 0, O_KH = O_QH + 64 * SK * 2, O_QE = O_KH + 160 * SK * 2, O_KET = O_QE + 64 * SK * 2, O_VT = O_KET + 128 * SS * 2, O_P = O_VT + 48 * SS * 2,
              O_SB = O_P + 64 * SS * 2, O_EBC = O_SB + 48 * SK * 2, O_TOT = O_EBC + 512, O_GT = O_TOT + 2048, O_END = O_GT + 2048 + 2 * 1280;
static_assert(O_END <= CTRL, "chunk LDS map");
__device__ __forceinline__ f32x4 mm(const LAS bf16* A, int sa, int ar, const LAS bf16* B, int sb, int br, int ksteps, f32x4 acc, int lane) {
    const int r = lane & 15, q8 = (lane >> 4) * 8;
    const LAS bf16* ap = A + (ar + r) * sa + q8; const LAS bf16* bp = B + (br + r) * sb + q8;
    for (int ks = 0; ks < ksteps; ++ks) { const bf16x8 a = *(const LAS bf16x8*)(ap + ks * 32), b = *(const LAS bf16x8*)(bp + ks * 32);
        acc = __builtin_amdgcn_mfma_f32_16x16x32_bf16(a, b, acc, 0, 0, 0); }
    return acc;
}
__device__ __forceinline__ bf16 f2bf(float x) { return (bf16)(pk2(x, x) & 0xffffu); }
__device__ __forceinline__ float bf2f(unsigned short x) { return __uint_as_float((unsigned)x << 16); }
__device__ __forceinline__ void tile_of(int tile, int& qi, int& kj) {
    qi = tile < 1 ? 0 : (tile < 3 ? 1 : (tile < 6 ? 2 : 3)); kj = tile - (qi * (qi + 1)) / 2; }

__device__ __forceinline__ void store_pairs(bf16* op, const f32x4& v, int lr) {
    const bool odd = lr & 1;
    const float r01 = __shfl_xor(odd ? v[0] : v[1], 1), r23 = __shfl_xor(odd ? v[2] : v[3], 1);
    const unsigned w01 = odd ? pk2(r01, v[1]) : pk2(v[0], r01), w23 = odd ? pk2(r23, v[3]) : pk2(v[2], r23);
    *(GAS unsigned*)(op + (size_t)(odd ? 1 : 0) * D) = w01; *(GAS unsigned*)(op + (size_t)(odd ? 3 : 2) * D) = w23;
}
template <int NSL, bool ML>
__device__ __forceinline__ void headnorm_tail(const Frame& F, const bf16* OF, float* SSQP, unsigned* cnt, const int b, const int col0, const int slot0, const int vs,
                                              const bf16* gate, const int ldg, const int gcol0, const float* gain, bf16* Y) {
    constexpr float INV_HD = 1.0f / (NSL * 32);
    const int q = F.tid & 3, r0 = F.tid >> 2;
    asm volatile("s_waitcnt vmcnt(0)" ::: "memory"); __syncthreads();
    const size_t rowb = (size_t)b * SEQ + r0;
#pragma unroll
    for (int i0 = 0; i0 < 16; i0 += 8) { u32x4 w[8];
#pragma unroll
        for (int i = 0; i < 8; ++i) w[i] = *(GAS const u32x4*)(OF + (rowb + 128 * (i0 + i)) * D + col0 + 8 * q);
#pragma unroll
        for (int i = 0; i < 8; ++i) {
            const float a0 = bflo(w[i].x), a1 = bfhi(w[i].x), a2 = bflo(w[i].y), a3 = bfhi(w[i].y), a4 = bflo(w[i].z), a5 = bfhi(w[i].z), a6 = bflo(w[i].w), a7 = bfhi(w[i].w);
            float ss = ((a0 * a0 + a1 * a1) + (a2 * a2 + a3 * a3)) + ((a4 * a4 + a5 * a5) + (a6 * a6 + a7 * a7));
            ss += __shfl_xor(ss, 1); ss += __shfl_xor(ss, 2);
            if (q == 0) *(GAS float*)(SSQP + (rowb + 128 * (i0 + i)) * 64 + slot0 + vs) = ss; } }
    asm volatile("s_waitcnt vmcnt(0)" ::: "memory"); __syncthreads();
    if (F.tid == 0) { __builtin_amdgcn_fence(__ATOMIC_RELEASE, "agent"); asm volatile("s_waitcnt vmcnt(0)" ::: "memory"); (void)xb_add(cnt, 1u);
        unsigned sp = 0u; while (xb_ld(cnt) < (unsigned)NSL) { __builtin_amdgcn_s_sleep(1); if (++sp > (1u << 24)) break; }
        __builtin_amdgcn_fence(__ATOMIC_ACQUIRE, "agent"); asm volatile("s_waitcnt vmcnt(0)" ::: "memory"); }
    __syncthreads();
    const f32x4 g0 = *(GAS const f32x4*)(gain + 8 * q), g1 = *(GAS const f32x4*)(gain + 8 * q + 4);
#pragma unroll
    for (int i0 = 0; i0 < 16; i0 += 4) {
        u32x4 w[4], gw[4]; f32x4 p0[4], p1[4];
#pragma unroll
        for (int j = 0; j < 4; ++j) { const size_t row = rowb + 128 * (i0 + j);
            w[j] = *(GAS const u32x4*)(OF + row * D + col0 + 8 * q); gw[j] = *(GAS const u32x4*)(gate + row * ldg + gcol0 + 8 * q);
            p0[j] = *(GAS const f32x4*)(SSQP + row * 64 + slot0); if constexpr (NSL == 8) p1[j] = *(GAS const f32x4*)(SSQP + row * 64 + slot0 + 4); else p1[j] = (f32x4){0.f, 0.f, 0.f, 0.f}; }
#pragma unroll
        for (int j = 0; j < 4; ++j) { const size_t row = rowb + 128 * (i0 + j);
            const float tot = ((p0[j][0] + p0[j][1]) + (p0[j][2] + p0[j][3])) + ((p1[j][0] + p1[j][1]) + (p1[j][2] + p1[j][3]));
            const float rstd = 1.0f / sqrtf(tot * INV_HD + EPS);
            float gg[8] = {bflo(gw[j].x), bfhi(gw[j].x), bflo(gw[j].y), bfhi(gw[j].y), bflo(gw[j].z), bfhi(gw[j].z), bflo(gw[j].w), bfhi(gw[j].w)};
            if constexpr (ML) {
#pragma unroll
                for (int e = 0; e < 8; ++e) gg[e] = sigmoidf_(gg[e]); }
            const f32x4 a = (f32x4){bflo(w[j].x), bfhi(w[j].x), bflo(w[j].y), bfhi(w[j].y)} * rstd * g0, c = (f32x4){bflo(w[j].z), bfhi(w[j].z), bflo(w[j].w), bfhi(w[j].w)} * rstd * g1;
            u32x4 o; o.x = pk2(a[0] * gg[0], a[1] * gg[1]); o.y = pk2(a[2] * gg[2], a[3] * gg[3]); o.z = pk2(c[0] * gg[4], c[1] * gg[5]); o.w = pk2(c[2] * gg[6], c[3] * gg[7]);
            *(GAS u32x4*)(Y + row * D + col0 + 8 * q) = o; } }
}
__device__ __forceinline__ void hg_chunk_phase(const Frame& F, const bf16* QB, const bf16* LF, const bf16* KB, const bf16* VB, bf16* OF, const bf16* GB, const float* gn, bf16* Y, float* SSQP, unsigned* hcnt) {
    LAS bf16* QH = (LAS bf16*)(F.lds + O_QH); LAS bf16* KH = (LAS bf16*)(F.lds + O_KH); LAS bf16* QE = (LAS bf16*)(F.lds + O_QE); LAS bf16* KET = (LAS bf16*)(F.lds + O_KET);
    LAS bf16* VT = (LAS bf16*)(F.lds + O_VT); LAS bf16* P = (LAS bf16*)(F.lds + O_P); LAS bf16* SB = (LAS bf16*)(F.lds + O_SB);
    LAS float* EBC = (LAS float*)(F.lds + O_EBC); LAS float* TOT = (LAS float*)(F.lds + O_TOT);
    const int tid = F.tid, lane = F.lane, w = F.wave, lq = lane >> 4, lr = lane & 15;
    const int g = w, i = g >> 1, d2 = 2 * lane, sv = tid >> 3, v4 = (tid & 7) * 4;
    for (int unit = F.bid; unit < 256; unit += F.G) {
        const int xk = unit >> 3, vs = xk & 3, gq = (xk >> 2) * 8 + (unit & 7); const int b = gq >> 4, h = gq & 15;
        __syncthreads();
        for (int e = tid; e < 64 * SS / 2; e += NT) ((LAS unsigned*)P)[e] = 0u;
        for (int e = tid; e < 48 * SK / 2; e += NT) ((LAS unsigned*)SB)[e] = 0u;
        f32x4 S0 = {0.f, 0.f, 0.f, 0.f}, S1 = {0.f, 0.f, 0.f, 0.f};
        unsigned lfA[8], lfB[8]; unsigned qvA[8], qvB[8]; u32x2 vvA, vvB;
        const size_t colb = (size_t)h * 128 + d2, colv = (size_t)h * 128 + vs * 32 + v4;
        auto load = [&](unsigned (&lfw)[8], unsigned (&qv)[8], u32x2& vv, const int cc) { const size_t r0 = (size_t)b * SEQ + (size_t)cc * 64 + 8 * g;
#pragma unroll
            for (int tt = 0; tt < 8; ++tt) { lfw[tt] = *(const unsigned*)(LF + (r0 + tt) * D + colb); qv[tt] = *(const unsigned*)(QB + (r0 + tt) * D + colb); }
            vv = *(const u32x2*)(VB + ((size_t)b * SEQ + (size_t)cc * 64 + sv) * D + colv); };
        load(lfA, qvA, vvA, 0); load(lfB, qvB, vvB, 1);
        auto step = [&](unsigned (&lfw)[8], unsigned (&qv)[8], u32x2& vv, const int c) {
            f32x2 lf[8], loc[8]; { f32x2 run = {0.f, 0.f};
#pragma unroll
                for (int tt = 0; tt < 8; ++tt) { lf[tt] = (f32x2){bflo(lfw[tt]), bfhi(lfw[tt])}; run += lf[tt]; loc[tt] = run; }
                *(LAS f32x2*)(TOT + g * 128 + d2) = run; }
            __syncthreads();
            { u32x2 s0, s1; s0.x = pk2(S0[0], S0[1]); s0.y = pk2(S0[2], S0[3]); s1.x = pk2(S1[0], S1[1]); s1.y = pk2(S1[2], S1[3]);
                *(LAS u32x2*)(SB + lr * SK + 16 * w + 4 * lq) = s0; *(LAS u32x2*)(SB + (16 + lr) * SK + 16 * w + 4 * lq) = s1; }
            f32x2 tg[8];
#pragma unroll
            for (int j = 0; j < 8; ++j) tg[j] = *(const LAS f32x2*)(TOT + j * 128 + d2);
            f32x2 Pf[4]; Pf[0] = (f32x2){0.f, 0.f}; Pf[1] = tg[0] + tg[1]; Pf[2] = Pf[1] + tg[2] + tg[3]; Pf[3] = Pf[2] + tg[4] + tg[5]; const f32x2 bC = Pf[3] + tg[6] + tg[7];
            const f32x2 Pi = i == 0 ? Pf[0] : (i == 1 ? Pf[1] : (i == 2 ? Pf[2] : Pf[3]));
            const f32x2 half = (g & 1) ? (g == 1 ? tg[0] : (g == 3 ? tg[2] : (g == 5 ? tg[4] : tg[6]))) : (f32x2){0.f, 0.f};
            const f32x2 eP = {__expf(Pi.x), __expf(Pi.y)}; const f32x2 eC = {__expf(bC.x - Pi.x), __expf(bC.y - Pi.y)};
            f32x2 fac[4];
#pragma unroll
            for (int ip = 0; ip < 4; ++ip) fac[ip] = (f32x2){__expf(Pf[ip].x - Pi.x), __expf(Pf[ip].y - Pi.y)};
            const int koff[4] = {0, 16, 48, 96};
            unsigned ke0[4], ke1[4];
#pragma unroll
            for (int tt = 0; tt < 8; ++tt) { const int t = 8 * g + tt; const f32x2 lo = loc[tt] + half;
                const float q0 = bflo(qv[tt]), q1 = bfhi(qv[tt]), k0 = 1.0f - __expf(lf[tt].x), k1 = 1.0f - __expf(lf[tt].y);
                const float e0 = __expf(fmaxf(lo.x, -80.f)), e1 = __expf(fmaxf(lo.y, -80.f));
                const float kr0 = k0 * __builtin_amdgcn_rcpf(e0), kr1 = k1 * __builtin_amdgcn_rcpf(e1);
                *(LAS unsigned*)(QH + t * SK + d2) = pk2(q0 * e0, q1 * e1); *(LAS unsigned*)(QE + t * SK + d2) = pk2(q0 * e0 * eP.x, q1 * e1 * eP.y);
#pragma unroll
                for (int ip = 0; ip < 4; ++ip) if (ip >= i) *(LAS unsigned*)(KH + (koff[ip] + t) * SK + d2) = pk2(kr0 * fac[ip].x, kr1 * fac[ip].y);
                const float c0 = kr0 * eC.x, c1 = kr1 * eC.y;
                if (tt & 1) { ke0[tt >> 1] = pk2(__uint_as_float(ke0[tt >> 1]), c0); ke1[tt >> 1] = pk2(__uint_as_float(ke1[tt >> 1]), c1); } else { ke0[tt >> 1] = __float_as_uint(c0); ke1[tt >> 1] = __float_as_uint(c1); } }
            *(LAS u32x4*)(KET + d2 * SS + 8 * g) = (u32x4){ke0[0], ke0[1], ke0[2], ke0[3]}; *(LAS u32x4*)(KET + (d2 + 1) * SS + 8 * g) = (u32x4){ke1[0], ke1[1], ke1[2], ke1[3]};
            if (g == 0) *(LAS f32x2*)(EBC + d2) = (f32x2){__expf(bC.x), __expf(bC.y)};
            VT[(v4 + 0) * SS + sv] = (bf16)(vv.x & 0xffffu); VT[(v4 + 1) * SS + sv] = (bf16)(vv.x >> 16); VT[(v4 + 2) * SS + sv] = (bf16)(vv.y & 0xffffu); VT[(v4 + 3) * SS + sv] = (bf16)(vv.y >> 16);
            if (c + 2 < SEQ / 64) load(lfw, qv, vv, c + 2);
            __syncthreads();
            for (int tile = w; tile < 10; tile += 8) { int qi, kj; tile_of(tile, qi, kj);
                f32x4 acc = {0.f, 0.f, 0.f, 0.f}; acc = mm(QH, SK, 16 * qi, KH, SK, koff[qi] + 16 * kj, 4, acc, lane);
#pragma unroll
                for (int r = 0; r < 4; ++r) { const int tl = 4 * lq + r; const float val = (qi != kj || lr <= tl) ? acc[r] : 0.f; P[(16 * qi + tl) * SS + 16 * kj + lr] = f2bf(val); } }
            __syncthreads();
            { const int tq = w & 3, nv = w >> 2; f32x4 acc = {0.f, 0.f, 0.f, 0.f};
                acc = mm(P, SS, 16 * tq, VT, SS, 16 * nv, tq < 2 ? 1 : 2, acc, lane);
                acc = mm(QE, SK, 16 * tq, SB, SK, 16 * nv, 4, acc, lane);
                bf16* op = OF + ((size_t)b * SEQ + c * 64 + 16 * tq + 4 * lq) * D + h * 128 + vs * 32 + 16 * nv + (lr & ~1);
                store_pairs(op, acc, lr); }
            { f32x4 U0 = {0.f, 0.f, 0.f, 0.f}, U1 = {0.f, 0.f, 0.f, 0.f}; U0 = mm(KET, SS, 16 * w, VT, SS, 0, 2, U0, lane); U1 = mm(KET, SS, 16 * w, VT, SS, 16, 2, U1, lane);
                const f32x4 dec = *(const LAS f32x4*)(EBC + 16 * w + 4 * lq); S0 = S0 * dec + U0; S1 = S1 * dec + U1; }
        };
        for (int c = 0; c < SEQ / 64; c += 2) { step(lfA, qvA, vvA, c); step(lfB, qvB, vvB, c + 1); }
        if (hcnt) headnorm_tail<4, false>(F, OF, SSQP, hcnt + b * 16 + h, b, h * 128 + vs * 32, h * 4, vs, GB, D, h * 128 + vs * 32, gn + vs * 32, Y);
    }
}

constexpr int A_QH = 0, A_KH = A_QH + 64 * SK * 2, A_IMG = A_KH + 160 * SK * 2;
constexpr int I_QE = 0, I_KET = I_QE + 64 * SK * 2, I_P = I_KET + 128 * SS * 2, I_EBC = I_P + 64 * SS * 2, I_VT = I_EBC + 512, IMG_BYTES = I_VT + 128 * SS * 2;
constexpr int A_TOT = A_IMG + IMG_BYTES, A_END = A_TOT + 4096;
constexpr int B_VT = I_VT, B_SB = B_VT + 32 * SS * 2, B_BUF = B_SB + 32 * SK * 2;
static_assert(IMG_BYTES == 64000 && A_END <= CTRL && 2 * B_BUF <= CTRL, "hg stage LDS maps");
__device__ __forceinline__ void hg_prep_phase(const Frame& F, const bf16* QB, const bf16* LF, const bf16* VB, unsigned char* IMG) {
    LAS bf16* QH = (LAS bf16*)(F.lds + A_QH); LAS bf16* KH = (LAS bf16*)(F.lds + A_KH); LAS bf16* QE = (LAS bf16*)(F.lds + A_IMG + I_QE); LAS bf16* KET = (LAS bf16*)(F.lds + A_IMG + I_KET);
    LAS bf16* VT = (LAS bf16*)(F.lds + A_IMG + I_VT); LAS bf16* P = (LAS bf16*)(F.lds + A_IMG + I_P); LAS float* EBC = (LAS float*)(F.lds + A_IMG + I_EBC); LAS float* TOT = (LAS float*)(F.lds + A_TOT);
    const int tid = F.tid, lane = F.lane, w = F.wave, lq = lane >> 4, lr = lane & 15;
    const int g = w, i = g >> 1, d2 = 2 * lane, sv = tid >> 3, vc = (tid & 7) * 16;
    constexpr int NITEM = BATCH * 16 * (SEQ / 64);
    __syncthreads();
    for (int e = tid; e < 64 * SS / 2; e += NT) ((LAS unsigned*)P)[e] = 0u;
    unsigned lfA[8], lfB[8], qvA[8], qvB[8];
    auto load = [&](unsigned (&lfw)[8], unsigned (&qv)[8], const int item) { const int c = item & 31, gq = item >> 5, b = gq >> 4, h = gq & 15;
        const size_t r0 = (size_t)b * SEQ + (size_t)c * 64 + 8 * g, colb = (size_t)h * 128 + d2;
#pragma unroll
        for (int tt = 0; tt < 8; ++tt) { lfw[tt] = *(GAS const unsigned*)(LF + (r0 + tt) * D + colb); qv[tt] = *(GAS const unsigned*)(QB + (r0 + tt) * D + colb); }
};
    const int first = F.bid, stride = F.G;
    if (first < NITEM) load(lfA, qvA, first);
    if (first + stride < NITEM) load(lfB, qvB, first + stride);
    auto step = [&](unsigned (&lfw)[8], unsigned (&qv)[8], const int item) {
        f32x2 lf[8], loc[8]; { f32x2 run = {0.f, 0.f};
#pragma unroll
            for (int tt = 0; tt < 8; ++tt) { lf[tt] = (f32x2){bflo(lfw[tt]), bfhi(lfw[tt])}; run += lf[tt]; loc[tt] = run; }
            *(LAS f32x2*)(TOT + g * 128 + d2) = run; }
        __syncthreads();
        f32x2 tg[8];
#pragma unroll
        for (int j = 0; j < 8; ++j) tg[j] = *(const LAS f32x2*)(TOT + j * 128 + d2);
        f32x2 Pf[4]; Pf[0] = (f32x2){0.f, 0.f}; Pf[1] = tg[0] + tg[1]; Pf[2] = Pf[1] + tg[2] + tg[3]; Pf[3] = Pf[2] + tg[4] + tg[5]; const f32x2 bC = Pf[3] + tg[6] + tg[7];
        const f32x2 Pi = i == 0 ? Pf[0] : (i == 1 ? Pf[1] : (i == 2 ? Pf[2] : Pf[3]));
        const f32x2 half = (g & 1) ? (g == 1 ? tg[0] : (g == 3 ? tg[2] : (g == 5 ? tg[4] : tg[6]))) : (f32x2){0.f, 0.f};
        const f32x2 eP = {__expf(Pi.x), __expf(Pi.y)}; const f32x2 eC = {__expf(bC.x - Pi.x), __expf(bC.y - Pi.y)};
        f32x2 fac[4];
#pragma unroll
        for (int ip = 0; ip < 4; ++ip) fac[ip] = (f32x2){__expf(Pf[ip].x - Pi.x), __expf(Pf[ip].y - Pi.y)};
        const int koff[4] = {0, 16, 48, 96};
        unsigned ke0[4], ke1[4];
#pragma unroll
        for (int tt = 0; tt < 8; ++tt) { const int t = 8 * g + tt; const f32x2 lo = loc[tt] + half;
            const float q0 = bflo(qv[tt]), q1 = bfhi(qv[tt]), k0 = 1.0f - __expf(lf[tt].x), k1 = 1.0f - __expf(lf[tt].y);
            const float e0 = __expf(fmaxf(lo.x, -80.f)), e1 = __expf(fmaxf(lo.y, -80.f));
            const float kr0 = k0 * __builtin_amdgcn_rcpf(e0), kr1 = k1 * __builtin_amdgcn_rcpf(e1);
            *(LAS unsigned*)(QH + t * SK + d2) = pk2(q0 * e0, q1 * e1); *(LAS unsigned*)(QE + t * SK + d2) = pk2(q0 * e0 * eP.x, q1 * e1 * eP.y);
#pragma unroll
            for (int ip = 0; ip < 4; ++ip) if (ip >= i) *(LAS unsigned*)(KH + (koff[ip] + t) * SK + d2) = pk2(kr0 * fac[ip].x, kr1 * fac[ip].y);
            const float c0 = kr0 * eC.x, c1 = kr1 * eC.y;
            if (tt & 1) { ke0[tt >> 1] = pk2(__uint_as_float(ke0[tt >> 1]), c0); ke1[tt >> 1] = pk2(__uint_as_float(ke1[tt >> 1]), c1); } else { ke0[tt >> 1] = __float_as_uint(c0); ke1[tt >> 1] = __float_as_uint(c1); } }
        *(LAS u32x4*)(KET + d2 * SS + 8 * g) = (u32x4){ke0[0], ke0[1], ke0[2], ke0[3]}; *(LAS u32x4*)(KET + (d2 + 1) * SS + 8 * g) = (u32x4){ke1[0], ke1[1], ke1[2], ke1[3]};
        if (g == 0) *(LAS f32x2*)(EBC + d2) = (f32x2){__expf(bC.x), __expf(bC.y)};
        load(lfw, qv, item + 2 * stride < NITEM ? item + 2 * stride : item);
        __syncthreads();
        for (int tile = w; tile < 10; tile += 8) { int qi, kj; tile_of(tile, qi, kj);
            f32x4 acc = {0.f, 0.f, 0.f, 0.f}; acc = mm(QH, SK, 16 * qi, KH, SK, koff[qi] + 16 * kj, 4, acc, lane);
#pragma unroll
            for (int r = 0; r < 4; ++r) { const int tl = 4 * lq + r; const float val = (qi != kj || lr <= tl) ? acc[r] : 0.f; P[(16 * qi + tl) * SS + 16 * kj + lr] = f2bf(val); } }
        __syncthreads();
        { unsigned char* img = IMG + (size_t)item * I_VT;
            for (int o = tid * 16; o < I_VT; o += NT * 16) *(GAS u32x4*)(img + o) = *(const LAS u32x4*)(F.lds + A_IMG + o); }
    };
    for (int item = first; item < NITEM; item += 2 * stride) { step(lfA, qvA, item); if (item + stride < NITEM) step(lfB, qvB, item + stride); }
}
__device__ __forceinline__ void hg_scan_phase(const Frame& F, const unsigned char* IMG, const bf16* VB, bf16* OF, const bf16* GB, const float* gn, bf16* Y, float* SSQP, unsigned* hcnt) {
    const int tid = F.tid, lane = F.lane, w = F.wave, lq = lane >> 4, lr = lane & 15;
    for (int unit = F.bid; unit < 256; unit += F.G) {
        const int xk = unit >> 3, vs = xk & 3, gq = (xk >> 2) * 8 + (unit & 7); const int b = gq >> 4, h = gq & 15;
        __syncthreads();
        f32x4 S0 = {0.f, 0.f, 0.f, 0.f}, S1 = {0.f, 0.f, 0.f, 0.f};
        constexpr int NC = I_VT / 16;
        const int p5 = tid + 5 * NT; const bool ok5 = p5 < NC; const int s5 = ok5 ? p5 * 16 : 0;
        const int sv = tid >> 3, v4 = (tid & 7) * 4; const size_t colv = (size_t)h * 128 + vs * 32 + v4;
        u32x4 rA[7], rB[7];
        auto load = [&](u32x4 (&r)[7], const int c) { const unsigned char* img = IMG + (size_t)(gq * 32 + c) * I_VT;
#pragma unroll
            for (int k = 0; k < 5; ++k) r[k] = *(GAS const u32x4*)(img + (tid + k * NT) * 16);
            r[5] = *(GAS const u32x4*)(img + s5); { const u32x2 vv = *(GAS const u32x2*)(VB + ((size_t)b * SEQ + (size_t)c * 64 + sv) * D + colv); r[6] = (u32x4){vv.x, vv.y, 0u, 0u}; } };
        load(rA, 0); load(rB, 1);
        auto step = [&](u32x4 (&r)[7], const int c) {
            LAS unsigned char* buf = F.lds + (c & 1) * B_BUF;
            LAS bf16* QE = (LAS bf16*)(buf + I_QE); LAS bf16* KET = (LAS bf16*)(buf + I_KET); LAS bf16* P = (LAS bf16*)(buf + I_P); LAS float* EBC = (LAS float*)(buf + I_EBC);
            LAS bf16* VT = (LAS bf16*)(buf + B_VT); LAS bf16* SB = (LAS bf16*)(buf + B_SB);
#pragma unroll
            for (int k = 0; k < 5; ++k) *(LAS u32x4*)(buf + (tid + k * NT) * 16) = r[k];
            if (ok5) *(LAS u32x4*)(buf + s5) = r[5];
            VT[(v4 + 0) * SS + sv] = (bf16)(r[6].x & 0xffffu); VT[(v4 + 1) * SS + sv] = (bf16)(r[6].x >> 16); VT[(v4 + 2) * SS + sv] = (bf16)(r[6].y & 0xffffu); VT[(v4 + 3) * SS + sv] = (bf16)(r[6].y >> 16);
            { u32x2 s0, s1; s0.x = pk2(S0[0], S0[1]); s0.y = pk2(S0[2], S0[3]); s1.x = pk2(S1[0], S1[1]); s1.y = pk2(S1[2], S1[3]);
                *(LAS u32x2*)(SB + lr * SK + 16 * w + 4 * lq) = s0; *(LAS u32x2*)(SB + (16 + lr) * SK + 16 * w + 4 * lq) = s1; }
            load(r, c + 2 < SEQ / 64 ? c + 2 : SEQ / 64 - 1);
            __syncthreads();
            { const int tq = w & 3, nv = w >> 2; f32x4 acc = {0.f, 0.f, 0.f, 0.f};
                acc = mm(P, SS, 16 * tq, VT, SS, 16 * nv, tq < 2 ? 1 : 2, acc, lane);
                acc = mm(QE, SK, 16 * tq, SB, SK, 16 * nv, 4, acc, lane);
                bf16* op = OF + ((size_t)b * SEQ + c * 64 + 16 * tq + 4 * lq) * D + h * 128 + vs * 32 + 16 * nv + (lr & ~1);
                store_pairs(op, acc, lr); }
            { f32x4 U0 = {0.f, 0.f, 0.f, 0.f}, U1 = {0.f, 0.f, 0.f, 0.f}; U0 = mm(KET, SS, 16 * w, VT, SS, 0, 2, U0, lane); U1 = mm(KET, SS, 16 * w, VT, SS, 16, 2, U1, lane);
                const f32x4 dec = *(const LAS f32x4*)(EBC + 16 * w + 4 * lq); S0 = S0 * dec + U0; S1 = S1 * dec + U1; }
        };
        for (int c = 0; c < SEQ / 64; c += 2) { step(rA, c); step(rB, c + 1); }
        if (hcnt) headnorm_tail<4, false>(F, OF, SSQP, hcnt + b * 16 + h, b, h * 128 + vs * 32, h * 4, vs, GB, D, h * 128 + vs * 32, gn + vs * 32, Y);
    }
}

__device__ __forceinline__ void ml_chunk_phase(const Frame& F, const bf16* PB, const float* gates, const float* bif, bf16* OF, const float* gn, bf16* Y, float* SSQP, unsigned* hcnt) {
    LAS bf16* QH = (LAS bf16*)(F.lds + O_QH); LAS bf16* KH = (LAS bf16*)(F.lds + O_KH); LAS bf16* KET = (LAS bf16*)(F.lds + O_KET);
    LAS bf16* VT = (LAS bf16*)(F.lds + O_VT); LAS bf16* P = (LAS bf16*)(F.lds + O_P); LAS bf16* SB = (LAS bf16*)(F.lds + O_SB);
    LAS float* GT0 = (LAS float*)(F.lds + O_GT + 2048);
    const int tid = F.tid, lane = F.lane, w = F.wave, lq = lane >> 4, lr = lane & 15;
    const int g = w, d2 = 2 * lane, sv = tid >> 3, v4 = (tid & 7) * 4;
    constexpr float S128 = 0.08838834764831845f;
    for (int unit = F.bid; unit < 256; unit += F.G) {
        const int xk = unit >> 3, vs = xk & 7, gq = (xk >> 3) * 8 + (unit & 7); const int b = gq >> 3, h = gq & 7;
        const float bi_ = *(GAS const float*)(bif + h), bf_ = *(GAS const float*)(bif + 8 + h);
        __syncthreads();
        for (int e = tid; e < 64 * SS / 2; e += NT) ((LAS unsigned*)P)[e] = 0u;
        for (int e = tid; e < 48 * SK / 2; e += NT) ((LAS unsigned*)SB)[e] = 0u;
        for (int e = tid; e < 16 * SS; e += NT) VT[32 * SS + e] = (e < 64) ? (bf16)0x3F80u : (bf16)0u;
        f32x4 S0 = {0.f, 0.f, 0.f, 0.f}, S1 = {0.f, 0.f, 0.f, 0.f}, S2 = {0.f, 0.f, 0.f, 0.f};
        unsigned qvA[8], kvA[8], qvB[8], kvB[8]; u32x2 vvA, vvB; float giA = 0.f, gfA = 0.f, giB = 0.f, gfB = 0.f;
        const size_t colq = (size_t)h * 128 + d2, colv = (size_t)2048 + h * 256 + vs * 32 + v4;
        auto load = [&](unsigned (&qv)[8], unsigned (&kv)[8], u32x2& vv, float& gi, float& gf, const int cc) { const size_t r0 = (size_t)b * SEQ + (size_t)cc * 64 + 8 * g;
#pragma unroll
            for (int tt = 0; tt < 8; ++tt) { qv[tt] = *(GAS const unsigned*)(PB + (r0 + tt) * ML_PROJ + colq); kv[tt] = *(GAS const unsigned*)(PB + (r0 + tt) * ML_PROJ + 1024 + colq); }
            vv = *(GAS const u32x2*)(PB + ((size_t)b * SEQ + (size_t)cc * 64 + sv) * ML_PROJ + colv);
            gi = *(GAS const float*)(gates + ((size_t)b * SEQ + (size_t)cc * 64 + lane) * 16 + h); gf = *(GAS const float*)(gates + ((size_t)b * SEQ + (size_t)cc * 64 + lane) * 16 + 8 + h); };
        load(qvA, kvA, vvA, giA, gfA, 0); load(qvB, kvB, vvB, giB, gfB, 1);
        auto step = [&](unsigned (&qv)[8], unsigned (&kv)[8], u32x2& vv, float& gi, float& gf, const int c) {
            LAS float* BT = GT0 + (c & 1) * 320; LAS float* WI = BT + 64; LAS float* WK = WI + 64; LAS float* EB = WK + 64; LAS float* EC = EB + 64;
            if (w == 0) {
                const float it = 15.0f * tanhf((gi + bi_) * (1.0f / 15.0f)); const float y = 15.0f * tanhf((gf + bf_) * (1.0f / 15.0f));
                const float lfv = -(fmaxf(-y, 0.f) + log1pf(expf(-fabsf(y))));
                float bt = lfv;
#pragma unroll
                for (int o = 1; o < 64; o <<= 1) { const float up = __shfl_up(bt, o); if (lane >= o) bt += up; }
                const float bC = __shfl(bt, 63);
                BT[lane] = bt; WI[lane] = it - bt; WK[lane] = __expf(bC - bt + it) * S128; EB[lane] = __expf(bt); if (lane == 0) EC[0] = __expf(bC);
            }
            __syncthreads();
            { u32x2 s0, s1, s2; s0.x = pk2(S0[0], S0[1]); s0.y = pk2(S0[2], S0[3]); s1.x = pk2(S1[0], S1[1]); s1.y = pk2(S1[2], S1[3]); s2.x = pk2(S2[0], S2[1]); s2.y = pk2(S2[2], S2[3]);
                *(LAS u32x2*)(SB + lr * SK + 16 * w + 4 * lq) = s0; *(LAS u32x2*)(SB + (16 + lr) * SK + 16 * w + 4 * lq) = s1; *(LAS u32x2*)(SB + (32 + lr) * SK + 16 * w + 4 * lq) = s2; }
            { unsigned ke0[4], ke1[4];
#pragma unroll
                for (int tt = 0; tt < 8; ++tt) { const int t = 8 * g + tt; *(LAS unsigned*)(QH + t * SK + d2) = qv[tt]; *(LAS unsigned*)(KH + t * SK + d2) = kv[tt];
                    const float wk = WK[t]; const float c0 = bflo(kv[tt]) * wk, c1 = bfhi(kv[tt]) * wk;
                    if (tt & 1) { ke0[tt >> 1] = pk2(__uint_as_float(ke0[tt >> 1]), c0); ke1[tt >> 1] = pk2(__uint_as_float(ke1[tt >> 1]), c1); } else { ke0[tt >> 1] = __float_as_uint(c0); ke1[tt >> 1] = __float_as_uint(c1); } }
                *(LAS u32x4*)(KET + d2 * SS + 8 * g) = (u32x4){ke0[0], ke0[1], ke0[2], ke0[3]}; *(LAS u32x4*)(KET + (d2 + 1) * SS + 8 * g) = (u32x4){ke1[0], ke1[1], ke1[2], ke1[3]}; }
            VT[(v4 + 0) * SS + sv] = (bf16)(vv.x & 0xffffu); VT[(v4 + 1) * SS + sv] = (bf16)(vv.x >> 16); VT[(v4 + 2) * SS + sv] = (bf16)(vv.y & 0xffffu); VT[(v4 + 3) * SS + sv] = (bf16)(vv.y >> 16);
            load(qv, kv, vv, gi, gf, c + 2 < SEQ / 64 ? c + 2 : SEQ / 64 - 1);
            __syncthreads();
            for (int tile = w; tile < 10; tile += 8) { int qi, kj; tile_of(tile, qi, kj);
                f32x4 acc = {0.f, 0.f, 0.f, 0.f}; acc = mm(QH, SK, 16 * qi, KH, SK, 16 * kj, 4, acc, lane);
                const float wis = WI[16 * kj + lr];
#pragma unroll
                for (int r = 0; r < 4; ++r) { const int tl = 4 * lq + r; const float wgt = __expf(BT[16 * qi + tl] + wis) * S128;
                    const float val = (qi != kj || lr <= tl) ? acc[r] * wgt : 0.f; P[(16 * qi + tl) * SS + 16 * kj + lr] = f2bf(val); } }
            __syncthreads();
            { const int tq = w & 3, nv = w >> 2, ksn = tq < 2 ? 1 : 2; f32x4 num = {0.f, 0.f, 0.f, 0.f}, den = num, qs = num, qn = num;
                num = mm(P, SS, 16 * tq, VT, SS, 16 * nv, ksn, num, lane); den = mm(P, SS, 16 * tq, VT, SS, 32, ksn, den, lane);
                qs = mm(QH, SK, 16 * tq, SB, SK, 16 * nv, 4, qs, lane); qn = mm(QH, SK, 16 * tq, SB, SK, 32, 4, qn, lane);
                const f32x4 eb = *(const LAS f32x4*)(EB + 16 * tq + 4 * lq);
                bf16* op = OF + ((size_t)b * SEQ + c * 64 + 16 * tq + 4 * lq) * D + h * 256 + vs * 32 + 16 * nv + (lr & ~1); f32x4 hv;
#pragma unroll
                for (int r = 0; r < 4; ++r) { const float nm = num[r] + eb[r] * qs[r]; float dn = den[r] + eb[r] * qn[r]; dn = __shfl(dn, lane & 48);
                    hv[r] = nm / fmaxf(fabsf(dn), 1.0f); }
                store_pairs(op, hv, lr); }
            { f32x4 U0 = {0.f, 0.f, 0.f, 0.f}, U1 = U0, U2 = U0; U0 = mm(KET, SS, 16 * w, VT, SS, 0, 2, U0, lane); U1 = mm(KET, SS, 16 * w, VT, SS, 16, 2, U1, lane); U2 = mm(KET, SS, 16 * w, VT, SS, 32, 2, U2, lane);
                const float dec = EC[0]; S0 = S0 * dec + U0; S1 = S1 * dec + U1; S2 = S2 * dec + U2; }
        };
        for (int c = 0; c < SEQ / 64; c += 2) { step(qvA, kvA, vvA, giA, gfA, c); step(qvB, kvB, vvB, giB, gfB, c + 1); }
        if (hcnt) headnorm_tail<8, true>(F, OF, SSQP, hcnt + b * 8 + h, b, h * 256 + vs * 32, h * 8, vs, PB, ML_PROJ, 4096 + h * 256 + vs * 32, gn + vs * 32, Y);
    }
}

constexpr int MA_KH = 0, MA_IMG = MA_KH + 64 * SK * 2, ML_IMG_BYTES = I_VT + 256 * SS * 2, MA_GS = MA_IMG + ML_IMG_BYTES, MA_END = MA_GS + 2 * 1280;
constexpr int MB_VT = I_VT, MB_SB = MB_VT + 48 * SS * 2, MB_BUF = MB_SB + 48 * SK * 2;
static_assert(MA_END <= CTRL && 2 * MB_BUF <= CTRL, "ml stage LDS maps");
__device__ __forceinline__ void ml_prep_phase(const Frame& F, const bf16* PB, const float* gates, const float* bif, unsigned char* IMG) {
    LAS bf16* KH = (LAS bf16*)(F.lds + MA_KH); LAS bf16* QH = (LAS bf16*)(F.lds + MA_IMG + I_QE); LAS bf16* KET = (LAS bf16*)(F.lds + MA_IMG + I_KET);
    LAS bf16* VT = (LAS bf16*)(F.lds + MA_IMG + I_VT); LAS bf16* P = (LAS bf16*)(F.lds + MA_IMG + I_P); LAS float* EBI = (LAS float*)(F.lds + MA_IMG + I_EBC);
    const int tid = F.tid, lane = F.lane, w = F.wave, lq = lane >> 4, lr = lane & 15;
    const int g = w, d2 = 2 * lane, tp = tid >> 4, vc = (tid & 15) * 16;
    constexpr float S128 = 0.08838834764831845f;
    constexpr int NITEM = BATCH * 8 * (SEQ / 64);
    __syncthreads();
    for (int e = tid; e < 64 * SS / 2; e += NT) ((LAS unsigned*)P)[e] = 0u;
    unsigned qvA[8], kvA[8], qvB[8], kvB[8]; float giA = 0.f, gfA = 0.f, giB = 0.f, gfB = 0.f;
    auto load = [&](unsigned (&qv)[8], unsigned (&kv)[8], float& gi, float& gf, const int item) { const int c = item & 31, gq = item >> 5, b = gq >> 3, h = gq & 7;
        const size_t r0 = (size_t)b * SEQ + (size_t)c * 64 + 8 * g, colq = (size_t)h * 128 + d2;
#pragma unroll
        for (int tt = 0; tt < 8; ++tt) { qv[tt] = *(GAS const unsigned*)(PB + (r0 + tt) * ML_PROJ + colq); kv[tt] = *(GAS const unsigned*)(PB + (r0 + tt) * ML_PROJ + 1024 + colq); }
        const size_t gr = ((size_t)b * SEQ + (size_t)c * 64 + lane) * 16 + h; gi = *(GAS const float*)(gates + gr) + *(GAS const float*)(bif + h); gf = *(GAS const float*)(gates + gr + 8) + *(GAS const float*)(bif + 8 + h); };
    const int first = F.bid, stride = F.G;
    if (first < NITEM) load(qvA, kvA, giA, gfA, first);
    if (first + stride < NITEM) load(qvB, kvB, giB, gfB, first + stride);
    int par = 0;
    auto step = [&](unsigned (&qv)[8], unsigned (&kv)[8], float& gi, float& gf, const int item) {
        LAS float* BT = (LAS float*)(F.lds + MA_GS) + par * 320; LAS float* WI = BT + 64; LAS float* WK = WI + 64; LAS float* EB = WK + 64; LAS float* EC = EB + 64;
        if (w == 0) {
            const float it = 15.0f * tanhf(gi * (1.0f / 15.0f)); const float y = 15.0f * tanhf(gf * (1.0f / 15.0f));
            const float lfv = -(fmaxf(-y, 0.f) + log1pf(expf(-fabsf(y))));
            float bt = lfv;
#pragma unroll
            for (int o = 1; o < 64; o <<= 1) { const float up = __shfl_up(bt, o); if (lane >= o) bt += up; }
            const float bC = __shfl(bt, 63);
            BT[lane] = bt; WI[lane] = it - bt; WK[lane] = __expf(bC - bt + it) * S128; EB[lane] = __expf(bt); if (lane == 0) EC[0] = __expf(bC);
        }
        __syncthreads();
        if (w == 0) { EBI[lane] = EB[lane]; if (lane == 0) EBI[64] = EC[0]; }
        { unsigned ke0[4], ke1[4];
#pragma unroll
            for (int tt = 0; tt < 8; ++tt) { const int t = 8 * g + tt; *(LAS unsigned*)(QH + t * SK + d2) = qv[tt]; *(LAS unsigned*)(KH + t * SK + d2) = kv[tt];
                const float wk = WK[t]; const float c0 = bflo(kv[tt]) * wk, c1 = bfhi(kv[tt]) * wk;
                if (tt & 1) { ke0[tt >> 1] = pk2(__uint_as_float(ke0[tt >> 1]), c0); ke1[tt >> 1] = pk2(__uint_as_float(ke1[tt >> 1]), c1); } else { ke0[tt >> 1] = __float_as_uint(c0); ke1[tt >> 1] = __float_as_uint(c1); } }
            *(LAS u32x4*)(KET + d2 * SS + 8 * g) = (u32x4){ke0[0], ke0[1], ke0[2], ke0[3]}; *(LAS u32x4*)(KET + (d2 + 1) * SS + 8 * g) = (u32x4){ke1[0], ke1[1], ke1[2], ke1[3]}; }
        load(qv, kv, gi, gf, item + 2 * stride < NITEM ? item + 2 * stride : item);
        __syncthreads();
        for (int tile = w; tile < 10; tile += 8) { int qi, kj; tile_of(tile, qi, kj);
            f32x4 acc = {0.f, 0.f, 0.f, 0.f}; acc = mm(QH, SK, 16 * qi, KH, SK, 16 * kj, 4, acc, lane);
            const float wis = WI[16 * kj + lr];
#pragma unroll
            for (int r = 0; r < 4; ++r) { const int tl = 4 * lq + r; const float wgt = __expf(BT[16 * qi + tl] + wis) * S128;
                const float val = (qi != kj || lr <= tl) ? acc[r] * wgt : 0.f; P[(16 * qi + tl) * SS + 16 * kj + lr] = f2bf(val); } }
        __syncthreads();
        { unsigned char* img = IMG + (size_t)item * I_VT;
            for (int o = tid * 16; o < I_VT; o += NT * 16) *(GAS u32x4*)(img + o) = *(const LAS u32x4*)(F.lds + MA_IMG + o); }
        par ^= 1;
    };
    for (int item = first; item < NITEM; item += 2 * stride) { step(qvA, kvA, giA, gfA, item); if (item + stride < NITEM) step(qvB, kvB, giB, gfB, item + stride); }
}
__device__ __forceinline__ void ml_scan_phase(const Frame& F, const unsigned char* IMG, bf16* OF, const bf16* PB, const float* gn, bf16* Y, float* SSQP, unsigned* hcnt) {
    const int tid = F.tid, lane = F.lane, w = F.wave, lq = lane >> 4, lr = lane & 15;
    for (int unit = F.bid; unit < 256; unit += F.G) {
        const int xk = unit >> 3, vs = xk & 7, gq = (xk >> 3) * 8 + (unit & 7); const int b = gq >> 3, h = gq & 7;
        __syncthreads();
#pragma unroll
        for (int bb = 0; bb < 2; ++bb) { LAS bf16* VTb = (LAS bf16*)(F.lds + bb * MB_BUF + MB_VT);
            for (int e = tid; e < 16 * SS; e += NT) VTb[32 * SS + e] = (e < 64) ? (bf16)0x3F80u : (bf16)0u; }
        f32x4 S0 = {0.f, 0.f, 0.f, 0.f}, S1 = {0.f, 0.f, 0.f, 0.f}, S2 = {0.f, 0.f, 0.f, 0.f};
        constexpr int NC = I_VT / 16;
        const int p5 = tid + 5 * NT; const bool ok5 = p5 < NC; const int s5 = ok5 ? p5 * 16 : 0;
        const int sv = tid >> 3, v4 = (tid & 7) * 4; const size_t colv = (size_t)2048 + h * 256 + vs * 32 + v4;
        u32x4 rA[7], rB[7];
        auto load = [&](u32x4 (&r)[7], const int c) { const unsigned char* img = IMG + (size_t)(gq * 32 + c) * I_VT;
#pragma unroll
            for (int k = 0; k < 5; ++k) r[k] = *(GAS const u32x4*)(img + (tid + k * NT) * 16);
            r[5] = *(GAS const u32x4*)(img + s5); { const u32x2 vv = *(GAS const u32x2*)(PB + ((size_t)b * SEQ + (size_t)c * 64 + sv) * ML_PROJ + colv); r[6] = (u32x4){vv.x, vv.y, 0u, 0u}; } };
        load(rA, 0); load(rB, 1);
        auto step = [&](u32x4 (&r)[7], const int c) {
            LAS unsigned char* buf = F.lds + (c & 1) * MB_BUF;
            LAS bf16* QH = (LAS bf16*)(buf + I_QE); LAS bf16* KET = (LAS bf16*)(buf + I_KET); LAS bf16* P = (LAS bf16*)(buf + I_P); LAS float* EB = (LAS float*)(buf + I_EBC);
            LAS bf16* VT = (LAS bf16*)(buf + MB_VT); LAS bf16* SB = (LAS bf16*)(buf + MB_SB);
#pragma unroll
            for (int k = 0; k < 5; ++k) *(LAS u32x4*)(buf + (tid + k * NT) * 16) = r[k];
            if (ok5) *(LAS u32x4*)(buf + s5) = r[5];
            VT[(v4 + 0) * SS + sv] = (bf16)(r[6].x & 0xffffu); VT[(v4 + 1) * SS + sv] = (bf16)(r[6].x >> 16); VT[(v4 + 2) * SS + sv] = (bf16)(r[6].y & 0xffffu); VT[(v4 + 3) * SS + sv] = (bf16)(r[6].y >> 16);
            { u32x2 s0, s1, s2; s0.x = pk2(S0[0], S0[1]); s0.y = pk2(S0[2], S0[3]); s1.x = pk2(S1[0], S1[1]); s1.y = pk2(S1[2], S1[3]); s2.x = pk2(S2[0], S2[1]); s2.y = pk2(S2[2], S2[3]);
                *(LAS u32x2*)(SB + lr * SK + 16 * w + 4 * lq) = s0; *(LAS u32x2*)(SB + (16 + lr) * SK + 16 * w + 4 * lq) = s1; *(LAS u32x2*)(SB + (32 + lr) * SK + 16 * w + 4 * lq) = s2; }
            load(r, c + 2 < SEQ / 64 ? c + 2 : SEQ / 64 - 1);
            __syncthreads();
            { const int tq = w & 3, nv = w >> 2, ksn = tq < 2 ? 1 : 2; f32x4 num = {0.f, 0.f, 0.f, 0.f}, den = num, qs = num, qn = num;
                num = mm(P, SS, 16 * tq, VT, SS, 16 * nv, ksn, num, lane); den = mm(P, SS, 16 * tq, VT, SS, 32, ksn, den, lane);
                qs = mm(QH, SK, 16 * tq, SB, SK, 16 * nv, 4, qs, lane); qn = mm(QH, SK, 16 * tq, SB, SK, 32, 4, qn, lane);
                const f32x4 eb = *(const LAS f32x4*)(EB + 16 * tq + 4 * lq);
                bf16* op = OF + ((size_t)b * SEQ + c * 64 + 16 * tq + 4 * lq) * D + h * 256 + vs * 32 + 16 * nv + (lr & ~1); f32x4 hv;
#pragma unroll
                for (int r4 = 0; r4 < 4; ++r4) { const float nm = num[r4] + eb[r4] * qs[r4]; float dn = den[r4] + eb[r4] * qn[r4]; dn = __shfl(dn, lane & 48);
                    hv[r4] = nm * __builtin_amdgcn_rcpf(fmaxf(fabsf(dn), 1.0f)); }
                store_pairs(op, hv, lr); }
            { f32x4 U0 = {0.f, 0.f, 0.f, 0.f}, U1 = U0, U2 = U0; U0 = mm(KET, SS, 16 * w, VT, SS, 0, 2, U0, lane); U1 = mm(KET, SS, 16 * w, VT, SS, 16, 2, U1, lane); U2 = mm(KET, SS, 16 * w, VT, SS, 32, 2, U2, lane);
                const float dec = EB[64]; S0 = S0 * dec + U0; S1 = S1 * dec + U1; S2 = S2 * dec + U2; }
        };
        for (int c = 0; c < SEQ / 64; c += 2) { step(rA, c); step(rB, c + 1); }
        if (hcnt) headnorm_tail<8, true>(F, OF, SSQP, hcnt + b * 8 + h, b, h * 256 + vs * 32, h * 8, vs, PB, ML_PROJ, 4096 + h * 256 + vs * 32, gn + vs * 32, Y);
    }
}
}

template <bool ML>
__device__ __forceinline__ void headnorm_rows(const Frame& F, const bf16* OF, const float* gn, const bf16* gate, int ldg, bf16* Y) {
    constexpr int HD = ML ? 256 : 128, LPH = HD / 32;
    for (int row = F.gw; row < M; row += F.NGW) {
        const u32x4* p = (const u32x4*)(OF + (size_t)row * D + F.lane * 32);
        f32x4 v[8]; float ss = 0.f;
#pragma unroll
        for (int j = 0; j < 4; ++j) { const u32x4 w = p[j]; v[2 * j] = (f32x4){bflo(w.x), bfhi(w.x), bflo(w.y), bfhi(w.y)}; v[2 * j + 1] = (f32x4){bflo(w.z), bfhi(w.z), bflo(w.w), bfhi(w.w)}; }
#pragma unroll
        for (int j = 0; j < 8; ++j) ss += (v[j][0] * v[j][0] + v[j][1] * v[j][1]) + (v[j][2] * v[j][2] + v[j][3] * v[j][3]);
#pragma unroll
        for (int o = 1; o < LPH; o <<= 1) ss += __shfl_xor(ss, o);
        const float rstd = 1.0f / sqrtf(ss * (1.0f / HD) + EPS);
        const int cih = (F.lane * 32) % HD;
        const u32x4* gp = (const u32x4*)(gate + (size_t)row * ldg + F.lane * 32);
        u32x4* yp = (u32x4*)(Y + (size_t)row * D + F.lane * 32);
#pragma unroll
        for (int j = 0; j < 4; ++j) { const u32x4 gw = gp[j]; const f32x4 g0 = *(GAS const f32x4*)(gn + cih + 8 * j), g1 = *(GAS const f32x4*)(gn + cih + 8 * j + 4);
            float gg[8] = {bflo(gw.x), bfhi(gw.x), bflo(gw.y), bfhi(gw.y), bflo(gw.z), bfhi(gw.z), bflo(gw.w), bfhi(gw.w)};
            if constexpr (ML) {
#pragma unroll
                for (int i = 0; i < 8; ++i) gg[i] = sigmoidf_(gg[i]); }
            const f32x4 a = v[2 * j] * rstd * g0, c = v[2 * j + 1] * rstd * g1;
            u32x4 w; w.x = pk2(a[0] * gg[0], a[1] * gg[1]); w.y = pk2(a[2] * gg[2], a[3] * gg[3]); w.z = pk2(c[0] * gg[4], c[1] * gg[5]); w.w = pk2(c[2] * gg[6], c[3] * gg[7]);
            yp[j] = w; }
    }
}
__device__ __forceinline__ void lru_conv(const Frame& F, const bf16* UR, const float* cw, const float* cb, bf16* UCB) {
    constexpr int total = (M / 4) * (D / 8);
    const int first = F.bid * NT + F.tid, c8 = (first % (D / 8)) * 8;
    f32x4 w0[4], w1[4];
#pragma unroll
    for (int j = 0; j < 4; ++j) { w0[j] = *(GAS const f32x4*)(cw + j * D + c8); w1[j] = *(GAS const f32x4*)(cw + j * D + c8 + 4); }
    const f32x4 b0 = *(GAS const f32x4*)(cb + c8), b1 = *(GAS const f32x4*)(cb + c8 + 4);
    for (int idx = first; idx < total; idx += F.G * NT) {
        const int row0 = (idx / (D / 8)) * 4, t0 = row0 % SEQ;
        u32x4 u[7];
#pragma unroll
        for (int i = 0; i < 7; ++i) { u[i] = (u32x4){0u, 0u, 0u, 0u}; if (i >= 3 || t0 > 0) u[i] = *(GAS const u32x4*)(UR + (size_t)(row0 + i - 3) * D + c8); }
#pragma unroll
        for (int o = 0; o < 4; ++o) { f32x4 a0 = b0, a1 = b1;
#pragma unroll
            for (int j = 0; j < 4; ++j) { const u32x4 v = u[o + j];
                a0 += w0[j] * (f32x4){bflo(v.x), bfhi(v.x), bflo(v.y), bfhi(v.y)}; a1 += w1[j] * (f32x4){bflo(v.z), bfhi(v.z), bflo(v.w), bfhi(v.w)}; }
            u32x4 w; w.x = pk2(a0[0], a0[1]); w.y = pk2(a0[2], a0[3]); w.z = pk2(a1[0], a1[1]); w.w = pk2(a1[2], a1[3]);
            *(GAS u32x4*)(UCB + (size_t)(row0 + o) * D + c8) = w; }
    }
}
__device__ __forceinline__ void lru_scan(const Frame& F, const bf16* LA, const bf16* INP, const bf16* GBR, bf16* Y) {
    LAS float* CP = (LAS float*)F.lds; LAS float* CH = CP + 128 * 32; LAS float* QP = CH + 128 * 32; LAS float* QH = QP + 16 * 32; LAS float* HC = QH + 16 * 32;
    const int seg = F.tid >> 2, q = F.tid & 3, ch = F.tid & 31, part = F.tid >> 5;
    for (int unit = F.bid; unit < BATCH * 64; unit += F.G) {
        const int b = unit >> 6;
        __syncthreads();
        if (F.tid < 32) HC[F.tid] = 0.f;
        for (int half = 0; half < 2; ++half) {
            const size_t base = ((size_t)b * SEQ + half * (SEQ / 2) + seg * 8) * D + (unit & 63) * 32 + 8 * q;
            u32x4 la[8], xi[8];
#pragma unroll
            for (int j = 0; j < 8; ++j) { la[j] = *(GAS const u32x4*)(LA + base + (size_t)j * D); xi[j] = *(GAS const u32x4*)(INP + base + (size_t)j * D); }
            float sl[8], h[8];
#pragma unroll
            for (int e = 0; e < 8; ++e) { sl[e] = 0.f; h[e] = 0.f; }
#pragma unroll
            for (int j = 0; j < 8; ++j) {
                const float l8[8] = {bflo(la[j].x), bfhi(la[j].x), bflo(la[j].y), bfhi(la[j].y), bflo(la[j].z), bfhi(la[j].z), bflo(la[j].w), bfhi(la[j].w)};
                const float x8[8] = {bflo(xi[j].x), bfhi(xi[j].x), bflo(xi[j].y), bfhi(xi[j].y), bflo(xi[j].z), bfhi(xi[j].z), bflo(xi[j].w), bfhi(xi[j].w)};
#pragma unroll
                for (int e = 0; e < 8; ++e) { h[e] = __expf(l8[e]) * h[e] + x8[e]; sl[e] += l8[e]; } }
            __syncthreads();
            *(LAS f32x4*)(CP + seg * 32 + 8 * q) = (f32x4){__expf(sl[0]), __expf(sl[1]), __expf(sl[2]), __expf(sl[3])}; *(LAS f32x4*)(CP + seg * 32 + 8 * q + 4) = (f32x4){__expf(sl[4]), __expf(sl[5]), __expf(sl[6]), __expf(sl[7])};
            *(LAS f32x4*)(CH + seg * 32 + 8 * q) = (f32x4){h[0], h[1], h[2], h[3]}; *(LAS f32x4*)(CH + seg * 32 + 8 * q + 4) = (f32x4){h[4], h[5], h[6], h[7]};
            __syncthreads();
            { float p = 1.f, hh = 0.f;
#pragma unroll
                for (int s = 0; s < 8; ++s) { const float cp = CP[(part * 8 + s) * 32 + ch], cv = CH[(part * 8 + s) * 32 + ch]; hh = cp * hh + cv; p *= cp; }
                QP[part * 32 + ch] = p; QH[part * 32 + ch] = hh; }
            __syncthreads();
            { float carry = HC[ch];
                for (int s = 0; s < part; ++s) carry = QP[s * 32 + ch] * carry + QH[s * 32 + ch];
#pragma unroll
                for (int s = 0; s < 8; ++s) { const int o = (part * 8 + s) * 32 + ch; const float cp = CP[o], cv = CH[o]; CH[o] = carry; carry = cp * carry + cv; }
                __syncthreads();
                if (part == 15) HC[ch] = carry; }
            { const f32x4 c0 = *(const LAS f32x4*)(CH + seg * 32 + 8 * q), c1 = *(const LAS f32x4*)(CH + seg * 32 + 8 * q + 4);
                h[0] = c0[0]; h[1] = c0[1]; h[2] = c0[2]; h[3] = c0[3]; h[4] = c1[0]; h[5] = c1[1]; h[6] = c1[2]; h[7] = c1[3]; }
            u32x4 gg[8];
#pragma unroll
            for (int j = 0; j < 8; ++j) gg[j] = *(GAS const u32x4*)(GBR + base + (size_t)j * D);
#pragma unroll
            for (int j = 0; j < 8; ++j) { const u32x4 lw = la[j], xw = xi[j], gw = gg[j];
                const float l8[8] = {bflo(lw.x), bfhi(lw.x), bflo(lw.y), bfhi(lw.y), bflo(lw.z), bfhi(lw.z), bflo(lw.w), bfhi(lw.w)};
                const float x8[8] = {bflo(xw.x), bfhi(xw.x), bflo(xw.y), bfhi(xw.y), bflo(xw.z), bfhi(xw.z), bflo(xw.w), bfhi(xw.w)};
                const float g8[8] = {bflo(gw.x), bfhi(gw.x), bflo(gw.y), bfhi(gw.y), bflo(gw.z), bfhi(gw.z), bflo(gw.w), bfhi(gw.w)};
                float y[8];
#pragma unroll
                for (int e = 0; e < 8; ++e) { h[e] = __expf(l8[e]) * h[e] + x8[e]; y[e] = g8[e] * h[e]; }
                u32x4 w; w.x = pk2(y[0], y[1]); w.y = pk2(y[2], y[3]); w.z = pk2(y[4], y[5]); w.w = pk2(y[6], y[7]);
                *(GAS u32x4*)(Y + base + (size_t)j * D) = w; }
        }
    }
}
__device__ __forceinline__ void softmax_rows(const Frame& F, const float* S, bf16* P) {
    for (int row = F.gw; row < 16 * SEQ; row += F.NGW) {
        const f32x4 s = ((const f32x4*)(S + (size_t)row * NMEM))[F.lane];
        const float mx = wave_max(fmaxf(fmaxf(s[0], s[1]), fmaxf(s[2], s[3])));
        const f32x4 e = {__expf(s[0] - mx), __expf(s[1] - mx), __expf(s[2] - mx), __expf(s[3] - mx)};
        const float inv = 1.0f / wave_sum((e[0] + e[1]) + (e[2] + e[3]));
        u32x2 w; w.x = pk2(e[0] * inv, e[1] * inv); w.y = pk2(e[2] * inv, e[3] * inv); ((u32x2*)(P + (size_t)row * NMEM))[F.lane] = w;
    }
}


__device__ __forceinline__ int uni(int v) { return __builtin_amdgcn_readfirstlane(v); }
__device__ __forceinline__ Frame make_frame(unsigned ldsb) {
    Frame F; F.lds = (LAS unsigned char*)(size_t)__builtin_amdgcn_readfirstlane(ldsb);
    F.lane = (int)__builtin_amdgcn_mbcnt_hi(~0u, __builtin_amdgcn_mbcnt_lo(~0u, 0u));
    const unsigned key = hw_wave_key(); int w = 0;
#pragma unroll
    for (int i = 1; i < NWAVES; ++i) { const unsigned k = __builtin_amdgcn_readfirstlane(*(const LAS unsigned*)(F.lds + CTRL + 16 + 4 * i)); w = (k == key) ? i : w; }
    F.wave = w; F.tid = w * 64 + F.lane;
    F.bid = __builtin_amdgcn_readfirstlane(*(const LAS int*)(F.lds + CTRL + 48)); F.G = __builtin_amdgcn_readfirstlane(*(const LAS int*)(F.lds + CTRL + 52));
    F.gw = F.bid * NWAVES + F.wave; F.NGW = F.G * NWAVES; return F;
}
__device__ __forceinline__ void phase_end(const unsigned ldsb, int bar_) {
    if (uni(bar_)) { asm volatile("" ::: "memory"); const Frame F = make_frame(ldsb); XcdBarrier b; b.bar = (unsigned*)(F.ws() + WS_CTL); b.x = xb_xcc_id(); b.st = (volatile LAS unsigned*)(F.lds + CTRL); xcd_barrier(b, F.tid, (unsigned)F.G); }
}
#define PHASE_FN static __device__ __noinline__ __attribute__((not_tail_called)) void
#define PHASE_FN_G static __device__ __forceinline__ void

__device__ __forceinline__ int cvt_njobs(int l, int part) { return part == 0 ? ((l % 3) == 1 ? 2 + 1 + 32 : 2 + 1) : 3; }
__device__ __forceinline__ CvtJob cvt_job(const Frame& F, int l, int part, int j) {
    unsigned char* ws = F.ws(); const float* ng = F.in(I_NORMG); const int kind = l % 3, idx = l / 3;
    CvtJob J; J.gk = nullptr; J.off = 0; J.gu = 0; J.nvalid = 1 << 30;
    if (j == 0) { J.W = F.in(I_WGU) + (size_t)(l * 2 + part) * D * NGU; J.WT = (bf16*)(ws + WS_WGU + (size_t)(l * 2 + part) * SZ_WGU); J.K = D; J.ldw = NGU; J.nrows = NGU; J.gu = 1; J.gk = ng + ((size_t)l * 4 + (part ? 3 : 0)) * D; return J; }
    if (j == 1) { J.W = F.in(I_WDN) + (size_t)(l * 2 + part) * DFF * D; J.WT = (bf16*)(ws + WS_WDN + (size_t)(l * 2 + part) * SZ_WDN); J.K = DFF; J.ldw = D; J.nrows = D; return J; }
    if (part == 1) { J.K = D; J.ldw = D; J.nrows = D;
        if (kind == 0) { J.W = F.in(I_HGOUT) + (size_t)idx * D * D; J.WT = (bf16*)(ws + WS_HGOUT + (size_t)idx * SZ_WDD); }
        else if (kind == 1) { J.W = F.in(I_LRUOUT); J.WT = (bf16*)(ws + WS_LRUOUT); }
        else { J.W = F.in(I_MLOUT); J.WT = (bf16*)(ws + WS_MLOUT); }
        return J; }
    J.gk = ng + ((size_t)l * 4 + 1) * D; J.K = D;
    if (kind == 0) { J.W = F.in(I_HGIN) + (size_t)idx * D * 4 * D; J.WT = (bf16*)(ws + WS_HGIN + (size_t)idx * 4 * SZ_WDD); J.ldw = 4 * D; J.nrows = 4 * D; return J; }
    if (kind == 2) { J.W = F.in(I_MLIN); J.WT = (bf16*)(ws + WS_MLIN); J.ldw = ML_IN; J.nrows = ML_PROJ; return J; }
    if (j == 2) { J.W = F.in(I_LRUIN); J.WT = (bf16*)(ws + WS_LRUIN); J.ldw = 2 * D; J.nrows = 2 * D; return J; }
    { const int q = j - 3, g = q >> 4, blk = (q >> 1) & 7, jj = q & 1;
        J.gk = nullptr; J.W = F.in(g ? I_LRUWX : I_LRUWA) + (size_t)blk * 256 * 256; J.WT = (bf16*)(ws + WS_LRUG) + (size_t)(blk * 512 + jj * 256 + g * 128) * 256; J.K = 256; J.ldw = 256; J.nrows = 128; J.off = jj * 128; return J; }
}
__device__ __forceinline__ void convert_set(const Frame& F, int& rot, int l, int part, int num0 = 0, int num1 = 8) {
    const int nj = cvt_njobs(l, part);
    for (int j = 0; j < nj; ++j) { const CvtJob J = cvt_job(F, l, part, j); convert_job_rt(F, rot, J, num0, num1); }
}
constexpr int CVT_SC = 3;
PHASE_FN_G ph_prologue(unsigned ldsb, int bar_) {
    const Frame F = make_frame(ldsb);
    unsigned char* ws = F.ws(); int rot = 0;
    convert_set(F, rot, 0, 0);
    for (int l = 0; l < DEPTH; ++l) for (int kv = 0; kv < 2; ++kv) { CvtJob J; J.gk = nullptr; J.gu = 0; J.nvalid = 1 << 30; J.K = D; J.ldw = 2 * D; J.nrows = D; J.off = kv * D;
        J.W = F.in(I_XAKV) + (size_t)l * D * 2 * D; J.WT = (bf16*)(ws + (kv ? WS_WV : WS_WK) + (size_t)l * SZ_WDD); convert_job_rt(F, rot, J); }
    for (int l = 0; l < DEPTH; ++l) { CvtJob J; J.gk = nullptr; J.gu = 0; J.nvalid = 1 << 30; J.K = D; J.ldw = D; J.nrows = D; J.off = 0;
        J.W = F.in(I_XAO) + (size_t)l * D * D; J.WT = (bf16*)(ws + WS_WO + (size_t)l * SZ_WDD); convert_job_rt(F, rot, J); }
    { const float* wq = F.in(I_XAQ); const float* ngq = F.in(I_NORMG); bf16* wqn = (bf16*)(ws + WS_WQ);
      for (size_t i = (size_t)F.bid * NT + F.tid; i < (size_t)DEPTH * D * D / 8; i += (size_t)F.G * NT) { const size_t e = i * 8; const int l = (int)(e / ((size_t)D * D)), d = (int)((e / D) % D);
          const float g = ngq[((size_t)l * 4 + 2) * D + d]; const f32x4 a = __builtin_nontemporal_load((const f32x4*)(wq + e)), b = __builtin_nontemporal_load((const f32x4*)(wq + e + 4));
          u32x4 w; w.x = pk2(a[0] * g, a[1] * g); w.y = pk2(a[2] * g, a[3] * g); w.z = pk2(b[0] * g, b[1] * g); w.w = pk2(b[2] * g, b[3] * g); *(u32x4*)(wqn + e) = w; } }
    float* misc = (float*)(ws + WS_MISC);
    const int gt = F.bid * NT + F.tid, GT = F.G * NT;
    const float* hglb = F.in(I_HGLB); const float* lamp = F.in(I_LRULAM);
    for (int c = gt; c < 2048; c += GT) {
        const float p0 = hglb[c], p1 = hglb[2048 + c], p2 = hglb[4096 + c], p3 = hglb[6144 + c];
        const float mx = fmaxf(fmaxf(p0, p1), fmaxf(p2, p3)); const float e0 = expf(p0 - mx), e1 = expf(p1 - mx), e2 = expf(p2 - mx), e3 = expf(p3 - mx); const float inv = 1.0f / (e0 + e1 + e2 + e3);
        misc[MISC_LB / 4 + c] = 0.f; misc[MISC_LB / 4 + 2048 + c] = e1 * inv; misc[MISC_LB / 4 + 4096 + c] = (e1 + e2) * inv; misc[MISC_LB / 4 + 6144 + c] = (e1 + e2 + e3) * inv;
        const float lam = lamp[c]; const float sp = fmaxf(-lam, 0.f) + log1pf(expf(-fabsf(lam)));
        misc[MISC_C8 / 4 + c] = 8.0f * sp;
    }
    { const float* mlin = F.in(I_MLIN); const float* g21 = F.in(I_NORMG) + ((size_t)2 * 4 + 1) * D;
      bf16* wgb = (bf16*)(misc + MISC_MLWG / 4);
      for (int i = gt; i < 16 * 2048; i += GT) { const int c = i >> 11, k = i & 2047; const float w_ = g21[k] * mlin[(size_t)k * ML_IN + ML_PROJ + c]; wgb[i] = (bf16)(pk2(w_, w_) & 0xffffu); } }
    x_to_stream(F, F.in(I_X), (bf16*)(ws + WS_HB), misc + MISC_SSQ / 4);
    norm_rows<false>(F, F.in(I_MEM), F.in(I_MEMG), (bf16*)(ws + WS_MEMN), MMEM, nullptr, nullptr);
    phase_end(ldsb, bar_);
}

enum { NRM_FFN1 = 0, NRM_MIX = 1, NRM_ATT = 2, NRM_FFN2 = 3 };
PHASE_FN ph_final(unsigned ldsb) { const Frame F = make_frame(ldsb); unsigned char* ws = F.ws();
    if (X_F32) final_norm(F, (const float*)(ws + WS_X), F.in(I_FINALG), F.out()); else final_norm_bf(F, (const bf16*)(ws + WS_HB), (const float*)(ws + WS_MISC) + MISC_SSQ / 4, F.in(I_FINALG), F.out()); }
constexpr size_t CTL_HCNT = 32768;
constexpr size_t HG_IMG_OFF = 64 * MiB;
static_assert(HG_IMG_OFF + (size_t)BATCH * 16 * (SEQ / 64) * ck::IMG_BYTES <= 192 * MiB, "hg images");
PHASE_FN_G ph_hg_prep(unsigned ldsb, int bar_) { const Frame F = make_frame(ldsb); unsigned char* ws = F.ws();
    bf16* QB = (bf16*)(ws + WS_P0); bf16* VB = QB + (size_t)2 * M * D; const bf16* LF = (const bf16*)(ws + WS_P1);
    ck::hg_prep_phase(F, QB, LF, VB, ws + WS_P1 + HG_IMG_OFF); phase_end(ldsb, bar_); }
PHASE_FN_G ph_hg_recur(unsigned ldsb, int l_, int bar_) { const Frame F = make_frame(ldsb); unsigned char* ws = F.ws(); const int l = uni(l_);
    bf16* GB = (bf16*)(ws + WS_P0) + (size_t)3 * M * D; bf16* OF = (bf16*)(ws + WS_P1) + (size_t)M * D;
    const bool fuse = FUSE_TAIL && F.G >= 256;
    ck::hg_scan_phase(F, ws + WS_P1 + HG_IMG_OFF, (const bf16*)(ws + WS_P0) + (size_t)2 * M * D, OF, GB, F.in(I_HGG) + (l / 3) * HG_D, (bf16*)(ws + WS_YB), (float*)(ws + WS_SC), fuse ? (unsigned*)(ws + WS_CTL + CTL_HCNT) + l * 64 : nullptr); phase_end(ldsb, bar_); }
PHASE_FN ph_hg_norm(unsigned ldsb, int idx_, int bar_) { const Frame F = make_frame(ldsb); unsigned char* ws = F.ws(); const int idx = uni(idx_); if (FUSE_TAIL && F.G >= 256) return;
    bf16* GB = (bf16*)(ws + WS_P0) + (size_t)3 * M * D; const bf16* OF = (const bf16*)(ws + WS_P1) + (size_t)M * D;
    headnorm_rows<false>(F, OF, F.in(I_HGG) + idx * HG_D, GB, D, (bf16*)(ws + WS_YB)); phase_end(ldsb, bar_); }
static_assert(HG_IMG_OFF + (size_t)BATCH * 8 * (SEQ / 64) * ck::ML_IMG_BYTES <= 192 * MiB, "ml images");
PHASE_FN_G ph_ml_prep(unsigned ldsb, int bar_) { const Frame F = make_frame(ldsb); unsigned char* ws = F.ws();
    ck::ml_prep_phase(F, (const bf16*)(ws + WS_P0), (const float*)(ws + WS_MISC) + MISC_GATES / 4, F.in(I_MLBIF), ws + WS_P1 + HG_IMG_OFF); phase_end(ldsb, bar_); }
PHASE_FN_G ph_ml_recur(unsigned ldsb, int l_, int bar_) { const Frame F = make_frame(ldsb); unsigned char* ws = F.ws(); const int l = uni(l_); const bool fuse = FUSE_TAIL && F.G >= 256;
    ck::ml_scan_phase(F, ws + WS_P1 + HG_IMG_OFF, (bf16*)(ws + WS_P1), (const bf16*)(ws + WS_P0), F.in(I_MLG), (bf16*)(ws + WS_YB), (float*)(ws + WS_SC), fuse ? (unsigned*)(ws + WS_CTL + CTL_HCNT) + l * 64 : nullptr); phase_end(ldsb, bar_); }
PHASE_FN ph_ml_gates(unsigned ldsb, int bar_) { const Frame F = make_frame(ldsb); unsigned char* ws = F.ws(); const float* misc = (const float*)(ws + WS_MISC);
    ml_gates_rows(F, (const bf16*)(ws + WS_HB), misc + MISC_SSQ / 4, (const bf16*)(misc + MISC_MLWG / 4), (float*)(ws + WS_MISC) + MISC_GATES / 4); phase_end(ldsb, bar_); }
PHASE_FN ph_ml_norm(unsigned ldsb, int bar_) { const Frame F = make_frame(ldsb); unsigned char* ws = F.ws(); if (FUSE_TAIL && F.G >= 256) return;
    headnorm_rows<true>(F, (const bf16*)(ws + WS_P1), F.in(I_MLG), (const bf16*)(ws + WS_P0) + 4096, ML_PROJ, (bf16*)(ws + WS_YB)); phase_end(ldsb, bar_); }
PHASE_FN ph_lru_conv(unsigned ldsb, int bar_) { const Frame F = make_frame(ldsb); unsigned char* ws = F.ws();
    lru_conv(F, (const bf16*)(ws + WS_P1), F.in(I_CONVW), F.in(I_CONVB), (bf16*)(ws + WS_P0) + (size_t)M * D); phase_end(ldsb, bar_); }
PHASE_FN ph_lru_scan(unsigned ldsb, int bar_) { const Frame F = make_frame(ldsb); unsigned char* ws = F.ws();
    lru_scan(F, (const bf16*)(ws + WS_P1) + (size_t)4 * M * D, (const bf16*)(ws + WS_P1) + (size_t)2 * M * D, (const bf16*)(ws + WS_P0), (bf16*)(ws + WS_YB)); phase_end(ldsb, bar_); }
PHASE_FN ph_softmax(unsigned ldsb, int bar_) { const Frame F = make_frame(ldsb); unsigned char* ws = F.ws(); softmax_rows(F, (const float*)(ws + WS_SC), (bf16*)(ws + WS_PB)); phase_end(ldsb, bar_); }

PHASE_FN_G ph_gemm_kv(unsigned ldsb, int bar_) {
    const Frame F = make_frame(ldsb); unsigned char* ws = F.ws(); const int half = F.G >> 1;
    if (F.bid < half) { pg8::PlainSched<D, D, MMEM, 4 * D> S; S.gsub = half; S.coff = 0; S.init(F.lds, ws + WS_MEMN, ws + WS_WK);
        auto E = [=]() { const Frame F2 = make_frame(ldsb); unsigned char* ws = F2.ws(); return pg8::EpiBf16P{(bf16*)(ws + WS_KALL), 4 * D, 0, 0, 1.f, nullptr}; };
        pg8::gemm_phase(F.lds, F.tid, D, D, D, S, E); }
    else { pg8::PlainSched<D, D, MMEM, 4 * D> S; S.gsub = F.G - half; S.coff = half; S.init(F.lds, ws + WS_MEMN, ws + WS_WV);
        auto E = [=]() { const Frame F2 = make_frame(ldsb); unsigned char* ws = F2.ws(); return pg8::EpiBf16P{(bf16*)(ws + WS_VT), 4 * D, 0, 0, 1.f, nullptr}; };
        pg8::gemm_phase(F.lds, F.tid, D, D, D, S, E); }
    phase_end(ldsb, bar_);
}
PHASE_FN_G ph_gemm_mlin(unsigned ldsb, int bar_) {
    const Frame F = make_frame(ldsb); unsigned char* ws = F.ws();
    pg8::PlainSched<D, D, M, ML_PROJ> S; S.init(F.lds, ws + WS_HB, ws + WS_MLIN); auto E = [=]() { const Frame F2 = make_frame(ldsb); unsigned char* ws = F2.ws(); (void)ws; return pg8::EpiBf16P{(bf16*)(ws + WS_P0), ML_PROJ, 0, 0, 1.f, (const float*)(ws + WS_MISC) + MISC_SSQ / 4}; };
    pg8::gemm_phase(F.lds, F.tid, D, D, D, S, E); phase_end(ldsb, bar_);
}
PHASE_FN_G ph_gemm_qproj(unsigned ldsb, int l_, int bar_) {
    const Frame F = make_frame(ldsb); const int l = uni(l_); unsigned char* ws = F.ws();
    pg8::PlainSched<D, D, M, D> S; S.init(F.lds, ws + WS_HB, ws + WS_WQ + (size_t)l * SZ_WDD); auto E = [=]() { const Frame F2 = make_frame(ldsb); unsigned char* ws = F2.ws(); (void)ws; return pg8::EpiBf16P{(bf16*)(ws + WS_QB2), D, 0, 0, 1.f, (const float*)(ws + WS_MISC) + MISC_SSQ / 4}; };
    pg8::gemm_phase(F.lds, F.tid, D, D, D, S, E); phase_end(ldsb, bar_);
}
PHASE_FN_G ph_gemm_dn(unsigned ldsb, int l_, int f_, int bar_) {
    const Frame F = make_frame(ldsb); const int l = uni(l_), f = uni(f_) & 1; const float dsc = uni(f_) >= 2 ? 0.0f : 0.5f; unsigned char* ws = F.ws();
    pg8::PlainSched<DFF, DFF, M, D> S; S.init(F.lds, ws + WS_ACT, ws + WS_WDN + (size_t)(l * 2 + f) * SZ_WDN); auto E = [=]() { const Frame F2 = make_frame(ldsb); unsigned char* ws = F2.ws(); (void)ws; float* X = (float*)(ws + WS_X); const float* xin = (l == 0 && f == 0) ? F2.in(I_X) : X; return pg8::EpiResid{xin, X, (bf16*)(ws + WS_HB), (float*)(ws + WS_MISC) + MISC_SSQ / 4, dsc, F2.lds, F2.tid}; };
    pg8::gemm_phase(F.lds, F.tid, DFF, DFF, DFF, S, E); phase_end(ldsb, bar_);
}
enum { GR_MIXOUT = 0, GR_OPROJ, GR_PROBE0 };
PHASE_FN_G ph_gemm_resid(unsigned ldsb, int which_, int l_, int bar_) {
    const Frame F = make_frame(ldsb); const int which = uni(which_), l = uni(l_); unsigned char* ws = F.ws();
    const int kind = l % 3, idx = l / 3;
    const size_t wo = which == GR_OPROJ ? WS_WO + (size_t)l * SZ_WDD : (kind == 0 ? WS_HGOUT + (size_t)idx * SZ_WDD : (kind == 1 ? WS_LRUOUT : WS_MLOUT));
    const size_t ao = which == GR_OPROJ ? WS_OB : WS_YB; const float rs_ = which == GR_PROBE0 ? 0.0f : 1.0f;
    pg8::PlainSched<D, D, M, D> S; S.init(F.lds, ws + ao, ws + wo); auto E = [=]() { const Frame F2 = make_frame(ldsb); unsigned char* ws = F2.ws(); (void)ws; float* X = (float*)(ws + WS_X); return pg8::EpiResid{X, X, (bf16*)(ws + WS_HB), (float*)(ws + WS_MISC) + MISC_SSQ / 4, rs_, F2.lds, F2.tid}; };
    pg8::gemm_phase(F.lds, F.tid, D, D, D, S, E); phase_end(ldsb, bar_);
}
PHASE_FN_G ph_gemm_gu(unsigned ldsb, int l_, int f_, int bar_) {
    const Frame F = make_frame(ldsb); const int l = uni(l_), f = uni(f_); unsigned char* ws = F.ws();
    pg8::PlainSched<D, D, M, NGU> S; S.init(F.lds, ws + WS_HB, ws + WS_WGU + (size_t)(l * 2 + f) * SZ_WGU); auto E = [=]() { const Frame F2 = make_frame(ldsb); unsigned char* ws = F2.ws(); (void)ws; return pg8::EpiSwiGLU{(bf16*)(ws + WS_ACT), (const float*)(ws + WS_MISC) + MISC_SSQ / 4}; };
    pg8::gemm_phase(F.lds, F.tid, D, D, D, S, E);
    { constexpr int NU = (M / 256) * (NGU / 256); const int rounds = (NU + F.G - 1) / F.G, busy = NU - (rounds - 1) * F.G;
        const int nl = f ? l + 1 : l, np = f ? 0 : 1;
        if (nl < DEPTH && F.bid >= busy && busy < F.G) { Frame Fc = F; Fc.gw = (F.bid - busy) * NWAVES + F.wave; Fc.NGW = (F.G - busy) * NWAVES; int rot = 0; convert_set(Fc, rot, nl, np); } }
    phase_end(ldsb, bar_);
}
PHASE_FN_G ph_gemm_hgin(unsigned ldsb, int l_, int bar_) {
    const Frame F = make_frame(ldsb); const int l = uni(l_), idx = l / 3; unsigned char* ws = F.ws();
    pg8::PlainSched<D, D, M, 4 * D> S; S.init(F.lds, ws + WS_HB, ws + WS_HGIN + (size_t)idx * 4 * SZ_WDD);
    auto E = [=]() { const Frame F2 = make_frame(ldsb); unsigned char* ws = F2.ws(); (void)ws; return pg8::EpiHgIn{(bf16*)(ws + WS_P0), (bf16*)(ws + WS_P1), (const float*)(ws + WS_MISC) + MISC_LB / 4 + l * 2048, (const float*)(ws + WS_MISC) + MISC_SSQ / 4}; };
    pg8::gemm_phase(F.lds, F.tid, D, D, D, S, E); phase_end(ldsb, bar_);
}
PHASE_FN_G ph_gemm_lruin(unsigned ldsb, int bar_) {
    const Frame F = make_frame(ldsb); unsigned char* ws = F.ws();
    pg8::PlainSched<D, D, M, 2 * D> S; S.init(F.lds, ws + WS_HB, ws + WS_LRUIN); auto E = [=]() { const Frame F2 = make_frame(ldsb); unsigned char* ws = F2.ws(); (void)ws; return pg8::EpiLruIn{(bf16*)(ws + WS_P0), (bf16*)(ws + WS_P1), (const float*)(ws + WS_MISC) + MISC_SSQ / 4}; };
    pg8::gemm_phase(F.lds, F.tid, D, D, D, S, E); phase_end(ldsb, bar_);
}
PHASE_FN_G ph_gemm_lrugate(unsigned ldsb, int bar_) {
    const Frame F = make_frame(ldsb); unsigned char* ws = F.ws();
    bf16* UCB = (bf16*)(ws + WS_P0) + (size_t)M * D;
    pg8::PlainSched<D, 256, M, 4096, 1, 512> S; S.init(F.lds, UCB, ws + WS_LRUG);
    auto E = [=]() { const Frame F2 = make_frame(ldsb); unsigned char* ws = F2.ws(); (void)ws; bf16* P1b = (bf16*)(ws + WS_P1); return pg8::EpiLruGate{(const bf16*)(ws + WS_P0) + (size_t)M * D, F2.in(I_LRUBA), F2.in(I_LRUBX), (const float*)(ws + WS_MISC) + MISC_C8 / 4, P1b + (size_t)4 * M * D, P1b + (size_t)2 * M * D}; };
    pg8::gemm_phase(F.lds, F.tid, D, 256, 256, S, E); phase_end(ldsb, bar_);
}
PHASE_FN_G ph_gemm_scores(unsigned ldsb, int l_, int bar_) {
    const Frame F = make_frame(ldsb); const int l = uni(l_); unsigned char* ws = F.ws();
    pg8::BatchSched S; S.init(F.lds, ws + WS_QB2, ws + WS_KALL + (size_t)l * D * 2);
    S.a_b = SEQ * D * 2; S.a_h = XA_D * 2; S.a_pm = 256 * D * 2; S.b_b = NMEM * 4 * D * 2; S.b_h = XA_D * 2; S.b_pn = 0; S.nM = SEQ / 256; S.nN = 1; S.nwg = 16 * S.nM;
    auto E = [=]() { const Frame F2 = make_frame(ldsb); unsigned char* ws = F2.ws(); (void)ws; return pg8::EpiF32Z{(float*)(ws + WS_SC), 0.044194173824159216f}; };
    pg8::gemm_phase(F.lds, F.tid, D, 4 * D, XA_D, S, E);
    phase_end(ldsb, bar_);
}
PHASE_FN_G ph_gemm_pv(unsigned ldsb, int l_, int bar_) {
    const Frame F = make_frame(ldsb); const int l = uni(l_); unsigned char* ws = F.ws();
    pg8::BatchSched S; S.init(F.lds, ws + WS_PB, ws + WS_VT + (size_t)l * D * MMEM * 2);
    S.a_b = 4 * SEQ * NMEM * 2; S.a_h = SEQ * NMEM * 2; S.a_pm = 256 * NMEM * 2; S.b_b = NMEM * 2; S.b_h = XA_D * MMEM * 2; S.b_pn = 256 * MMEM * 2; S.nM = SEQ / 256; S.nN = 2; S.nwg = 16 * S.nM * 2;
    auto E = [=]() { const Frame F2 = make_frame(ldsb); unsigned char* ws = F2.ws(); (void)ws; return pg8::EpiBf16P{(bf16*)(ws + WS_OB), D, (size_t)SEQ * D, XA_D, 1.f, nullptr}; };
    pg8::gemm_phase(F.lds, F.tid, NMEM, MMEM, NMEM, S, E);
    phase_end(ldsb, bar_);
}

PHASE_FN_G ph_attn(unsigned ldsb, int l_, int bar_) {
    const Frame F = make_frame(ldsb); const int l = uni(l_); unsigned char* ws = F.ws();
    for (int u = F.bid; u < 256; u += F.G) {
        const int z = u >> 4, pm = (u >> 1) & 7, pn = u & 1, b = z >> 2, h = z & 3;
        bf16* Pc = (bf16*)(ws + (pn ? WS_SC : WS_PB)) + ((size_t)z * SEQ + pm * 256) * NMEM;
        { pg8::OneSched S; S.A = (const char*)((const bf16*)(ws + WS_QB2) + ((size_t)b * SEQ + pm * 256) * D + h * XA_D); S.B = (const char*)((const bf16*)(ws + WS_KALL) + (size_t)b * NMEM * 4 * D + (size_t)l * D + h * XA_D); S.u0 = pg8::Unit{pm, 0, z};
          auto E = [=]() { const Frame F2 = make_frame(ldsb); return pg8::EpiSoftmax{Pc, 0.044194173824159216f, F2.lds}; };
          pg8::gemm_phase(F.lds, F.tid, D, 4 * D, XA_D, S, E); }
        if (F.tid == 0) __builtin_amdgcn_fence(__ATOMIC_ACQUIRE, "agent");
        asm volatile("s_waitcnt vmcnt(0)" ::: "memory"); __syncthreads();
        { pg8::OneSched S; S.A = (const char*)Pc; S.B = (const char*)((const bf16*)(ws + WS_VT) + ((size_t)l * D + h * XA_D + pn * 256) * MMEM + b * NMEM); S.u0 = pg8::Unit{pm, pn, z};
          auto E = [=]() { const Frame F2 = make_frame(ldsb); unsigned char* ws2 = F2.ws(); return pg8::EpiBf16P{(bf16*)(ws2 + WS_OB), D, (size_t)SEQ * D, XA_D, 1.f, nullptr}; };
          pg8::gemm_phase(F.lds, F.tid, NMEM, MMEM, NMEM, S, E); }
    }
    phase_end(ldsb, bar_);
}

__device__ __forceinline__ void gtut_units(const Frame& F, const unsigned ldsb, int la, int lb, int gsub, int coff, int coff_ut) {
    unsigned char* ws = F.ws(); const int c = (F.bid >= coff && F.bid < coff + gsub) ? F.bid - coff : -1, cu = (F.bid >= coff_ut && F.bid < coff_ut + gsub) ? F.bid - coff_ut : -1;
    { pg8::GtSched S{(const char*)(ws + WS_KALL), (const char*)(ws + WS_WQ), gsub, c, la * 128, lb * 128};
      auto E = [=]() { const Frame F2 = make_frame(ldsb); unsigned char* ws2 = F2.ws(); return pg8::EpiBf16P{(bf16*)(ws2 + WS_GT), D, (size_t)4 * NMEM * D, (size_t)NMEM * D, 1.f, nullptr}; };
      pg8::gemm_phase(F.lds, F.tid, 4 * D, D, XA_D, S, E); }
    { pg8::UtSched S{(const char*)(ws + WS_WO), (const char*)(ws + WS_VT), gsub, cu, la * 128, lb * 128};
      auto E = [=]() { const Frame F2 = make_frame(ldsb); unsigned char* ws2 = F2.ws(); return pg8::EpiBf16P{(bf16*)(ws2 + WS_UT), 4 * NMEM, (size_t)D * 4 * NMEM, (size_t)NMEM, 1.f, nullptr}; };
      pg8::gemm_phase(F.lds, F.tid, D, 4 * D, XA_D, S, E); }
}
PHASE_FN_G ph_gemm_gtut(unsigned ldsb, int bar_) {
    const Frame F = make_frame(ldsb); if (F.G >= 256) gtut_units(F, ldsb, 0, 1, 128, 0, 128); else gtut_units(F, ldsb, 0, 1, F.G, 0, 0);
    phase_end(ldsb, bar_);
}
PHASE_FN_G ph_attn_scores(unsigned ldsb, int l_, int bar_) {
    const Frame F = make_frame(ldsb); const int l = uni(l_); unsigned char* ws = F.ws();
    pg8::ScSched S{(const char*)(ws + WS_HB), (const char*)(ws + WS_GT) + (size_t)l * 16 * NMEM * D * 2, F.G, F.bid};
    auto E = [=]() { const Frame F2 = make_frame(ldsb); unsigned char* ws2 = F2.ws(); return pg8::EpiSoftmax{(bf16*)(ws2 + WS_PB), 0.044194173824159216f, F2.lds, (const float*)(ws2 + WS_MISC) + MISC_SSQ / 4}; };
    pg8::gemm_phase(F.lds, F.tid, D, D, D, S, E);
    if (l + 1 < DEPTH) gtut_units(F, ldsb, l + 1, l + 2, F.G > 128 ? F.G - 128 : F.G, F.G > 128 ? 128 : 0, F.G > 128 ? 128 : 0);
    phase_end(ldsb, bar_);
}
PHASE_FN_G ph_gemm_attnout(unsigned ldsb, int l_, int bar_) {
    const Frame F = make_frame(ldsb); const int l = uni(l_); unsigned char* ws = F.ws();
    pg8::PlainSched<4 * NMEM, 4 * NMEM, M, D, 30, 0, 3, (unsigned)(D * 4 * NMEM * 2)> S; S.init(F.lds, ws + WS_PB, ws + WS_UT + (size_t)l * 4 * D * 4 * NMEM * 2);
    auto E = [=]() { const Frame F2 = make_frame(ldsb); unsigned char* ws2 = F2.ws(); float* X = (float*)(ws2 + WS_X); return pg8::EpiResid{X, X, (bf16*)(ws2 + WS_HB), (float*)(ws2 + WS_MISC) + MISC_SSQ / 4, 1.0f, F2.lds, F2.tid}; };
    pg8::gemm_phase(F.lds, F.tid, 4 * NMEM, 4 * NMEM, 4 * NMEM, S, E);
    phase_end(ldsb, bar_);
}

constexpr int SLOTS = 20, PH_LAYER0 = 3, PH_FINAL = PH_LAYER0 + DEPTH * SLOTS, N_PHASES = PH_FINAL + 1;
enum { SL_NORM0 = 0, SL_GU1, SL_DN1, SL_NORM1, SL_MIXIN, SL_MIXA, SL_MIXB, SL_MIXC, SL_MIXD, SL_MIXOUT, SL_NORM2, SL_QPROJ, SL_SCORES, SL_SOFTMAX, SL_PV, SL_OPROJ, SL_NORM3, SL_GU2, SL_DN2, SL_SPARE };
__host__ __device__ constexpr bool phase_used(int ph) {
    if (ph < PH_LAYER0 || ph == PH_FINAL) return true;
    const int l = (ph - PH_LAYER0) / SLOTS, s = (ph - PH_LAYER0) % SLOTS, kind = l % 3;
    if (s == SL_SPARE || s == SL_QPROJ || s == SL_SOFTMAX || s == SL_PV || s == SL_NORM0 || s == SL_NORM1 || s == SL_NORM2 || s == SL_NORM3) return false;
    if (s == SL_MIXC) return true;
    if (s == SL_MIXD) return kind == 2;
    return true;
}
__device__ __forceinline__ int ctl_lo(unsigned ldsb) { return __builtin_amdgcn_readfirstlane(*(volatile LAS int*)((LAS unsigned char*)(size_t)ldsb + CTRL + 56)); }
__device__ __forceinline__ int ctl_hi(unsigned ldsb) { return __builtin_amdgcn_readfirstlane(*(volatile LAS int*)((LAS unsigned char*)(size_t)ldsb + CTRL + 60)); }
#ifndef PROBE_SEL
#define PROBE_SEL -1
#endif
#if PROBE_SEL >= 0
#ifndef PROBE_AMP
#define PROBE_AMP 4
#endif
__host__ __device__ constexpr int probe_cls(int k) { if (k < PH_LAYER0) return PROBE_SEL >= 20 ? 20 + k : 0; if (k >= PH_FINAL) return 8; const int s = (k - PH_LAYER0) % SLOTS;
    { const int l = (k - PH_LAYER0) / SLOTS, kind = l % 3;
      if (PROBE_SEL >= 10) { if (kind == 0 && s == SL_MIXA) return 10; if (kind == 0 && s == SL_MIXB) return 16; if (kind == 1 && s == SL_MIXA) return 11; if (kind == 1 && s == SL_MIXB) return 12; if (kind == 1 && s == SL_MIXC) return 13;
          if (kind == 2 && s == SL_MIXA) return 14; if (kind == 2 && s == SL_MIXB) return 15; if (kind == 2 && s == SL_MIXC) return 17; if (kind == 2 && s == SL_MIXD) return 18; if (kind == 0 && s == SL_MIXC) return 19; return 99; } }
    return (s == SL_GU1 || s == SL_GU2) ? 1 : (s == SL_DN1 || s == SL_DN2) ? 2 : s == SL_MIXIN ? 3 : (s == SL_MIXA || s == SL_MIXB || s == SL_MIXC || s == SL_MIXD) ? 4 : s == SL_MIXOUT ? 5 : s == SL_SCORES ? 6 : 7; }
__device__ __forceinline__ void probe_t0(unsigned ldsb) { const Frame F = make_frame(ldsb); if (F.tid == 0) *(volatile LAS unsigned long long*)(F.lds + CTRL + 320) = __builtin_amdgcn_s_memrealtime(); }
__device__ __forceinline__ void probe_t1(unsigned ldsb, int cls) { const Frame F = make_frame(ldsb); if (F.tid == 0 && cls == PROBE_SEL) { const unsigned long long t1 = __builtin_amdgcn_s_memrealtime(), t0 = *(volatile LAS unsigned long long*)(F.lds + CTRL + 320);
        *(volatile LAS unsigned*)(F.lds + CTRL + 328) = *(volatile LAS unsigned*)(F.lds + CTRL + 328) + (unsigned)(t1 - t0); } }
#define RUN(k, fn, ...) do { const int hi_ = ctl_hi(ldsb); if (ctl_lo(ldsb) <= (k) && (k) < hi_) { probe_t0(ldsb); fn(ldsb, ##__VA_ARGS__, ((k) + 1 < hi_) ? 1 : 0); probe_t1(ldsb, probe_cls(k)); } } while (0)
#else
#define RUN(k, fn, ...) do { const int hi_ = ctl_hi(ldsb); if (ctl_lo(ldsb) <= (k) && (k) < hi_) fn(ldsb, ##__VA_ARGS__, ((k) + 1 < hi_) ? 1 : 0); } while (0)
#endif

template <int L> __device__ __forceinline__ void run_layer(const unsigned ldsb) {
    constexpr int pb = PH_LAYER0 + L * SLOTS, kind = L % 3;
    RUN(pb + SL_GU1, ph_gemm_gu, L, 0);
    RUN(pb + SL_DN1, ph_gemm_dn, L, 0);
    if constexpr (kind == 0) {
        RUN(pb + SL_MIXIN, ph_gemm_hgin, L);
        RUN(pb + SL_MIXA, ph_hg_prep);
        RUN(pb + SL_MIXB, ph_hg_recur, L);
        RUN(pb + SL_MIXC, ph_hg_norm, L / 3);
    } else if constexpr (kind == 1) {
        RUN(pb + SL_MIXIN, ph_gemm_lruin);
        RUN(pb + SL_MIXA, ph_lru_conv);
        RUN(pb + SL_MIXB, ph_gemm_lrugate);
        RUN(pb + SL_MIXC, ph_lru_scan);
    } else {
        RUN(pb + SL_MIXIN, ph_gemm_mlin);
        RUN(pb + SL_MIXA, ph_ml_gates);
        RUN(pb + SL_MIXB, ph_ml_prep);
        RUN(pb + SL_MIXC, ph_ml_recur, L);
        RUN(pb + SL_MIXD, ph_ml_norm);
    }
    RUN(pb + SL_MIXOUT, ph_gemm_resid, GR_MIXOUT, L);
    RUN(pb + SL_SCORES, ph_attn_scores, L);
    RUN(pb + SL_OPROJ, ph_gemm_attnout, L);
    RUN(pb + SL_GU2, ph_gemm_gu, L, 1);
    RUN(pb + SL_DN2, ph_gemm_dn, L, 1);
}

__global__ void __launch_bounds__(NT, 2) fwd_kernel(Args args) {
    extern __shared__ __attribute__((aligned(16))) unsigned char lds_raw[];
    LAS unsigned char* lds = (LAS unsigned char*)lds_raw;
    const unsigned ldsb = (unsigned)(size_t)lds;
    {
        const int tid = threadIdx.x, lane = tid & 63, wave = tid >> 6;
        LAS unsigned* cw = (LAS unsigned*)(lds + CTRL);
        if (tid < 4) cw[tid] = 0u;
        if (tid == 0) cw[82] = 0u;
        if (lane == 0) cw[4 + wave] = hw_wave_key();
        if (tid == 0) { cw[12] = blockIdx.x; cw[13] = gridDim.x; cw[14] = (unsigned)args.ph_lo; cw[15] = (unsigned)args.ph_hi;
            LAS unsigned long long* ap = (LAS unsigned long long*)(lds + CTRL + 64);
#pragma unroll
            for (int i = 0; i < 27; ++i) ap[i] = (unsigned long long)args.in[i];
            ap[27] = (unsigned long long)args.out; ap[28] = (unsigned long long)args.ws; }
        __syncthreads();
        if (args.ph_hi - args.ph_lo > 1 && tid == 0) (void)xb_add(&((unsigned*)(args.ws + WS_CTL))[XB_XCNT(xb_xcc_id())], 1u);
    }
    RUN(0, ph_prologue);
    RUN(1, ph_gemm_kv);
    RUN(2, ph_gemm_gtut);
    run_layer<0>(ldsb); run_layer<1>(ldsb); run_layer<2>(ldsb); run_layer<3>(ldsb);
    { if (ctl_lo(ldsb) <= PH_FINAL && PH_FINAL < ctl_hi(ldsb)) ph_final(ldsb); }
#if PROBE_SEL >= 0
    { const Frame F = make_frame(ldsb); if (F.bid == 0) { __syncthreads(); const unsigned acc = *(volatile LAS unsigned*)(F.lds + CTRL + 328);
        const unsigned long long tend = __builtin_amdgcn_s_memrealtime() + (unsigned long long)acc * PROBE_AMP; while (__builtin_amdgcn_s_memrealtime() < tend) __builtin_amdgcn_s_sleep(8); } }
#endif
}

extern "C" void kernel_launch(void* const* d_in, const int* in_sizes, int n_in, void* d_out, int out_size, void* d_ws, size_t ws_size, hipStream_t stream) {
    static int grid = 0;
    if (grid == 0) {
        if (n_in != 27 || in_sizes[0] != M * D || out_size != M * D || ws_size < WS_END) { fprintf(stderr, "kernel_launch: unexpected shapes (n_in %d, in0 %d, out %d, ws %zu < %zu)\n", n_in, n_in > 0 ? in_sizes[0] : -1, out_size, ws_size, (size_t)WS_END); grid = -1; return; }
        int dev = 0, cus = 0, per_cu = 0;
        if (hipGetDevice(&dev) != hipSuccess || hipDeviceGetAttribute(&cus, hipDeviceAttributeMultiprocessorCount, dev) != hipSuccess) { grid = -1; return; }
        if (hipFuncSetAttribute((const void*)fwd_kernel, hipFuncAttributeMaxDynamicSharedMemorySize, LDS_BYTES) != hipSuccess) { fprintf(stderr, "kernel_launch: hipFuncSetAttribute failed\n"); grid = -1; return; }
        if (hipOccupancyMaxActiveBlocksPerMultiprocessor(&per_cu, (const void*)fwd_kernel, NT, LDS_BYTES) != hipSuccess || per_cu < 1) fprintf(stderr, "kernel_launch: occupancy query reports %d\n", per_cu);
        (void)hipGetLastError();
        grid = cus;
    }
    if (grid < 0) return;
    if (hipMemsetAsync((char*)d_ws + WS_CTL, 0, CTL_BYTES, stream) != hipSuccess) { fprintf(stderr, "kernel_launch: memset failed\n"); return; }
    Args a{};
    for (int i = 0; i < 27; ++i) a.in[i] = (const float*)d_in[i];
    a.out = (float*)d_out; a.ws = (unsigned char*)d_ws;
#if MK_ONE_LAUNCH
    a.ph_lo = 0; a.ph_hi = N_PHASES;
    hipLaunchKernelGGL(fwd_kernel, dim3(grid), dim3(NT), LDS_BYTES, stream, a);
#else
    for (int ph = 0; ph < N_PHASES; ++ph) { if (!phase_used(ph)) continue; a.ph_lo = ph; a.ph_hi = ph + 1;
        hipLaunchKernelGGL(fwd_kernel, dim3(grid), dim3(NT), LDS_BYTES, stream, a);
        const hipError_t le = hipPeekAtLastError(); if (le != hipSuccess) { fprintf(stderr, "kernel_launch: launch of phase %d failed: %s\n", ph, hipGetErrorName(le)); break; } }
#endif
}
```
